# Optimizing an MI355X kernel written in HIP

```python
import math
import jax, jax.numpy as jnp
from jax import lax
import numpy as np

D_MODEL = 1024
BATCH = 8
SEQ = 2048
DEPTH = 2

F32 = jnp.float32
EPS = 1e-6
NEG_INF = -1e30

N_BRANCH = 4
BRANCH_W = D_MODEL // 2
HEAD_DIM = 64
Q_BLOCK = 128
DA_HEADS = BRANCH_W // (2 * HEAD_DIM)
CONV_W = 3
POOL_WINDOWS = (2, 4, 8, 16)
N_POOL = len(POOL_WINDOWS)
POOL_GROUP = BRANCH_W // N_POOL
SW_WINDOW = 128
SW_Q_HEADS = BRANCH_W // HEAD_DIM
SW_KV_HEADS = 2
SW_REP = SW_Q_HEADS // SW_KV_HEADS
PEER_HEADS = 8
PEER_NKEYS = 128
PEER_EXPERTS = PEER_NKEYS * PEER_NKEYS
PEER_DKEY = 256
PEER_TOPK = 16
PEER_CHUNK = 128

COL_SIZES = (
    DA_HEADS * 2 * HEAD_DIM, DA_HEADS * 2 * HEAD_DIM, DA_HEADS * 2 * HEAD_DIM,
    BRANCH_W, BRANCH_W, BRANCH_W,
    BRANCH_W,
    SW_Q_HEADS * HEAD_DIM, SW_KV_HEADS * HEAD_DIM, SW_KV_HEADS * HEAD_DIM,
    N_BRANCH * D_MODEL,
)
IN_COLS = sum(COL_SIZES)
SPLIT_POINTS = tuple(int(v) for v in np.cumsum(COL_SIZES)[:-1])

kernel_name = 'hybrid_gated_parallel_mixers_peer'


def rmsnorm(x, g):
    xf = x.astype(F32)
    y = xf * lax.rsqrt(jnp.mean(xf * xf, axis=-1, keepdims=True) + EPS)
    return (y * g.astype(F32)).astype(x.dtype)


def diff_attention(q, k, v, lam_q1, lam_k1, lam_q2, lam_k2, g_subln, lam_init):
    Bn, S = q.shape[0], q.shape[1]
    lam = (jnp.exp(jnp.sum(lam_q1.astype(F32) * lam_k1.astype(F32)))
           - jnp.exp(jnp.sum(lam_q2.astype(F32) * lam_k2.astype(F32))) + lam_init)
    scale = HEAD_DIM ** -0.5
    outs = []
    for i in range(S // Q_BLOCK):
        q0 = i * Q_BLOCK
        kend = q0 + Q_BLOCK
        s = jnp.einsum('bqhcd,bkhcd->bhcqk', q[:, q0:kend], k[:, :kend]).astype(F32) * scale
        causal = jnp.arange(kend)[None, :] <= (q0 + jnp.arange(Q_BLOCK))[:, None]
        p = jax.nn.softmax(jnp.where(causal, s, NEG_INF), axis=-1)
        attn = p[:, :, 0] - lam * p[:, :, 1]
        outs.append(jnp.einsum('bhqk,bkhe->bqhe', attn.astype(v.dtype), v[:, :kend]))
    o = jnp.concatenate(outs, axis=1)
    o = rmsnorm(o, g_subln) * (1.0 - lam_init)
    return o.reshape(Bn, S, DA_HEADS * 2 * HEAD_DIM)


def short_conv_mixer(gate_b, gate_c, xt, conv_w):
    S = xt.shape[1]
    z = gate_c * xt
    zp = jnp.pad(z, ((0, 0), (CONV_W - 1, 0), (0, 0)))
    y = sum(conv_w[j] * zp[:, j:j + S] for j in range(CONV_W))
    return gate_b * y


def multiscale_pool(z, w_pool, pool_scale):
    Bn, S, _ = z.shape
    zg = z.astype(F32).reshape(Bn, S, N_POOL, POOL_GROUP)
    cs = jnp.cumsum(zg, axis=1)
    pos1 = jnp.arange(1, S + 1)
    means = []
    for gi, w in enumerate(POOL_WINDOWS):
        cp = jnp.pad(cs[:, :, gi], ((0, 0), (w, 0), (0, 0)))
        win_sum = cp[:, w:] - cp[:, :S]
        count = jnp.minimum(pos1, w).astype(F32)
        means.append(win_sum / count[None, :, None])
    d = jnp.stack(means, axis=2) - zg
    y = jnp.einsum('bsgc,gce->bsge', d, w_pool.astype(F32))
    return (y.reshape(Bn, S, BRANCH_W) * pool_scale.astype(F32)).astype(z.dtype)


def sliding_window_sink_attention(q, k, v, sinks):
    Bn, S = q.shape[0], q.shape[1]
    nb = S // Q_BLOCK
    qb = q.reshape(Bn, nb, Q_BLOCK, SW_KV_HEADS, SW_REP, HEAD_DIM)

    def with_prev(t):
        t = t.reshape(Bn, nb, Q_BLOCK, SW_KV_HEADS, HEAD_DIM)
        prev = jnp.pad(t, ((0, 0), (1, 0), (0, 0), (0, 0), (0, 0)))[:, :nb]
        return jnp.concatenate([prev, t], axis=2)

    kk, vv = with_prev(k), with_prev(v)
    s = jnp.einsum('bnqgrd,bnkgd->bngrqk', qb, kk).astype(F32) * (HEAD_DIM ** -0.5)
    qi = jnp.arange(Q_BLOCK)[:, None]
    kj = jnp.arange(2 * Q_BLOCK)[None, :]
    rel = qi + Q_BLOCK - kj
    band = (rel >= 0) & (rel < SW_WINDOW)
    valid = band[None] & ((jnp.arange(nb)[:, None, None] > 0) | (kj >= Q_BLOCK)[None])
    s = jnp.where(valid[None, :, None, None], s, NEG_INF)
    sink = sinks.astype(F32).reshape(SW_KV_HEADS, SW_REP)[None, None, :, :, None, None]
    sink = jnp.broadcast_to(sink, s.shape[:-1] + (1,))
    p = jax.nn.softmax(jnp.concatenate([s, sink], axis=-1), axis=-1)[..., :-1]
    o = jnp.einsum('bngrqk,bnkgd->bnqgrd', p.astype(v.dtype), vv)
    return o.reshape(Bn, S, SW_Q_HEADS * HEAD_DIM)


def peer_ffn(h, w_q, sub_keys, u_experts, v_experts):
    Bn, S, D = h.shape
    T = Bn * S
    ht = h.reshape(T, D)
    q = (ht @ w_q).reshape(T, PEER_HEADS, 2, PEER_DKEY // 2)
    s = jnp.einsum('thpd,pnd->thpn', q, sub_keys).astype(F32)
    top_s, top_i = lax.top_k(s, PEER_TOPK)
    cand_s = (top_s[:, :, 0, :, None] + top_s[:, :, 1, None, :]).reshape(T, PEER_HEADS, -1)
    cand_i = (top_i[:, :, 0, :, None] * PEER_NKEYS + top_i[:, :, 1, None, :]).reshape(T, PEER_HEADS, -1)
    best_s, best_pos = lax.top_k(cand_s, PEER_TOPK)
    idx = jnp.take_along_axis(cand_i, best_pos, axis=-1)
    g = jax.nn.softmax(best_s, axis=-1)
    nchunk = T // PEER_CHUNK

    def expert_chunk(args):
        xc, ic, gc = args
        act = jax.nn.gelu(jnp.einsum('cd,chkd->chk', xc, u_experts[ic]).astype(F32), approximate=False)
        wgt = (gc * act).astype(xc.dtype)
        return jnp.einsum('chk,chkd->cd', wgt, v_experts[ic])

    out = lax.map(expert_chunk, (ht.reshape(nchunk, PEER_CHUNK, D),
                                 idx.reshape(nchunk, PEER_CHUNK, PEER_HEADS, PEER_TOPK),
                                 g.reshape(nchunk, PEER_CHUNK, PEER_HEADS, PEER_TOPK)))
    return out.reshape(Bn, S, D)


def hybrid_layer(x, mod, g_norm1, w_in, lam_q1, lam_k1, lam_q2, lam_k2, g_subln, conv_w,
                 w_pool, pool_scale, sinks, w_branch, w_o, g_norm2, w_q, sub_keys,
                 u_experts, v_experts, lam_init):
    Bn, S, _ = x.shape
    shift1, scale1, gate1, shift2, scale2, gate2 = [m[:, None, :] for m in jnp.split(mod, 6, axis=-1)]
    h = rmsnorm(x, g_norm1) * (1.0 + scale1) + shift1
    aq, ak, av, bb, bc, bx, cz, dq, dk, dv, gl = jnp.split(h @ w_in, SPLIT_POINTS, axis=-1)
    ya = diff_attention(aq.reshape(Bn, S, DA_HEADS, 2, HEAD_DIM),
                        ak.reshape(Bn, S, DA_HEADS, 2, HEAD_DIM),
                        av.reshape(Bn, S, DA_HEADS, 2 * HEAD_DIM),
                        lam_q1, lam_k1, lam_q2, lam_k2, g_subln, lam_init)
    yb = short_conv_mixer(bb, bc, bx, conv_w)
    yc = multiscale_pool(cz, w_pool, pool_scale)
    yd = sliding_window_sink_attention(dq.reshape(Bn, S, SW_Q_HEADS, HEAD_DIM),
                                       dk.reshape(Bn, S, SW_KV_HEADS, HEAD_DIM),
                                       dv.reshape(Bn, S, SW_KV_HEADS, HEAD_DIM), sinks)
    branches = jnp.einsum('bsgc,gcd->bsgd', jnp.stack([ya, yb, yc, yd], axis=2), w_branch)
    gates = jax.nn.sigmoid(gl.reshape(Bn, S, N_BRANCH, D_MODEL))
    mixed = jnp.sum(gates * branches, axis=2) @ w_o
    x = x + gate1 * mixed
    h2 = rmsnorm(x, g_norm2) * (1.0 + scale2) + shift2
    return x + gate2 * peer_ffn(h2, w_q, sub_keys, u_experts, v_experts)


def setup_inputs(seed: int = 0) -> dict:
    key = jax.random.key(seed)
    ks = jax.random.split(key, 24)
    L, D = DEPTH, D_MODEL

    def nrm(k, shape, scale):
        return jax.random.normal(k, shape, F32) * scale

    return {
        'x': nrm(ks[0], (BATCH, SEQ, D), 1.0),
        'c': nrm(ks[1], (BATCH, D), 1.0),
        'w_ada': nrm(ks[2], (L, D, 6 * D), 0.5 * D ** -0.5),
        'b_ada': nrm(ks[3], (L, 6 * D), 0.01),
        'g_norm1': 1.0 + nrm(ks[4], (L, D), 0.02),
        'w_in': nrm(ks[5], (L, D, IN_COLS), D ** -0.5),
        'lam_q1': nrm(ks[6], (L, HEAD_DIM), 0.1),
        'lam_k1': nrm(ks[7], (L, HEAD_DIM), 0.1),
        'lam_q2': nrm(ks[8], (L, HEAD_DIM), 0.1),
        'lam_k2': nrm(ks[9], (L, HEAD_DIM), 0.1),
        'g_subln': 1.0 + nrm(ks[10], (L, 2 * HEAD_DIM), 0.02),
        'conv_w': nrm(ks[11], (L, CONV_W, BRANCH_W), CONV_W ** -0.5),
        'w_pool': nrm(ks[12], (L, N_POOL, POOL_GROUP, POOL_GROUP), POOL_GROUP ** -0.5),
        'pool_scale': 1.0 + nrm(ks[13], (L, BRANCH_W), 0.1),
        'sinks': nrm(ks[14], (L, SW_Q_HEADS), 1.0),
        'w_branch': nrm(ks[15], (L, N_BRANCH, BRANCH_W, D), BRANCH_W ** -0.5),
        'w_o': nrm(ks[16], (L, D, D), D ** -0.5),
        'g_norm2': 1.0 + nrm(ks[17], (L, D), 0.02),
        'w_q': nrm(ks[18], (L, D, PEER_HEADS * PEER_DKEY), D ** -0.5),
        'sub_keys': nrm(ks[19], (L, 2, PEER_NKEYS, PEER_DKEY // 2), (PEER_DKEY // 2) ** -0.5),
        'u_experts': nrm(ks[20], (L, PEER_EXPERTS, D), D ** -0.5),
        'v_experts': nrm(ks[21], (L, PEER_EXPERTS, D), 1.0),
        'g_final': 1.0 + nrm(ks[22], (D,), 0.02),
    }


def reference(x, c, w_ada, b_ada, g_norm1, w_in, lam_q1, lam_k1, lam_q2, lam_k2, g_subln,
              conv_w, w_pool, pool_scale, sinks, w_branch, w_o, g_norm2, w_q, sub_keys,
              u_experts, v_experts, g_final):
    c_act = jax.nn.silu(c)
    for l in range(DEPTH):
        mod = c_act @ w_ada[l] + b_ada[l]
        lam_init = 0.8 - 0.6 * math.exp(-0.3 * l)
        x = hybrid_layer(x, mod, g_norm1[l], w_in[l], lam_q1[l], lam_k1[l], lam_q2[l], lam_k2[l],
                         g_subln[l], conv_w[l], w_pool[l], pool_scale[l], sinks[l], w_branch[l],
                         w_o[l], g_norm2[l], w_q[l], sub_keys[l], u_experts[l], v_experts[l],
                         lam_init)
    return rmsnorm(x, g_final)
```

```cpp
#include <hip/hip_runtime.h>
#include <cstdio>
#include <cstdint>
#include <type_traits>
namespace pg8 {
#define PG8_LAS __attribute__((address_space(3)))
typedef unsigned short bf16_t;
typedef short bf16x8 __attribute__((ext_vector_type(8)));
typedef float f32x4 __attribute__((ext_vector_type(4)));
typedef unsigned u32x4 __attribute__((ext_vector_type(4)));
constexpr int BM = 256, BK = 64, HALF = 128, HTB = HALF * BK * 2  , STAGE_BYTES = 8 * HTB, NXCD = 8, WGM = 8;

__host__ __device__ __forceinline__ int lds_byte(int r, int c) { const int st = (r >> 4) * 2 + (c >> 5), rr = r & 15, cc = c & 31, ob = rr * 64 + cc * 2; return st * 1024 + (ob ^ (((ob >> 9) & 1) << 5)); }
__host__ __device__ __forceinline__ void stage_rc(int b, int& R, int& C) { const int st = b / 1024, sb = b % 1024, swz = sb ^ (((sb >> 9) & 1) << 5); R = (st >> 1) * 16 + swz / 64; C = (st & 1) * 32 + (swz % 64) / 2; }
__host__ __device__ __forceinline__ int perm32(int rho) { const int n = rho >> 4, i = rho & 15; return 8 * (i >> 2) + 4 * n + (i & 3); }

struct Unit { int pm, pn, z; };
struct Gemm { const bf16_t* A; const bf16_t* Bt; int lda, ldb, K; size_t zA, zB; };

struct StaticOrder {
    int nM, nN, nwg, G, c;
    __host__ __device__ void init(int M, int N, int G_, int c_) { nM = M / BM; nN = N / BM; nwg = nM * nN; G = G_; c = c_; }
    __host__ __device__ bool next(int i, Unit& u) const {
        const long L = (long)i * G + c; if (L >= nwg) return false;
        int wgid = (int)L; { const int q = nwg / NXCD, r = nwg % NXCD, xcd = wgid % NXCD, off = wgid / NXCD; wgid = (xcd < r ? xcd * (q + 1) : r * (q + 1) + (xcd - r) * q) + off; }
        const int nig = WGM * nN, gid = wgid / nig, fm = gid * WGM, gsz = (nM - fm) < WGM ? (nM - fm) : WGM;
        u.pm = fm + ((wgid % nig) % gsz); u.pn = (wgid % nig) / gsz; u.z = 0; return true;
    }
    __device__ __forceinline__ void a_ready(const Unit&) const {}
    __device__ __forceinline__ void done(const Unit&) const {}
};
template <int NZ> struct ZOrder {
    StaticOrder S;
    __host__ __device__ void init(int M, int N, int G_, int c_) { S.init(M, N, G_, c_); }
    __host__ __device__ bool next(int i, Unit& u) const { if (!S.next(i / NZ, u)) return false; u.z = i % NZ; return true; }
    __device__ __forceinline__ void a_ready(const Unit&) const {}
    __device__ __forceinline__ void done(const Unit&) const {}
};

__device__ __forceinline__ unsigned cvt_pk_bf16(float lo, float hi) { unsigned r; asm volatile("v_cvt_pk_bf16_f32 %0, %1, %2" : "=v"(r) : "v"(lo), "v"(hi)); return r; }
__device__ __forceinline__ float bf_lo(unsigned w) { return __builtin_bit_cast(float, w << 16); }
__device__ __forceinline__ float bf_hi(unsigned w) { return __builtin_bit_cast(float, w & 0xffff0000u); }
__device__ __forceinline__ float sigmoidf_(float x) { return __builtin_amdgcn_rcpf(1.0f + __expf(-x)); }

__device__ __forceinline__ void store_lines(bf16_t* p, size_t ldc_rows8  , int fr, u32x4 w0, u32x4 w1) {
    const bool up = fr & 8;
    u32x4 x = up ? w0 : w1, r;
    r.x = (unsigned)__builtin_amdgcn_mov_dpp((int)x.x, 0x128, 0xF, 0xF, true); r.y = (unsigned)__builtin_amdgcn_mov_dpp((int)x.y, 0x128, 0xF, 0xF, true);
    r.z = (unsigned)__builtin_amdgcn_mov_dpp((int)x.z, 0x128, 0xF, 0xF, true); r.w = (unsigned)__builtin_amdgcn_mov_dpp((int)x.w, 0x128, 0xF, 0xF, true);
    bf16_t* pa = up ? p - ldc_rows8 + 32 : p; bf16_t* pb = up ? p + 32 : p + ldc_rows8;
    *(u32x4*)pa = up ? r : w0;
    *(u32x4*)pb = up ? w1 : r;
}
struct EpiBf16 {
    static constexpr bool PERM = true, AFTER_DRAIN = false;
    static __device__ __forceinline__ bool keeps_acc(const Unit&) { return false; }
    bf16_t* O; int ldc;
    __device__ __forceinline__ void operator()(const f32x4 (&acc)[2][2][4][2], const Unit& u, int wr, int wc, int fr, int fq) const {
        const int row0 = u.pm * BM + wr * 64 + fr, col0 = u.pn * BM + wc * 64 + 8 * fq;
#pragma unroll
        for (int ai = 0; ai < 2; ++ai)
#pragma unroll
            for (int m = 0; m < 4; ++m) { bf16_t* rowp = O + (size_t)(row0 + ai * HALF + m * 16) * ldc + col0;
                u32x4 w[2];
#pragma unroll
                for (int bj = 0; bj < 2; ++bj) { const f32x4 v0 = acc[ai][bj][m][0], v1 = acc[ai][bj][m][1];
                    w[bj].x = cvt_pk_bf16(v0[0], v0[1]); w[bj].y = cvt_pk_bf16(v0[2], v0[3]); w[bj].z = cvt_pk_bf16(v1[0], v1[1]); w[bj].w = cvt_pk_bf16(v1[2], v1[3]); }
                store_lines(rowp, (size_t)8 * ldc, fr, w[0], w[1]); }
    }
};
struct EpiProj {
    static constexpr bool PERM = true, AFTER_DRAIN = false;
    static __device__ __forceinline__ bool keeps_acc(const Unit&) { return false; }
    bf16_t* proj; bf16_t* gates;
    __device__ __forceinline__ void operator()(const f32x4 (&acc)[2][2][4][2], const Unit& u, int wr, int wc, int fr, int fq) const {
        const bool isg = u.pn >= 17; bf16_t* base = isg ? gates : proj; const int ldc = isg ? 4096 : 4352;
        const int row0 = u.pm * BM + wr * 64 + fr, col0 = (isg ? u.pn - 17 : u.pn) * BM + wc * 64 + 8 * fq;
#pragma unroll
        for (int ai = 0; ai < 2; ++ai)
#pragma unroll
            for (int m = 0; m < 4; ++m) { bf16_t* rowp = base + (size_t)(row0 + ai * HALF + m * 16) * ldc + col0;
                if (isg) {
                    f32x4 E[4];
#pragma unroll
                    for (int z = 0; z < 4; ++z)
#pragma unroll
                        for (int e = 0; e < 4; ++e) E[z][e] = 1.0f + __expf(-acc[ai][z >> 1][m][z & 1][e]);
                    bf16_t* gp = gates + (size_t)(row0 + ai * HALF + m * 16) * 4096 + (u.pn - 17) * 64 + wc * 16 + 4 * fq;
#pragma unroll
                    for (int z = 0; z < 4; ++z) { f32x4 f;
#pragma unroll
                        for (int e = 0; e < 4; ++e) f[e] = (z < 3 ? E[z + 1][e] : 1.0f) * __builtin_amdgcn_rcpf(E[z][e]);
                        typedef unsigned u32x2 __attribute__((ext_vector_type(2)));
                        u32x2 w; w.x = cvt_pk_bf16(f[0], f[1]); w.y = cvt_pk_bf16(f[2], f[3]); *(u32x2*)(gp + z * 1024) = w; }
                } else {
                { u32x4 w[2];
#pragma unroll
                for (int bj = 0; bj < 2; ++bj) { const f32x4 v0 = acc[ai][bj][m][0], v1 = acc[ai][bj][m][1];
                    w[bj].x = cvt_pk_bf16(v0[0], v0[1]); w[bj].y = cvt_pk_bf16(v0[2], v0[3]); w[bj].z = cvt_pk_bf16(v1[0], v1[1]); w[bj].w = cvt_pk_bf16(v1[2], v1[3]); }
                store_lines(rowp, (size_t)8 * ldc, fr, w[0], w[1]); } } }
    }
};
struct EpiMerge {
    static constexpr bool PERM = true, AFTER_DRAIN = false;
    static __device__ __forceinline__ bool keeps_acc(const Unit&) { return false; }
    const bf16_t* gates; float* s32; bf16_t* s16;
    __device__ __forceinline__ void operator()(const f32x4 (&acc)[2][2][4][2], const Unit& u, int wr, int wc, int fr, int fq) const {
        const int row0 = u.pm * BM + wr * 64 + fr, col0 = u.pn * BM + wc * 64 + 8 * fq, z = u.z;
#pragma unroll
        for (int ai = 0; ai < 2; ++ai)
#pragma unroll
            for (int m = 0; m < 4; ++m) { const size_t row = (size_t)(row0 + ai * HALF + m * 16);
#pragma unroll
                for (int bj = 0; bj < 2; ++bj) { const int col = col0 + bj * 32;
                    const u32x4 gw = *(const u32x4*)(gates + row * 4096 + (size_t)z * 1024 + col);
                    f32x4 v0 = acc[ai][bj][m][0], v1 = acc[ai][bj][m][1];
                    v0[0] *= bf_lo(gw.x); v0[1] *= bf_hi(gw.x); v0[2] *= bf_lo(gw.y); v0[3] *= bf_hi(gw.y);
                    v1[0] *= bf_lo(gw.z); v1[1] *= bf_hi(gw.z); v1[2] *= bf_lo(gw.w); v1[3] *= bf_hi(gw.w);
                    float* sp = s32 + row * 1024 + col;
                    if (z > 0) { v0 += *(const f32x4*)sp; v1 += *(const f32x4*)(sp + 4); }
                    if (z < 3) { *(f32x4*)sp = v0; *(f32x4*)(sp + 4) = v1; }
                    else { u32x4 w; w.x = cvt_pk_bf16(v0[0], v0[1]); w.y = cvt_pk_bf16(v0[2], v0[3]); w.z = cvt_pk_bf16(v1[0], v1[1]); w.w = cvt_pk_bf16(v1[2], v1[3]);
                        *(u32x4*)(s16 + row * 1024 + col) = w; } } }
    }
};
struct EpiWo {
    static constexpr bool PERM = false, AFTER_DRAIN = false;
    static __device__ __forceinline__ bool keeps_acc(const Unit&) { return false; }
    const float* xin; float* out; const float* gate;
    __device__ __forceinline__ void operator()(const f32x4 (&acc)[2][2][4][2], const Unit& u, int wr, int wc, int fr, int fq) const {
        const int row0 = u.pm * BM + wr * 64 + fr, col0 = u.pn * BM + wc * 32 + 4 * fq; const float* gb = gate + (size_t)(u.pm >> 3) * 6144;
#pragma unroll
        for (int bj = 0; bj < 2; ++bj)
#pragma unroll
            for (int n = 0; n < 2; ++n) { const int col = col0 + bj * HALF + n * 16; const f32x4 gv = *(const f32x4*)(gb + col);
#pragma unroll
                for (int ai = 0; ai < 2; ++ai)
#pragma unroll
                    for (int m = 0; m < 4; ++m) { const size_t off = (size_t)(row0 + ai * HALF + m * 16) * 1024 + col;
                        const f32x4 o = *(const f32x4*)(xin + off) + gv * acc[ai][bj][m][n]; *(f32x4*)(out + off) = o; } }
    }
};

struct EpiF32 {
    static constexpr bool PERM = false, AFTER_DRAIN = false;
    static __device__ __forceinline__ bool keeps_acc(const Unit&) { return false; }
    float* O; int ldc;
    __device__ __forceinline__ void operator()(const f32x4 (&acc)[2][2][4][2], const Unit& u, int wr, int wc, int fr, int fq) const {
        const int row0 = u.pm * BM + wr * 64 + fr, col0 = u.pn * BM + wc * 32 + 4 * fq;
#pragma unroll
        for (int bj = 0; bj < 2; ++bj)
#pragma unroll
            for (int n = 0; n < 2; ++n)
#pragma unroll
                for (int ai = 0; ai < 2; ++ai)
#pragma unroll
                    for (int m = 0; m < 4; ++m) *(f32x4*)(O + (size_t)(row0 + ai * HALF + m * 16) * ldc + col0 + bj * HALF + n * 16) = acc[ai][bj][m][n];
    }
};

struct EpiWoN {
    static constexpr bool PERM = false, AFTER_DRAIN = false;
    static __device__ __forceinline__ bool keeps_acc(const Unit&) { return false; }
    const float* xin; float* out; const float* modl; const float* g2; bf16_t* hb; float* ssq;
    __device__ __forceinline__ void operator()(const f32x4 (&acc)[2][2][4][2], const Unit& u, int wr, int wc, int fr, int fq) const {
        const int row0 = u.pm * BM + wr * 64 + fr, col0 = u.pn * BM + wc * 32 + 4 * fq; const float* mb = modl + (size_t)(u.pm >> 3) * 6144;
        float sq[2][4];
#pragma unroll
        for (int ai = 0; ai < 2; ++ai)
#pragma unroll
            for (int m = 0; m < 4; ++m) sq[ai][m] = 0.f;
#pragma unroll
        for (int bj = 0; bj < 2; ++bj)
#pragma unroll
            for (int n = 0; n < 2; ++n) { const int col = col0 + bj * HALF + n * 16; const f32x4 gv = *(const f32x4*)(mb + 2048 + col);
                const f32x4 gm = *(const f32x4*)(g2 + col) * (*(const f32x4*)(mb + 4096 + col) + 1.0f);
#pragma unroll
                for (int ai = 0; ai < 2; ++ai)
#pragma unroll
                    for (int m = 0; m < 4; ++m) { const size_t off = (size_t)(row0 + ai * HALF + m * 16) * 1024 + col;
                        const f32x4 o = *(const f32x4*)(xin + off) + gv * acc[ai][bj][m][n]; *(f32x4*)(out + off) = o;
                        sq[ai][m] += (o[0] * o[0] + o[1] * o[1]) + (o[2] * o[2] + o[3] * o[3]);
                        const f32x4 a = o * gm; typedef unsigned u32x2 __attribute__((ext_vector_type(2)));
                        u32x2 w; w.x = cvt_pk_bf16(a[0], a[1]); w.y = cvt_pk_bf16(a[2], a[3]); *(u32x2*)(hb + off) = w; } }
#pragma unroll
        for (int ai = 0; ai < 2; ++ai)
#pragma unroll
            for (int m = 0; m < 4; ++m) { float s = sq[ai][m]; s += __shfl_xor(s, 16); s += __shfl_xor(s, 32);
                if (fq == 0) ssq[(size_t)(row0 + ai * HALF + m * 16) * 16 + u.pn * 4 + wc] = s; }
    }
};
struct EpiQN {
    static constexpr bool PERM = true, AFTER_DRAIN = false;
    static __device__ __forceinline__ bool keeps_acc(const Unit&) { return false; }
    bf16_t* O; const float* ssq; const float* cq; float eps;
    __device__ __forceinline__ void operator()(const f32x4 (&acc)[2][2][4][2], const Unit& u, int wr, int wc, int fr, int fq) const {
        const int row0 = u.pm * BM + wr * 64 + fr, col0 = u.pn * BM + wc * 64 + 8 * fq; const float* cb = cq + (size_t)(u.pm >> 3) * 2048 + col0;
        f32x4 c[2][2];
#pragma unroll
        for (int bj = 0; bj < 2; ++bj) { c[bj][0] = *(const f32x4*)(cb + bj * 32); c[bj][1] = *(const f32x4*)(cb + bj * 32 + 4); }
#pragma unroll
        for (int ai = 0; ai < 2; ++ai)
#pragma unroll
            for (int m = 0; m < 4; ++m) { const int row = row0 + ai * HALF + m * 16; const f32x4* sp = (const f32x4*)(ssq + (size_t)row * 16);
                const f32x4 s0 = sp[0], s1 = sp[1], s2 = sp[2], s3 = sp[3];
                const float ss = ((((s0[0] + s0[1]) + (s0[2] + s0[3])) + ((s1[0] + s1[1]) + (s1[2] + s1[3]))) + (((s2[0] + s2[1]) + (s2[2] + s2[3])) + ((s3[0] + s3[1]) + (s3[2] + s3[3]))));
                const float r = 1.0f / sqrtf(ss * (1.0f / 1024.0f) + eps);
                bf16_t* rowp = O + (size_t)row * 2048 + col0;
                u32x4 w[2];
#pragma unroll
                for (int bj = 0; bj < 2; ++bj) { const f32x4 v0 = acc[ai][bj][m][0] * r + c[bj][0], v1 = acc[ai][bj][m][1] * r + c[bj][1];
                    w[bj].x = cvt_pk_bf16(v0[0], v0[1]); w[bj].y = cvt_pk_bf16(v0[2], v0[3]); w[bj].z = cvt_pk_bf16(v1[0], v1[1]); w[bj].w = cvt_pk_bf16(v1[2], v1[3]); }
                store_lines(rowp, (size_t)8 * 2048, fr, w[0], w[1]); }
    }
};

struct EpiMergeK {
    static constexpr bool PERM = true, AFTER_DRAIN = false;
    static __device__ __forceinline__ bool keeps_acc(const Unit& u) { return u.z < 3; }
    const bf16_t* gates; bf16_t* s16;
    __device__ __forceinline__ void operator()(f32x4 (&acc)[2][2][4][2], const Unit& u, int wr, int wc, int fr, int fq) const {
        const int row0 = u.pm * BM + wr * 64 + fr, col0 = u.pn * BM + wc * 64 + 8 * fq, z = u.z;
#pragma unroll
        for (int ai = 0; ai < 2; ++ai)
#pragma unroll
            for (int m = 0; m < 4; ++m) { const size_t row = (size_t)(row0 + ai * HALF + m * 16);
#pragma unroll
                for (int bj = 0; bj < 2; ++bj) { const int col = col0 + bj * 32;
                    const u32x4 gw = *(const u32x4*)(gates + row * 4096 + (size_t)z * 1024 + col);
                    const float g[8] = {bf_lo(gw.x), bf_hi(gw.x), bf_lo(gw.y), bf_hi(gw.y), bf_lo(gw.z), bf_hi(gw.z), bf_lo(gw.w), bf_hi(gw.w)};
                    f32x4 v0 = acc[ai][bj][m][0], v1 = acc[ai][bj][m][1];
                    v0[0] *= g[0]; v0[1] *= g[1]; v0[2] *= g[2]; v0[3] *= g[3]; v1[0] *= g[4]; v1[1] *= g[5]; v1[2] *= g[6]; v1[3] *= g[7];
                    if (z < 3) { acc[ai][bj][m][0] = v0; acc[ai][bj][m][1] = v1; }
                    else { u32x4 w; w.x = cvt_pk_bf16(v0[0], v0[1]); w.y = cvt_pk_bf16(v0[2], v0[3]); w.z = cvt_pk_bf16(v1[0], v1[1]); w.w = cvt_pk_bf16(v1[2], v1[3]);
                        *(u32x4*)(s16 + row * 1024 + col) = w; } } }
    }
};

template <class Epi, class Sched, bool ALIGN_EPI = false, bool SP2 = false>
__device__ __forceinline__ void gemm_phase(PG8_LAS unsigned char* lds, const Gemm g, const Sched& S, const Epi& E) {
    const int tid = threadIdx.x, wid = __builtin_amdgcn_readfirstlane(tid >> 6), lane = tid & 63, wr = wid >> 2, wc = wid & 3, fr = lane & 15, fq = lane >> 4;
    const int K = g.K, nt = K / BK;
    unsigned voffA[2], voffB[2];
#pragma unroll
    for (int i = 0; i < 2; ++i) { int R, C; stage_rc(tid * 16 + i * 8192, R, C); const int Rb = Epi::PERM ? (64 * (R >> 5) + perm32(R & 31)) : R;
        voffA[i] = (unsigned)(R * g.lda + C) * 2u; voffB[i] = (unsigned)(Rb * g.ldb + C) * 2u; }
    const size_t kstep = (size_t)(BK * 2);
    const size_t hstepA = (size_t)HALF * g.lda * 2, hstepB = (size_t)(Epi::PERM ? 32 : HALF) * g.ldb * 2;
    const size_t tstepA = 2 * hstepA, tstepB = (size_t)BM * g.ldb * 2;
    const unsigned ldsw = (unsigned)wid * 1024u;
    const int aoff = lds_byte(wr * 64 + fr, fq * 8), boff = lds_byte(wc * 32 + fr, fq * 8);
#define PG8_SA(b, h) (((b) * 2 + (h)) * HTB)
#define PG8_SB(b, h) ((4 + (b) * 2 + (h)) * HTB)
#define PG8_STAGE(bufoff, gbase, voff) do { _Pragma("unroll") for (int _i = 0; _i < 2; ++_i) \
        __builtin_amdgcn_global_load_lds((const unsigned*)((const char*)(gbase) + (voff)[_i]), (PG8_LAS unsigned*)(lds + (bufoff) + ldsw + _i * 8192), 16, 0, 0); } while (0)
#define PG8_LDA(dst, b, h) do { _Pragma("unroll") for (int m = 0; m < 4; ++m) _Pragma("unroll") for (int k = 0; k < 2; ++k) dst[m][k] = *(const PG8_LAS bf16x8*)(lds + PG8_SA(b, h) + aoff + m * 2048 + k * 1024); } while (0)
#define PG8_LDB(dst, b, h) do { _Pragma("unroll") for (int n = 0; n < 2; ++n) _Pragma("unroll") for (int k = 0; k < 2; ++k) dst[n][k] = *(const PG8_LAS bf16x8*)(lds + PG8_SB(b, h) + boff + n * 2048 + k * 1024); } while (0)
#define PG8_MMA(ai, bj, At, Bt) do { __builtin_amdgcn_s_setprio(1); _Pragma("unroll") for (int m = 0; m < 4; ++m) _Pragma("unroll") for (int n = 0; n < 2; ++n) _Pragma("unroll") for (int k = 0; k < 2; ++k) \
        acc[ai][bj][m][n] = __builtin_amdgcn_mfma_f32_16x16x32_bf16(Bt[n][k], At[m][k], acc[ai][bj][m][n], 0, 0, 0); __builtin_amdgcn_s_setprio(0); } while (0)
#define PG8_WAIT_V(n) asm volatile("s_waitcnt vmcnt(" #n ")" ::: "memory")
#define PG8_WAIT_L(n) asm volatile("s_waitcnt lgkmcnt(" #n ")" ::: "memory")
#define PG8_BAR __builtin_amdgcn_s_barrier()
#define PG8_SCHED __builtin_amdgcn_sched_barrier(0)
    Unit cur, nxt; int ui = 0;
    if (!S.next(0, cur)) return;
    f32x4 acc[2][2][4][2];
#pragma unroll
    for (int a = 0; a < 2; ++a)
#pragma unroll
        for (int b = 0; b < 2; ++b)
#pragma unroll
            for (int m = 0; m < 4; ++m)
#pragma unroll
                for (int n = 0; n < 2; ++n) acc[a][b][m][n] = (f32x4){0.f, 0.f, 0.f, 0.f};
    bf16x8 At[4][2], B0[2][2], B1[2][2];
    const char* cA = (const char*)g.A + (size_t)cur.pm * tstepA + (size_t)cur.z * g.zA; const char* cB = (const char*)g.Bt + (size_t)cur.pn * tstepB + (size_t)cur.z * g.zB;
    S.a_ready(cur);
    if constexpr (SP2) {
        PG8_STAGE(PG8_SB(0, 0), cB, voffB); PG8_STAGE(PG8_SB(0, 1), cB + hstepB, voffB); PG8_STAGE(PG8_SA(0, 0), cA, voffA); PG8_STAGE(PG8_SA(0, 1), cA + hstepA, voffA);
        if (wr == 1) PG8_BAR;
        PG8_WAIT_V(2); PG8_BAR;
        PG8_STAGE(PG8_SB(1, 0), cB + kstep, voffB); PG8_STAGE(PG8_SA(1, 0), cA + kstep, voffA); PG8_STAGE(PG8_SB(1, 1), cB + hstepB + kstep, voffB);
        PG8_WAIT_V(6); PG8_BAR;
    } else {
        PG8_STAGE(PG8_SB(0, 0), cB, voffB); PG8_STAGE(PG8_SA(0, 0), cA, voffA); PG8_STAGE(PG8_SB(0, 1), cB + hstepB, voffB); PG8_STAGE(PG8_SA(0, 1), cA + hstepA, voffA);
        if (wr == 1) PG8_BAR;
        PG8_WAIT_V(4); PG8_BAR;
        PG8_STAGE(PG8_SB(1, 0), cB + kstep, voffB); PG8_STAGE(PG8_SA(1, 0), cA + kstep, voffA); PG8_STAGE(PG8_SB(1, 1), cB + hstepB + kstep, voffB);
        PG8_WAIT_V(6); PG8_BAR;
    }
    for (;;) {
        const bool has_next = S.next(ui + 1, nxt);
        const char* nA = has_next ? (const char*)g.A + (size_t)nxt.pm * tstepA + (size_t)nxt.z * g.zA : cA; const char* nB = has_next ? (const char*)g.Bt + (size_t)nxt.pn * tstepB + (size_t)nxt.z * g.zB : cB;
        for (int t = 0; t < nt; t += 2) {
            const bool last = (t == nt - 2);
            const char* a1 = cA + (size_t)(t + 1) * kstep;
            const char* a2 = last ? nA : cA + (size_t)(t + 2) * kstep; const char* b2 = last ? nB : cB + (size_t)(t + 2) * kstep;
            const char* a3 = a2 + kstep; const char* b3 = b2 + kstep;
            if (last && has_next) S.a_ready(nxt);
            if constexpr (SP2) {
            PG8_LDB(B0, 0, 0); PG8_LDB(B1, 0, 1); PG8_SCHED; PG8_LDA(At, 0, 0); PG8_STAGE(PG8_SA(1, 1), a1 + hstepA, voffA);
            PG8_WAIT_V(8); PG8_WAIT_L(0); PG8_BAR; PG8_MMA(0, 0, At, B0); PG8_MMA(0, 1, At, B1); PG8_BAR; PG8_SCHED;
            PG8_LDA(At, 0, 1); PG8_STAGE(PG8_SB(0, 0), b2, voffB); PG8_STAGE(PG8_SB(0, 1), b2 + hstepB, voffB); PG8_STAGE(PG8_SA(0, 0), a2, voffA);
            PG8_WAIT_V(8); PG8_WAIT_L(0); PG8_BAR; PG8_MMA(1, 0, At, B0); PG8_MMA(1, 1, At, B1); PG8_BAR; PG8_SCHED;
            PG8_LDB(B0, 1, 0); PG8_LDB(B1, 1, 1); PG8_SCHED; PG8_LDA(At, 1, 0); PG8_STAGE(PG8_SA(0, 1), a2 + hstepA, voffA);
            PG8_WAIT_V(8); PG8_WAIT_L(0); PG8_BAR; PG8_MMA(0, 0, At, B0); PG8_MMA(0, 1, At, B1); PG8_BAR; PG8_SCHED;
            PG8_LDA(At, 1, 1); PG8_STAGE(PG8_SB(1, 0), b3, voffB); PG8_STAGE(PG8_SB(1, 1), b3 + hstepB, voffB); PG8_STAGE(PG8_SA(1, 0), a3, voffA);
            PG8_WAIT_V(8); PG8_WAIT_L(0); PG8_BAR; PG8_MMA(1, 0, At, B0); PG8_MMA(1, 1, At, B1); PG8_BAR; PG8_SCHED;
            } else {
            PG8_LDB(B0, 0, 0); PG8_SCHED; PG8_LDA(At, 0, 0); PG8_STAGE(PG8_SA(1, 1), a1 + hstepA, voffA);
            PG8_WAIT_L(8); PG8_BAR; PG8_WAIT_L(0); PG8_MMA(0, 0, At, B0); PG8_BAR; PG8_SCHED;
            PG8_LDB(B1, 0, 1); PG8_STAGE(PG8_SB(0, 0), b2, voffB);
            PG8_BAR; PG8_WAIT_L(0); PG8_MMA(0, 1, At, B1); PG8_BAR;
            PG8_LDA(At, 0, 1); PG8_STAGE(PG8_SA(0, 0), a2, voffA);
            PG8_BAR; PG8_WAIT_L(0); PG8_MMA(1, 0, At, B0); PG8_BAR; PG8_SCHED;
            PG8_STAGE(PG8_SB(0, 1), b2 + hstepB, voffB);
            PG8_WAIT_V(6); PG8_BAR; PG8_MMA(1, 1, At, B1); PG8_BAR;
            PG8_LDB(B0, 1, 0); PG8_SCHED; PG8_LDA(At, 1, 0); PG8_STAGE(PG8_SA(0, 1), a2 + hstepA, voffA);
            PG8_WAIT_L(8); PG8_BAR; PG8_WAIT_L(0); PG8_MMA(0, 0, At, B0); PG8_BAR; PG8_SCHED;
            PG8_LDB(B1, 1, 1); PG8_STAGE(PG8_SB(1, 0), b3, voffB);
            PG8_BAR; PG8_WAIT_L(0); PG8_MMA(0, 1, At, B1); PG8_BAR;
            PG8_LDA(At, 1, 1); PG8_STAGE(PG8_SA(1, 0), a3, voffA);
            PG8_BAR; PG8_WAIT_L(0); PG8_MMA(1, 0, At, B0); PG8_BAR; PG8_SCHED;
            PG8_STAGE(PG8_SB(1, 1), b3 + hstepB, voffB);
            PG8_WAIT_V(6); PG8_BAR; PG8_MMA(1, 1, At, B1); PG8_BAR;
            }
        }
        if constexpr (ALIGN_EPI) { if (wr == 0) PG8_BAR; }
        if constexpr (!Epi::AFTER_DRAIN) { E(acc, cur, wr, wc, fr, fq); S.done(cur); }
        if (!has_next) break;
        if (!Epi::keeps_acc(cur)) {
#pragma unroll
        for (int a = 0; a < 2; ++a)
#pragma unroll
            for (int b = 0; b < 2; ++b)
#pragma unroll
                for (int m = 0; m < 4; ++m)
#pragma unroll
                    for (int n = 0; n < 2; ++n) acc[a][b][m][n] = (f32x4){0.f, 0.f, 0.f, 0.f};
        }
        cur = nxt; cA = nA; cB = nB; ++ui;
        if constexpr (ALIGN_EPI) { if (wr == 1) PG8_BAR; }
    }
    PG8_WAIT_V(0);
    if constexpr (!ALIGN_EPI) { if (wr == 0) PG8_BAR; }
    PG8_BAR;
    if constexpr (Epi::AFTER_DRAIN) { E.fused(acc, cur, wr, wc, fr, fq, lds, wid, lane); S.done(cur); }
#undef PG8_SA
#undef PG8_SB
#undef PG8_STAGE
#undef PG8_LDA
#undef PG8_LDB
#undef PG8_MMA
#undef PG8_WAIT_V
#undef PG8_WAIT_L
#undef PG8_BAR
#undef PG8_SCHED
}
}

#ifndef PG8_SP2
#define PG8_SP2 true
#endif
#ifndef PG8_ALIGN
#define PG8_ALIGN true
#endif
#include <hip/hip_bf16.h>
#include <cmath>
namespace attn_body {
using bf16=__hip_bfloat16;
using bf16x8=__attribute__((ext_vector_type(8)))short;
using s16x4=__attribute__((ext_vector_type(4)))short;
using f32x16=__attribute__((ext_vector_type(16)))float;
using u32x4=__attribute__((ext_vector_type(4)))unsigned;
constexpr int SEQ=2048,D=64,PQ=4352,PK=4352,PV=4352,PO=1024;
constexpr int NW=8,QBLK=32,QB=QBLK*NW,KVBLK=64,NQB=SEQ/QB;
constexpr int ATTN_UNIT_ROWS=QB;
__device__ __forceinline__ int crow(int r,int hi){return (r&3)+8*(r>>2)+4*hi;}
#define SBAR() __builtin_amdgcn_sched_barrier(0)
__device__ __forceinline__ void cmask(f32x16&p0,f32x16&p1,int jb,int qrel,int hi){
  const float NEG=-INFINITY; int kb=64*jb+4*hi;
  #pragma unroll
  for(int r=0;r<16;++r){int kv=kb+(r&3)+8*(r>>2); if(kv>qrel)p0[r]=NEG; if(kv+32>qrel)p1[r]=NEG;}
}

constexpr int NSLOT=3, SLOTB=8192;
constexpr int LDS_K=0, LDS_V=NSLOT*SLOTB, LDS_WS=2*NSLOT*SLOTB, LDS_OST=LDS_WS+NW*64*4, LDS_BYTES=LDS_OST+NW*4096;
constexpr float C2=0.125f*1.4426950408889634f;
__device__ __forceinline__ void glds16(const void*gsrc,unsigned lds_dst){unsigned keep;
  asm volatile("s_mov_b32 %0, m0\n\ts_mov_b32 m0, %2\n\ts_nop 0\n\tglobal_load_lds_dwordx4 %1, off\n\ts_mov_b32 m0, %0":"=&s"(keep):"v"(gsrc),"s"(lds_dst):"memory");}
__device__ __forceinline__ float max3f(float a,float b,float c){float r;asm("v_max3_f32 %0, %1, %2, %3":"=v"(r):"v"(a),"v"(b),"v"(c));return r;}
__device__ __forceinline__ float max2f(float a,float b){float r;asm("v_max_f32_e32 %0, %1, %2":"=v"(r):"v"(a),"v"(b));return r;}
__device__ __forceinline__ float fadd_s(float a,float b){float r;asm("v_add_f32_e32 %0, %1, %2":"=v"(r):"v"(a),"v"(b));return r;}
__device__ __forceinline__ float fsub_s(float a,float b){float r;asm("v_sub_f32_e32 %0, %1, %2":"=v"(r):"v"(a),"v"(b));return r;}
typedef float f32x2_t __attribute__((ext_vector_type(2))); typedef __bf16 bf16x2_t __attribute__((ext_vector_type(2)));
__device__ __forceinline__ unsigned cvtpk_s(float lo,float hi){f32x2_t v={lo,hi};bf16x2_t b=__builtin_convertvector(v,bf16x2_t);return __builtin_bit_cast(unsigned,b);}
#define WAIT_BAR(N) asm volatile("s_waitcnt vmcnt(" #N ") lgkmcnt(0)\n\ts_barrier":::"memory")

__device__ __forceinline__ void qkt(f32x16&p0,f32x16&p1,const char*Kslot,const bf16x8*qr,const f32x16&negm,int r32,int hi){
  const char*kb=Kslot+hi*1024+r32*16;
  #pragma unroll
  for(int d0=0;d0<4;++d0){
    const bf16x8 b0=*reinterpret_cast<const bf16x8*>(kb+d0*2048);
    const bf16x8 b1=*reinterpret_cast<const bf16x8*>(kb+d0*2048+512);
    if(d0==0){p0=__builtin_amdgcn_mfma_f32_32x32x16_bf16(b0,qr[0],negm,0,0,0);p1=__builtin_amdgcn_mfma_f32_32x32x16_bf16(b1,qr[0],negm,0,0,0);}
    else{p0=__builtin_amdgcn_mfma_f32_32x32x16_bf16(b0,qr[d0],p0,0,0,0);p1=__builtin_amdgcn_mfma_f32_32x32x16_bf16(b1,qr[d0],p1,0,0,0);}}
}
typedef __attribute__((address_space(3))) const char* lds_cptr;
typedef short v4i16_t __attribute__((ext_vector_type(4)));
__device__ __forceinline__ void kload8(bf16x8*kf,lds_cptr kp){
  kf[0]=*(const __attribute__((address_space(3))) bf16x8*)(kp);      kf[1]=*(const __attribute__((address_space(3))) bf16x8*)(kp+512);
  kf[2]=*(const __attribute__((address_space(3))) bf16x8*)(kp+2048); kf[3]=*(const __attribute__((address_space(3))) bf16x8*)(kp+2560);
  kf[4]=*(const __attribute__((address_space(3))) bf16x8*)(kp+4096); kf[5]=*(const __attribute__((address_space(3))) bf16x8*)(kp+4608);
  kf[6]=*(const __attribute__((address_space(3))) bf16x8*)(kp+6144); kf[7]=*(const __attribute__((address_space(3))) bf16x8*)(kp+6656);
}
__device__ __forceinline__ void kload2(bf16x8*kf,lds_cptr kp,int j){ kf[2*j]=*(const __attribute__((address_space(3))) bf16x8*)(kp+j*2048); kf[2*j+1]=*(const __attribute__((address_space(3))) bf16x8*)(kp+j*2048+512); }
__device__ __forceinline__ s16x4 vtr(lds_cptr p){ return __builtin_bit_cast(s16x4,__builtin_amdgcn_ds_read_tr16_b64_v4i16((__attribute__((address_space(3))) v4i16_t*)p)); }
__device__ __forceinline__ float rowmax(const f32x16&p0,const f32x16&p1){
  float a=max3f(p0[0],p0[1],p1[0]),b=max3f(p0[2],p0[3],p1[1]);a=max3f(a,p1[2],p1[3]);
  #pragma unroll
  for(int r=4;r<16;r+=4){a=max3f(a,p0[r],p0[r+1]);b=max3f(b,p0[r+2],p0[r+3]);a=max3f(a,p1[r],p1[r+1]);b=max3f(b,p1[r+2],p1[r+3]);}
  const float m=max2f(a,b);
  auto rr=__builtin_amdgcn_permlane32_swap(__float_as_uint(m),__float_as_uint(m),false,false);
  return max2f(__uint_as_float(rr[0]),__uint_as_float(rr[1]));
}
__device__ __forceinline__ void pv(f32x16*o,int vb,bf16x8 pa0,bf16x8 pa1,bf16x8 pa2,bf16x8 pa3){
  #pragma unroll
  for(int d0=0;d0<2;++d0){s16x4 lo[4],hi[4];
    #pragma unroll
    for(int ks=0;ks<4;++ks){
      asm volatile("ds_read_b64_tr_b16 %0,%1 offset:%c2":"=&v"(lo[ks]):"v"(vb),"i"(d0*4096+ks*1024):"memory");
      asm volatile("ds_read_b64_tr_b16 %0,%1 offset:%c2":"=&v"(hi[ks]):"v"(vb),"i"(d0*4096+ks*1024+512):"memory");}
    asm volatile("s_waitcnt lgkmcnt(0)":::"memory");SBAR();
    #define PK(k) (bf16x8){lo[k][0],lo[k][1],lo[k][2],lo[k][3],hi[k][0],hi[k][1],hi[k][2],hi[k][3]}
    o[d0]=__builtin_amdgcn_mfma_f32_32x32x16_bf16(pa0,PK(0),o[d0],0,0,0);
    o[d0]=__builtin_amdgcn_mfma_f32_32x32x16_bf16(pa1,PK(1),o[d0],0,0,0);
    o[d0]=__builtin_amdgcn_mfma_f32_32x32x16_bf16(pa2,PK(2),o[d0],0,0,0);
    o[d0]=__builtin_amdgcn_mfma_f32_32x32x16_bf16(pa3,PK(3),o[d0],0,0,0);
    #undef PK
  }
}

#ifndef ATTN_STORE16
#define ATTN_STORE16(p,v) (*(u32x4*)(p)=(v))
#endif
template<int THRL> __device__ __forceinline__ void attn_unit(int b,int qcol,int kcol,int vcol,int ocol,int qb,const bf16*Q,const bf16*__restrict__ K,const bf16*__restrict__ V,bf16*O,char*shm){
  const int tid=threadIdx.x,lane=tid&63,r32=lane&31,hi=lane>>5; const int wid=__builtin_amdgcn_readfirstlane(tid>>6);
  const long rowbase=(long)b*SEQ; const int q0=qb*QB;
  const bf16*Qw=Q+(rowbase+q0+wid*QBLK)*PQ+qcol;
  const bf16*Kh=K+rowbase*PK+kcol,*Vh=V+rowbase*PV+vcol;
  const unsigned lds0=(unsigned)(uintptr_t)shm;
  float*wsf=(float*)(shm+LDS_WS)+wid*64;
  const bf16*ksrc=Kh+(long)lane*PK+wid*8;
  const bf16*vsrc=Vh+(long)(16*(wid&3)+(lane>>2))*PV+(wid>>2)*32+(lane&3)*8;
  const unsigned kdst=lds0+LDS_K+wid*1024, vdst=lds0+LDS_V+wid*1024;
  #define DMA_K(t,slot) glds16(ksrc+(long)(t)*KVBLK*PK,(unsigned)__builtin_amdgcn_readfirstlane(kdst+(slot)))
  #define DMA_V(t,slot) glds16(vsrc+(long)(t)*KVBLK*PV,(unsigned)__builtin_amdgcn_readfirstlane(vdst+(slot)))
  const int vb0=(int)(lds0+LDS_V)+((lane>>4)&1)*32+(lane&3)*8+(4*hi+((lane&15)>>2))*64;
  const char*Kbase=shm+LDS_K; bf16x8 kf[8];
  const lds_cptr shm3=(lds_cptr)shm; const lds_cptr kp0=shm3+LDS_K+hi*1024+r32*16; const lds_cptr vp0=shm3+LDS_V+((lane>>4)&1)*32+(lane&3)*8+(4*hi+((lane&15)>>2))*64;
  const int NT=(q0+QB)/KVBLK;
  DMA_K(0,0);DMA_V(0,0);DMA_K(1,SLOTB);
  bf16x8 qr[4];
  #pragma unroll
  for(int d0=0;d0<4;++d0)qr[d0]=*reinterpret_cast<const bf16x8*>(&Qw[(long)r32*PQ+d0*16+hi*8]);
  float mhat=0.f,l_reg=0.f;f32x16 o[2];o[0]=f32x16{};o[1]=f32x16{};f32x16 negm=f32x16{};asm volatile("":"+v"(negm));
  const int qrel=wid*QBLK+r32;
  #define CMASK(P0,P1,t) do{int jb_=(t)-(NT-4); if(jb_>=0)cmask(P0,P1,jb_,qrel,hi);}while(0)
  bool resc=false;
  #define START(P0,P1) do{ const float rm=rowmax(P0,P1); resc=false; \
    { const float dl=rm; mhat=fadd_s(mhat,dl); \
      _Pragma("unroll") for(int r=0;r<16;++r){P0[r]=fsub_s(P0[r],dl);P1[r]=fsub_s(P1[r],dl);} \
      _Pragma("unroll") for(int r=0;r<16;++r)negm[r]=-mhat; asm volatile("":"+v"(negm)); } \
    _Pragma("unroll") for(int r=0;r<16;++r)P0[r]=__builtin_amdgcn_exp2f(P0[r]); }while(0)
  #define RESC() do{ if(resc){ asm volatile("s_waitcnt lgkmcnt(0)":::"memory"); \
      _Pragma("unroll") for(int d_=0;d_<2;++d_) _Pragma("unroll") for(int r=0;r<16;++r)o[d_][r]*=wsf[crow(r,hi)]; } }while(0)
  f32x16 pA0,pA1,pB0,pB1;
  int sl_prev=0,sl_cur=0,sl_next=SLOTB;
  #define ROT() do{sl_prev=sl_cur;sl_cur=sl_next;sl_next=(sl_next==(NSLOT-1)*SLOTB)?0:sl_next+SLOTB;}while(0)
  DMA_K(2,2*SLOTB);
  WAIT_BAR(3);
  qkt(pA0,pA1,Kbase,qr,negm,r32,hi);asm volatile("s_nop 15\n\ts_nop 7":"+v"(pA0),"+v"(pA1));CMASK(pA0,pA1,0);
  START(pA0,pA1);
  _Pragma("unroll") for(int r=0;r<16;++r)pA1[r]=__builtin_amdgcn_exp2f(pA1[r]);
  WAIT_BAR(0);
  DMA_K(3,0);DMA_V(1,SLOTB);
  ROT();
  kload8(kf,kp0+sl_cur);
  WAIT_BAR(2);
  s16x4 vlo[8],vhi[8]; u32x4 pw0,pw1,pw2,pw3;
  #define PKW(P,B) cvtpk_s(P[B],P[B+1])
  #define PAF(k) __builtin_bit_cast(bf16x8,pw##k)
  #define VFR(i) (bf16x8){vlo[i][0],vlo[i][1],vlo[i][2],vlo[i][3],vhi[i][0],vhi[i][1],vhi[i][2],vhi[i][3]}
  #define PIN(x) asm volatile("":"+v"(x))
  #define MX3(a,b,c) __builtin_fmaxf(__builtin_fmaxf((a),(b)),(c))
  #define GAPA(MF,A0,A1,A2,A3,W0,W1,PW) do{ MF; sacc+=A0; sacc+=A1; sacc+=A2; sacc+=A3; PIN(sacc); W0; W1; PIN(PW); SBAR(); }while(0)
  #define EX(v) __builtin_amdgcn_exp2f(v)
  #define GAPB(MF,X,B) do{ MF; X[B]=EX(X[B]); X[B+1]=EX(X[B+1]); X[B+2]=EX(X[B+2]); X[B+3]=EX(X[B+3]); PIN(X); SBAR(); }while(0)
  #define VRD(i) do{ vlo[i]=vtr(vp_+(((i)>>2)*4096+((i)&3)*1024)); vhi[i]=vtr(vp_+(((i)>>2)*4096+((i)&3)*1024+512)); }while(0)
  #define KRD(G,j) do{ if(G){ kload2(kf,kp0+sl_next,j); SBAR(); } }while(0)
  #define STEP(C0,C1,P0,P1,t,GK,GV,GL) do{ SBAR(); \
    const lds_cptr vp_=vp0+sl_prev; \
    VRD(0); SBAR(); float sacc=(P0[0]+P0[1]); \
    GAPA(C0=__builtin_amdgcn_mfma_f32_32x32x16_bf16(kf[0],qr[0],negm,0,0,0), P0[2],P0[3],P0[4],P0[5],     pw0[0]=PKW(P0,0), pw0[1]=PKW(P0,2), pw0); \
    VRD(4); SBAR(); GAPA(C1=__builtin_amdgcn_mfma_f32_32x32x16_bf16(kf[1],qr[0],negm,0,0,0), P0[6],P0[7],P0[8],P0[9],     pw0[2]=PKW(P0,4), pw0[3]=PKW(P0,6), pw0); \
    VRD(1); SBAR(); GAPA(C0=__builtin_amdgcn_mfma_f32_32x32x16_bf16(kf[2],qr[1],C0,0,0,0),   P0[10],P0[11],P0[12],P0[13], pw1[0]=PKW(P0,8), pw1[1]=PKW(P0,10), pw1); \
    VRD(5); SBAR(); GAPA(C1=__builtin_amdgcn_mfma_f32_32x32x16_bf16(kf[3],qr[1],C1,0,0,0),   P0[14],P0[15],P1[0],P1[1],   pw1[2]=PKW(P0,12),pw1[3]=PKW(P0,14), pw1); \
    VRD(2); SBAR(); GAPA(C0=__builtin_amdgcn_mfma_f32_32x32x16_bf16(kf[4],qr[2],C0,0,0,0),   P1[2],P1[3],P1[4],P1[5],     pw2[0]=PKW(P1,0), pw2[1]=PKW(P1,2), pw2); \
    VRD(6); SBAR(); GAPA(C1=__builtin_amdgcn_mfma_f32_32x32x16_bf16(kf[5],qr[2],C1,0,0,0),   P1[6],P1[7],P1[8],P1[9],     pw2[2]=PKW(P1,4), pw2[3]=PKW(P1,6), pw2); \
    VRD(3); SBAR(); GAPA(C0=__builtin_amdgcn_mfma_f32_32x32x16_bf16(kf[6],qr[3],C0,0,0,0),   P1[10],P1[11],P1[12],P1[13], pw3[0]=PKW(P1,8), pw3[1]=PKW(P1,10), pw3); \
    VRD(7); SBAR(); GAPA(C1=__builtin_amdgcn_mfma_f32_32x32x16_bf16(kf[7],qr[3],C1,0,0,0),   P1[14],P1[15],0.f,0.f,       pw3[2]=PKW(P1,12),pw3[3]=PKW(P1,14), pw3); \
    l_reg+=sacc; \
    if(GK){DMA_K((t)+3,sl_cur);} if(GV){DMA_V((t)+1,sl_next);} \
    CMASK(C0,C1,t); \
    { float a=MX3(C0[0],C0[1],C1[0]),b=MX3(C0[2],C0[3],C1[1]); a=MX3(a,C1[2],C1[3]); \
      _Pragma("unroll") for(int r=4;r<16;r+=4){a=MX3(a,C0[r],C0[r+1]);b=MX3(b,C0[r+2],C0[r+3]);a=MX3(a,C1[r],C1[r+1]);b=MX3(b,C1[r+2],C1[r+3]);} \
      float rm=__builtin_fmaxf(a,b); { auto rr=__builtin_amdgcn_permlane32_swap(__float_as_uint(rm),__float_as_uint(rm),false,false); rm=__builtin_fmaxf(__uint_as_float(rr[0]),__uint_as_float(rr[1])); } \
      resc=false; \
      if(__builtin_expect(__any(rm>(float)THRL),0)){ const float dl=__builtin_fmaxf(rm,0.f); mhat+=dl; \
        _Pragma("unroll") for(int r=0;r<16;++r){C0[r]-=dl;C1[r]-=dl;} \
        _Pragma("unroll") for(int r=0;r<16;++r)negm[r]=-mhat; asm volatile("":"+v"(negm)); \
        const float f=__builtin_amdgcn_exp2f(-dl); l_reg*=f; if(hi==0)wsf[r32]=f; resc=true; } } \
    SBAR(); \
    GAPB(o[0]=__builtin_amdgcn_mfma_f32_32x32x16_bf16(PAF(0),VFR(0),o[0],0,0,0), C0,0); \
    GAPB(o[1]=__builtin_amdgcn_mfma_f32_32x32x16_bf16(PAF(0),VFR(4),o[1],0,0,0), C0,4); \
    KRD(GL,0); GAPB(o[0]=__builtin_amdgcn_mfma_f32_32x32x16_bf16(PAF(1),VFR(1),o[0],0,0,0), C0,8); \
    KRD(GL,1); GAPB(o[1]=__builtin_amdgcn_mfma_f32_32x32x16_bf16(PAF(1),VFR(5),o[1],0,0,0), C0,12); \
    KRD(GL,2); GAPB(o[0]=__builtin_amdgcn_mfma_f32_32x32x16_bf16(PAF(2),VFR(2),o[0],0,0,0), C1,0); \
    KRD(GL,3); GAPB(o[1]=__builtin_amdgcn_mfma_f32_32x32x16_bf16(PAF(2),VFR(6),o[1],0,0,0), C1,4); \
    GAPB(o[0]=__builtin_amdgcn_mfma_f32_32x32x16_bf16(PAF(3),VFR(3),o[0],0,0,0), C1,8); \
    GAPB(o[1]=__builtin_amdgcn_mfma_f32_32x32x16_bf16(PAF(3),VFR(7),o[1],0,0,0), C1,12); \
    }while(0)
  int t=1;
  #undef CMASK
  #define CMASK(P0,P1,t) do{}while(0)
  for(;t+5<NT;t+=2){
    STEP(pB0,pB1,pA0,pA1,t,true,true,true);     WAIT_BAR(2); RESC(); ROT();
    STEP(pA0,pA1,pB0,pB1,t+1,true,true,true);   WAIT_BAR(2); RESC(); ROT();
  }
  #undef CMASK
  #define CMASK(P0,P1,t) do{int jb_=(t)-(NT-4); if(jb_>=0)cmask(P0,P1,jb_,qrel,hi);}while(0)
  #define ENDW(tt) do{ if((tt)+3<NT){WAIT_BAR(2);} else if((tt)+2<NT){WAIT_BAR(1);} else {WAIT_BAR(0);} }while(0)
  for(;t+1<NT;t+=2){
    STEP(pB0,pB1,pA0,pA1,t,(t+3<NT),(t+1<NT),(t+1<NT));       ENDW(t);   RESC(); ROT();
    STEP(pA0,pA1,pB0,pB1,t+1,(t+4<NT),(t+2<NT),(t+2<NT));     ENDW(t+1); RESC(); ROT();
  }
  STEP(pB0,pB1,pA0,pA1,NT-1,false,false,false); RESC();
  { float sacc=pB0[0]+pB0[1]; _Pragma("unroll") for(int r=2;r<16;++r)sacc+=pB0[r]; _Pragma("unroll") for(int r=0;r<16;++r)sacc+=pB1[r]; l_reg+=sacc;
    pw0=(u32x4){PKW(pB0,0),PKW(pB0,2),PKW(pB0,4),PKW(pB0,6)};pw1=(u32x4){PKW(pB0,8),PKW(pB0,10),PKW(pB0,12),PKW(pB0,14)};pw2=(u32x4){PKW(pB1,0),PKW(pB1,2),PKW(pB1,4),PKW(pB1,6)};pw3=(u32x4){PKW(pB1,8),PKW(pB1,10),PKW(pB1,12),PKW(pB1,14)};
    SBAR(); pv(o,vb0+sl_cur,PAF(0),PAF(1),PAF(2),PAF(3)); }
  #undef PKW
  #undef PAF
  #undef VFR
  #undef PIN
  #undef MX3
  #undef GAPA
  #undef GAPB
  #undef EX
  #undef VRD
  #undef KRD
  #undef STEP
  #undef ENDW
  {auto rr=__builtin_amdgcn_permlane32_swap(__float_as_uint(l_reg),__float_as_uint(l_reg),false,false);l_reg=__uint_as_float(rr[0])+__uint_as_float(rr[1]);}
  if(hi==0)wsf[32+r32]=l_reg;asm volatile("s_waitcnt lgkmcnt(0)":::"memory");
  float rli[16];
  #pragma unroll
  for(int r=0;r<16;++r)rli[r]=__builtin_amdgcn_rcpf(wsf[32+crow(r,hi)]);
  bf16*Ow=O+(rowbase+q0+wid*QBLK)*PO+ocol;
  { bf16*stg=(bf16*)(shm+LDS_OST)+wid*2048;
    #pragma unroll
    for(int r=0;r<16;++r){const int orow=crow(r,hi);
      #pragma unroll
      for(int d0=0;d0<2;++d0)stg[orow*64+d0*32+r32]=__float2bfloat16(o[d0][r]*rli[r]);}
    asm volatile("s_waitcnt lgkmcnt(0)":::"memory");
    #pragma unroll
    for(int i=0;i<4;++i){const int row=i*8+(lane>>3),ch=lane&7; const u32x4 v=*(const u32x4*)(stg+row*64+ch*8); ATTN_STORE16(Ow+(long)row*PO+ch*8,v);} }
  asm volatile("s_waitcnt lgkmcnt(0)\n\ts_barrier":::"memory");
  #undef DMA_K
  #undef DMA_V
  #undef CMASK
  #undef START
  #undef RESC
  #undef ROT
}
constexpr int ATTN_LDS_BYTES=LDS_BYTES;
struct AttnTensors { const bf16* Q; const bf16* K; const bf16* V; bf16* O; };
struct AttnUnit { int bj; int qb; };
struct StaticOrder {
  int vcu;
  __device__ __forceinline__ explicit StaticOrder(int grid,int block):vcu((block%8)*(grid/8)+block/8){}
  __device__ __forceinline__ bool next(int i,AttnUnit&u)const{ if(i>=4)return false; const int s0=2*(vcu&1); u.bj=vcu>>1; u.qb=(i==0)?s0:(i==1)?7-s0:(i==2)?s0+1:6-s0; return true; }
};
template<class Sched,int THRL=8> __device__ __forceinline__ void attn_phase(char*lds,const AttnTensors&T,const Sched&S){
  AttnUnit u;
  for(int i=0;S.next(i,u);++i){ const int b=u.bj>>4,j=u.bj&15,h=j>>2,c=(j>>1)&1,vh=j&1;
    attn_unit<THRL>(b,h*128+c*64,512+h*128+c*64,1024+h*128+vh*64,j*64,u.qb,T.Q,T.K,T.V,T.O,lds); }
}
#undef SBAR
#undef WAIT_BAR
}
constexpr int NWAVES = 8;
constexpr int NB = 8, SEQ = 2048, T = NB * SEQ, D = 1024, DEPTH = 2;
constexpr int NPROJ = 4352, NGATE = 4096, NIN = 8448;
constexpr float EPS = 1e-6f;
constexpr float C2 = 0.125f * 1.4426950408889634f;
constexpr float LOG2E = 1.4426950408889634f;
constexpr int C_AQ = 0, C_AK = 512, C_AV = 1024, C_BB = 1536, C_BC = 2048, C_BX = 2560, C_CZ = 3072, C_DQ = 3584, C_DK = 4096, C_DV = 4224;
enum { I_X = 0, I_C, I_WADA, I_BADA, I_GN1, I_WIN, I_LQ1, I_LK1, I_LQ2, I_LK2, I_GSUB, I_CONVW, I_WPOOL, I_PSCALE, I_SINKS, I_WBR, I_WO, I_GN2, I_WQ, I_SK, I_UE, I_VE, I_GFIN, N_IN };

constexpr size_t MiB = 1u << 20;
constexpr size_t WS_CTL = 0, CTL_ZERO_BYTES = 1 * MiB;
constexpr size_t WS_MOD = 1 * MiB;
constexpr size_t WS_W = 2 * MiB, W_LAYER = 27 * MiB;
constexpr size_t W_WIN = 0, W_WBR = 16 * MiB + MiB / 2, W_WO = W_WBR + 4 * MiB, W_WQ = W_WO + 2 * MiB, W_SK = W_WQ + 4 * MiB, W_WP = W_SK + 65536;
constexpr size_t WS_H = 56 * MiB;
constexpr size_t WS_PROJ = 88 * MiB;
constexpr size_t WS_S32 = WS_PROJ;
constexpr size_t WS_Q2 = WS_PROJ;
#ifndef DBG_ROUTE32
#define DBG_ROUTE32 0
#endif
#if DBG_ROUTE32
constexpr size_t WS_H3 = WS_PROJ;
constexpr size_t WS_Q32 = 224 * MiB;
constexpr size_t WS_IDX = 416 * MiB, WS_WTS = WS_IDX + 8 * MiB;
#else
constexpr size_t WS_IDX = WS_PROJ + 64 * MiB, WS_WTS = WS_IDX + 8 * MiB;
#endif
constexpr size_t WS_GATES = 224 * MiB;
constexpr size_t WS_Y = 352 * MiB;
#ifndef EXP_I8
#define EXP_I8 1
#endif
#define EXP_I8_OWN (EXP_I8 && !DBG_ROUTE32)
#if DBG_ROUTE32
constexpr size_t WS_UE = WS_PROJ, WS_VE = WS_PROJ + 32 * MiB;
constexpr size_t WS_WQ3 = WS_Y;
#else
#if EXP_I8_OWN
constexpr size_t WS_UE = 448 * MiB, WS_VE = 464 * MiB;
#else
constexpr size_t WS_UE = WS_GATES, WS_VE = WS_GATES + 32 * MiB;
#endif
#endif
constexpr size_t WS_US = 480 * MiB, WS_VS = WS_US + 65536;
constexpr size_t WS_O = 416 * MiB;
#ifndef NORM_FOLD
#define NORM_FOLD (!DBG_ROUTE32)
#ifndef EPI_HOIST
#define EPI_HOIST 1
#endif
#ifndef H2C_HOIST
#define H2C_HOIST 1
#endif
#ifndef X1_PREFETCH
#define X1_PREFETCH 1
#endif
#ifndef V_ABID
#define V_ABID 1
#endif
#ifndef ROUTE_SORTNET
#define ROUTE_SORTNET 1
#endif
#ifndef H_PLANES
#define H_PLANES 1
#endif
#ifndef BAR_FLAT_RELEASE
#define BAR_FLAT_RELEASE 1
#endif
#ifndef TREE_BANKMASK
#define TREE_BANKMASK 1
#endif
#ifndef ROUTE_BATCH
#define ROUTE_BATCH 4
#endif
#ifndef ROW_OFFS
#define ROW_OFFS 1
#endif
#ifndef DMA_NOMASK
#define DMA_NOMASK 1
#endif
#ifndef ROW_PIPE
#define ROW_PIPE 1
#endif
#ifndef EXP6B
#define EXP6B 1
#endif
#ifndef V_PLANES
#define V_PLANES 1
#endif
constexpr unsigned EROW = EXP6B ? 768u : 1024u;
#ifndef V_MFMA
#define V_MFMA 1
#endif
#endif
constexpr size_t WS_SSQ = 481 * MiB;
constexpr size_t WS_CQ = WS_MOD + 512 * 1024;
constexpr size_t WS_END = (EXP_I8_OWN || NORM_FOLD) ? 482 * MiB : 448 * MiB;
constexpr int CW_PEERQ = 8192;
#ifndef PEER_DYNAMIC
#define PEER_DYNAMIC 0
#endif
constexpr int CW_BAR = 4096;

constexpr int RING_OFF = 0, RING_BYTES = 131072;
constexpr int LDSCTL_OFF = RING_BYTES, MISC_OFF = LDSCTL_OFF + 320;
constexpr int HAND_OFF = LDSCTL_OFF + 1024;
constexpr int LDS_BYTES = HAND_OFF + 8 * 3072;

#define GAS __attribute__((address_space(1)))
#define LAS __attribute__((address_space(3)))
typedef unsigned short bf16;
typedef unsigned v4u __attribute__((ext_vector_type(4)));
typedef unsigned v2u __attribute__((ext_vector_type(2)));
typedef float f32x4 __attribute__((ext_vector_type(4)));
typedef GAS unsigned gu32;
#define LDS_WAIT() asm volatile("s_waitcnt lgkmcnt(0)" ::: "memory")
__device__ __forceinline__ unsigned f2bf(float f) { unsigned u = __builtin_bit_cast(unsigned, f); return (u + 0x7fffu + ((u >> 16) & 1u)) >> 16; }
__device__ __forceinline__ unsigned pk2(float lo, float hi) { return f2bf(lo) | (f2bf(hi) << 16); }
__device__ __forceinline__ float bflo(unsigned w) { return __builtin_bit_cast(float, w << 16); }
__device__ __forceinline__ float bfhi(unsigned w) { return __builtin_bit_cast(float, w & 0xffff0000u); }
__device__ __forceinline__ float bf1(bf16 h) { return __builtin_bit_cast(float, (unsigned)h << 16); }

#define XB_TMO      128
#define XB_XCNT(j)  (256  + 64 * (j))
#define XB_XSUB(j)  (1280 + 64 * (j))
#define XB_XGEN(j)  (2304 + 64 * (j))
#define XB_TOP      3328
#define XB_TOPGEN   3392
#define XCD_BAR_WORDS 3456
#define XB_SPIN_CAP (1u << 18)
__device__ __forceinline__ unsigned xb_ld(unsigned* p)              { return __hip_atomic_load(p, __ATOMIC_RELAXED, __HIP_MEMORY_SCOPE_AGENT); }
__device__ __forceinline__ unsigned xb_add(unsigned* p, unsigned v) { return __hip_atomic_fetch_add(p, v, __ATOMIC_RELAXED, __HIP_MEMORY_SCOPE_AGENT); }
__device__ __forceinline__ unsigned xb_xcc_id() { return (unsigned)__builtin_amdgcn_s_getreg((3 << 11) | 20) & 0xFu; }
#define XB_SPIN(cond, bar) do { unsigned _sp = 0; while (cond) { __builtin_amdgcn_s_sleep(1); \
    if ((++_sp & 255u) == 0u) { if (xb_ld(&(bar)[XB_TMO])) break; if (_sp > XB_SPIN_CAP) { atomicAdd(&(bar)[XB_TMO], 1u); break; } } } } while (0)
struct XcdBarrier { unsigned* bar; unsigned x; volatile LAS unsigned* st; };
__device__ __forceinline__ XcdBarrier xcd_barrier_post(unsigned* bar, volatile LAS unsigned* st) {
    XcdBarrier b; b.bar = bar; b.x = xb_xcc_id(); b.st = st;
    if (threadIdx.x == 0) (void)xb_add(&bar[XB_XCNT(b.x)], 1u);
    return b;
}
__device__ __forceinline__ void xcd_barrier_complete(unsigned* bar, unsigned x, unsigned& nloc, unsigned& nx) {
    const unsigned G = gridDim.x * gridDim.y * gridDim.z;
    unsigned sum, cnt, mine, sp = 0u;
    for (;;) {
        sum = 0u; cnt = 0u; mine = 0u;
#pragma unroll
        for (unsigned j = 0; j < 16; ++j) { const unsigned c = xb_ld(&bar[XB_XCNT(j)]); sum += c; cnt += (c > 0u) ? 1u : 0u; mine = (j == x) ? c : mine; }
        if (sum == G) break;
        __builtin_amdgcn_s_sleep(1);
        if ((++sp & 255u) == 0u) { if (xb_ld(&bar[XB_TMO])) break; if (sp > XB_SPIN_CAP) { atomicAdd(&bar[XB_TMO], 1u); break; } }
    }
    nloc = mine > 0u ? mine : 1u; nx = cnt > 0u ? cnt : 1u;
}
__device__ __forceinline__ void xcd_barrier(const XcdBarrier& b) {
    asm volatile("s_waitcnt vmcnt(0)" ::: "memory");
    __syncthreads();
    if (threadIdx.x == 0) {
        unsigned* bar = b.bar;
        __builtin_amdgcn_s_waitcnt(0);
        unsigned nloc = b.st[0], nx = b.st[1];
        if (nloc == 0u) { xcd_barrier_complete(bar, b.x, nloc, nx); b.st[0] = nloc; b.st[1] = nx; }
        const unsigned old = xb_add(&bar[XB_XSUB(b.x)], 1u);
        const unsigned gen = old / nloc;
        if (old + 1u == (gen + 1u) * nloc) {
            __builtin_amdgcn_fence(__ATOMIC_RELEASE, "agent");
            asm volatile("s_waitcnt vmcnt(0)" ::: "memory");
            const unsigned og = xb_add(&bar[XB_TOP], 1u);
            const unsigned tg = og / nx;
            if (og + 1u == (tg + 1u) * nx) xb_add(&bar[XB_TOPGEN], 1u);
            else XB_SPIN(xb_ld(&bar[XB_TOPGEN]) == tg, bar);
            __builtin_amdgcn_fence(__ATOMIC_ACQUIRE, "agent");
#if !BAR_FLAT_RELEASE
            xb_add(&bar[XB_XGEN(b.x)], 1u);
#endif
            asm volatile("s_waitcnt vmcnt(0)" ::: "memory");
        } else {
#if BAR_FLAT_RELEASE
            XB_SPIN(xb_ld(&bar[XB_TOPGEN]) == gen, bar);
#else
            XB_SPIN(xb_ld(&bar[XB_XGEN(b.x)]) == gen, bar);
#endif
            __builtin_amdgcn_fence(__ATOMIC_ACQUIRE, "agent");
            asm volatile("s_waitcnt vmcnt(0)" ::: "memory");
        }
    }
    __syncthreads();
}

__device__ __forceinline__ float rdlane(float v, int l) { return __builtin_bit_cast(float, __builtin_amdgcn_readlane(__builtin_bit_cast(int, v), l)); }
__device__ __forceinline__ int rdlanei(int v, int l) { return __builtin_amdgcn_readlane(v, l); }
template <int CTRL> __device__ __forceinline__ float dppf(float v) { return __builtin_bit_cast(float, __builtin_amdgcn_mov_dpp(__builtin_bit_cast(int, v), CTRL, 0xF, 0xF, true)); }
template <int CTRL> __device__ __forceinline__ int dppi(int v) { return __builtin_amdgcn_mov_dpp(v, CTRL, 0xF, 0xF, true); }
__device__ __forceinline__ float wave_sum(float v) {
    v += dppf<0xB1>(v); v += dppf<0x4E>(v); v += dppf<0x124>(v); v += dppf<0x128>(v);
    return (rdlane(v, 0) + rdlane(v, 16)) + (rdlane(v, 32) + rdlane(v, 48));
}
__device__ __forceinline__ int wave_sumi(int v) {
    v += dppi<0xB1>(v); v += dppi<0x4E>(v); v += dppi<0x124>(v); v += dppi<0x128>(v);
    return (rdlanei(v, 0) + rdlanei(v, 16)) + (rdlanei(v, 32) + rdlanei(v, 48));
}
__device__ __forceinline__ float wave_max(float v) {
    v = fmaxf(v, dppf<0xB1>(v)); v = fmaxf(v, dppf<0x4E>(v)); v = fmaxf(v, dppf<0x124>(v)); v = fmaxf(v, dppf<0x128>(v));
    return fmaxf(fmaxf(rdlane(v, 0), rdlane(v, 16)), fmaxf(rdlane(v, 32), rdlane(v, 48)));
}

struct Ctx {
    LAS unsigned char* lds;
    int tid, lane, wave, vcu, G, gw, NGW;
};
struct Args { const float* in[N_IN]; float* out; unsigned char* ws; int ph_lo, ph_hi; };
typedef const __attribute__((address_space(4))) Args& KArgs;

template <bool GPERM = false> __device__ __forceinline__ void p0_transpose_item(const float* W, int K, int N, bf16* WT, LAS float* scr, int item, int lane, float scale) {
    const int nblk = N / 32, kb = item / nblk, nb = item % nblk, k0 = 64 * kb, n0 = 32 * nb;
#pragma unroll 8
    for (int i = 0; i < 32; ++i) { const int kk = 2 * i + (lane >> 5); scr[kk * 33 + (lane & 31)] = W[(size_t)(k0 + kk) * N + n0 + (lane & 31)] * scale; }
    LDS_WAIT(); asm volatile("" ::: "memory");
    const int c = lane & 7;
#pragma unroll
    for (int j = 0; j < 4; ++j) { const int n = (lane >> 3) + 8 * j; const LAS float* s = scr + (8 * c) * 33 + n;
        v4u o; o.x = pk2(s[0 * 33], s[1 * 33]); o.y = pk2(s[2 * 33], s[3 * 33]); o.z = pk2(s[4 * 33], s[5 * 33]); o.w = pk2(s[6 * 33], s[7 * 33]);
        int nr = n0 + n; if (GPERM && nr >= 4352) { const int z = (nr - 4352) >> 10, cc = (nr - 4352) & 1023, ch = cc & 63; nr = 4352 + 256 * (cc >> 6) + 64 * (ch >> 4) + 32 * (z >> 1) + 8 * ((ch >> 2) & 3) + 4 * (z & 1) + (ch & 3); }
        *(GAS v4u*)(WT + (size_t)nr * K + k0 + 8 * c) = o; }
    LDS_WAIT(); asm volatile("" ::: "memory");
}

__device__ __forceinline__ void norm_mod_row(int lane, const float* xrow, const float* g, const float* scale, const float* shift, bf16* orow) {
    const f32x4* xr = (const f32x4*)xrow + lane;
    f32x4 v[4]; float s = 0.f;
#pragma unroll
    for (int j = 0; j < 4; ++j) { v[j] = xr[64 * j]; s += (v[j].x * v[j].x + v[j].y * v[j].y) + (v[j].z * v[j].z + v[j].w * v[j].w); }
    const float r = 1.0f / sqrtf(wave_sum(s) * (1.0f / D) + EPS);
    unsigned long long* o8 = (unsigned long long*)orow + lane;
#pragma unroll
    for (int j = 0; j < 4; ++j) {
        const f32x4 gg = ((const f32x4*)g)[lane + 64 * j], sc = ((const f32x4*)scale)[lane + 64 * j], sh = ((const f32x4*)shift)[lane + 64 * j];
        const f32x4 y = (v[j] * r) * gg * (sc + 1.0f) + sh;
        o8[64 * j] = (unsigned long long)pk2(y.x, y.y) | ((unsigned long long)pk2(y.z, y.w) << 32);
    }
}

__device__ __forceinline__ void phase_pre(const Ctx& F, KArgs A) {
    float* mod = (float*)(A.ws + WS_MOD);
    for (int it = F.gw; it < DEPTH * 768; it += F.NGW) {
        const int l = it / 768, j0 = (it % 768) * 8;
        float acc[8][8];
#pragma unroll
        for (int b = 0; b < 8; ++b)
#pragma unroll
            for (int j = 0; j < 8; ++j) acc[b][j] = 0.f;
        for (int i = 0; i < 16; ++i) {
            const int k = F.lane + 64 * i;
            const float* wp = A.in[I_WADA] + ((size_t)l * D + k) * 6144 + j0;
            const f32x4 w0 = *(const f32x4*)wp, w1 = *(const f32x4*)(wp + 4);
#pragma unroll
            for (int b = 0; b < 8; ++b) { const float cv = A.in[I_C][b * D + k]; const float s = cv / (1.0f + __expf(-cv));
                acc[b][0] += s * w0.x; acc[b][1] += s * w0.y; acc[b][2] += s * w0.z; acc[b][3] += s * w0.w;
                acc[b][4] += s * w1.x; acc[b][5] += s * w1.y; acc[b][6] += s * w1.z; acc[b][7] += s * w1.w; }
        }
#pragma unroll
        for (int b = 0; b < 8; ++b) {
            float r[8];
#pragma unroll
            for (int j = 0; j < 8; ++j) r[j] = wave_sum(acc[b][j]);
            if (F.lane == 0) { const float* bp = A.in[I_BADA] + (size_t)l * 6144 + j0; float* mp = mod + ((size_t)l * 8 + b) * 6144 + j0;
                *(f32x4*)mp = (f32x4){r[0] + bp[0], r[1] + bp[1], r[2] + bp[2], r[3] + bp[3]}; *(f32x4*)(mp + 4) = (f32x4){r[4] + bp[4], r[5] + bp[5], r[6] + bp[6], r[7] + bp[7]}; }
        }
    }
    LAS float* scr = (LAS float*)(F.lds + RING_OFF + F.wave * 16384);
    constexpr int I_IN = 16 * 264, I_BR = 8 * 32, I_O = 16 * 32, I_Q = 16 * 64, I_P = 2 * 4;
    constexpr int PER_LAYER = I_IN + 4 * I_BR + I_O + I_Q + 4 * I_P;
    for (int it = F.gw; it < DEPTH * PER_LAYER; it += F.NGW) {
        const int l = it / PER_LAYER; int r = it % PER_LAYER;
        unsigned char* wl = A.ws + WS_W + (size_t)l * W_LAYER;
        if (r < I_IN) { const int n0 = 32 * (r % 264); const float sc = (n0 < 512 || (n0 >= C_DQ && n0 < C_DK)) ? C2 : 1.0f;
            p0_transpose_item<true>(A.in[I_WIN] + (size_t)l * D * NIN, D, NIN, (bf16*)(wl + W_WIN), scr, r, F.lane, sc); continue; }
        r -= I_IN;
        if (r < 4 * I_BR) { const int g = r / I_BR; p0_transpose_item(A.in[I_WBR] + ((size_t)l * 4 + g) * 512 * D, 512, D, (bf16*)(wl + W_WBR) + (size_t)g * D * 512, scr, r % I_BR, F.lane, 1.0f); continue; }
        r -= 4 * I_BR;
        if (r < I_O) { p0_transpose_item(A.in[I_WO] + (size_t)l * D * D, D, D, (bf16*)(wl + W_WO), scr, r, F.lane, 1.0f); continue; }
        r -= I_O;
        if (r < I_Q) { p0_transpose_item(A.in[I_WQ] + (size_t)l * D * 2048, D, 2048, (bf16*)(wl + W_WQ), scr, r, F.lane, 1.0f); continue; }
        r -= I_Q;
        { const int g = r / I_P; p0_transpose_item(A.in[I_WPOOL] + ((size_t)l * 4 + g) * 128 * 128, 128, 128, (bf16*)(wl + W_WP) + (size_t)g * 128 * 128, scr, r % I_P, F.lane, 1.0f); }
    }
    for (int i = F.gw * 64 + F.lane; i < DEPTH * 32768 / 4; i += F.NGW * 64) {
        const int l = i / 8192, e = (i % 8192) * 4;
        const f32x4 v = *(const f32x4*)(A.in[I_SK] + (size_t)l * 32768 + e);
        v2u o; o.x = pk2(v.x, v.y); o.y = pk2(v.z, v.w);
        *(v2u*)((bf16*)(A.ws + WS_W + (size_t)l * W_LAYER + W_SK) + e) = o;
    }
}
__device__ __forceinline__ void phase_h0(const Ctx& F, KArgs A) {
    const float* mod = (const float*)(A.ws + WS_MOD);
#if NORM_FOLD
    {
        float* cq = (float*)(A.ws + WS_CQ);
        for (int it = F.gw; it < DEPTH * 256; it += F.NGW) {
            const int l = it / 256, j0 = (it % 256) * 8;
            float acc[8][8];
#pragma unroll
            for (int b = 0; b < 8; ++b)
#pragma unroll
                for (int j = 0; j < 8; ++j) acc[b][j] = 0.f;
            for (int i = 0; i < 16; ++i) {
                const int k = F.lane + 64 * i;
                const float* wp = A.in[I_WQ] + ((size_t)l * D + k) * 2048 + j0;
                const f32x4 w0 = *(const f32x4*)wp, w1 = *(const f32x4*)(wp + 4);
#pragma unroll
                for (int b = 0; b < 8; ++b) { const float s = mod[((size_t)l * 8 + b) * 6144 + 3072 + k];
                    acc[b][0] += s * w0.x; acc[b][1] += s * w0.y; acc[b][2] += s * w0.z; acc[b][3] += s * w0.w;
                    acc[b][4] += s * w1.x; acc[b][5] += s * w1.y; acc[b][6] += s * w1.z; acc[b][7] += s * w1.w; }
            }
#pragma unroll
            for (int b = 0; b < 8; ++b) {
                float r[8];
#pragma unroll
                for (int j = 0; j < 8; ++j) r[j] = wave_sum(acc[b][j]);
                if (F.lane == 0) { float* cp = cq + ((size_t)l * 8 + b) * 2048 + j0; *(f32x4*)cp = (f32x4){r[0], r[1], r[2], r[3]}; *(f32x4*)(cp + 4) = (f32x4){r[4], r[5], r[6], r[7]}; }
            }
        }
    }
#endif
    bf16* H = (bf16*)(A.ws + WS_H);
    for (int m = F.gw; m < T; m += F.NGW) { const float* mb = mod + (size_t)(m >> 11) * 6144;
        norm_mod_row(F.lane, A.in[I_X] + (size_t)m * D, A.in[I_GN1], mb + 1024, mb, H + (size_t)m * D); }
}
__device__ __forceinline__ void phase_swa_naive(const Ctx& F, KArgs A, int l) {
    const bf16* P = (const bf16*)(A.ws + WS_PROJ); bf16* Y = (bf16*)(A.ws + WS_Y);
    const float* sinks = A.in[I_SINKS] + l * 8;
    for (int it = F.gw; it < T * 8; it += F.NGW) {
        const int t = it >> 3, hq = it & 7, g = hq >> 2, pos = t & (SEQ - 1);
        float q[64];
        { const v4u* qp = (const v4u*)(P + (size_t)t * NPROJ + C_DQ + hq * 64);
#pragma unroll
          for (int i = 0; i < 8; ++i) { const v4u w = qp[i]; q[8 * i] = bflo(w.x); q[8 * i + 1] = bfhi(w.x); q[8 * i + 2] = bflo(w.y); q[8 * i + 3] = bfhi(w.y); q[8 * i + 4] = bflo(w.z); q[8 * i + 5] = bfhi(w.z); q[8 * i + 6] = bflo(w.w); q[8 * i + 7] = bfhi(w.w); } }
        float s[2];
#pragma unroll
        for (int j = 0; j < 2; ++j) { const int kk = F.lane + 64 * j; float a = -1e30f;
            if (pos - kk >= 0) { const v4u* kp = (const v4u*)(P + (size_t)(t - kk) * NPROJ + C_DK + g * 64); a = 0.f;
#pragma unroll
                for (int i = 0; i < 8; ++i) { const v4u w = kp[i]; a += q[8 * i] * bflo(w.x) + q[8 * i + 1] * bfhi(w.x) + q[8 * i + 2] * bflo(w.y) + q[8 * i + 3] * bfhi(w.y) + q[8 * i + 4] * bflo(w.z) + q[8 * i + 5] * bfhi(w.z) + q[8 * i + 6] * bflo(w.w) + q[8 * i + 7] * bfhi(w.w); } }
            s[j] = a; }
        const float sk2 = sinks[hq] * LOG2E;
        const float mx = fmaxf(wave_max(fmaxf(s[0], s[1])), sk2);
        const float p0 = (pos - F.lane >= 0) ? exp2f(s[0] - mx) : 0.f, p1 = (pos - F.lane - 64 >= 0) ? exp2f(s[1] - mx) : 0.f;
        const float den = wave_sum(p0 + p1) + exp2f(sk2 - mx);
        float acc = 0.f;
        const int nk = (pos + 1 < 128) ? pos + 1 : 128;
        const bf16* vp = P + (size_t)t * NPROJ + C_DV + g * 64 + F.lane;
        for (int kk = 0; kk < nk; ++kk) { const float pk = (kk < 64) ? rdlane(p0, kk) : rdlane(p1, kk - 64); acc += pk * bf1(vp[-(long)kk * NPROJ]); }
        Y[(size_t)t * 2048 + 1536 + hq * 64 + F.lane] = (bf16)f2bf(acc / den);
    }
}
__device__ __forceinline__ void phase_conv_naive(const Ctx& F, KArgs A, int l) {
    const bf16* P = (const bf16*)(A.ws + WS_PROJ); bf16* Y = (bf16*)(A.ws + WS_Y);
    const float* cw = A.in[I_CONVW] + (size_t)l * 3 * 512;
    for (int it = F.gw * 64 + F.lane; it < (T / 4) * 64; it += F.NGW * 64) {
        const int t0 = (it >> 6) * 4, c0 = (it & 63) * 8; const bool first = (t0 & (SEQ - 1)) == 0;
        v4u za[6], zb[6], gb[4];
#pragma unroll
        for (int r = 0; r < 6; ++r) { const int row = (first && r < 2) ? t0 : t0 - 2 + r; za[r] = *(const v4u*)(P + (size_t)row * NPROJ + C_BC + c0); zb[r] = *(const v4u*)(P + (size_t)row * NPROJ + C_BX + c0); }
#pragma unroll
        for (int k = 0; k < 4; ++k) gb[k] = *(const v4u*)(P + (size_t)(t0 + k) * NPROJ + C_BB + c0);
        const f32x4 w00 = *(const f32x4*)(cw + c0), w01 = *(const f32x4*)(cw + c0 + 4), w10 = *(const f32x4*)(cw + 512 + c0), w11 = *(const f32x4*)(cw + 512 + c0 + 4), w20 = *(const f32x4*)(cw + 1024 + c0), w21 = *(const f32x4*)(cw + 1024 + c0 + 4);
        float z[6][8];
#pragma unroll
        for (int r = 0; r < 6; ++r) { const float m = (first && r < 2) ? 0.f : 1.f; const v4u a = za[r], b = zb[r];
            z[r][0] = m * bflo(a.x) * bflo(b.x); z[r][1] = m * bfhi(a.x) * bfhi(b.x); z[r][2] = m * bflo(a.y) * bflo(b.y); z[r][3] = m * bfhi(a.y) * bfhi(b.y);
            z[r][4] = m * bflo(a.z) * bflo(b.z); z[r][5] = m * bfhi(a.z) * bfhi(b.z); z[r][6] = m * bflo(a.w) * bflo(b.w); z[r][7] = m * bfhi(a.w) * bfhi(b.w); }
#pragma unroll
        for (int k = 0; k < 4; ++k) { const v4u g = gb[k];
            const float bb[8] = {bflo(g.x), bfhi(g.x), bflo(g.y), bfhi(g.y), bflo(g.z), bfhi(g.z), bflo(g.w), bfhi(g.w)};
            float y[8];
#pragma unroll
            for (int e = 0; e < 4; ++e) { y[e] = bb[e] * (w00[e] * z[k][e] + w10[e] * z[k + 1][e] + w20[e] * z[k + 2][e]); y[4 + e] = bb[4 + e] * (w01[e] * z[k][4 + e] + w11[e] * z[k + 1][4 + e] + w21[e] * z[k + 2][4 + e]); }
            v4u o; o.x = pk2(y[0], y[1]); o.y = pk2(y[2], y[3]); o.z = pk2(y[4], y[5]); o.w = pk2(y[6], y[7]);
            *(v4u*)(Y + (size_t)(t0 + k) * 2048 + 512 + c0) = o; }
    }
}
__device__ __forceinline__ void phase_pool_naive(const Ctx& F, KArgs A, int l) {
    const bf16* P = (const bf16*)(A.ws + WS_PROJ); bf16* Y = (bf16*)(A.ws + WS_Y);
    for (int it = F.gw; it < T * 4; it += F.NGW) {
        const int t = it >> 2, g = it & 3, w = 2 << g, pos = t & (SEQ - 1), cnt = (pos + 1 < w) ? pos + 1 : w;
        float d[2];
#pragma unroll
        for (int j = 0; j < 2; ++j) { const bf16* zp = P + (size_t)t * NPROJ + C_CZ + g * 128 + F.lane + 64 * j; float s = 0.f;
            for (int i = 0; i < cnt; ++i) s += bf1(zp[-(long)i * NPROJ]);
            d[j] = s / (float)cnt - bf1(zp[0]); }
        const float* wp = A.in[I_WPOOL] + ((size_t)l * 4 + g) * 128 * 128;
        float y0 = 0.f, y1 = 0.f;
        for (int c = 0; c < 64; ++c) { const float dc = rdlane(d[0], c); y0 += dc * wp[c * 128 + F.lane]; y1 += dc * wp[c * 128 + 64 + F.lane]; }
        for (int c = 0; c < 64; ++c) { const float dc = rdlane(d[1], c); y0 += dc * wp[(64 + c) * 128 + F.lane]; y1 += dc * wp[(64 + c) * 128 + 64 + F.lane]; }
        const float* ps = A.in[I_PSCALE] + (size_t)l * 512 + g * 128;
        Y[(size_t)t * 2048 + 1024 + g * 128 + F.lane] = (bf16)f2bf(y0 * ps[F.lane]);
        Y[(size_t)t * 2048 + 1024 + g * 128 + 64 + F.lane] = (bf16)f2bf(y1 * ps[64 + F.lane]);
    }
}
typedef float f32x16s __attribute__((ext_vector_type(16)));
typedef short bf16x8s __attribute__((ext_vector_type(8)));
__device__ __forceinline__ void phase_swa(const Ctx& F, KArgs A, int l) {
    const bf16* P = (const bf16*)(A.ws + WS_PROJ); bf16* Y = (bf16*)(A.ws + WS_Y);
    const float* sinks = A.in[I_SINKS] + l * 8;
    const int qi = F.lane & 31, kh = F.lane >> 5;
    for (int u = F.gw; u < (T / 32) * 8; u += F.NGW) {
        const int tq = u >> 3, hq = u & 7, g = hq >> 2, t0 = tq * 32, p0 = t0 & (SEQ - 1);
        bf16x8s qf[4];
        { const bf16* qp = P + (size_t)(t0 + qi) * NPROJ + C_DQ + hq * 64 + 8 * kh;
#pragma unroll
          for (int s = 0; s < 4; ++s) qf[s] = *(const bf16x8s*)(qp + 16 * s); }
        f32x16s acc[5];
#pragma unroll
        for (int kt = 0; kt < 5; ++kt) {
            int kr = t0 - 128 + 32 * kt + qi; if (p0 - 128 + 32 * kt + qi < 0) kr = t0;
            const bf16* kp = P + (size_t)kr * NPROJ + C_DK + g * 64 + 8 * kh;
            f32x16s c = (f32x16s){0.f, 0.f, 0.f, 0.f, 0.f, 0.f, 0.f, 0.f, 0.f, 0.f, 0.f, 0.f, 0.f, 0.f, 0.f, 0.f};
#pragma unroll
            for (int s = 0; s < 4; ++s) c = __builtin_amdgcn_mfma_f32_32x32x16_bf16(*(const bf16x8s*)(kp + 16 * s), qf[s], c, 0, 0, 0);
            acc[kt] = c;
        }
        const float sk2 = sinks[hq] * LOG2E;
        float m = sk2;
#pragma unroll
        for (int kt = 0; kt < 5; ++kt)
#pragma unroll
            for (int r = 0; r < 16; ++r) { const int koff = (r & 3) + 8 * (r >> 2) + 4 * kh, rel = qi + 128 - 32 * kt - koff;
                const bool valid = (rel >= 0) && (rel < 128) && (p0 - 128 + 32 * kt + koff >= 0);
                acc[kt][r] = valid ? acc[kt][r] : -1e30f; m = fmaxf(m, acc[kt][r]); }
        m = fmaxf(m, __shfl_xor(m, 32));
        float ls = 0.f;
#pragma unroll
        for (int kt = 0; kt < 5; ++kt)
#pragma unroll
            for (int r = 0; r < 16; ++r) { const float pv = exp2f(acc[kt][r] - m); acc[kt][r] = pv; ls += pv; }
        ls += __shfl_xor(ls, 32); ls += exp2f(sk2 - m);
        f32x16s o[2];
        o[0] = (f32x16s){0.f, 0.f, 0.f, 0.f, 0.f, 0.f, 0.f, 0.f, 0.f, 0.f, 0.f, 0.f, 0.f, 0.f, 0.f, 0.f}; o[1] = o[0];
#pragma unroll
        for (int kt = 0; kt < 5; ++kt)
#pragma unroll
            for (int s2 = 0; s2 < 2; ++s2) {
                v4u bw; bw.x = pk2(acc[kt][8 * s2 + 0], acc[kt][8 * s2 + 1]); bw.y = pk2(acc[kt][8 * s2 + 2], acc[kt][8 * s2 + 3]); bw.z = pk2(acc[kt][8 * s2 + 4], acc[kt][8 * s2 + 5]); bw.w = pk2(acc[kt][8 * s2 + 6], acc[kt][8 * s2 + 7]);
                const bf16x8s bfr = __builtin_bit_cast(bf16x8s, bw);
                int vr0 = t0 - 128 + 32 * kt + 16 * s2 + 4 * kh; const bool pre = (p0 - 128 + 32 * kt + 16 * s2 + 4 * kh < 0);
                int vr1 = vr0 + 8; const bool pre1 = (p0 - 128 + 32 * kt + 16 * s2 + 4 * kh + 8 < 0);
                if (pre) vr0 = t0; if (pre1) vr1 = t0;
#pragma unroll
                for (int mt = 0; mt < 2; ++mt) {
                    const bf16* v0 = P + (size_t)vr0 * NPROJ + C_DV + g * 64 + 32 * mt + qi; const bf16* v1 = P + (size_t)vr1 * NPROJ + C_DV + g * 64 + 32 * mt + qi;
                    v4u aw; aw.x = (unsigned)v0[0] | ((unsigned)v0[NPROJ] << 16); aw.y = (unsigned)v0[2 * NPROJ] | ((unsigned)v0[3 * NPROJ] << 16);
                    aw.z = (unsigned)v1[0] | ((unsigned)v1[NPROJ] << 16); aw.w = (unsigned)v1[2 * NPROJ] | ((unsigned)v1[3 * NPROJ] << 16);
                    o[mt] = __builtin_amdgcn_mfma_f32_32x32x16_bf16(__builtin_bit_cast(bf16x8s, aw), bfr, o[mt], 0, 0, 0);
                }
            }
        const float rl = 1.0f / ls;
        bf16* yp = Y + (size_t)(t0 + qi) * 2048 + 1536 + hq * 64 + 4 * kh;
#pragma unroll
        for (int mt = 0; mt < 2; ++mt)
#pragma unroll
            for (int q = 0; q < 4; ++q) { v2u w; w.x = pk2(o[mt][4 * q] * rl, o[mt][4 * q + 1] * rl); w.y = pk2(o[mt][4 * q + 2] * rl, o[mt][4 * q + 3] * rl);
                *(v2u*)(yp + 32 * mt + 8 * q) = w; }
    }
}
typedef short s16x4s __attribute__((ext_vector_type(4)));
__device__ __forceinline__ void phase_swa2(const Ctx& F, KArgs A, int l) {
    const bf16* P = (const bf16*)(A.ws + WS_PROJ); bf16* Y = (bf16*)(A.ws + WS_Y);
    const float* sinks = A.in[I_SINKS] + l * 8;
    constexpr int RS = 272, VOFF = 160 * RS;
    LAS unsigned char* kb = F.lds + RING_OFF; LAS unsigned char* vb = kb + VOFF;
    const int qi = F.lane & 31, kh = F.lane >> 5, hq = F.wave, g = hq >> 2;
    for (int tq = F.vcu; tq < T / 32; tq += F.G) {
        const int t0 = tq * 32, p0 = t0 & (SEQ - 1);
        __syncthreads();
#pragma unroll
        for (int c = 0; c < 5; ++c) { const int chunk = F.tid + 512 * c, row = chunk >> 4, ch = chunk & 15;
            const int gr = (p0 - 128 + row < 0) ? t0 : t0 - 128 + row;
            const v4u kv = *(const v4u*)(P + (size_t)gr * NPROJ + C_DK + ch * 8), vv = *(const v4u*)(P + (size_t)gr * NPROJ + C_DV + ch * 8);
            *(LAS v4u*)(kb + row * RS + ch * 16) = kv; *(LAS v4u*)(vb + row * RS + ch * 16) = vv; }
        bf16x8s qf[4];
        { const bf16* qp = P + (size_t)(t0 + qi) * NPROJ + C_DQ + hq * 64 + 8 * kh;
#pragma unroll
          for (int s = 0; s < 4; ++s) qf[s] = *(const bf16x8s*)(qp + 16 * s); }
        __syncthreads();
        f32x16s acc[5];
#pragma unroll
        for (int kt = 0; kt < 5; ++kt) {
            const LAS unsigned char* kp = kb + (32 * kt + qi) * RS + g * 128 + 16 * kh;
            f32x16s c = (f32x16s){0.f, 0.f, 0.f, 0.f, 0.f, 0.f, 0.f, 0.f, 0.f, 0.f, 0.f, 0.f, 0.f, 0.f, 0.f, 0.f};
#pragma unroll
            for (int s = 0; s < 4; ++s) c = __builtin_amdgcn_mfma_f32_32x32x16_bf16(*(const LAS bf16x8s*)(kp + 32 * s), qf[s], c, 0, 0, 0);
            acc[kt] = c;
        }
        const float sk2 = sinks[hq] * LOG2E;
        float m = sk2;
#pragma unroll
        for (int kt = 0; kt < 5; ++kt)
#pragma unroll
            for (int r = 0; r < 16; ++r) { const int koff = (r & 3) + 8 * (r >> 2) + 4 * kh, rel = qi + 128 - 32 * kt - koff;
                const bool valid = (rel >= 0) && (rel < 128) && (p0 - 128 + 32 * kt + koff >= 0);
                acc[kt][r] = valid ? acc[kt][r] : -1e30f; m = fmaxf(m, acc[kt][r]); }
        m = fmaxf(m, __shfl_xor(m, 32));
        float ls = 0.f;
#pragma unroll
        for (int kt = 0; kt < 5; ++kt)
#pragma unroll
            for (int r = 0; r < 16; ++r) { const float pv = exp2f(acc[kt][r] - m); acc[kt][r] = pv; ls += pv; }
        ls += __shfl_xor(ls, 32); ls += exp2f(sk2 - m);
        f32x16s o[2];
        o[0] = (f32x16s){0.f, 0.f, 0.f, 0.f, 0.f, 0.f, 0.f, 0.f, 0.f, 0.f, 0.f, 0.f, 0.f, 0.f, 0.f, 0.f}; o[1] = o[0];
        const LAS unsigned char* vl = vb + (4 * kh + ((F.lane & 15) >> 2)) * RS + (g * 64 + 16 * ((F.lane >> 4) & 1) + 4 * (F.lane & 3)) * 2;
#pragma unroll
        for (int kt = 0; kt < 5; ++kt)
#pragma unroll
            for (int s2 = 0; s2 < 2; ++s2) {
                v4u bw; bw.x = pk2(acc[kt][8 * s2 + 0], acc[kt][8 * s2 + 1]); bw.y = pk2(acc[kt][8 * s2 + 2], acc[kt][8 * s2 + 3]); bw.z = pk2(acc[kt][8 * s2 + 4], acc[kt][8 * s2 + 5]); bw.w = pk2(acc[kt][8 * s2 + 6], acc[kt][8 * s2 + 7]);
                const bf16x8s bfr = __builtin_bit_cast(bf16x8s, bw);
#pragma unroll
                for (int mt = 0; mt < 2; ++mt) {
                    const LAS unsigned char* va = vl + (32 * kt + 16 * s2) * RS + 64 * mt;
                    const s16x4s lo = __builtin_bit_cast(s16x4s, __builtin_amdgcn_ds_read_tr16_b64_v4i16((LAS s16x4s*)va));
                    const s16x4s hi = __builtin_bit_cast(s16x4s, __builtin_amdgcn_ds_read_tr16_b64_v4i16((LAS s16x4s*)(va + 8 * RS)));
                    const bf16x8s afr = (bf16x8s){lo[0], lo[1], lo[2], lo[3], hi[0], hi[1], hi[2], hi[3]};
                    o[mt] = __builtin_amdgcn_mfma_f32_32x32x16_bf16(afr, bfr, o[mt], 0, 0, 0);
                }
            }
        const float rl = 1.0f / ls;
        bf16* yp = Y + (size_t)(t0 + qi) * 2048 + 1536 + hq * 64 + 4 * kh;
#pragma unroll
        for (int mt = 0; mt < 2; ++mt)
#pragma unroll
            for (int q = 0; q < 4; ++q) { v2u w; w.x = pk2(o[mt][4 * q] * rl, o[mt][4 * q + 1] * rl); w.y = pk2(o[mt][4 * q + 2] * rl, o[mt][4 * q + 3] * rl);
                *(v2u*)(yp + 32 * mt + 8 * q) = w; }
    }
    __syncthreads();
}
__device__ __forceinline__ void phase_pool(const Ctx& F, KArgs A, int l) {
    const bf16* P = (const bf16*)(A.ws + WS_PROJ); bf16* Y = (bf16*)(A.ws + WS_Y);
    const bf16* WP = (const bf16*)(A.ws + WS_W + (size_t)l * W_LAYER + W_WP);
    const int ti = F.lane & 31, kh = F.lane >> 5;
    for (int u = F.gw; u < (T / 32) * 4; u += F.NGW) {
        const int tq = u >> 2, g = u & 3, w = 2 << g, t = tq * 32 + ti, pos = t & (SEQ - 1), cnt = (pos + 1 < w) ? pos + 1 : w;
        const float rc = 1.0f / (float)cnt;
        f32x16s acc[4];
#pragma unroll
        for (int mt = 0; mt < 4; ++mt) acc[mt] = (f32x16s){0.f, 0.f, 0.f, 0.f, 0.f, 0.f, 0.f, 0.f, 0.f, 0.f, 0.f, 0.f, 0.f, 0.f, 0.f, 0.f};
        for (int s = 0; s < 8; ++s) {
            const bf16* zp = P + (size_t)t * NPROJ + C_CZ + g * 128 + 16 * s + 8 * kh;
            float sum[8];
#pragma unroll
            for (int e = 0; e < 8; ++e) sum[e] = 0.f;
            auto win = [&](auto WC) { constexpr int W = decltype(WC)::value; v4u zw[W];
#pragma unroll
                for (int i = 0; i < W; ++i) zw[i] = *(const v4u*)(zp - (size_t)((i < cnt) ? i : 0) * NPROJ);
#pragma unroll
                for (int i = 0; i < W; ++i) { const float m = (i < cnt) ? 1.0f : 0.0f;
                    sum[0] += m * bflo(zw[i].x); sum[1] += m * bfhi(zw[i].x); sum[2] += m * bflo(zw[i].y); sum[3] += m * bfhi(zw[i].y); sum[4] += m * bflo(zw[i].z); sum[5] += m * bfhi(zw[i].z); sum[6] += m * bflo(zw[i].w); sum[7] += m * bfhi(zw[i].w); } };
            if (g == 0) win(std::integral_constant<int, 2>{}); else if (g == 1) win(std::integral_constant<int, 4>{}); else if (g == 2) win(std::integral_constant<int, 8>{}); else win(std::integral_constant<int, 16>{});
            bf16x8s afr[4];
#pragma unroll
            for (int mt = 0; mt < 4; ++mt) afr[mt] = *(const bf16x8s*)(WP + ((size_t)g * 128 + 32 * mt + ti) * 128 + 16 * s + 8 * kh);
            const v4u z0 = *(const v4u*)zp;
            v4u dw; dw.x = pk2(sum[0] * rc - bflo(z0.x), sum[1] * rc - bfhi(z0.x)); dw.y = pk2(sum[2] * rc - bflo(z0.y), sum[3] * rc - bfhi(z0.y));
            dw.z = pk2(sum[4] * rc - bflo(z0.z), sum[5] * rc - bfhi(z0.z)); dw.w = pk2(sum[6] * rc - bflo(z0.w), sum[7] * rc - bfhi(z0.w));
            const bf16x8s bfr = __builtin_bit_cast(bf16x8s, dw);
            asm volatile("" : "+v"(afr[0]), "+v"(afr[1]), "+v"(afr[2]), "+v"(afr[3]));
#pragma unroll
            for (int mt = 0; mt < 4; ++mt) acc[mt] = __builtin_amdgcn_mfma_f32_32x32x16_bf16(afr[mt], bfr, acc[mt], 0, 0, 0);
        }
        const float* ps = A.in[I_PSCALE] + (size_t)l * 512 + g * 128;
        bf16* yp = Y + (size_t)t * 2048 + 1024 + g * 128 + 4 * kh;
#pragma unroll
        for (int hb = 0; hb < 2; ++hb) {
            f32x4 scv[8];
#pragma unroll
            for (int i = 0; i < 8; ++i) scv[i] = *(const f32x4*)(ps + 32 * (2 * hb + (i >> 2)) + 8 * (i & 3) + 4 * kh);
#pragma unroll
            for (int m2 = 0; m2 < 2; ++m2)
#pragma unroll
                for (int q = 0; q < 4; ++q) { const int mt = 2 * hb + m2; const f32x4 sc = scv[4 * m2 + q];
                    v2u wv; wv.x = pk2(acc[mt][4 * q] * sc.x, acc[mt][4 * q + 1] * sc.y); wv.y = pk2(acc[mt][4 * q + 2] * sc.z, acc[mt][4 * q + 3] * sc.w);
                    *(v2u*)(yp + 32 * mt + 8 * q) = wv; } }
    }
}
__device__ __forceinline__ void phase_ya(const Ctx& F, KArgs A, int l) {
    const bf16* O = (const bf16*)(A.ws + WS_O); bf16* Y = (bf16*)(A.ws + WS_Y);
    const float lam_init = (l == 0) ? 0.2f : (0.8f - 0.6f * 0.7408182206817179f);
    const float d1 = wave_sum(A.in[I_LQ1][l * 64 + F.lane] * A.in[I_LK1][l * 64 + F.lane]);
    const float d2 = wave_sum(A.in[I_LQ2][l * 64 + F.lane] * A.in[I_LK2][l * 64 + F.lane]);
    const float lam = expf(d1) - expf(d2) + lam_init;
    const int sub = F.lane & 15, grp = F.lane >> 4;
    float gs[8];
#pragma unroll
    for (int e = 0; e < 8; ++e) gs[e] = A.in[I_GSUB][l * 128 + 8 * sub + e] * (1.0f - lam_init);
    static_assert(T % (4 * 256 * NWAVES) == 0, "phase_ya: 4 tokens per trip");
    for (int it0 = F.gw; it0 < T; it0 += 4 * F.NGW) {
        v4u av[4], bv[4];
#pragma unroll
        for (int j = 0; j < 4; ++j) { const int t = it0 + j * F.NGW; av[j] = *(const v4u*)(O + (size_t)t * 1024 + grp * 256 + 8 * sub); bv[j] = *(const v4u*)(O + (size_t)t * 1024 + grp * 256 + 128 + 8 * sub); }
#pragma unroll
      for (int j = 0; j < 4; ++j) {
        const int t = it0 + j * F.NGW, h = grp; const v4u a = av[j], b = bv[j];
        float y[8] = {bflo(a.x) - lam * bflo(b.x), bfhi(a.x) - lam * bfhi(b.x), bflo(a.y) - lam * bflo(b.y), bfhi(a.y) - lam * bfhi(b.y), bflo(a.z) - lam * bflo(b.z), bfhi(a.z) - lam * bfhi(b.z), bflo(a.w) - lam * bflo(b.w), bfhi(a.w) - lam * bfhi(b.w)};
        float ss = 0.f;
#pragma unroll
        for (int e = 0; e < 8; ++e) ss += y[e] * y[e];
        ss += __shfl_xor(ss, 1); ss += __shfl_xor(ss, 2); ss += __shfl_xor(ss, 4); ss += __shfl_xor(ss, 8);
        const float r = 1.0f / sqrtf(ss * (1.0f / 128.0f) + EPS);
        v4u o; o.x = pk2(y[0] * r * gs[0], y[1] * r * gs[1]); o.y = pk2(y[2] * r * gs[2], y[3] * r * gs[3]); o.z = pk2(y[4] * r * gs[4], y[5] * r * gs[5]); o.w = pk2(y[6] * r * gs[6], y[7] * r * gs[7]);
        *(v4u*)(Y + (size_t)t * 2048 + h * 128 + 8 * sub) = o;
      }
    }
}
__device__ __forceinline__ void expert_quant(KArgs A, int l, int lane, int w, int nw) {
    const float* ue = A.in[I_UE] + (size_t)l * 16384 * 1024; const float* ve = A.in[I_VE] + (size_t)l * 16384 * 1024;
    for (int r = w; r < 2 * 16384; r += nw) {
        const bool isv = r >= 16384; const int row = isv ? r - 16384 : r; const float* src = (isv ? ve : ue) + (size_t)row * 1024 + 8 * lane;
        const f32x4 a0 = *(const f32x4*)src, a1 = *(const f32x4*)(src + 4), b0 = *(const f32x4*)(src + 512), b1 = *(const f32x4*)(src + 516);
        float am = 0.f;
#pragma unroll
        for (int e = 0; e < 4; ++e) am = fmaxf(fmaxf(am, fmaxf(fabsf(a0[e]), fabsf(a1[e]))), fmaxf(fabsf(b0[e]), fabsf(b1[e])));
        am = wave_max(am);
#if EXP6B
        { const float inv6 = am > 0.f ? 31.0f / am : 0.f; unsigned X0 = 0, X1 = 0, Y = 0;
#pragma unroll
          for (int i = 0; i < 4; ++i) {
              const unsigned u0 = (unsigned)((int)rintf(a0[i] * inv6) + 32), u2 = (unsigned)((int)rintf(b0[i] * inv6) + 32);
              const unsigned s1 = (unsigned)(int)rintf(a1[i] * inv6) & 63u, s3 = (unsigned)(int)rintf(b1[i] * inv6) & 63u;
              X0 |= ((u0 & 15u) | ((s1 >> 2) << 4)) << (8 * i); X1 |= ((u2 & 15u) | ((s3 >> 2) << 4)) << (8 * i);
              Y |= (((u0 >> 4) << 4) | ((s1 & 3u) << 2) | ((u2 >> 4) << 6) | (s3 & 3u)) << (8 * i); }
          unsigned char* dst = A.ws + (isv ? WS_VE : WS_UE) + (size_t)row * 768;
          *(unsigned long long*)(dst + 8 * lane) = (unsigned long long)X0 | ((unsigned long long)X1 << 32); *(unsigned*)(dst + 512 + 4 * lane) = Y;
          if (lane == 0) ((float*)(A.ws + (isv ? WS_VS : WS_US)))[row] = am * (1.0f / 31.0f);
          continue; }
#endif
        const float inv = am > 0.f ? 127.0f / am : 0.f; const int bias = (isv && !V_MFMA) ? 128 : 0;
        unsigned o[4];
#pragma unroll
        for (int wd = 0; wd < 4; ++wd) { const f32x4 v = wd == 0 ? a0 : wd == 1 ? a1 : wd == 2 ? b0 : b1; unsigned x = 0;
#pragma unroll
            for (int e = 0; e < 4; ++e) x |= ((unsigned)((int)rintf(v[e] * inv) + bias) & 255u) << (8 * e);
            o[wd] = x; }
        *(v4u*)(A.ws + (isv ? WS_VE : WS_UE) + (size_t)row * 1024 + 16 * lane) = (v4u){o[0], o[1], o[2], o[3]};
        if (lane == 0) ((float*)(A.ws + (isv ? WS_VS : WS_US)))[row] = am * (1.0f / 127.0f);
    }
}
__device__ __forceinline__ void phase_h2(const Ctx& F, KArgs A, int l) {
    const float* mod = (const float*)(A.ws + WS_MOD) + (size_t)l * 8 * 6144;
    bf16* H = (bf16*)(A.ws + WS_H);
    for (int m = F.gw; m < T; m += F.NGW) { const float* mb = mod + (size_t)(m >> 11) * 6144;
        norm_mod_row(F.lane, A.out + (size_t)m * D, A.in[I_GN2] + (size_t)l * D, mb + 4096, mb + 3072, H + (size_t)m * D); }
#if DBG_ROUTE32
    {
        bf16* H3 = (bf16*)(A.ws + WS_H3);
        for (int m = F.gw; m < T; m += F.NGW) { const float* mb = mod + (size_t)(m >> 11) * 6144;
            const f32x4* xr = (const f32x4*)(A.out + (size_t)m * D) + F.lane; f32x4 v[4]; float s = 0.f;
#pragma unroll
            for (int j = 0; j < 4; ++j) { v[j] = xr[64 * j]; s += (v[j].x * v[j].x + v[j].y * v[j].y) + (v[j].z * v[j].z + v[j].w * v[j].w); }
            const float r = 1.0f / sqrtf(wave_sum(s) * (1.0f / D) + EPS);
#pragma unroll
            for (int j = 0; j < 4; ++j) {
                const f32x4 gg = ((const f32x4*)(A.in[I_GN2] + (size_t)l * D))[F.lane + 64 * j], sc = ((const f32x4*)(mb + 4096))[F.lane + 64 * j], sh = ((const f32x4*)(mb + 3072))[F.lane + 64 * j];
                const f32x4 y = (v[j] * r) * gg * (sc + 1.0f) + sh;
                unsigned hi[4], lo[4];
#pragma unroll
                for (int e = 0; e < 4; ++e) { hi[e] = f2bf(y[e]); lo[e] = f2bf(y[e] - __builtin_bit_cast(float, hi[e] << 16)); }
                const unsigned long long hw = (unsigned long long)(hi[0] | (hi[1] << 16)) | ((unsigned long long)(hi[2] | (hi[3] << 16)) << 32);
                const unsigned long long lw = (unsigned long long)(lo[0] | (lo[1] << 16)) | ((unsigned long long)(lo[2] | (lo[3] << 16)) << 32);
                unsigned long long* o8 = (unsigned long long*)(H3 + (size_t)m * 3072) + F.lane + 64 * j;
                o8[0] = hw; o8[256] = hw; o8[512] = lw;
            } }
        bf16* W3 = (bf16*)(A.ws + WS_WQ3); const float* W = A.in[I_WQ] + (size_t)l * D * 2048;
        for (size_t i = (size_t)F.gw * 64 + F.lane; i < (size_t)2048 * 1024; i += (size_t)F.NGW * 64) { const int n = (int)(i >> 10), k = (int)(i & 1023);
            const float w = W[(size_t)k * 2048 + n]; const unsigned hi = f2bf(w), lo = f2bf(w - __builtin_bit_cast(float, hi << 16));
            W3[(size_t)n * 3072 + k] = (bf16)hi; W3[(size_t)n * 3072 + 1024 + k] = (bf16)lo; W3[(size_t)n * 3072 + 2048 + k] = (bf16)hi; }
    }
}
__device__ __forceinline__ void phase_expert_convert(const Ctx& F, KArgs A, int l) {
#else
#endif
    const float* ue = A.in[I_UE] + (size_t)l * 16384 * 1024; const float* ve = A.in[I_VE] + (size_t)l * 16384 * 1024;
#if EXP_I8_OWN
    return;
#endif
    bf16* UE = (bf16*)(A.ws + WS_UE); bf16* VE = (bf16*)(A.ws + WS_VE);
    for (size_t i = (size_t)F.gw * 64 + F.lane; i < (size_t)2 * 16384 * 1024 / 8; i += (size_t)F.NGW * 64) {
        const bool isv = i >= (size_t)16384 * 1024 / 8; const size_t e = (isv ? i - (size_t)16384 * 1024 / 8 : i) * 8;
        const float* src = (isv ? ve : ue) + e; const f32x4 a = *(const f32x4*)src, b = *(const f32x4*)(src + 4);
        v4u o; o.x = pk2(a.x, a.y); o.y = pk2(a.z, a.w); o.z = pk2(b.x, b.y); o.w = pk2(b.z, b.w);
        *(v4u*)((isv ? VE : UE) + e) = o;
    }
}
__device__ __forceinline__ void phase_route_naive(const Ctx& F, KArgs A, int l) {
#if DBG_ROUTE32
    const float* Q32 = (const float*)(A.ws + WS_Q32); const float* SKF = A.in[I_SK] + (size_t)l * 32768;
#else
    const bf16* Q2 = (const bf16*)(A.ws + WS_Q2); const bf16* SK = (const bf16*)(A.ws + WS_W + (size_t)l * W_LAYER + W_SK);
#endif
    int* IDX = (int*)(A.ws + WS_IDX); float* WTS = (float*)(A.ws + WS_WTS);
    for (int it = F.gw; it < T * 8; it += F.NGW) {
        const int t = it >> 3, hh = it & 7;
        float ts[2]; int ti[2];
#pragma unroll
        for (int p = 0; p < 2; ++p) {
#if DBG_ROUTE32
            const float* qp = Q32 + (size_t)t * 2048 + hh * 256 + p * 128;
            const float* ka = SKF + ((size_t)p * 128 + F.lane) * 128; const float* kb = ka + 64 * 128;
            float sa = 0.f, sb = 0.f;
            for (int i = 0; i < 32; ++i) { const f32x4 qv = *(const f32x4*)(qp + 4 * i), av = *(const f32x4*)(ka + 4 * i), bv = *(const f32x4*)(kb + 4 * i);
                sa += qv.x * av.x + qv.y * av.y + qv.z * av.z + qv.w * av.w; sb += qv.x * bv.x + qv.y * bv.y + qv.z * bv.z + qv.w * bv.w; }
#else
            const bf16* qp = Q2 + (size_t)t * 2048 + hh * 256 + p * 128;
            const bf16* ka = SK + ((size_t)p * 128 + F.lane) * 128; const bf16* kb = ka + 64 * 128;
            float sa = 0.f, sb = 0.f;
            for (int i = 0; i < 16; ++i) { const v4u qw = *(const v4u*)(qp + 8 * i), aw = *(const v4u*)(ka + 8 * i), bw = *(const v4u*)(kb + 8 * i);
                sa += bflo(qw.x) * bflo(aw.x) + bfhi(qw.x) * bfhi(aw.x) + bflo(qw.y) * bflo(aw.y) + bfhi(qw.y) * bfhi(aw.y) + bflo(qw.z) * bflo(aw.z) + bfhi(qw.z) * bfhi(aw.z) + bflo(qw.w) * bflo(aw.w) + bfhi(qw.w) * bfhi(aw.w);
                sb += bflo(qw.x) * bflo(bw.x) + bfhi(qw.x) * bfhi(bw.x) + bflo(qw.y) * bflo(bw.y) + bfhi(qw.y) * bfhi(bw.y) + bflo(qw.z) * bflo(bw.z) + bfhi(qw.z) * bfhi(bw.z) + bflo(qw.w) * bflo(bw.w) + bfhi(qw.w) * bfhi(bw.w); }
#endif
            float tsv = 0.f; int tiv = 0;
            for (int r = 0; r < 16; ++r) {
                const float m = wave_max(fmaxf(sa, sb));
                const unsigned long long ba = __ballot(sa == m), bb = __ballot(sb == m);
                int idx;
                if (ba) { const int ln = __ffsll((long long)ba) - 1; idx = ln; if (F.lane == ln) sa = -3.0e38f; }
                else { const int ln = __ffsll((long long)bb) - 1; idx = 64 + ln; if (F.lane == ln) sb = -3.0e38f; }
                if (F.lane == r) { tsv = m; tiv = idx; }
            }
            ts[p] = tsv; ti[p] = tiv;
        }
        float cv[4];
#pragma unroll
        for (int k = 0; k < 4; ++k) cv[k] = __shfl(ts[0], (F.lane >> 4) + 4 * k) + __shfl(ts[1], F.lane & 15);
        float bs = 0.f; int bid = 0;
        for (int r = 0; r < 16; ++r) {
            const float m = wave_max(fmaxf(fmaxf(cv[0], cv[1]), fmaxf(cv[2], cv[3])));
            int id = -1;
#pragma unroll
            for (int k = 0; k < 4; ++k) { const unsigned long long bk = __ballot(cv[k] == m);
                if (id < 0 && bk) { const int ln = __ffsll((long long)bk) - 1; id = ln + 64 * k; if (F.lane == ln) cv[k] = -3.0e38f; } }
            if (F.lane == r) { bs = m; bid = id; }
        }
        const int ei = __shfl(ti[0], bid >> 4) * 128 + __shfl(ti[1], bid & 15);
        const float m0 = __shfl(bs, 0);
        const float e = (F.lane < 16) ? expf(bs - m0) : 0.f;
        const float den = wave_sum(e);
        if (F.lane < 16) { IDX[(size_t)t * 128 + hh * 16 + F.lane] = ei; WTS[(size_t)t * 128 + hh * 16 + F.lane] = e / den; }
    }
}
typedef float f32x16r __attribute__((ext_vector_type(16)));
typedef short bf16x8r __attribute__((ext_vector_type(8)));
__device__ __forceinline__ unsigned srt_key(float f) { const unsigned u = __builtin_bit_cast(unsigned, f); return u ^ ((unsigned)((int)u >> 31) | 0x80000000u); }
__device__ __forceinline__ float srt_val(unsigned k) { const unsigned u = (k & 0x80000000u) ? (k ^ 0x80000000u) : ~k; return __builtin_bit_cast(float, u); }
#define INS16(L, x) do { unsigned x_ = (x); _Pragma("unroll") for (int k_ = 0; k_ < 16; ++k_) { const unsigned h_ = L[k_] > x_ ? L[k_] : x_; x_ = L[k_] > x_ ? x_ : L[k_]; L[k_] = h_; } } while (0)
#if ROUTE_SORTNET
#define CE_(a, b) do { const unsigned h_ = (a) > (b) ? (a) : (b); (b) = (a) > (b) ? (b) : (a); (a) = h_; } while (0)
__device__ __forceinline__ void sort16_desc(unsigned (&v)[16]) { CE_(v[0], v[1]); CE_(v[2], v[3]); CE_(v[0], v[2]); CE_(v[1], v[3]); CE_(v[1], v[2]); CE_(v[4], v[5]); CE_(v[6], v[7]); CE_(v[4], v[6]); CE_(v[5], v[7]); CE_(v[5], v[6]); CE_(v[0], v[4]); CE_(v[2], v[6]); CE_(v[2], v[4]); CE_(v[1], v[5]); CE_(v[3], v[7]); CE_(v[3], v[5]); CE_(v[1], v[2]); CE_(v[3], v[4]); CE_(v[5], v[6]); CE_(v[8], v[9]); CE_(v[10], v[11]); CE_(v[8], v[10]); CE_(v[9], v[11]); CE_(v[9], v[10]); CE_(v[12], v[13]); CE_(v[14], v[15]); CE_(v[12], v[14]); CE_(v[13], v[15]); CE_(v[13], v[14]); CE_(v[8], v[12]); CE_(v[10], v[14]); CE_(v[10], v[12]); CE_(v[9], v[13]); CE_(v[11], v[15]); CE_(v[11], v[13]); CE_(v[9], v[10]); CE_(v[11], v[12]); CE_(v[13], v[14]); CE_(v[0], v[8]); CE_(v[4], v[12]); CE_(v[4], v[8]); CE_(v[2], v[10]); CE_(v[6], v[14]); CE_(v[6], v[10]); CE_(v[2], v[4]); CE_(v[6], v[8]); CE_(v[10], v[12]); CE_(v[1], v[9]); CE_(v[5], v[13]); CE_(v[5], v[9]); CE_(v[3], v[11]); CE_(v[7], v[15]); CE_(v[7], v[11]); CE_(v[3], v[5]); CE_(v[7], v[9]); CE_(v[11], v[13]); CE_(v[1], v[2]); CE_(v[3], v[4]); CE_(v[5], v[6]); CE_(v[7], v[8]); CE_(v[9], v[10]); CE_(v[11], v[12]); CE_(v[13], v[14]); }
__device__ __forceinline__ void merge16_top(unsigned (&R)[16], const unsigned (&C)[16]) {
#pragma unroll
    for (int i = 0; i < 16; ++i) R[i] = R[i] > C[15 - i] ? R[i] : C[15 - i];
    CE_(R[0], R[8]); CE_(R[1], R[9]); CE_(R[2], R[10]); CE_(R[3], R[11]); CE_(R[4], R[12]); CE_(R[5], R[13]); CE_(R[6], R[14]); CE_(R[7], R[15]); CE_(R[0], R[4]); CE_(R[1], R[5]); CE_(R[2], R[6]); CE_(R[3], R[7]); CE_(R[8], R[12]); CE_(R[9], R[13]); CE_(R[10], R[14]); CE_(R[11], R[15]); CE_(R[0], R[2]); CE_(R[1], R[3]); CE_(R[4], R[6]); CE_(R[5], R[7]); CE_(R[8], R[10]); CE_(R[9], R[11]); CE_(R[12], R[14]); CE_(R[13], R[15]); CE_(R[0], R[1]); CE_(R[2], R[3]); CE_(R[4], R[5]); CE_(R[6], R[7]); CE_(R[8], R[9]); CE_(R[10], R[11]); CE_(R[12], R[13]); CE_(R[14], R[15]); }
#endif
__device__ __forceinline__ void route_top16(unsigned (&tk)[16], const bf16* qrow, const GAS bf16* skp, int lane) {
    f32x16r acc[4];
#pragma unroll
    for (int mt = 0; mt < 4; ++mt) acc[mt] = (f32x16r){0.f, 0.f, 0.f, 0.f, 0.f, 0.f, 0.f, 0.f, 0.f, 0.f, 0.f, 0.f, 0.f, 0.f, 0.f, 0.f};
#if ROUTE_BATCH
#pragma unroll
    for (int s0 = 0; s0 < 8; s0 += ROUTE_BATCH) { bf16x8r bq[ROUTE_BATCH], a[ROUTE_BATCH][4];
#pragma unroll
        for (int i = 0; i < ROUTE_BATCH; ++i) { bq[i] = *(const bf16x8r*)(qrow + 16 * (s0 + i));
#pragma unroll
            for (int mt = 0; mt < 4; ++mt) a[i][mt] = *(const GAS bf16x8r*)(skp + (size_t)mt * 32 * 128 + 16 * (s0 + i)); }
#pragma unroll
        for (int i = 0; i < ROUTE_BATCH; ++i) asm volatile("" : "+v"(bq[i]), "+v"(a[i][0]), "+v"(a[i][1]), "+v"(a[i][2]), "+v"(a[i][3]));
#pragma unroll
        for (int i = 0; i < ROUTE_BATCH; ++i)
#pragma unroll
            for (int mt = 0; mt < 4; ++mt) acc[mt] = __builtin_amdgcn_mfma_f32_32x32x16_bf16(a[i][mt], bq[i], acc[mt], 0, 0, 0); }
#else
#pragma unroll
    for (int s = 0; s < 8; ++s) { const bf16x8r bq = *(const bf16x8r*)(qrow + 16 * s);
#pragma unroll
        for (int mt = 0; mt < 4; ++mt) { const bf16x8r a = *(const GAS bf16x8r*)(skp + (size_t)mt * 32 * 128 + 16 * s);
            acc[mt] = __builtin_amdgcn_mfma_f32_32x32x16_bf16(a, bq, acc[mt], 0, 0, 0); } }
#endif
    const unsigned lowb = (lane & 32) ? 0u : 4u;
#if ROUTE_SORTNET
#pragma unroll
    for (int mt = 0; mt < 4; ++mt) { unsigned c[16];
#pragma unroll
        for (int r = 0; r < 16; ++r) { const unsigned idx0 = 32u * mt + (r & 3) + 8u * (r >> 2);
            c[r] = (srt_key(acc[mt][r]) & ~127u) | ((127u - idx0) & ~4u) | lowb; }
        sort16_desc(c);
        if (mt == 0) {
#pragma unroll
            for (int k = 0; k < 16; ++k) tk[k] = c[k]; }
        else merge16_top(tk, c); }
    unsigned pk[16];
#pragma unroll
    for (int k = 0; k < 16; ++k) pk[k] = (unsigned)__shfl_xor((int)tk[k], 32);
    merge16_top(tk, pk);
}
#else
#pragma unroll
    for (int k = 0; k < 16; ++k) tk[k] = 0u;
#pragma unroll
    for (int mt = 0; mt < 4; ++mt)
#pragma unroll
        for (int r = 0; r < 16; ++r) { const unsigned idx0 = 32u * mt + (r & 3) + 8u * (r >> 2);
            const unsigned key = (srt_key(acc[mt][r]) & ~127u) | ((127u - idx0) & ~4u) | lowb; INS16(tk, key); }
    unsigned pk[16];
#pragma unroll
    for (int k = 0; k < 16; ++k) pk[k] = (unsigned)__shfl_xor((int)tk[k], 32);
#pragma unroll
    for (int k = 0; k < 16; ++k) INS16(tk, pk[k]);
}
#endif
template <class IP, class WP> __device__ __forceinline__ void route_unit(const Ctx& F, KArgs A, int l, int u, LAS unsigned char* scr, IP IDX, WP WTS, int tbase) {
    const bf16* Q2 = (const bf16*)(A.ws + WS_Q2); const bf16* SK = (const bf16*)(A.ws + WS_W + (size_t)l * W_LAYER + W_SK);
    asm volatile("" : "+s"(SK));
    const int row = F.lane & 31, kh = F.lane >> 5;
    {
        const int t = 4 * u + (row >> 3), hh = row & 7;
        unsigned tk0[16], tk1[16];
        const GAS bf16* SKg = (const GAS bf16*)SK;
        route_top16(tk0, Q2 + (size_t)t * 2048 + hh * 256 + 8 * kh, SKg + (size_t)row * 128 + 8 * kh, F.lane);
        route_top16(tk1, Q2 + (size_t)t * 2048 + hh * 256 + 128 + 8 * kh, SKg + 128 * 128 + (size_t)row * 128 + 8 * kh, F.lane);
        float s0[16], s1[16];
#pragma unroll
        for (int k = 0; k < 16; ++k) { s0[k] = srt_val(tk0[k] & ~127u); s1[k] = srt_val(tk1[k] & ~127u); }
        LAS unsigned* sw = (LAS unsigned*)(scr + F.lane * 36);
#pragma unroll
        for (int k = 0; k < 4; ++k) {
            sw[k] = (127u - (tk0[4 * k] & 127u)) | ((127u - (tk0[4 * k + 1] & 127u)) << 8) | ((127u - (tk0[4 * k + 2] & 127u)) << 16) | ((127u - (tk0[4 * k + 3] & 127u)) << 24);
            sw[4 + k] = (127u - (tk1[4 * k] & 127u)) | ((127u - (tk1[4 * k + 1] & 127u)) << 8) | ((127u - (tk1[4 * k + 2] & 127u)) << 16) | ((127u - (tk1[4 * k + 3] & 127u)) << 24); }
        unsigned bk[16];
#if ROUTE_SORTNET
#define PKEY_(i, j) ((srt_key(s0[i] + s1[j]) & ~255u) | (255u - (unsigned)((i) * 16 + (j))))
        {
            unsigned c[16];
#pragma unroll
            for (int j = 0; j < 16; ++j) bk[j] = PKEY_(0, j);
#pragma unroll
            for (int i = 1; i < 16; ++i) c[i - 1] = PKEY_(i, 0);
            c[15] = 0u;
            merge16_top(bk, c);
            int n = 0;
#pragma unroll
            for (int i = 1; i < 8; ++i)
#pragma unroll
                for (int j = 1; j < 8; ++j) if ((i + 1) * (j + 1) <= 16) { const unsigned key = PKEY_(i, j); if (n < 16) c[n] = key; else INS16(bk, key); ++n; }
            sort16_desc(c);
            merge16_top(bk, c);
        }
#undef PKEY_
#else
#pragma unroll
        for (int k = 0; k < 16; ++k) bk[k] = 0u;
#pragma unroll
        for (int i = 0; i < 16; ++i)
#pragma unroll
            for (int j = 0; j < 16; ++j) if ((i + 1) * (j + 1) <= 16) { const unsigned key = (srt_key(s0[i] + s1[j]) & ~255u) | (255u - (unsigned)(i * 16 + j)); INS16(bk, key); }
#endif
        LDS_WAIT();
        const LAS unsigned char* sb = (const LAS unsigned char*)(scr + F.lane * 36);
        int ei[16]; float wv[16]; float den = 0.f; const float m0 = srt_val(bk[0] & ~255u);
#pragma unroll
        for (int r = 0; r < 16; ++r) { const unsigned ij = 255u - (bk[r] & 255u); ei[r] = (int)sb[ij >> 4] * 128 + (int)sb[16 + (ij & 15)];
            wv[r] = __expf(srt_val(bk[r] & ~255u) - m0); den += wv[r]; }
        const float rden = 1.0f / den;
        if (kh == 0) {
#pragma unroll
            for (int r = 0; r < 16; ++r) IDX[(size_t)(t - tbase) * 128 + hh * 16 + r] = ei[r]; }
        else {
#pragma unroll
            for (int r = 0; r < 16; ++r) WTS[(size_t)(t - tbase) * 128 + hh * 16 + r] = wv[r] * rden; }
        LDS_WAIT();
    }
}
__device__ __forceinline__ void phase_route(const Ctx& F, KArgs A, int l) {
    LAS unsigned char* scr = F.lds + RING_OFF + F.wave * 4096;
    for (int u = F.gw; u < T / 4; u += F.NGW) route_unit(F, A, l, u, scr, (int*)(A.ws + WS_IDX), (float*)(A.ws + WS_WTS), 0);
}
#ifndef PROBE_U_VALU
#define PROBE_U_VALU 0
#endif
#ifndef PROBE_EXP_REP
#define PROBE_EXP_REP 1
#endif
typedef __bf16 bf16x2_t __attribute__((ext_vector_type(2)));
__device__ __forceinline__ float dot2bf(unsigned a, unsigned b, float c) { return __builtin_amdgcn_fdot2_f32_bf16(__builtin_bit_cast(bf16x2_t, a), __builtin_bit_cast(bf16x2_t, b), c, false); }
template <int XM> __device__ __forceinline__ float lane_xchg(float v) {
    const int x = __builtin_bit_cast(int, v);
    if constexpr (XM == 1) return __builtin_bit_cast(float, __builtin_amdgcn_mov_dpp(x, 0xB1, 0xF, 0xF, true));
    else if constexpr (XM == 2) return __builtin_bit_cast(float, __builtin_amdgcn_mov_dpp(x, 0x4E, 0xF, 0xF, true));
    else if constexpr (XM == 4) return __builtin_bit_cast(float, __builtin_amdgcn_ds_swizzle(x, 0x101F));
    else if constexpr (XM == 8) return __builtin_bit_cast(float, __builtin_amdgcn_ds_swizzle(x, 0x201F));
    else if constexpr (XM == 16) return __builtin_bit_cast(float, __builtin_amdgcn_ds_swizzle(x, 0x401F));
    else return __shfl_xor(v, 32);
}
template <int XM> __device__ __forceinline__ int lane_xchg(int x) {
    if constexpr (XM == 1) return __builtin_amdgcn_mov_dpp(x, 0xB1, 0xF, 0xF, true);
    else if constexpr (XM == 2) return __builtin_amdgcn_mov_dpp(x, 0x4E, 0xF, 0xF, true);
    else if constexpr (XM == 4) return __builtin_amdgcn_ds_swizzle(x, 0x101F);
    else if constexpr (XM == 8) return __builtin_amdgcn_ds_swizzle(x, 0x201F);
    else if constexpr (XM == 16) return __builtin_amdgcn_ds_swizzle(x, 0x401F);
    else return __shfl_xor(x, 32);
}
__device__ __forceinline__ float reduce16(const float (&p)[16], int lane) {
    float a[8], b[4], c[2];
    const bool b0 = lane & 1, b1 = lane & 2, b2 = lane & 4, b3 = lane & 8;
#pragma unroll
    for (int i = 0; i < 8; ++i) a[i] = (b0 ? p[2 * i + 1] : p[2 * i]) + lane_xchg<1>(b0 ? p[2 * i] : p[2 * i + 1]);
#pragma unroll
    for (int i = 0; i < 4; ++i) b[i] = (b1 ? a[2 * i + 1] : a[2 * i]) + lane_xchg<2>(b1 ? a[2 * i] : a[2 * i + 1]);
#pragma unroll
    for (int i = 0; i < 2; ++i) c[i] = (b2 ? b[2 * i + 1] : b[2 * i]) + lane_xchg<4>(b2 ? b[2 * i] : b[2 * i + 1]);
    float d = (b3 ? c[1] : c[0]) + lane_xchg<8>(b3 ? c[0] : c[1]);
    d += lane_xchg<16>(d);
    d += lane_xchg<32>(d);
    return d;
}
__device__ __forceinline__ void expert_token(const Ctx& F, KArgs A, int l, int t, const int idx0, const int idx1, const float wt0, const float wt1) {
    const bf16* H = (const bf16*)(A.ws + WS_H); const unsigned char* UE = A.ws + WS_UE; const unsigned char* VE = A.ws + WS_VE;
    const float* mod = (const float*)(A.ws + WS_MOD);
    bf16* Hn = (bf16*)(A.ws + WS_H);
    const unsigned lo16 = (unsigned)F.lane * 16u; (void)lo16;
    {
        const v4u ha = *(const v4u*)(H + (size_t)t * D + 8 * F.lane), hb = *(const v4u*)(H + (size_t)t * D + 512 + 8 * F.lane);
#if EXP_I8 && !DBG_ROUTE32
        const float su0 = ((const float*)(A.ws + WS_US))[idx0], su1 = ((const float*)(A.ws + WS_US))[idx1], sv0 = ((const float*)(A.ws + WS_VS))[idx0], sv1 = ((const float*)(A.ws + WS_VS))[idx1];
        float hv[16];
        hv[0] = bflo(ha.x); hv[1] = bfhi(ha.x); hv[2] = bflo(ha.y); hv[3] = bfhi(ha.y); hv[4] = bflo(ha.z); hv[5] = bfhi(ha.z); hv[6] = bflo(ha.w); hv[7] = bfhi(ha.w);
        hv[8] = bflo(hb.x); hv[9] = bfhi(hb.x); hv[10] = bflo(hb.y); hv[11] = bfhi(hb.y); hv[12] = bflo(hb.z); hv[13] = bfhi(hb.z); hv[14] = bflo(hb.w); hv[15] = bfhi(hb.w);
        float hs = 0.f;
#pragma unroll
        for (int k = 0; k < 16; ++k) hs += hv[k];
        const float hsum = wave_sum(hs);
        const unsigned lo16b = (unsigned)F.lane * 16u;
#define UB(w, i) ((float)(((w) >> (8 * (i))) & 255u))
        float act0 = 0.f, act1 = 0.f;
        for (int b = 0; b < 8 * PROBE_EXP_REP; ++b) {
            const int isel = ((b & 7) < 4) ? idx0 : idx1; const int lb = 16 * (b & 3);
            v4u rr[16];
#pragma unroll
            for (int j = 0; j < 16; ++j) { const unsigned ie = (unsigned)rdlanei(isel, lb + j); rr[j] = *(const v4u*)(UE + (size_t)ie * 1024u + lo16b) ^ 0x80808080u; }
            float p[16];
#pragma unroll
            for (int j = 0; j < 16; ++j) { const v4u r = rr[j];
                float s0 = hv[0] * UB(r.x, 0); s0 += hv[1] * UB(r.x, 1); s0 += hv[2] * UB(r.x, 2); s0 += hv[3] * UB(r.x, 3);
                float s1 = hv[4] * UB(r.y, 0); s1 += hv[5] * UB(r.y, 1); s1 += hv[6] * UB(r.y, 2); s1 += hv[7] * UB(r.y, 3);
                s0 += hv[8] * UB(r.z, 0); s0 += hv[9] * UB(r.z, 1); s0 += hv[10] * UB(r.z, 2); s0 += hv[11] * UB(r.z, 3);
                s1 += hv[12] * UB(r.w, 0); s1 += hv[13] * UB(r.w, 1); s1 += hv[14] * UB(r.w, 2); s1 += hv[15] * UB(r.w, 3);
                p[j] = s0 + s1; }
#if PROBE_U_VALU
            asm volatile("" : "+v"(hv[0]), "+v"(hv[1]), "+v"(hv[2]), "+v"(hv[3]), "+v"(hv[4]), "+v"(hv[5]), "+v"(hv[6]), "+v"(hv[7]));
#pragma unroll
            for (int j = 0; j < 16; ++j) { const v4u r = rr[j];
                float s0 = hv[0] * UB(r.x, 0); s0 += hv[1] * UB(r.x, 1); s0 += hv[2] * UB(r.x, 2); s0 += hv[3] * UB(r.x, 3);
                float s1 = hv[4] * UB(r.y, 0); s1 += hv[5] * UB(r.y, 1); s1 += hv[6] * UB(r.y, 2); s1 += hv[7] * UB(r.y, 3);
                s0 += hv[8] * UB(r.z, 0); s0 += hv[9] * UB(r.z, 1); s0 += hv[10] * UB(r.z, 2); s0 += hv[11] * UB(r.z, 3);
                s1 += hv[12] * UB(r.w, 0); s1 += hv[13] * UB(r.w, 1); s1 += hv[14] * UB(r.w, 2); s1 += hv[15] * UB(r.w, 3);
                p[j] = 0.5f * (p[j] + (s0 + s1)); }
#endif
            const float tot = reduce16(p, F.lane);
            if ((F.lane >> 4) == (b & 3)) { if ((b & 7) < 4) act0 = tot; else act1 = tot; }
        }
        act0 = su0 * (act0 - 128.0f * hsum); act1 = su1 * (act1 - 128.0f * hsum);
        const float w0 = wt0 * sv0 * 0.5f * act0 * (1.0f + erff(act0 * 0.7071067811865476f)), w1 = wt1 * sv1 * 0.5f * act1 * (1.0f + erff(act1 * 0.7071067811865476f));
        const float csum = wave_sum(w0 + w1);
        float o[16];
#pragma unroll
        for (int k = 0; k < 16; ++k) o[k] = 0.f;
        for (int b = 0; b < 8 * PROBE_EXP_REP; ++b) {
            if (b == 8) {
#pragma unroll
                for (int k = 0; k < 16; ++k) o[k] = 0.f; }
            const int isel = ((b & 7) < 4) ? idx0 : idx1; const float wsel = ((b & 7) < 4) ? w0 : w1; const int lb = 16 * (b & 3);
            v4u rr[16];
#pragma unroll
            for (int j = 0; j < 16; ++j) { const unsigned ie = (unsigned)rdlanei(isel, lb + j); rr[j] = *(const v4u*)(VE + (size_t)ie * 1024u + lo16b); }
#pragma unroll
            for (int j = 0; j < 16; ++j) { const float we = rdlane(wsel, lb + j); const v4u r = rr[j];
                o[0] += we * UB(r.x, 0); o[1] += we * UB(r.x, 1); o[2] += we * UB(r.x, 2); o[3] += we * UB(r.x, 3); o[4] += we * UB(r.y, 0); o[5] += we * UB(r.y, 1); o[6] += we * UB(r.y, 2); o[7] += we * UB(r.y, 3);
                o[8] += we * UB(r.z, 0); o[9] += we * UB(r.z, 1); o[10] += we * UB(r.z, 2); o[11] += we * UB(r.z, 3); o[12] += we * UB(r.w, 0); o[13] += we * UB(r.w, 1); o[14] += we * UB(r.w, 2); o[15] += we * UB(r.w, 3); }
        }
#pragma unroll
        for (int k = 0; k < 16; ++k) o[k] -= 128.0f * csum;
#undef UB
#else
        float act0 = 0.f, act1 = 0.f;
        for (int b = 0; b < 8 * PROBE_EXP_REP; ++b) {
            const int isel = ((b & 7) < 4) ? idx0 : idx1; const int lb = 16 * (b & 3);
            v4u ra[16], rb[16];
#pragma unroll
            for (int j = 0; j < 16; ++j) { const unsigned ie = (unsigned)rdlanei(isel, lb + j); const unsigned char* up = UE + (size_t)ie * 2048u + lo16;
                ra[j] = *(const v4u*)up; rb[j] = *(const v4u*)(up + 1024); }
            float p[16];
#pragma unroll
            for (int j = 0; j < 16; ++j) { float s = dot2bf(ha.x, ra[j].x, 0.f); s = dot2bf(ha.y, ra[j].y, s); s = dot2bf(ha.z, ra[j].z, s); s = dot2bf(ha.w, ra[j].w, s);
                s = dot2bf(hb.x, rb[j].x, s); s = dot2bf(hb.y, rb[j].y, s); s = dot2bf(hb.z, rb[j].z, s); s = dot2bf(hb.w, rb[j].w, s); p[j] = s; }
            const float tot = reduce16(p, F.lane);
            if ((F.lane >> 4) == (b & 3)) { if ((b & 7) < 4) act0 = tot; else act1 = tot; }
        }
        const float w0 = wt0 * 0.5f * act0 * (1.0f + erff(act0 * 0.7071067811865476f)), w1 = wt1 * 0.5f * act1 * (1.0f + erff(act1 * 0.7071067811865476f));
        float o[16];
#pragma unroll
        for (int k = 0; k < 16; ++k) o[k] = 0.f;
        for (int b = 0; b < 8 * PROBE_EXP_REP; ++b) {
            if (b == 8) {
#pragma unroll
                for (int k = 0; k < 16; ++k) o[k] = 0.f; }
            const int isel = ((b & 7) < 4) ? idx0 : idx1; const float wsel = ((b & 7) < 4) ? w0 : w1; const int lb = 16 * (b & 3);
            v4u ra[16], rb[16];
#pragma unroll
            for (int j = 0; j < 16; ++j) { const unsigned ie = (unsigned)rdlanei(isel, lb + j); const unsigned char* vp = VE + (size_t)ie * 2048u + lo16;
                ra[j] = *(const v4u*)vp; rb[j] = *(const v4u*)(vp + 1024); }
#pragma unroll
            for (int j = 0; j < 16; ++j) { const float we = rdlane(wsel, lb + j); const v4u a = ra[j], bb = rb[j];
                o[0] += we * bflo(a.x); o[1] += we * bfhi(a.x); o[2] += we * bflo(a.y); o[3] += we * bfhi(a.y); o[4] += we * bflo(a.z); o[5] += we * bfhi(a.z); o[6] += we * bflo(a.w); o[7] += we * bfhi(a.w);
                o[8] += we * bflo(bb.x); o[9] += we * bfhi(bb.x); o[10] += we * bflo(bb.y); o[11] += we * bfhi(bb.y); o[12] += we * bflo(bb.z); o[13] += we * bfhi(bb.z); o[14] += we * bflo(bb.w); o[15] += we * bfhi(bb.w); }
        }
#endif
        const int b = t >> 11; const float* mb = mod + ((size_t)l * 8 + b) * 6144;
        float x2[16]; float ss = 0.f;
#pragma unroll
        for (int hseg = 0; hseg < 2; ++hseg)
#pragma unroll
            for (int q4 = 0; q4 < 2; ++q4) { const int col = hseg * 512 + 8 * F.lane + 4 * q4;
                const f32x4 xv = *(const f32x4*)(A.out + (size_t)t * D + col), gv = *(const f32x4*)(mb + 5120 + col);
#pragma unroll
                for (int e = 0; e < 4; ++e) { const float v = xv[e] + gv[e] * o[hseg * 8 + q4 * 4 + e]; x2[hseg * 8 + q4 * 4 + e] = v; ss += v * v; } }
        const float r = 1.0f / sqrtf(wave_sum(ss) * (1.0f / D) + EPS);
        if (l + 1 < DEPTH) {
            const float* mn = mod + ((size_t)(l + 1) * 8 + b) * 6144; const float* gn = A.in[I_GN1] + (size_t)(l + 1) * D;
#pragma unroll
            for (int hseg = 0; hseg < 2; ++hseg) { const int col = hseg * 512 + 8 * F.lane;
                float hn[8];
#pragma unroll
                for (int q4 = 0; q4 < 2; ++q4) { const f32x4 gg = *(const f32x4*)(gn + col + 4 * q4), sc = *(const f32x4*)(mn + 1024 + col + 4 * q4), sh = *(const f32x4*)(mn + col + 4 * q4);
                    f32x4 xo;
#pragma unroll
                    for (int e = 0; e < 4; ++e) { xo[e] = x2[hseg * 8 + q4 * 4 + e]; hn[q4 * 4 + e] = xo[e] * r * gg[e] * (1.0f + sc[e]) + sh[e]; }
                    *(f32x4*)(A.out + (size_t)t * D + col + 4 * q4) = xo; }
                v4u ov; ov.x = pk2(hn[0], hn[1]); ov.y = pk2(hn[2], hn[3]); ov.z = pk2(hn[4], hn[5]); ov.w = pk2(hn[6], hn[7]);
                *(v4u*)(Hn + (size_t)t * D + col) = ov; }
        } else {
            const float* gf = A.in[I_GFIN];
#pragma unroll
            for (int hseg = 0; hseg < 2; ++hseg)
#pragma unroll
                for (int q4 = 0; q4 < 2; ++q4) { const int col = hseg * 512 + 8 * F.lane + 4 * q4; const f32x4 gg = *(const f32x4*)(gf + col); f32x4 xo;
#pragma unroll
                    for (int e = 0; e < 4; ++e) xo[e] = x2[hseg * 8 + q4 * 4 + e] * r * gg[e];
                    *(f32x4*)(A.out + (size_t)t * D + col) = xo; }
        }
    }
}

struct HQ { int q1[4], q2[4]; float s1, s2; int c1, c2; };
struct NextB { const unsigned char* tab; int isel; int lb; };
template <int N> __device__ __forceinline__ void vm_wait() { asm volatile("s_waitcnt vmcnt(%0)" :: "n"(N) : "memory"); }
__device__ __forceinline__ void dma_row(const NextB& nb, int j, unsigned lo16b, LAS unsigned char* slot) {
    const unsigned ie = (unsigned)rdlanei(nb.isel, nb.lb + j);
#if EXP6B
#if DMA_NOMASK
    const unsigned off = lo16b < (lo16b - 768u) ? lo16b : lo16b - 768u;
#if ROW_OFFS
    __builtin_amdgcn_global_load_lds((const unsigned*)(nb.tab + (size_t)(ie + off)), (LAS unsigned*)slot, 16, 0, 0);
#else
    __builtin_amdgcn_global_load_lds((const unsigned*)(nb.tab + (size_t)ie * 768u + off), (LAS unsigned*)slot, 16, 0, 0);
#endif
#else
    if (lo16b < 768u) __builtin_amdgcn_global_load_lds((const unsigned*)(nb.tab + (size_t)ie * 768u + lo16b), (LAS unsigned*)slot, 16, 0, 0);
#endif
#else
    __builtin_amdgcn_global_load_lds((const unsigned*)(nb.tab + (size_t)ie * 1024u + lo16b), (LAS unsigned*)slot, 16, 0, 0);
#endif
}
#define UBF(w, i) ((float)(((w) >> (8 * (i))) & 255u))
__device__ __forceinline__ v4u ring_row(const LAS unsigned char* slot, unsigned lo16b) {
#if EXP6B
    const v2u X = *(const LAS v2u*)(slot + (lo16b >> 1)); const unsigned Y = *(const LAS unsigned*)(slot + 512 + (lo16b >> 2));
    v4u r;
    r.x = (X.x & 0x0F0F0F0Fu) | (Y & 0x30303030u);
    r.y = (X.x & 0xF0F0F0F0u) | (Y & 0x0C0C0C0Cu);
    r.z = (X.y & 0x0F0F0F0Fu) | ((Y >> 2) & 0x30303030u);
    r.w = (X.y & 0xF0F0F0F0u) | ((Y << 2) & 0x0C0C0C0Cu);
    return r;
#else
    return *(const LAS v4u*)(slot + lo16b);
#endif
}
#if ROW_PIPE
__device__ __forceinline__ void lds_raw(v4u& raw, const LAS unsigned char* slot, unsigned lo16b) {
#if EXP6B
    const v2u X = *(const LAS v2u*)(slot + (lo16b >> 1)); raw.x = X.x; raw.y = X.y; raw.z = *(const LAS unsigned*)(slot + 512 + (lo16b >> 2));
#else
    raw = *(const LAS v4u*)(slot + lo16b);
#endif
}
__device__ __forceinline__ v4u decode_raw(const v4u& raw) {
#if EXP6B
    v4u r;
    r.x = (raw.x & 0x0F0F0F0Fu) | (raw.z & 0x30303030u);
    r.y = (raw.x & 0xF0F0F0F0u) | (raw.z & 0x0C0C0C0Cu);
    r.z = (raw.y & 0x0F0F0F0Fu) | ((raw.z >> 2) & 0x30303030u);
    r.w = (raw.y & 0xF0F0F0F0u) | ((raw.z << 2) & 0x0C0C0C0Cu);
    return r;
#else
    return raw;
#endif
}
__device__ __forceinline__ void vm_wait_n(int n) {
    switch (n) { case 15: vm_wait<15>(); break; case 14: vm_wait<14>(); break; case 13: vm_wait<13>(); break; case 12: vm_wait<12>(); break; case 11: vm_wait<11>(); break; case 10: vm_wait<10>(); break;
        case 9: vm_wait<9>(); break; case 8: vm_wait<8>(); break; case 7: vm_wait<7>(); break; case 6: vm_wait<6>(); break; case 5: vm_wait<5>(); break; case 4: vm_wait<4>(); break;
        case 3: vm_wait<3>(); break; case 2: vm_wait<2>(); break; case 1: vm_wait<1>(); break; case 0: vm_wait<0>(); break; default: break; }
}
__device__ __forceinline__ v4u row_step(LAS unsigned char* ring, v4u& raw, const NextB& nb, unsigned lo16b, int B, bool refill, int waitn) {
    __builtin_amdgcn_sched_barrier(0);
#if EXP6B
    asm volatile("s_waitcnt lgkmcnt(0)" : "+v"(raw.x), "+v"(raw.y), "+v"(raw.z) :: "memory");
#else
    asm volatile("s_waitcnt lgkmcnt(0)" : "+v"(raw.x), "+v"(raw.y), "+v"(raw.z), "+v"(raw.w) :: "memory");
#endif
    if (refill) dma_row(nb, B, lo16b, ring + B * 1024);
    const v4u cur = raw;
    if (waitn >= 0) { vm_wait_n(waitn); lds_raw(raw, ring + ((B + 1) & 15) * 1024, lo16b); __builtin_amdgcn_sched_barrier(0); }
    return decode_raw(cur);
}
#endif
#if EXP6B && H_PLANES == 1
typedef int TreeT;
#else
typedef float TreeT;
#endif
template <int L, int B> __device__ __forceinline__ TreeT rs_tree(LAS unsigned char* ring, const HQ& hq, const NextB& nb, int lane, unsigned lo16b, v4u& raw) {
    if constexpr (L == 0) {
#if ROW_PIPE
        const v4u r = row_step(ring, raw, nb, lo16b, B, true, 15);
#else
        vm_wait<15>();
        const v4u r = ring_row(ring + B * 1024, lo16b);
#endif
#if EXP6B
        int e1 = __builtin_amdgcn_sdot4(hq.q1[0], (int)r.x, 0, false); e1 = __builtin_amdgcn_sdot4(hq.q1[2], (int)r.z, e1, false);
        int d1 = __builtin_amdgcn_sdot4(hq.q1[1], (int)r.y, hq.c1, false); d1 = __builtin_amdgcn_sdot4(hq.q1[3], (int)r.w, d1, false); d1 += e1 << 2;
#if H_PLANES == 2
        int e2 = __builtin_amdgcn_sdot4(hq.q2[0], (int)r.x, 0, false); e2 = __builtin_amdgcn_sdot4(hq.q2[2], (int)r.z, e2, false);
        int d2 = __builtin_amdgcn_sdot4(hq.q2[1], (int)r.y, hq.c2, false); d2 = __builtin_amdgcn_sdot4(hq.q2[3], (int)r.w, d2, false); d2 += e2 << 2;
#endif
#else
        int d1 = __builtin_amdgcn_sdot4(hq.q1[0], (int)r.x, 0, false); d1 = __builtin_amdgcn_sdot4(hq.q1[1], (int)r.y, d1, false); d1 = __builtin_amdgcn_sdot4(hq.q1[2], (int)r.z, d1, false); d1 = __builtin_amdgcn_sdot4(hq.q1[3], (int)r.w, d1, false);
        int d2 = __builtin_amdgcn_sdot4(hq.q2[0], (int)r.x, 0, false); d2 = __builtin_amdgcn_sdot4(hq.q2[1], (int)r.y, d2, false); d2 = __builtin_amdgcn_sdot4(hq.q2[2], (int)r.z, d2, false); d2 = __builtin_amdgcn_sdot4(hq.q2[3], (int)r.w, d2, false);
#endif
#if H_PLANES == 2
        const float p = (float)d1 * hq.s1 + (float)d2 * hq.s2;
#else
        const int p = d1;
#endif
#if !ROW_PIPE
        asm volatile("s_waitcnt lgkmcnt(0)" :: "v"(p) : "memory");
        dma_row(nb, B, lo16b, ring + B * 1024);
#endif
        return p;
    } else {
        constexpr int HS = 1 << (L - 1);
        const TreeT lo = rs_tree<L - 1, B>(ring, hq, nb, lane, lo16b, raw), hi = rs_tree<L - 1, B + HS>(ring, hq, nb, lane, lo16b, raw);
#if TREE_BANKMASK && EXP6B && H_PLANES == 1
        if constexpr (HS >= 4) {
            int t;
            if constexpr (HS == 4) { t = lo + __builtin_amdgcn_mov_dpp(lo, 0x104, 0xF, 0xF, true);
                asm volatile("s_nop 1\n\tv_add_u32_dpp %0, %1, %1 row_shr:4 row_mask:0xf bank_mask:0xa" : "+v"(t) : "v"(hi)); }
            else { t = lo + __builtin_amdgcn_mov_dpp(lo, 0x128, 0xF, 0xF, true);
                asm volatile("s_nop 1\n\tv_add_u32_dpp %0, %1, %1 row_ror:8 row_mask:0xf bank_mask:0xc" : "+v"(t) : "v"(hi)); }
            return t;
        }
#endif
        const bool up = lane & HS;
        return (up ? hi : lo) + lane_xchg<HS>(up ? lo : hi);
    }
}
__device__ __forceinline__ float consume_u(LAS unsigned char* ring, const HQ& hq, const NextB& nb, int lane, unsigned lo16b, v4u& raw) {
    TreeT d = rs_tree<4, 0>(ring, hq, nb, lane, lo16b, raw);
    d += lane_xchg<16>(d);
    d += lane_xchg<32>(d);
#if EXP6B && H_PLANES == 1
    return (float)d * hq.s1;
#else
    return d;
#endif
}
template <bool LASTB> __device__ __forceinline__ void consume_v(LAS unsigned char* ring, float (&o)[16], float wsel, int lb, const NextB& nb, unsigned lo16b) {
#pragma unroll
    for (int j = 0; j < 16; ++j) {
        if constexpr (LASTB) { switch (j) { case 0: vm_wait<15>(); break; case 1: vm_wait<14>(); break; case 2: vm_wait<13>(); break; case 3: vm_wait<12>(); break; case 4: vm_wait<11>(); break; case 5: vm_wait<10>(); break; case 6: vm_wait<9>(); break; case 7: vm_wait<8>(); break;
            case 8: vm_wait<7>(); break; case 9: vm_wait<6>(); break; case 10: vm_wait<5>(); break; case 11: vm_wait<4>(); break; case 12: vm_wait<3>(); break; case 13: vm_wait<2>(); break; case 14: vm_wait<1>(); break; default: vm_wait<0>(); break; } }
        else vm_wait<15>();
        const float we = rdlane(wsel, lb + j); const v4u r = *(const LAS v4u*)(ring + j * 1024 + lo16b);
        o[0] += we * UBF(r.x, 0); o[1] += we * UBF(r.x, 1); o[2] += we * UBF(r.x, 2); o[3] += we * UBF(r.x, 3); o[4] += we * UBF(r.y, 0); o[5] += we * UBF(r.y, 1); o[6] += we * UBF(r.y, 2); o[7] += we * UBF(r.y, 3);
        o[8] += we * UBF(r.z, 0); o[9] += we * UBF(r.z, 1); o[10] += we * UBF(r.z, 2); o[11] += we * UBF(r.z, 3); o[12] += we * UBF(r.w, 0); o[13] += we * UBF(r.w, 1); o[14] += we * UBF(r.w, 2); o[15] += we * UBF(r.w, 3);
        if constexpr (!LASTB) { asm volatile("s_waitcnt lgkmcnt(0)" :: "v"(o[0]), "v"(o[5]), "v"(o[10]), "v"(o[15]) : "memory"); dma_row(nb, j, lo16b, ring + j * 1024); }
    }
}
#if V_MFMA
typedef int v4i __attribute__((ext_vector_type(4)));
#if V_ABID
template <bool LASTB, int J> __device__ __forceinline__ void vm_row(LAS unsigned char* ring, v4i (&a1)[4], int aq, const NextB& nb, unsigned lo16b, v4u& raw) {
    const v4u r = row_step(ring, raw, nb, lo16b, J, !LASTB, LASTB ? 14 - J : 15);
    a1[0] = __builtin_amdgcn_mfma_i32_4x4x4i8(aq, (int)r.x, a1[0], 4, J, 0); a1[1] = __builtin_amdgcn_mfma_i32_4x4x4i8(aq, (int)r.y, a1[1], 4, J, 0);
    a1[2] = __builtin_amdgcn_mfma_i32_4x4x4i8(aq, (int)r.z, a1[2], 4, J, 0); a1[3] = __builtin_amdgcn_mfma_i32_4x4x4i8(aq, (int)r.w, a1[3], 4, J, 0);
}
template <bool LASTB> __device__ __forceinline__ void consume_vm(LAS unsigned char* ring, v4i (&a1)[4], v4i (&a2)[4], int cqsel, int lb, const NextB& nb, unsigned lo16b, unsigned sh8, v4u& raw) {
    static_assert(ROW_PIPE && V_PLANES == 1, "V_ABID: pipelined rows, one c plane");
    const int aq = (__shfl(cqsel, lb + (int)(lo16b >> 6)) & 255) << sh8;
    vm_row<LASTB, 0>(ring, a1, aq, nb, lo16b, raw); vm_row<LASTB, 1>(ring, a1, aq, nb, lo16b, raw); vm_row<LASTB, 2>(ring, a1, aq, nb, lo16b, raw); vm_row<LASTB, 3>(ring, a1, aq, nb, lo16b, raw);
    vm_row<LASTB, 4>(ring, a1, aq, nb, lo16b, raw); vm_row<LASTB, 5>(ring, a1, aq, nb, lo16b, raw); vm_row<LASTB, 6>(ring, a1, aq, nb, lo16b, raw); vm_row<LASTB, 7>(ring, a1, aq, nb, lo16b, raw);
    vm_row<LASTB, 8>(ring, a1, aq, nb, lo16b, raw); vm_row<LASTB, 9>(ring, a1, aq, nb, lo16b, raw); vm_row<LASTB, 10>(ring, a1, aq, nb, lo16b, raw); vm_row<LASTB, 11>(ring, a1, aq, nb, lo16b, raw);
    vm_row<LASTB, 12>(ring, a1, aq, nb, lo16b, raw); vm_row<LASTB, 13>(ring, a1, aq, nb, lo16b, raw); vm_row<LASTB, 14>(ring, a1, aq, nb, lo16b, raw); vm_row<LASTB, 15>(ring, a1, aq, nb, lo16b, raw);
    (void)a2;
}
#else
template <bool LASTB> __device__ __forceinline__ void consume_vm(LAS unsigned char* ring, v4i (&a1)[4], v4i (&a2)[4], int cqsel, int lb, const NextB& nb, unsigned lo16b, unsigned sh8, v4u& raw) {
#pragma unroll
    for (int j = 0; j < 16; ++j) {
#if ROW_PIPE
        const v4u r = row_step(ring, raw, nb, lo16b, j, !LASTB, LASTB ? 14 - j : 15); const int cs = rdlanei(cqsel, lb + j);
#else
        if constexpr (LASTB) { switch (j) { case 0: vm_wait<15>(); break; case 1: vm_wait<14>(); break; case 2: vm_wait<13>(); break; case 3: vm_wait<12>(); break; case 4: vm_wait<11>(); break; case 5: vm_wait<10>(); break; case 6: vm_wait<9>(); break; case 7: vm_wait<8>(); break;
            case 8: vm_wait<7>(); break; case 9: vm_wait<6>(); break; case 10: vm_wait<5>(); break; case 11: vm_wait<4>(); break; case 12: vm_wait<3>(); break; case 13: vm_wait<2>(); break; case 14: vm_wait<1>(); break; default: vm_wait<0>(); break; } }
        else vm_wait<15>();
        const int cs = rdlanei(cqsel, lb + j); const v4u r = ring_row(ring + j * 1024, lo16b);
#endif
        const int c1 = (cs & 255) << sh8, c2 = ((cs >> 8) & 255) << sh8;
#if V_PLANES == 2
        a1[0] = __builtin_amdgcn_mfma_i32_4x4x4i8(c1, (int)r.x, a1[0], 0, 0, 0); a2[0] = __builtin_amdgcn_mfma_i32_4x4x4i8(c2, (int)r.x, a2[0], 0, 0, 0);
        a1[1] = __builtin_amdgcn_mfma_i32_4x4x4i8(c1, (int)r.y, a1[1], 0, 0, 0); a2[1] = __builtin_amdgcn_mfma_i32_4x4x4i8(c2, (int)r.y, a2[1], 0, 0, 0);
        a1[2] = __builtin_amdgcn_mfma_i32_4x4x4i8(c1, (int)r.z, a1[2], 0, 0, 0); a2[2] = __builtin_amdgcn_mfma_i32_4x4x4i8(c2, (int)r.z, a2[2], 0, 0, 0);
        a1[3] = __builtin_amdgcn_mfma_i32_4x4x4i8(c1, (int)r.w, a1[3], 0, 0, 0); a2[3] = __builtin_amdgcn_mfma_i32_4x4x4i8(c2, (int)r.w, a2[3], 0, 0, 0);
#else
        a1[0] = __builtin_amdgcn_mfma_i32_4x4x4i8(c1, (int)r.x, a1[0], 0, 0, 0); a1[1] = __builtin_amdgcn_mfma_i32_4x4x4i8(c1, (int)r.y, a1[1], 0, 0, 0);
        a1[2] = __builtin_amdgcn_mfma_i32_4x4x4i8(c1, (int)r.z, a1[2], 0, 0, 0); a1[3] = __builtin_amdgcn_mfma_i32_4x4x4i8(c1, (int)r.w, a1[3], 0, 0, 0); (void)c2;
#endif
#if !ROW_PIPE
        if constexpr (!LASTB) { asm volatile("s_waitcnt lgkmcnt(0)" :: "v"(r.x), "v"(r.y), "v"(r.z), "v"(r.w) : "memory"); dma_row(nb, j, lo16b, ring + j * 1024); }
#endif
    }
}
#endif
#endif
template <bool HAVE_X1> __device__ __forceinline__ void expert_epilogue(const Ctx& F, KArgs A, int l, int t, const float (&o)[16], const float (&x1v)[16]) {
    const float* mod = (const float*)(A.ws + WS_MOD); bf16* Hn = (bf16*)(A.ws + WS_H);
    const int b = t >> 11; const float* mb = mod + ((size_t)l * 8 + b) * 6144;
    float x2[16]; float ss = 0.f;
#pragma unroll
    for (int hseg = 0; hseg < 2; ++hseg)
#pragma unroll
        for (int q4 = 0; q4 < 2; ++q4) { const int col = hseg * 512 + 8 * F.lane + 4 * q4;
            f32x4 xv; if constexpr (HAVE_X1) xv = (f32x4){x1v[hseg * 8 + q4 * 4], x1v[hseg * 8 + q4 * 4 + 1], x1v[hseg * 8 + q4 * 4 + 2], x1v[hseg * 8 + q4 * 4 + 3]}; else xv = *(const f32x4*)(A.out + (size_t)t * D + col);
            const f32x4 gv = *(const f32x4*)(mb + 5120 + col);
#pragma unroll
            for (int e = 0; e < 4; ++e) { const float v = xv[e] + gv[e] * o[hseg * 8 + q4 * 4 + e]; x2[hseg * 8 + q4 * 4 + e] = v; ss += v * v; } }
    const float r = 1.0f / sqrtf(wave_sum(ss) * (1.0f / D) + EPS);
    if (l + 1 < DEPTH) {
        const float* mn = mod + ((size_t)(l + 1) * 8 + b) * 6144; const float* gn = A.in[I_GN1] + (size_t)(l + 1) * D;
#pragma unroll
        for (int hseg = 0; hseg < 2; ++hseg) { const int col = hseg * 512 + 8 * F.lane;
            float hn[8];
#pragma unroll
            for (int q4 = 0; q4 < 2; ++q4) { const f32x4 gg = *(const f32x4*)(gn + col + 4 * q4), sc = *(const f32x4*)(mn + 1024 + col + 4 * q4), sh = *(const f32x4*)(mn + col + 4 * q4);
                f32x4 xo;
#pragma unroll
                for (int e = 0; e < 4; ++e) { xo[e] = x2[hseg * 8 + q4 * 4 + e]; hn[q4 * 4 + e] = xo[e] * r * gg[e] * (1.0f + sc[e]) + sh[e]; }
                *(f32x4*)(A.out + (size_t)t * D + col + 4 * q4) = xo; }
            v4u ov; ov.x = pk2(hn[0], hn[1]); ov.y = pk2(hn[2], hn[3]); ov.z = pk2(hn[4], hn[5]); ov.w = pk2(hn[6], hn[7]);
            *(v4u*)(Hn + (size_t)t * D + col) = ov; }
    } else {
        const float* gf = A.in[I_GFIN];
#pragma unroll
        for (int hseg = 0; hseg < 2; ++hseg)
#pragma unroll
            for (int q4 = 0; q4 < 2; ++q4) { const int col = hseg * 512 + 8 * F.lane + 4 * q4; const f32x4 gg = *(const f32x4*)(gf + col); f32x4 xo;
#pragma unroll
                for (int e = 0; e < 4; ++e) xo[e] = x2[hseg * 8 + q4 * 4 + e] * r * gg[e];
                *(f32x4*)(A.out + (size_t)t * D + col) = xo; }
    }
}
#if EPI_HOIST
struct EpiC { float g2[16], cn[16], shn[16]; };
__device__ __forceinline__ void epi_coeffs(EpiC& C, const Ctx& F, KArgs A, int l, int t0) {
    const float* mod = (const float*)(A.ws + WS_MOD); const int b = t0 >> 11; const float* mb = mod + ((size_t)l * 8 + b) * 6144;
#pragma unroll
    for (int i = 0; i < 4; ++i) { const int col = (i >> 1) * 512 + 8 * F.lane + 4 * (i & 1);
        const f32x4 gv = *(const f32x4*)(mb + 5120 + col);
        f32x4 gg, sc, sh;
        if (l + 1 < DEPTH) { const float* mn = mod + ((size_t)(l + 1) * 8 + b) * 6144; gg = *(const f32x4*)(A.in[I_GN1] + (size_t)(l + 1) * D + col); sc = *(const f32x4*)(mn + 1024 + col); sh = *(const f32x4*)(mn + col); }
        else { gg = *(const f32x4*)(A.in[I_GFIN] + col); sc = (f32x4){0.f, 0.f, 0.f, 0.f}; sh = sc; }
#pragma unroll
        for (int e = 0; e < 4; ++e) { C.g2[4 * i + e] = gv[e]; C.cn[4 * i + e] = gg[e] * (1.0f + sc[e]); C.shn[4 * i + e] = sh[e]; } }
}
__device__ __forceinline__ void expert_epilogue_c(const Ctx& F, KArgs A, int l, int t, const float (&o)[16], const float (&x1v)[16], const EpiC& C) {
    bf16* Hn = (bf16*)(A.ws + WS_H);
    float x2[16]; float ss = 0.f;
#pragma unroll
    for (int e = 0; e < 16; ++e) { const float v = x1v[e] + C.g2[e] * o[e]; x2[e] = v; ss += v * v; }
    const float r = 1.0f / sqrtf(wave_sum(ss) * (1.0f / D) + EPS);
    if (l + 1 < DEPTH) {
#pragma unroll
        for (int hseg = 0; hseg < 2; ++hseg) { const int col = hseg * 512 + 8 * F.lane;
            float hn[8];
#pragma unroll
            for (int q4 = 0; q4 < 2; ++q4) { f32x4 xo;
#pragma unroll
                for (int e = 0; e < 4; ++e) { xo[e] = x2[hseg * 8 + q4 * 4 + e]; hn[q4 * 4 + e] = xo[e] * r * C.cn[hseg * 8 + q4 * 4 + e] + C.shn[hseg * 8 + q4 * 4 + e]; }
                *(f32x4*)(A.out + (size_t)t * D + col + 4 * q4) = xo; }
            v4u ov; ov.x = pk2(hn[0], hn[1]); ov.y = pk2(hn[2], hn[3]); ov.z = pk2(hn[4], hn[5]); ov.w = pk2(hn[6], hn[7]);
            *(v4u*)(Hn + (size_t)t * D + col) = ov; }
    } else {
#pragma unroll
        for (int hseg = 0; hseg < 2; ++hseg)
#pragma unroll
            for (int q4 = 0; q4 < 2; ++q4) { const int col = hseg * 512 + 8 * F.lane + 4 * q4; f32x4 xo;
#pragma unroll
                for (int e = 0; e < 4; ++e) xo[e] = x2[hseg * 8 + q4 * 4 + e] * r * C.cn[hseg * 8 + q4 * 4 + e];
                *(f32x4*)(A.out + (size_t)t * D + col) = xo; }
    }
}
#endif
__device__ __forceinline__ void experts_unit4(const Ctx& F, KArgs A, int l, int t0, LAS unsigned char* ring, const LAS unsigned short* il, const LAS float* wl) {
    const bf16* H = (const bf16*)(A.ws + WS_H); const unsigned char* UE = A.ws + WS_UE; const unsigned char* VE = A.ws + WS_VE;
    const float* US = (const float*)(A.ws + WS_US); const float* VS = (const float*)(A.ws + WS_VS);
    const unsigned lo16b = (unsigned)F.lane * 16u;
#if EPI_HOIST
    static_assert(NORM_FOLD, "EPI_HOIST: x1 comes from the token loop");
    EpiC EC; epi_coeffs(EC, F, A, l, t0);
#endif
#if H2C_HOIST
    float cg[16], csh[16];
    { const float* mb = (const float*)(A.ws + WS_MOD) + ((size_t)l * 8 + (t0 >> 11)) * 6144; const float* g2 = A.in[I_GN2] + (size_t)l * D;
#pragma unroll
      for (int i = 0; i < 4; ++i) { const int col = (i >> 1) * 512 + 8 * F.lane + 4 * (i & 1);
          const f32x4 gg = *(const f32x4*)(g2 + col), sc = *(const f32x4*)(mb + 4096 + col), sh = *(const f32x4*)(mb + 3072 + col);
#pragma unroll
          for (int e = 0; e < 4; ++e) { cg[4 * i + e] = gg[e] * (1.0f + sc[e]); csh[4 * i + e] = sh[e]; } } }
#endif
#if X1_PREFETCH
    f32x4 xn[4];
    { const float* xr = A.out + (size_t)t0 * D;
#pragma unroll
      for (int i = 0; i < 4; ++i) xn[i] = *(const f32x4*)(xr + (i >> 1) * 512 + 8 * F.lane + 4 * (i & 1)); }
#endif
    int nidx0 = il[F.lane];
#if ROW_OFFS
    int nro0 = nidx0 * (int)EROW;
#else
#define nro0 nidx0
#define ro0 idx0
#define ro1 idx1
#endif
    { NextB nb{UE, nro0, 0};
#pragma unroll
      for (int j = 0; j < 16; ++j) dma_row(nb, j, lo16b, ring + j * 1024); }
    v4u raw = (v4u){0u, 0u, 0u, 0u};
#pragma unroll 1
    for (int k = 0; k < 4; ++k) {
        const int t = t0 + k; const int idx0 = nidx0, idx1 = il[k * 128 + 64 + F.lane]; const float wx0k = wl[k * 128 + F.lane], wx1k = wl[k * 128 + 64 + F.lane];
#if ROW_OFFS
        const int ro0 = nro0, ro1 = idx1 * (int)EROW;
#endif
        nidx0 = il[(k < 3 ? k + 1 : 3) * 128 + F.lane];
#if ROW_OFFS
        nro0 = nidx0 * (int)EROW;
#endif
        const float su0 = US[idx0], su1 = US[idx1], sv0 = VS[idx0], sv1 = VS[idx1];
        HQ hq; float x1v[16];
        { float hv[16];
#if NORM_FOLD
          {
              const float* xr = A.out + (size_t)t * D; const float* mb = (const float*)(A.ws + WS_MOD) + ((size_t)l * 8 + (t >> 11)) * 6144; const float* g2 = A.in[I_GN2] + (size_t)l * D;
              float ss = 0.f;
#pragma unroll
              for (int hseg = 0; hseg < 2; ++hseg)
#pragma unroll
                  for (int q4 = 0; q4 < 2; ++q4) {
#if X1_PREFETCH
                      const f32x4 xv = xn[hseg * 2 + q4];
#else
                      const f32x4 xv = *(const f32x4*)(xr + hseg * 512 + 8 * F.lane + 4 * q4);
#endif
#pragma unroll
                      for (int e = 0; e < 4; ++e) { hv[hseg * 8 + q4 * 4 + e] = xv[e]; x1v[hseg * 8 + q4 * 4 + e] = xv[e]; ss += xv[e] * xv[e]; } }
#if X1_PREFETCH
              { const float* xq = xr + (k < 3 ? D : 0);
#pragma unroll
                for (int i = 0; i < 4; ++i) xn[i] = *(const f32x4*)(xq + (i >> 1) * 512 + 8 * F.lane + 4 * (i & 1)); }
#endif
              const float r = 1.0f / sqrtf(wave_sum(ss) * (1.0f / D) + EPS);
#pragma unroll
              for (int hseg = 0; hseg < 2; ++hseg)
#pragma unroll
#if H2C_HOIST
                  for (int q4 = 0; q4 < 2; ++q4) {
#pragma unroll
                      for (int e = 0; e < 4; ++e) hv[hseg * 8 + q4 * 4 + e] = hv[hseg * 8 + q4 * 4 + e] * r * cg[hseg * 8 + q4 * 4 + e] + csh[hseg * 8 + q4 * 4 + e]; }
#else
                  for (int q4 = 0; q4 < 2; ++q4) { const int col = hseg * 512 + 8 * F.lane + 4 * q4;
                      const f32x4 gg = *(const f32x4*)(g2 + col), sc = *(const f32x4*)(mb + 4096 + col), sh = *(const f32x4*)(mb + 3072 + col);
#pragma unroll
                      for (int e = 0; e < 4; ++e) hv[hseg * 8 + q4 * 4 + e] = hv[hseg * 8 + q4 * 4 + e] * r * gg[e] * (1.0f + sc[e]) + sh[e]; }
#endif
          }
#else
          const v4u ha = *(const v4u*)(H + (size_t)t * D + 8 * F.lane), hb = *(const v4u*)(H + (size_t)t * D + 512 + 8 * F.lane);
          hv[0] = bflo(ha.x); hv[1] = bfhi(ha.x); hv[2] = bflo(ha.y); hv[3] = bfhi(ha.y); hv[4] = bflo(ha.z); hv[5] = bfhi(ha.z); hv[6] = bflo(ha.w); hv[7] = bfhi(ha.w);
          hv[8] = bflo(hb.x); hv[9] = bfhi(hb.x); hv[10] = bflo(hb.y); hv[11] = bfhi(hb.y); hv[12] = bflo(hb.z); hv[13] = bfhi(hb.z); hv[14] = bflo(hb.w); hv[15] = bfhi(hb.w);
#endif
          float am = 0.f;
#pragma unroll
          for (int e = 0; e < 16; ++e) am = fmaxf(am, fabsf(hv[e]));
          am = wave_max(am);
          const float inv1 = am > 0.f ? 127.0f / am : 0.f; hq.s1 = am * (1.0f / 127.0f); hq.s2 = hq.s1 * (1.0f / 254.0f); const float inv2 = inv1 * 254.0f;
#pragma unroll
          for (int w = 0; w < 4; ++w) { unsigned p1 = 0, p2 = 0;
#pragma unroll
              for (int e = 0; e < 4; ++e) { const float h = hv[4 * w + e]; const float a = rintf(h * inv1); const float b = fminf(fmaxf(rintf((h - a * hq.s1) * inv2), -127.f), 127.f);
                  p1 |= ((unsigned)(int)a & 255u) << (8 * e); p2 |= ((unsigned)(int)b & 255u) << (8 * e); }
              hq.q1[w] = (int)p1; hq.q2[w] = (int)p2; }
#if EXP6B
          hq.c1 = -128 * __builtin_amdgcn_sdot4(hq.q1[0], 0x01010101, __builtin_amdgcn_sdot4(hq.q1[2], 0x01010101, 0, false), false);
          hq.c2 = -128 * __builtin_amdgcn_sdot4(hq.q2[0], 0x01010101, __builtin_amdgcn_sdot4(hq.q2[2], 0x01010101, 0, false), false);
          hq.s1 *= 0.25f; hq.s2 *= 0.25f;
#else
          hq.c1 = 0; hq.c2 = 0;
#endif
        }
#if ROW_PIPE
        if (k == 0) { vm_wait<15>(); lds_raw(raw, ring, lo16b); }
#endif
        float act0 = 0.f, act1 = 0.f;
#pragma unroll 1
        for (int q = 0; q < 8; ++q) {
            const int qn = (q + 1) & 7; NextB nb{q < 7 ? UE : VE, qn < 4 ? ro0 : ro1, 16 * (qn & 3)};
            const float tot = consume_u(ring, hq, nb, F.lane, lo16b, raw);
            if ((F.lane >> 4) == (q & 3)) { if (q < 4) act0 = tot; else act1 = tot; }
        }
        act0 *= su0; act1 *= su1;
        const float w0 = wx0k * sv0 * 0.5f * act0 * (1.0f + erff(act0 * 0.7071067811865476f)), w1 = wx1k * sv1 * 0.5f * act1 * (1.0f + erff(act1 * 0.7071067811865476f));
#if V_MFMA
        float o[16];
        { const float cam = wave_max(fmaxf(fabsf(w0), fabsf(w1)));
          const float ci1 = cam > 0.f ? 127.0f / cam : 0.f, S1 = cam * (1.0f / 127.0f), S2 = S1 * (1.0f / 254.0f), ci2 = ci1 * 254.0f;
          int cq0, cq1;
          { const float a = rintf(w0 * ci1), b = fminf(fmaxf(rintf((w0 - a * S1) * ci2), -127.f), 127.f); cq0 = ((int)a & 255) | (((int)b & 255) << 8); }
          { const float a = rintf(w1 * ci1), b = fminf(fmaxf(rintf((w1 - a * S1) * ci2), -127.f), 127.f); cq1 = ((int)a & 255) | (((int)b & 255) << 8); }
          const unsigned sh8 = 8u * ((unsigned)F.lane & 3u);
          v4i a1[4], a2[4];
#pragma unroll
          for (int e = 0; e < 4; ++e) { a1[e] = (v4i){0, 0, 0, 0}; a2[e] = (v4i){0, 0, 0, 0}; }
#pragma unroll 1
          for (int q = 0; q < 7; ++q) {
              const int qn = q + 1; NextB nb{VE, qn < 4 ? ro0 : ro1, 16 * (qn & 3)};
              consume_vm<false>(ring, a1, a2, q < 4 ? cq0 : cq1, 16 * (q & 3), nb, lo16b, sh8, raw);
          }
          if (k < 3) { NextB nb{UE, nro0, 0}; consume_vm<false>(ring, a1, a2, cq1, 48, nb, lo16b, sh8, raw); }
          else { NextB nb{UE, 0, 0}; consume_vm<true>(ring, a1, a2, cq1, 48, nb, lo16b, sh8, raw); }
#if EXP6B
          static_assert(V_PLANES == 1, "6-bit rows: one c plane");
          { const int csum = wave_sumi((int)(signed char)(cq0 & 255) + (int)(signed char)(cq1 & 255));
#pragma unroll
            for (int e = 0; e < 16; ++e) o[e] = ((e >> 2) & 1) ? (0.25f * S1) * (float)a1[e >> 2][e & 3] : S1 * (float)(a1[e >> 2][e & 3] - 32 * csum); }
#else
#pragma unroll
          for (int e = 0; e < 16; ++e) o[e] = S1 * (float)a1[e >> 2][e & 3] + S2 * (float)a2[e >> 2][e & 3];
#endif
        }
#else
        const float csum = wave_sum(w0 + w1);
        float o[16];
#pragma unroll
        for (int e = 0; e < 16; ++e) o[e] = 0.f;
#pragma unroll 1
        for (int q = 0; q < 7; ++q) {
            const int qn = q + 1; NextB nb{VE, qn < 4 ? idx0 : idx1, 16 * (qn & 3)};
            consume_v<false>(ring, o, q < 4 ? w0 : w1, 16 * (q & 3), nb, lo16b);
        }
        if (k < 3) { NextB nb{UE, nidx0, 0}; consume_v<false>(ring, o, w1, 48, nb, lo16b); }
        else { NextB nb{UE, 0, 0}; consume_v<true>(ring, o, w1, 48, nb, lo16b); }
#pragma unroll
        for (int e = 0; e < 16; ++e) o[e] -= 128.0f * csum;
#endif
#if EPI_HOIST
        expert_epilogue_c(F, A, l, t, o, x1v, EC);
#else
        expert_epilogue<(NORM_FOLD) != 0>(F, A, l, t, o, x1v);
#endif
    }
}
#undef UBF
__device__ __forceinline__ void phase_experts(const Ctx& F, KArgs A, int l) {
    const int* IDX = (const int*)(A.ws + WS_IDX); const float* WTS = (const float*)(A.ws + WS_WTS);
    for (int t = F.gw; t < T; t += F.NGW)
        expert_token(F, A, l, t, IDX[(size_t)t * 128 + F.lane], IDX[(size_t)t * 128 + 64 + F.lane], WTS[(size_t)t * 128 + F.lane], WTS[(size_t)t * 128 + 64 + F.lane]);
}
__device__ __forceinline__ void phase_peer(const Ctx& F, KArgs A, int l) {
    LAS unsigned char* scr = F.lds + RING_OFF + F.wave * 16384;
    LAS unsigned short* il = (LAS unsigned short*)(F.lds + HAND_OFF + F.wave * 3072); LAS float* wl = (LAS float*)(F.lds + HAND_OFF + F.wave * 3072 + 1024);
#ifndef PROBE_PEER_CUS
#define PROBE_PEER_CUS 256
#endif
    if (F.vcu >= PROBE_PEER_CUS) return;
#if PEER_DYNAMIC
    unsigned* ctr = (unsigned*)(A.ws + WS_CTL) + CW_PEERQ + 64 * l;
    for (int u = F.gw; u < T / 4; ) {
#else
    for (int u = F.gw; u < T / 4; u += PROBE_PEER_CUS * NWAVES) {
#endif
        Ctx G = F; asm volatile("" : "+v"(G.lane));
        route_unit(G, A, l, u, scr, il, wl, 4 * u);
        LDS_WAIT();
#if EXP_I8 && !DBG_ROUTE32
        asm volatile("" : "+v"(G.lane));
        experts_unit4(G, A, l, 4 * u, scr, il, wl);
#if PEER_DYNAMIC
        { unsigned nu = 0; if (F.lane == 0) nu = __hip_atomic_fetch_add(ctr, 1u, __ATOMIC_RELAXED, __HIP_MEMORY_SCOPE_AGENT); u = (int)__builtin_amdgcn_readfirstlane(nu) + F.NGW; }
#endif
#else
#pragma unroll 1
        for (int k = 0; k < 4; ++k) expert_token(F, A, l, 4 * u + k, il[k * 128 + F.lane], il[k * 128 + 64 + F.lane], wl[k * 128 + F.lane], wl[k * 128 + 64 + F.lane]);
#endif
        LDS_WAIT();
    }
}
__device__ __forceinline__ bool ph_in_range(int k) {
    const __attribute__((address_space(4))) Args* ap_ = (const __attribute__((address_space(4))) Args*)__builtin_amdgcn_kernarg_segment_ptr(); asm volatile("" : "+s"(ap_));
    return ap_->ph_lo <= k && k < ap_->ph_hi;
}
#ifndef FUSE_PEER
#define FUSE_PEER (!DBG_ROUTE32)
#endif
constexpr int PPL = (FUSE_PEER ? 8 : 9) - ((NORM_FOLD) ? 1 : 0);
constexpr int N_PHASES = 2 + PPL * DEPTH;
#ifndef ONLY_MASK
#define ONLY_MASK 0xffffffffu
#endif
#ifndef REP_MASK
#define REP_MASK 0u
#endif
#define ONLY(k, stmt) do { if constexpr ((ONLY_MASK >> (k)) & 1u) { for (int rep_ = 0; rep_ < (((REP_MASK >> (k)) & 1u) ? 2 : 1); ++rep_) { stmt; } } } while (0)
__global__ void __launch_bounds__(NWAVES * 64, 2) mega_fwd(Args args) {
    extern __shared__ __attribute__((aligned(16))) unsigned char lds[];
#define MKARGS() const __attribute__((address_space(4))) Args* ap_ = (const __attribute__((address_space(4))) Args*)__builtin_amdgcn_kernarg_segment_ptr(); asm volatile("" : "+s"(ap_)); KArgs A = *ap_
#define MKCTX() MKARGS(); Ctx F; { int tid_ = threadIdx.x; asm volatile("" : "+v"(tid_)); int bx_ = blockIdx.x; asm volatile("" : "+s"(bx_)); \
        F.lds = (LAS unsigned char*)lds; F.tid = tid_; F.lane = tid_ & 63; F.wave = __builtin_amdgcn_readfirstlane(tid_ >> 6); F.G = gridDim.x; \
        F.vcu = (F.G % 8 == 0) ? (bx_ % 8) * (F.G / 8) + bx_ / 8 : bx_; F.gw = F.vcu * NWAVES + F.wave; F.NGW = F.G * NWAVES; }
    for (int u = threadIdx.x; u < (LDS_BYTES - LDSCTL_OFF) / 4; u += NWAVES * 64) ((LAS unsigned*)((LAS unsigned char*)lds + LDSCTL_OFF))[u] = 0u;
    __syncthreads();
    { MKARGS();
      if (A.ph_hi - A.ph_lo > 1) (void)xcd_barrier_post((unsigned*)(A.ws + WS_CTL) + CW_BAR, (volatile LAS unsigned*)((LAS unsigned char*)lds + MISC_OFF) + 8); }

#define IN(k) ph_in_range(k)
#define SEAM(k) do { if (IN(k) && IN((k) + 1)) { MKARGS(); XcdBarrier b_; b_.bar = (unsigned*)(A.ws + WS_CTL) + CW_BAR; b_.x = xb_xcc_id(); b_.st = (volatile LAS unsigned*)((LAS unsigned char*)lds + MISC_OFF) + 8; xcd_barrier(b_); } } while (0)
    if (IN(0)) { MKCTX(); ONLY(0, phase_pre(F, A)); } SEAM(0);
    if (IN(1)) { MKCTX(); ONLY(1, phase_h0(F, A)); } SEAM(1);
#if DBG_ROUTE32
#define QGEMM(l) do { pg8::Gemm g{(const bf16*)(A.ws + WS_H3), (const bf16*)(A.ws + WS_WQ3), 3072, 3072, 3072, 0, 0}; pg8::StaticOrder S; S.init(T, 2048, F.G, (int)blockIdx.x); \
        pg8::EpiF32 E{(float*)(A.ws + WS_Q32), 2048}; pg8::gemm_phase<pg8::EpiF32, pg8::StaticOrder, true, true>(F.lds + RING_OFF, g, S, E); } while (0)
#define ROUTE_EXTRA(l) phase_expert_convert(F, A, (l))
#define ROUTE(l) phase_route_naive(F, A, (l))
#else
#define QGEMM(l) do { unsigned char* wl = A.ws + WS_W + (size_t)(l) * W_LAYER; \
        pg8::Gemm g{(const bf16*)(A.ws + WS_H), (const bf16*)(wl + W_WQ), D, D, D, 0, 0}; pg8::StaticOrder S; S.init(T, 2048, F.G, (int)blockIdx.x); \
        QEPI(l); } while (0)
#define ROUTE_EXTRA(l) do {} while (0)
#if NORM_FOLD
#define WOEPI(l) pg8::EpiWoN E{(l) == 0 ? A.in[I_X] : A.out, A.out, (const float*)(A.ws + WS_MOD) + (size_t)(l) * 8 * 6144, A.in[I_GN2] + (size_t)(l) * D, (bf16*)(A.ws + WS_H), (float*)(A.ws + WS_SSQ)}; \
        ONLY(9, (pg8::gemm_phase<pg8::EpiWoN, pg8::StaticOrder, true, true>(F.lds + RING_OFF, g, S, E)))
#else
#define WOEPI(l) pg8::EpiWo E{(l) == 0 ? A.in[I_X] : A.out, A.out, (const float*)(A.ws + WS_MOD) + (size_t)(l) * 8 * 6144 + 2048}; \
        ONLY(9, (pg8::gemm_phase<pg8::EpiWo, pg8::StaticOrder, true, true>(F.lds + RING_OFF, g, S, E)))
#endif
#if NORM_FOLD
#define QEPI(l) pg8::EpiQN E{(bf16*)(A.ws + WS_Q2), (const float*)(A.ws + WS_SSQ), (const float*)(A.ws + WS_CQ) + (size_t)(l) * 8 * 2048, EPS}; \
        pg8::gemm_phase<pg8::EpiQN, pg8::StaticOrder, true, true>(F.lds + RING_OFF, g, S, E)
#else
#define QEPI(l) pg8::EpiBf16 E{(bf16*)(A.ws + WS_Q2), 2048}; \
        pg8::gemm_phase<pg8::EpiBf16, pg8::StaticOrder, true, true>(F.lds + RING_OFF, g, S, E)
#endif
#define ROUTE(l) phase_route(F, A, (l))
#endif
#ifndef NAIVE_MIX
#define NAIVE_MIX 0
#endif
#if NAIVE_MIX & 1
#define MIX_SWA(l) phase_swa_naive(F, A, (l))
#else
#define MIX_SWA(l) phase_swa2(F, A, (l))
#endif
#if NAIVE_MIX & 2
#define MIX_POOL(l) phase_pool_naive(F, A, (l))
#else
#define MIX_POOL(l) phase_pool(F, A, (l))
#endif
#define LAYER(l) do { \
    constexpr int P0_ = 2 + PPL * (l); \
    if (IN(P0_ + 0)) { MKCTX(); unsigned char* wl = A.ws + WS_W + (size_t)(l) * W_LAYER; \
        pg8::Gemm g{(const bf16*)(A.ws + WS_H), (const bf16*)(wl + W_WIN), D, D, D, 0, 0}; pg8::StaticOrder S; S.init(T, NIN, F.G, (int)blockIdx.x); \
        pg8::EpiProj E{(bf16*)(A.ws + WS_PROJ), (bf16*)(A.ws + WS_GATES)}; \
        ONLY(2, (pg8::gemm_phase<pg8::EpiProj, pg8::StaticOrder, true, true>(F.lds + RING_OFF, g, S, E))); \
        if (EXP_I8_OWN && (int)blockIdx.x >= 64) expert_quant(A, (l), F.lane, ((int)blockIdx.x - 64) * NWAVES + F.wave, (F.G - 64) * NWAVES);     \
        } \
    SEAM(P0_ + 0); \
    if (IN(P0_ + 1)) { { MKARGS(); \
        const attn_body::AttnTensors AT{(const attn_body::bf16*)(A.ws + WS_PROJ), (const attn_body::bf16*)(A.ws + WS_PROJ), (const attn_body::bf16*)(A.ws + WS_PROJ), (attn_body::bf16*)(A.ws + WS_O)}; \
        const attn_body::StaticOrder S((int)gridDim.x, (int)blockIdx.x); \
        ONLY(3, attn_body::attn_phase<attn_body::StaticOrder>((char*)lds + RING_OFF, AT, S)); } \
        { MKCTX(); ONLY(4, MIX_SWA(l)); ONLY(5, phase_conv_naive(F, A, (l))); ONLY(6, MIX_POOL(l)); } } \
    SEAM(P0_ + 1); \
    if (IN(P0_ + 2)) { MKCTX(); ONLY(7, phase_ya(F, A, (l))); } \
    SEAM(P0_ + 2); \
    if (IN(P0_ + 3)) { MKCTX(); unsigned char* wl = A.ws + WS_W + (size_t)(l) * W_LAYER; \
        pg8::Gemm g{(const bf16*)(A.ws + WS_Y), (const bf16*)(wl + W_WBR), 2048, 512, 512, (size_t)512 * 2, (size_t)D * 512 * 2}; pg8::ZOrder<4> S; S.init(T, D, F.G, (int)blockIdx.x); \
        pg8::EpiMergeK E{(const bf16*)(A.ws + WS_GATES), (bf16*)(A.ws + WS_O)}; \
        ONLY(8, (pg8::gemm_phase<pg8::EpiMergeK, pg8::ZOrder<4>, true, true>(F.lds + RING_OFF, g, S, E))); } \
    SEAM(P0_ + 3); \
    if (IN(P0_ + 4)) { MKCTX(); unsigned char* wl = A.ws + WS_W + (size_t)(l) * W_LAYER; \
        pg8::Gemm g{(const bf16*)(A.ws + WS_O), (const bf16*)(wl + W_WO), D, D, D, 0, 0}; pg8::StaticOrder S; S.init(T, D, F.G, (int)blockIdx.x); \
        WOEPI(l); } \
    SEAM(P0_ + 4); \
    if constexpr (!(NORM_FOLD)) { \
        if (IN(P0_ + 5)) { MKCTX(); ONLY(10, phase_h2(F, A, (l))); } \
        SEAM(P0_ + 5); \
    } \
    constexpr int PQ_ = P0_ + ((NORM_FOLD) ? 5 : 6); \
    if (IN(PQ_)) { MKCTX(); ONLY(11, QGEMM(l)); } \
    SEAM(PQ_); \
    if constexpr (FUSE_PEER) { \
        if (IN(PQ_ + 1)) { MKCTX(); ONLY(13, phase_peer(F, A, (l))); } \
        SEAM(PQ_ + 1); \
    } else { \
        if (IN(PQ_ + 1)) { MKCTX(); ONLY(12, ROUTE(l)); ROUTE_EXTRA(l); } \
        SEAM(PQ_ + 1); \
        if (IN(PQ_ + 2)) { MKCTX(); ONLY(13, phase_experts(F, A, (l))); } \
        SEAM(PQ_ + 2); \
    } \
} while (0)
    LAYER(0);
    LAYER(1);
#undef LAYER
#undef IN
#undef SEAM
}

#ifndef MK_SINGLE
#define MK_SINGLE 1
#endif
extern "C" void kernel_launch(void* const* d_in, const int* in_sizes, int n_in, void* d_out, int out_size, void* d_ws, size_t ws_size, hipStream_t stream) {
    static int grid = 0;
    if (grid == 0) {
        if (n_in != N_IN || in_sizes[0] != T * D || out_size != T * D || ws_size < WS_END) { fprintf(stderr, "kernel_launch: unexpected shapes: n_in %d in0 %d out %d ws %zu\n", n_in, n_in > 0 ? in_sizes[0] : -1, out_size, ws_size); grid = -1; return; }
        int dev = 0, cus = 0;
        if (hipGetDevice(&dev) != hipSuccess || hipDeviceGetAttribute(&cus, hipDeviceAttributeMultiprocessorCount, dev) != hipSuccess) { grid = -1; return; }
        if (hipFuncSetAttribute((const void*)mega_fwd, hipFuncAttributeMaxDynamicSharedMemorySize, LDS_BYTES) != hipSuccess) { fprintf(stderr, "kernel_launch: hipFuncSetAttribute failed\n"); grid = -1; return; }
        (void)hipGetLastError();
        grid = cus;
        if (grid != 256) fprintf(stderr, "kernel_launch: %d CUs; this kernel is built for 256\n", grid);
    }
    if (grid < 0) return;
    if (hipMemsetAsync((char*)d_ws + WS_CTL, 0, CTL_ZERO_BYTES, stream) != hipSuccess) return;
    Args a{};
    for (int i = 0; i < N_IN; ++i) a.in[i] = (const float*)d_in[i];
    a.out = (float*)d_out; a.ws = (unsigned char*)d_ws;
#if MK_SINGLE
    a.ph_lo = 0; a.ph_hi = N_PHASES;
    hipLaunchKernelGGL(mega_fwd, dim3(grid), dim3(NWAVES * 64), LDS_BYTES, stream, a);
#else
    for (int ph = 0; ph < N_PHASES; ++ph) { a.ph_lo = ph; a.ph_hi = ph + 1; hipLaunchKernelGGL(mega_fwd, dim3(grid), dim3(NWAVES * 64), LDS_BYTES, stream, a); }
#endif
}
```

```cpp
#include <hip/hip_runtime.h>
#include <cstdio>
#include <cstdint>
#include <type_traits>
namespace pg8 {
#define PG8_LAS __attribute__((address_space(3)))
typedef unsigned short bf16_t;
typedef short bf16x8 __attribute__((ext_vector_type(8)));
typedef float f32x4 __attribute__((ext_vector_type(4)));
typedef unsigned u32x4 __attribute__((ext_vector_type(4)));
constexpr int BM = 256, BK = 64, HALF = 128, HTB = HALF * BK * 2  , STAGE_BYTES = 8 * HTB, NXCD = 8, WGM = 8;

__host__ __device__ __forceinline__ int lds_byte(int r, int c) { const int st = (r >> 4) * 2 + (c >> 5), rr = r & 15, cc = c & 31, ob = rr * 64 + cc * 2; return st * 1024 + (ob ^ (((ob >> 9) & 1) << 5)); }
__host__ __device__ __forceinline__ void stage_rc(int b, int& R, int& C) { const int st = b / 1024, sb = b % 1024, swz = sb ^ (((sb >> 9) & 1) << 5); R = (st >> 1) * 16 + swz / 64; C = (st & 1) * 32 + (swz % 64) / 2; }
__host__ __device__ __forceinline__ int perm32(int rho) { const int n = rho >> 4, i = rho & 15; return 8 * (i >> 2) + 4 * n + (i & 3); }

struct Unit { int pm, pn, z; };
struct Gemm { const bf16_t* A; const bf16_t* Bt; int lda, ldb, K; size_t zA, zB; };

struct StaticOrder {
    int nM, nN, nwg, G, c;
    __host__ __device__ void init(int M, int N, int G_, int c_) { nM = M / BM; nN = N / BM; nwg = nM * nN; G = G_; c = c_; }
    __host__ __device__ bool next(int i, Unit& u) const {
        const long L = (long)i * G + c; if (L >= nwg) return false;
        int wgid = (int)L; { const int q = nwg / NXCD, r = nwg % NXCD, xcd = wgid % NXCD, off = wgid / NXCD; wgid = (xcd < r ? xcd * (q + 1) : r * (q + 1) + (xcd - r) * q) + off; }
        const int nig = WGM * nN, gid = wgid / nig, fm = gid * WGM, gsz = (nM - fm) < WGM ? (nM - fm) : WGM;
        u.pm = fm + ((wgid % nig) % gsz); u.pn = (wgid % nig) / gsz; u.z = 0; return true;
    }
    __device__ __forceinline__ void a_ready(const Unit&) const {}
    __device__ __forceinline__ void done(const Unit&) const {}
};
template <int NZ> struct ZOrder {
    StaticOrder S;
    __host__ __device__ void init(int M, int N, int G_, int c_) { S.init(M, N, G_, c_); }
    __host__ __device__ bool next(int i, Unit& u) const { if (!S.next(i / NZ, u)) return false; u.z = i % NZ; return true; }
    __device__ __forceinline__ void a_ready(const Unit&) const {}
    __device__ __forceinline__ void done(const Unit&) const {}
};

__device__ __forceinline__ unsigned cvt_pk_bf16(float lo, float hi) { unsigned r; asm volatile("v_cvt_pk_bf16_f32 %0, %1, %2" : "=v"(r) : "v"(lo), "v"(hi)); return r; }
__device__ __forceinline__ float bf_lo(unsigned w) { return __builtin_bit_cast(float, w << 16); }
__device__ __forceinline__ float bf_hi(unsigned w) { return __builtin_bit_cast(float, w & 0xffff0000u); }
__device__ __forceinline__ float sigmoidf_(float x) { return __builtin_amdgcn_rcpf(1.0f + __expf(-x)); }

__device__ __forceinline__ void store_lines(bf16_t* p, size_t ldc_rows8  , int fr, u32x4 w0, u32x4 w1) {
    const bool up = fr & 8;
    u32x4 x = up ? w0 : w1, r;
    r.x = (unsigned)__builtin_amdgcn_mov_dpp((int)x.x, 0x128, 0xF, 0xF, true); r.y = (unsigned)__builtin_amdgcn_mov_dpp((int)x.y, 0x128, 0xF, 0xF, true);
    r.z = (unsigned)__builtin_amdgcn_mov_dpp((int)x.z, 0x128, 0xF, 0xF, true); r.w = (unsigned)__builtin_amdgcn_mov_dpp((int)x.w, 0x128, 0xF, 0xF, true);
    bf16_t* pa = up ? p - ldc_rows8 + 32 : p; bf16_t* pb = up ? p + 32 : p + ldc_rows8;
    *(u32x4*)pa = up ? r : w0;
    *(u32x4*)pb = up ? w1 : r;
}
struct EpiBf16 {
    static constexpr bool PERM = true, AFTER_DRAIN = false;
    static __device__ __forceinline__ bool keeps_acc(const Unit&) { return false; }
    bf16_t* O; int ldc;
    __device__ __forceinline__ void operator()(const f32x4 (&acc)[2][2][4][2], const Unit& u, int wr, int wc, int fr, int fq) const {
        const int row0 = u.pm * BM + wr * 64 + fr, col0 = u.pn * BM + wc * 64 + 8 * fq;
#pragma unroll
        for (int ai = 0; ai < 2; ++ai)
#pragma unroll
            for (int m = 0; m < 4; ++m) { bf16_t* rowp = O + (size_t)(row0 + ai * HALF + m * 16) * ldc + col0;
                u32x4 w[2];
#pragma unroll
                for (int bj = 0; bj < 2; ++bj) { const f32x4 v0 = acc[ai][bj][m][0], v1 = acc[ai][bj][m][1];
                    w[bj].x = cvt_pk_bf16(v0[0], v0[1]); w[bj].y = cvt_pk_bf16(v0[2], v0[3]); w[bj].z = cvt_pk_bf16(v1[0], v1[1]); w[bj].w = cvt_pk_bf16(v1[2], v1[3]); }
                store_lines(rowp, (size_t)8 * ldc, fr, w[0], w[1]); }
    }
};
struct EpiProj {
    static constexpr bool PERM = true, AFTER_DRAIN = false;
    static __device__ __forceinline__ bool keeps_acc(const Unit&) { return false; }
    bf16_t* proj; bf16_t* gates;
    __device__ __forceinline__ void operator()(const f32x4 (&acc)[2][2][4][2], const Unit& u, int wr, int wc, int fr, int fq) const {
        const bool isg = u.pn >= 17; bf16_t* base = isg ? gates : proj; const int ldc = isg ? 4096 : 4352;
        const int row0 = u.pm * BM + wr * 64 + fr, col0 = (isg ? u.pn - 17 : u.pn) * BM + wc * 64 + 8 * fq;
#pragma unroll
        for (int ai = 0; ai < 2; ++ai)
#pragma unroll
            for (int m = 0; m < 4; ++m) { bf16_t* rowp = base + (size_t)(row0 + ai * HALF + m * 16) * ldc + col0;
                if (isg) {
                    f32x4 E[4];
#pragma unroll
                    for (int z = 0; z < 4; ++z)
#pragma unroll
                        for (int e = 0; e < 4; ++e) E[z][e] = 1.0f + __expf(-acc[ai][z >> 1][m][z & 1][e]);
                    bf16_t* gp = gates + (size_t)(row0 + ai * HALF + m * 16) * 4096 + (u.pn - 17) * 64 + wc * 16 + 4 * fq;
#pragma unroll
                    for (int z = 0; z < 4; ++z) { f32x4 f;
#pragma unroll
                        for (int e = 0; e < 4; ++e) f[e] = (z < 3 ? E[z + 1][e] : 1.0f) * __builtin_amdgcn_rcpf(E[z][e]);
                        typedef unsigned u32x2 __attribute__((ext_vector_type(2)));
                        u32x2 w; w.x = cvt_pk_bf16(f[0], f[1]); w.y = cvt_pk_bf16(f[2], f[3]); *(u32x2*)(gp + z * 1024) = w; }
                } else {
                { u32x4 w[2];
#pragma unroll
                for (int bj = 0; bj < 2; ++bj) { const f32x4 v0 = acc[ai][bj][m][0], v1 = acc[ai][bj][m][1];
                    w[bj].x = cvt_pk_bf16(v0[0], v0[1]); w[bj].y = cvt_pk_bf16(v0[2], v0[3]); w[bj].z = cvt_pk_bf16(v1[0], v1[1]); w[bj].w = cvt_pk_bf16(v1[2], v1[3]); }
                store_lines(rowp, (size_t)8 * ldc, fr, w[0], w[1]); } } }
    }
};
struct EpiMerge {
    static constexpr bool PERM = true, AFTER_DRAIN = false;
    static __device__ __forceinline__ bool keeps_acc(const Unit&) { return false; }
    const bf16_t* gates; float* s32; bf16_t* s16;
    __device__ __forceinline__ void operator()(const f32x4 (&acc)[2][2][4][2], const Unit& u, int wr, int wc, int fr, int fq) const {
        const int row0 = u.pm * BM + wr * 64 + fr, col0 = u.pn * BM + wc * 64 + 8 * fq, z = u.z;
#pragma unroll
        for (int ai = 0; ai < 2; ++ai)
#pragma unroll
            for (int m = 0; m < 4; ++m) { const size_t row = (size_t)(row0 + ai * HALF + m * 16);
#pragma unroll
                for (int bj = 0; bj < 2; ++bj) { const int col = col0 + bj * 32;
                    const u32x4 gw = *(const u32x4*)(gates + row * 4096 + (size_t)z * 1024 + col);
                    f32x4 v0 = acc[ai][bj][m][0], v1 = acc[ai][bj][m][1];
                    v0[0] *= bf_lo(gw.x); v0[1] *= bf_hi(gw.x); v0[2] *= bf_lo(gw.y); v0[3] *= bf_hi(gw.y);
                    v1[0] *= bf_lo(gw.z); v1[1] *= bf_hi(gw.z); v1[2] *= bf_lo(gw.w); v1[3] *= bf_hi(gw.w);
                    float* sp = s32 + row * 1024 + col;
                    if (z > 0) { v0 += *(const f32x4*)sp; v1 += *(const f32x4*)(sp + 4); }
                    if (z < 3) { *(f32x4*)sp = v0; *(f32x4*)(sp + 4) = v1; }
                    else { u32x4 w; w.x = cvt_pk_bf16(v0[0], v0[1]); w.y = cvt_pk_bf16(v0[2], v0[3]); w.z = cvt_pk_bf16(v1[0], v1[1]); w.w = cvt_pk_bf16(v1[2], v1[3]);
                        *(u32x4*)(s16 + row * 1024 + col) = w; } } }
    }
};
struct EpiWo {
    static constexpr bool PERM = false, AFTER_DRAIN = false;
    static __device__ __forceinline__ bool keeps_acc(const Unit&) { return false; }
    const float* xin; float* out; const float* gate;
    __device__ __forceinline__ void operator()(const f32x4 (&acc)[2][2][4][2], const Unit& u, int wr, int wc, int fr, int fq) const {
        const int row0 = u.pm * BM + wr * 64 + fr, col0 = u.pn * BM + wc * 32 + 4 * fq; const float* gb = gate + (size_t)(u.pm >> 3) * 6144;
#pragma unroll
        for (int bj = 0; bj < 2; ++bj)
#pragma unroll
            for (int n = 0; n < 2; ++n) { const int col = col0 + bj * HALF + n * 16; const f32x4 gv = *(const f32x4*)(gb + col);
#pragma unroll
                for (int ai = 0; ai < 2; ++ai)
#pragma unroll
                    for (int m = 0; m < 4; ++m) { const size_t off = (size_t)(row0 + ai * HALF + m * 16) * 1024 + col;
                        const f32x4 o = *(const f32x4*)(xin + off) + gv * acc[ai][bj][m][n]; *(f32x4*)(out + off) = o; } }
    }
};

struct EpiF32 {
    static constexpr bool PERM = false, AFTER_DRAIN = false;
    static __device__ __forceinline__ bool keeps_acc(const Unit&) { return false; }
    float* O; int ldc;
    __device__ __forceinline__ void operator()(const f32x4 (&acc)[2][2][4][2], const Unit& u, int wr, int wc, int fr, int fq) const {
        const int row0 = u.pm * BM + wr * 64 + fr, col0 = u.pn * BM + wc * 32 + 4 * fq;
#pragma unroll
        for (int bj = 0; bj < 2; ++bj)
#pragma unroll
            for (int n = 0; n < 2; ++n)
#pragma unroll
                for (int ai = 0; ai < 2; ++ai)
#pragma unroll
                    for (int m = 0; m < 4; ++m) *(f32x4*)(O + (size_t)(row0 + ai * HALF + m * 16) * ldc + col0 + bj * HALF + n * 16) = acc[ai][bj][m][n];
    }
};

struct EpiWoN {
    static constexpr bool PERM = false, AFTER_DRAIN = false;
    static __device__ __forceinline__ bool keeps_acc(const Unit&) { return false; }
    const float* xin; float* out; const float* modl; const float* g2; bf16_t* hb; float* ssq;
    __device__ __forceinline__ void operator()(const f32x4 (&acc)[2][2][4][2], const Unit& u, int wr, int wc, int fr, int fq) const {
        const int row0 = u.pm * BM + wr * 64 + fr, col0 = u.pn * BM + wc * 32 + 4 * fq; const float* mb = modl + (size_t)(u.pm >> 3) * 6144;
        float sq[2][4];
#pragma unroll
        for (int ai = 0; ai < 2; ++ai)
#pragma unroll
            for (int m = 0; m < 4; ++m) sq[ai][m] = 0.f;
#pragma unroll
        for (int bj = 0; bj < 2; ++bj)
#pragma unroll
            for (int n = 0; n < 2; ++n) { const int col = col0 + bj * HALF + n * 16; const f32x4 gv = *(const f32x4*)(mb + 2048 + col);
                const f32x4 gm = *(const f32x4*)(g2 + col) * (*(const f32x4*)(mb + 4096 + col) + 1.0f);
#pragma unroll
                for (int ai = 0; ai < 2; ++ai)
#pragma unroll
                    for (int m = 0; m < 4; ++m) { const size_t off = (size_t)(row0 + ai * HALF + m * 16) * 1024 + col;
                        const f32x4 o = *(const f32x4*)(xin + off) + gv * acc[ai][bj][m][n]; *(f32x4*)(out + off) = o;
                        sq[ai][m] += (o[0] * o[0] + o[1] * o[1]) + (o[2] * o[2] + o[3] * o[3]);
                        const f32x4 a = o * gm; typedef unsigned u32x2 __attribute__((ext_vector_type(2)));
                        u32x2 w; w.x = cvt_pk_bf16(a[0], a[1]); w.y = cvt_pk_bf16(a[2], a[3]); *(u32x2*)(hb + off) = w; } }
#pragma unroll
        for (int ai = 0; ai < 2; ++ai)
#pragma unroll
            for (int m = 0; m < 4; ++m) { float s = sq[ai][m]; s += __shfl_xor(s, 16); s += __shfl_xor(s, 32);
                if (fq == 0) ssq[(size_t)(row0 + ai * HALF + m * 16) * 16 + u.pn * 4 + wc] = s; }
    }
};
struct EpiQN {
    static constexpr bool PERM = true, AFTER_DRAIN = false;
    static __device__ __forceinline__ bool keeps_acc(const Unit&) { return false; }
    bf16_t* O; const float* ssq; const float* cq; float eps;
    __device__ __forceinline__ void operator()(const f32x4 (&acc)[2][2][4][2], const Unit& u, int wr, int wc, int fr, int fq) const {
        const int row0 = u.pm * BM + wr * 64 + fr, col0 = u.pn * BM + wc * 64 + 8 * fq; const float* cb = cq + (size_t)(u.pm >> 3) * 2048 + col0;
        f32x4 c[2][2];
#pragma unroll
        for (int bj = 0; bj < 2; ++bj) { c[bj][0] = *(const f32x4*)(cb + bj * 32); c[bj][1] = *(const f32x4*)(cb + bj * 32 + 4); }
#pragma unroll
        for (int ai = 0; ai < 2; ++ai)
#pragma unroll
            for (int m = 0; m < 4; ++m) { const int row = row0 + ai * HALF + m * 16; const f32x4* sp = (const f32x4*)(ssq + (size_t)row * 16);
                const f32x4 s0 = sp[0], s1 = sp[1], s2 = sp[2], s3 = sp[3];
                const float ss = ((((s0[0] + s0[1]) + (s0[2] + s0[3])) + ((s1[0] + s1[1]) + (s1[2] + s1[3]))) + (((s2[0] + s2[1]) + (s2[2] + s2[3])) + ((s3[0] + s3[1]) + (s3[2] + s3[3]))));
                const float r = 1.0f / sqrtf(ss * (1.0f / 1024.0f) + eps);
                bf16_t* rowp = O + (size_t)row * 2048 + col0;
                u32x4 w[2];
#pragma unroll
                for (int bj = 0; bj < 2; ++bj) { const f32x4 v0 = acc[ai][bj][m][0] * r + c[bj][0], v1 = acc[ai][bj][m][1] * r + c[bj][1];
                    w[bj].x = cvt_pk_bf16(v0[0], v0[1]); w[bj].y = cvt_pk_bf16(v0[2], v0[3]); w[bj].z = cvt_pk_bf16(v1[0], v1[1]); w[bj].w = cvt_pk_bf16(v1[2], v1[3]); }
                store_lines(rowp, (size_t)8 * 2048, fr, w[0], w[1]); }
    }
};

struct EpiMergeK {
    static constexpr bool PERM = true, AFTER_DRAIN = false;
    static __device__ __forceinline__ bool keeps_acc(const Unit& u) { return u.z < 3; }
    const bf16_t* gates; bf16_t* s16;
    __device__ __forceinline__ void operator()(f32x4 (&acc)[2][2][4][2], const Unit& u, int wr, int wc, int fr, int fq) const {
        const int row0 = u.pm * BM + wr * 64 + fr, col0 = u.pn * BM + wc * 64 + 8 * fq, z = u.z;
#pragma unroll
        for (int ai = 0; ai < 2; ++ai)
#pragma unroll
            for (int m = 0; m < 4; ++m) { const size_t row = (size_t)(row0 + ai * HALF + m * 16);
#pragma unroll
                for (int bj = 0; bj < 2; ++bj) { const int col = col0 + bj * 32;
                    const u32x4 gw = *(const u32x4*)(gates + row * 4096 + (size_t)z * 1024 + col);
                    const float g[8] = {bf_lo(gw.x), bf_hi(gw.x), bf_lo(gw.y), bf_hi(gw.y), bf_lo(gw.z), bf_hi(gw.z), bf_lo(gw.w), bf_hi(gw.w)};
                    f32x4 v0 = acc[ai][bj][m][0], v1 = acc[ai][bj][m][1];
                    v0[0] *= g[0]; v0[1] *= g[1]; v0[2] *= g[2]; v0[3] *= g[3]; v1[0] *= g[4]; v1[1] *= g[5]; v1[2] *= g[6]; v1[3] *= g[7];
                    if (z < 3) { acc[ai][bj][m][0] = v0; acc[ai][bj][m][1] = v1; }
                    else { u32x4 w; w.x = cvt_pk_bf16(v0[0], v0[1]); w.y = cvt_pk_bf16(v0[2], v0[3]); w.z = cvt_pk_bf16(v1[0], v1[1]); w.w = cvt_pk_bf16(v1[2], v1[3]);
                        *(u32x4*)(s16 + row * 1024 + col) = w; } } }
    }
};

template <class Epi, class Sched, bool ALIGN_EPI = false, bool SP2 = false>
__device__ __forceinline__ void gemm_phase(PG8_LAS unsigned char* lds, const Gemm g, const Sched& S, const Epi& E) {
    const int tid = threadIdx.x, wid = __builtin_amdgcn_readfirstlane(tid >> 6), lane = tid & 63, wr = wid >> 2, wc = wid & 3, fr = lane & 15, fq = lane >> 4;
    const int K = g.K, nt = K / BK;
    unsigned voffA[2], voffB[2];
#pragma unroll
    for (int i = 0; i < 2; ++i) { int R, C; stage_rc(tid * 16 + i * 8192, R, C); const int Rb = Epi::PERM ? (64 * (R >> 5) + perm32(R & 31)) : R;
        voffA[i] = (unsigned)(R * g.lda + C) * 2u; voffB[i] = (unsigned)(Rb * g.ldb + C) * 2u; }
    const size_t kstep = (size_t)(BK * 2);
    const size_t hstepA = (size_t)HALF * g.lda * 2, hstepB = (size_t)(Epi::PERM ? 32 : HALF) * g.ldb * 2;
    const size_t tstepA = 2 * hstepA, tstepB = (size_t)BM * g.ldb * 2;
    const unsigned ldsw = (unsigned)wid * 1024u;
    const int aoff = lds_byte(wr * 64 + fr, fq * 8), boff = lds_byte(wc * 32 + fr, fq * 8);
#define PG8_SA(b, h) (((b) * 2 + (h)) * HTB)
#define PG8_SB(b, h) ((4 + (b) * 2 + (h)) * HTB)
#define PG8_STAGE(bufoff, gbase, voff) do { _Pragma("unroll") for (int _i = 0; _i < 2; ++_i) \
        __builtin_amdgcn_global_load_lds((const unsigned*)((const char*)(gbase) + (voff)[_i]), (PG8_LAS unsigned*)(lds + (bufoff) + ldsw + _i * 8192), 16, 0, 0); } while (0)
#define PG8_LDA(dst, b, h) do { _Pragma("unroll") for (int m = 0; m < 4; ++m) _Pragma("unroll") for (int k = 0; k < 2; ++k) dst[m][k] = *(const PG8_LAS bf16x8*)(lds + PG8_SA(b, h) + aoff + m * 2048 + k * 1024); } while (0)
#define PG8_LDB(dst, b, h) do { _Pragma("unroll") for (int n = 0; n < 2; ++n) _Pragma("unroll") for (int k = 0; k < 2; ++k) dst[n][k] = *(const PG8_LAS bf16x8*)(lds + PG8_SB(b, h) + boff + n * 2048 + k * 1024); } while (0)
#define PG8_MMA(ai, bj, At, Bt) do { __builtin_amdgcn_s_setprio(1); _Pragma("unroll") for (int m = 0; m < 4; ++m) _Pragma("unroll") for (int n = 0; n < 2; ++n) _Pragma("unroll") for (int k = 0; k < 2; ++k) \
        acc[ai][bj][m][n] = __builtin_amdgcn_mfma_f32_16x16x32_bf16(Bt[n][k], At[m][k], acc[ai][bj][m][n], 0, 0, 0); __builtin_amdgcn_s_setprio(0); } while (0)
#define PG8_WAIT_V(n) asm volatile("s_waitcnt vmcnt(" #n ")" ::: "memory")
#define PG8_WAIT_L(n) asm volatile("s_waitcnt lgkmcnt(" #n ")" ::: "memory")
#define PG8_BAR __builtin_amdgcn_s_barrier()
#define PG8_SCHED __builtin_amdgcn_sched_barrier(0)
    Unit cur, nxt; int ui = 0;
    if (!S.next(0, cur)) return;
    f32x4 acc[2][2][4][2];
#pragma unroll
    for (int a = 0; a < 2; ++a)
#pragma unroll
        for (int b = 0; b < 2; ++b)
#pragma unroll
            for (int m = 0; m < 4; ++m)
#pragma unroll
                for (int n = 0; n < 2; ++n) acc[a][b][m][n] = (f32x4){0.f, 0.f, 0.f, 0.f};
    bf16x8 At[4][2], B0[2][2], B1[2][2];
    const char* cA = (const char*)g.A + (size_t)cur.pm * tstepA + (size_t)cur.z * g.zA; const char* cB = (const char*)g.Bt + (size_t)cur.pn * tstepB + (size_t)cur.z * g.zB;
    S.a_ready(cur);
    if constexpr (SP2) {
        PG8_STAGE(PG8_SB(0, 0), cB, voffB); PG8_STAGE(PG8_SB(0, 1), cB + hstepB, voffB); PG8_STAGE(PG8_SA(0, 0), cA, voffA); PG8_STAGE(PG8_SA(0, 1), cA + hstepA, voffA);
        if (wr == 1) PG8_BAR;
        PG8_WAIT_V(2); PG8_BAR;
        PG8_STAGE(PG8_SB(1, 0), cB + kstep, voffB); PG8_STAGE(PG8_SA(1, 0), cA + kstep, voffA); PG8_STAGE(PG8_SB(1, 1), cB + hstepB + kstep, voffB);
        PG8_WAIT_V(6); PG8_BAR;
    } else {
        PG8_STAGE(PG8_SB(0, 0), cB, voffB); PG8_STAGE(PG8_SA(0, 0), cA, voffA); PG8_STAGE(PG8_SB(0, 1), cB + hstepB, voffB); PG8_STAGE(PG8_SA(0, 1), cA + hstepA, voffA);
        if (wr == 1) PG8_BAR;
        PG8_WAIT_V(4); PG8_BAR;
        PG8_STAGE(PG8_SB(1, 0), cB + kstep, voffB); PG8_STAGE(PG8_SA(1, 0), cA + kstep, voffA); PG8_STAGE(PG8_SB(1, 1), cB + hstepB + kstep, voffB);
        PG8_WAIT_V(6); PG8_BAR;
    }
    for (;;) {
        const bool has_next = S.next(ui + 1, nxt);
        const char* nA = has_next ? (const char*)g.A + (size_t)nxt.pm * tstepA + (size_t)nxt.z * g.zA : cA; const char* nB = has_next ? (const char*)g.Bt + (size_t)nxt.pn * tstepB + (size_t)nxt.z * g.zB : cB;
        for (int t = 0; t < nt; t += 2) {
            const bool last = (t == nt - 2);
            const char* a1 = cA + (size_t)(t + 1) * kstep;
            const char* a2 = last ? nA : cA + (size_t)(t + 2) * kstep; const char* b2 = last ? nB : cB + (size_t)(t + 2) * kstep;
            const char* a3 = a2 + kstep; const char* b3 = b2 + kstep;
            if (last && has_next) S.a_ready(nxt);
            if constexpr (SP2) {
            PG8_LDB(B0, 0, 0); PG8_LDB(B1, 0, 1); PG8_SCHED; PG8_LDA(At, 0, 0); PG8_STAGE(PG8_SA(1, 1), a1 + hstepA, voffA);
            PG8_WAIT_V(8); PG8_WAIT_L(0); PG8_BAR; PG8_MMA(0, 0, At, B0); PG8_MMA(0, 1, At, B1); PG8_BAR; PG8_SCHED;
            PG8_LDA(At, 0, 1); PG8_STAGE(PG8_SB(0, 0), b2, voffB); PG8_STAGE(PG8_SB(0, 1), b2 + hstepB, voffB); PG8_STAGE(PG8_SA(0, 0), a2, voffA);
            PG8_WAIT_V(8); PG8_WAIT_L(0); PG8_BAR; PG8_MMA(1, 0, At, B0); PG8_MMA(1, 1, At, B1); PG8_BAR; PG8_SCHED;
            PG8_LDB(B0, 1, 0); PG8_LDB(B1, 1, 1); PG8_SCHED; PG8_LDA(At, 1, 0); PG8_STAGE(PG8_SA(0, 1), a2 + hstepA, voffA);
            PG8_WAIT_V(8); PG8_WAIT_L(0); PG8_BAR; PG8_MMA(0, 0, At, B0); PG8_MMA(0, 1, At, B1); PG8_BAR; PG8_SCHED;
            PG8_LDA(At, 1, 1); PG8_STAGE(PG8_SB(1, 0), b3, voffB); PG8_STAGE(PG8_SB(1, 1), b3 + hstepB, voffB); PG8_STAGE(PG8_SA(1, 0), a3, voffA);
            PG8_WAIT_V(8); PG8_WAIT_L(0); PG8_BAR; PG8_MMA(1, 0, At, B0); PG8_MMA(1, 1, At, B1); PG8_BAR; PG8_SCHED;
            } else {
            PG8_LDB(B0, 0, 0); PG8_SCHED; PG8_LDA(At, 0, 0); PG8_STAGE(PG8_SA(1, 1), a1 + hstepA, voffA);
            PG8_WAIT_L(8); PG8_BAR; PG8_WAIT_L(0); PG8_MMA(0, 0, At, B0); PG8_BAR; PG8_SCHED;
            PG8_LDB(B1, 0, 1); PG8_STAGE(PG8_SB(0, 0), b2, voffB);
            PG8_BAR; PG8_WAIT_L(0); PG8_MMA(0, 1, At, B1); PG8_BAR;
            PG8_LDA(At, 0, 1); PG8_STAGE(PG8_SA(0, 0), a2, voffA);
            PG8_BAR; PG8_WAIT_L(0); PG8_MMA(1, 0, At, B0); PG8_BAR; PG8_SCHED;
            PG8_STAGE(PG8_SB(0, 1), b2 + hstepB, voffB);
            PG8_WAIT_V(6); PG8_BAR; PG8_MMA(1, 1, At, B1); PG8_BAR;
            PG8_LDB(B0, 1, 0); PG8_SCHED; PG8_LDA(At, 1, 0); PG8_STAGE(PG8_SA(0, 1), a2 + hstepA, voffA);
            PG8_WAIT_L(8); PG8_BAR; PG8_WAIT_L(0); PG8_MMA(0, 0, At, B0); PG8_BAR; PG8_SCHED;
            PG8_LDB(B1, 1, 1); PG8_STAGE(PG8_SB(1, 0), b3, voffB);
            PG8_BAR; PG8_WAIT_L(0); PG8_MMA(0, 1, At, B1); PG8_BAR;
            PG8_LDA(At, 1, 1); PG8_STAGE(PG8_SA(1, 0), a3, voffA);
            PG8_BAR; PG8_WAIT_L(0); PG8_MMA(1, 0, At, B0); PG8_BAR; PG8_SCHED;
            PG8_STAGE(PG8_SB(1, 1), b3 + hstepB, voffB);
            PG8_WAIT_V(6); PG8_BAR; PG8_MMA(1, 1, At, B1); PG8_BAR;
            }
        }
        if constexpr (ALIGN_EPI) { if (wr == 0) PG8_BAR; }
        if constexpr (!Epi::AFTER_DRAIN) { E(acc, cur, wr, wc, fr, fq); S.done(cur); }
        if (!has_next) break;
        if (!Epi::keeps_acc(cur)) {
#pragma unroll
        for (int a = 0; a < 2; ++a)
#pragma unroll
            for (int b = 0; b < 2; ++b)
#pragma unroll
                for (int m = 0; m < 4; ++m)
#pragma unroll
                    for (int n = 0; n < 2; ++n) acc[a][b][m][n] = (f32x4){0.f, 0.f, 0.f, 0.f};
        }
        cur = nxt; cA = nA; cB = nB; ++ui;
        if constexpr (ALIGN_EPI) { if (wr == 1) PG8_BAR; }
    }
    PG8_WAIT_V(0);
    if constexpr (!ALIGN_EPI) { if (wr == 0) PG8_BAR; }
    PG8_BAR;
    if constexpr (Epi::AFTER_DRAIN) { E.fused(acc, cur, wr, wc, fr, fq, lds, wid, lane); S.done(cur); }
#undef PG8_SA
#undef PG8_SB
#undef PG8_STAGE
#undef PG8_LDA
#undef PG8_LDB
#undef PG8_MMA
#undef PG8_WAIT_V
#undef PG8_WAIT_L
#undef PG8_BAR
#undef PG8_SCHED
}
}

#ifndef PG8_SP2
#define PG8_SP2 true
#endif
#ifndef PG8_ALIGN
#define PG8_ALIGN true
#endif
#include <hip/hip_bf16.h>
#include <cmath>
namespace attn_body {
using bf16=__hip_bfloat16;
using bf16x8=__attribute__((ext_vector_type(8)))short;
using s16x4=__attribute__((ext_vector_type(4)))short;
using f32x16=__attribute__((ext_vector_type(16)))float;
using u32x4=__attribute__((ext_vector_type(4)))unsigned;
constexpr int SEQ=2048,D=64,PQ=4352,PK=4352,PV=4352,PO=1024;
constexpr int NW=8,QBLK=32,QB=QBLK*NW,KVBLK=64,NQB=SEQ/QB;
constexpr int ATTN_UNIT_ROWS=QB;
__device__ __forceinline__ int crow(int r,int hi){return (r&3)+8*(r>>2)+4*hi;}
#define SBAR() __builtin_amdgcn_sched_barrier(0)
__device__ __forceinline__ void cmask(f32x16&p0,f32x16&p1,int jb,int qrel,int hi){
  const float NEG=-INFINITY; int kb=64*jb+4*hi;
  #pragma unroll
  for(int r=0;r<16;++r){int kv=kb+(r&3)+8*(r>>2); if(kv>qrel)p0[r]=NEG; if(kv+32>qrel)p1[r]=NEG;}
}

constexpr int NSLOT=3, SLOTB=8192;
constexpr int LDS_K=0, LDS_V=NSLOT*SLOTB, LDS_WS=2*NSLOT*SLOTB, LDS_OST=LDS_WS+NW*64*4, LDS_BYTES=LDS_OST+NW*4096;
constexpr float C2=0.125f*1.4426950408889634f;
__device__ __forceinline__ void glds16(const void*gsrc,unsigned lds_dst){unsigned keep;
  asm volatile("s_mov_b32 %0, m0\n\ts_mov_b32 m0, %2\n\ts_nop 0\n\tglobal_load_lds_dwordx4 %1, off\n\ts_mov_b32 m0, %0":"=&s"(keep):"v"(gsrc),"s"(lds_dst):"memory");}
__device__ __forceinline__ float max3f(float a,float b,float c){float r;asm("v_max3_f32 %0, %1, %2, %3":"=v"(r):"v"(a),"v"(b),"v"(c));return r;}
__device__ __forceinline__ float max2f(float a,float b){float r;asm("v_max_f32_e32 %0, %1, %2":"=v"(r):"v"(a),"v"(b));return r;}
__device__ __forceinline__ float fadd_s(float a,float b){float r;asm("v_add_f32_e32 %0, %1, %2":"=v"(r):"v"(a),"v"(b));return r;}
__device__ __forceinline__ float fsub_s(float a,float b){float r;asm("v_sub_f32_e32 %0, %1, %2":"=v"(r):"v"(a),"v"(b));return r;}
typedef float f32x2_t __attribute__((ext_vector_type(2))); typedef __bf16 bf16x2_t __attribute__((ext_vector_type(2)));
__device__ __forceinline__ unsigned cvtpk_s(float lo,float hi){f32x2_t v={lo,hi};bf16x2_t b=__builtin_convertvector(v,bf16x2_t);return __builtin_bit_cast(unsigned,b);}
#define WAIT_BAR(N) asm volatile("s_waitcnt vmcnt(" #N ") lgkmcnt(0)\n\ts_barrier":::"memory")

__device__ __forceinline__ void qkt(f32x16&p0,f32x16&p1,const char*Kslot,const bf16x8*qr,const f32x16&negm,int r32,int hi){
  const char*kb=Kslot+hi*1024+r32*16;
  #pragma unroll
  for(int d0=0;d0<4;++d0){
    const bf16x8 b0=*reinterpret_cast<const bf16x8*>(kb+d0*2048);
    const bf16x8 b1=*reinterpret_cast<const bf16x8*>(kb+d0*2048+512);
    if(d0==0){p0=__builtin_amdgcn_mfma_f32_32x32x16_bf16(b0,qr[0],negm,0,0,0);p1=__builtin_amdgcn_mfma_f32_32x32x16_bf16(b1,qr[0],negm,0,0,0);}
    else{p0=__builtin_amdgcn_mfma_f32_32x32x16_bf16(b0,qr[d0],p0,0,0,0);p1=__builtin_amdgcn_mfma_f32_32x32x16_bf16(b1,qr[d0],p1,0,0,0);}}
}
typedef __attribute__((address_space(3))) const char* lds_cptr;
typedef short v4i16_t __attribute__((ext_vector_type(4)));
__device__ __forceinline__ void kload8(bf16x8*kf,lds_cptr kp){
  kf[0]=*(const __attribute__((address_space(3))) bf16x8*)(kp);      kf[1]=*(const __attribute__((address_space(3))) bf16x8*)(kp+512);
  kf[2]=*(const __attribute__((address_space(3))) bf16x8*)(kp+2048); kf[3]=*(const __attribute__((address_space(3))) bf16x8*)(kp+2560);
  kf[4]=*(const __attribute__((address_space(3))) bf16x8*)(kp+4096); kf[5]=*(const __attribute__((address_space(3))) bf16x8*)(kp+4608);
  kf[6]=*(const __attribute__((address_space(3))) bf16x8*)(kp+6144); kf[7]=*(const __attribute__((address_space(3))) bf16x8*)(kp+6656);
}
__device__ __forceinline__ void kload2(bf16x8*kf,lds_cptr kp,int j){ kf[2*j]=*(const __attribute__((address_space(3))) bf16x8*)(kp+j*2048); kf[2*j+1]=*(const __attribute__((address_space(3))) bf16x8*)(kp+j*2048+512); }
__device__ __forceinline__ s16x4 vtr(lds_cptr p){ return __builtin_bit_cast(s16x4,__builtin_amdgcn_ds_read_tr16_b64_v4i16((__attribute__((address_space(3))) v4i16_t*)p)); }
__device__ __forceinline__ float rowmax(const f32x16&p0,const f32x16&p1){
  float a=max3f(p0[0],p0[1],p1[0]),b=max3f(p0[2],p0[3],p1[1]);a=max3f(a,p1[2],p1[3]);
  #pragma unroll
  for(int r=4;r<16;r+=4){a=max3f(a,p0[r],p0[r+1]);b=max3f(b,p0[r+2],p0[r+3]);a=max3f(a,p1[r],p1[r+1]);b=max3f(b,p1[r+2],p1[r+3]);}
  const float m=max2f(a,b);
  auto rr=__builtin_amdgcn_permlane32_swap(__float_as_uint(m),__float_as_uint(m),false,false);
  return max2f(__uint_as_float(rr[0]),__uint_as_float(rr[1]));
}
__device__ __forceinline__ void pv(f32x16*o,int vb,bf16x8 pa0,bf16x8 pa1,bf16x8 pa2,bf16x8 pa3){
  #pragma unroll
  for(int d0=0;d0<2;++d0){s16x4 lo[4],hi[4];
    #pragma unroll
    for(int ks=0;ks<4;++ks){
      asm volatile("ds_read_b64_tr_b16 %0,%1 offset:%c2":"=&v"(lo[ks]):"v"(vb),"i"(d0*4096+ks*1024):"memory");
      asm volatile("ds_read_b64_tr_b16 %0,%1 offset:%c2":"=&v"(hi[ks]):"v"(vb),"i"(d0*4096+ks*1024+512):"memory");}
    asm volatile("s_waitcnt lgkmcnt(0)":::"memory");SBAR();
    #define PK(k) (bf16x8){lo[k][0],lo[k][1],lo[k][2],lo[k][3],hi[k][0],hi[k][1],hi[k][2],hi[k][3]}
    o[d0]=__builtin_amdgcn_mfma_f32_32x32x16_bf16(pa0,PK(0),o[d0],0,0,0);
    o[d0]=__builtin_amdgcn_mfma_f32_32x32x16_bf16(pa1,PK(1),o[d0],0,0,0);
    o[d0]=__builtin_amdgcn_mfma_f32_32x32x16_bf16(pa2,PK(2),o[d0],0,0,0);
    o[d0]=__builtin_amdgcn_mfma_f32_32x32x16_bf16(pa3,PK(3),o[d0],0,0,0);
    #undef PK
  }
}

#ifndef ATTN_STORE16
#define ATTN_STORE16(p,v) (*(u32x4*)(p)=(v))
#endif
template<int THRL> __device__ __forceinline__ void attn_unit(int b,int qcol,int kcol,int vcol,int ocol,int qb,const bf16*Q,const bf16*__restrict__ K,const bf16*__restrict__ V,bf16*O,char*shm){
  const int tid=threadIdx.x,lane=tid&63,r32=lane&31,hi=lane>>5; const int wid=__builtin_amdgcn_readfirstlane(tid>>6);
  const long rowbase=(long)b*SEQ; const int q0=qb*QB;
  const bf16*Qw=Q+(rowbase+q0+wid*QBLK)*PQ+qcol;
  const bf16*Kh=K+rowbase*PK+kcol,*Vh=V+rowbase*PV+vcol;
  const unsigned lds0=(unsigned)(uintptr_t)shm;
  float*wsf=(float*)(shm+LDS_WS)+wid*64;
  const bf16*ksrc=Kh+(long)lane*PK+wid*8;
  const bf16*vsrc=Vh+(long)(16*(wid&3)+(lane>>2))*PV+(wid>>2)*32+(lane&3)*8;
  const unsigned kdst=lds0+LDS_K+wid*1024, vdst=lds0+LDS_V+wid*1024;
  #define DMA_K(t,slot) glds16(ksrc+(long)(t)*KVBLK*PK,(unsigned)__builtin_amdgcn_readfirstlane(kdst+(slot)))
  #define DMA_V(t,slot) glds16(vsrc+(long)(t)*KVBLK*PV,(unsigned)__builtin_amdgcn_readfirstlane(vdst+(slot)))
  const int vb0=(int)(lds0+LDS_V)+((lane>>4)&1)*32+(lane&3)*8+(4*hi+((lane&15)>>2))*64;
  const char*Kbase=shm+LDS_K; bf16x8 kf[8];
  const lds_cptr shm3=(lds_cptr)shm; const lds_cptr kp0=shm3+LDS_K+hi*1024+r32*16; const lds_cptr vp0=shm3+LDS_V+((lane>>4)&1)*32+(lane&3)*8+(4*hi+((lane&15)>>2))*64;
  const int NT=(q0+QB)/KVBLK;
  DMA_K(0,0);DMA_V(0,0);DMA_K(1,SLOTB);
  bf16x8 qr[4];
  #pragma unroll
  for(int d0=0;d0<4;++d0)qr[d0]=*reinterpret_cast<const bf16x8*>(&Qw[(long)r32*PQ+d0*16+hi*8]);
  float mhat=0.f,l_reg=0.f;f32x16 o[2];o[0]=f32x16{};o[1]=f32x16{};f32x16 negm=f32x16{};asm volatile("":"+v"(negm));
  const int qrel=wid*QBLK+r32;
  #define CMASK(P0,P1,t) do{int jb_=(t)-(NT-4); if(jb_>=0)cmask(P0,P1,jb_,qrel,hi);}while(0)
  bool resc=false;
  #define START(P0,P1) do{ const float rm=rowmax(P0,P1); resc=false; \
    { const float dl=rm; mhat=fadd_s(mhat,dl); \
      _Pragma("unroll") for(int r=0;r<16;++r){P0[r]=fsub_s(P0[r],dl);P1[r]=fsub_s(P1[r],dl);} \
      _Pragma("unroll") for(int r=0;r<16;++r)negm[r]=-mhat; asm volatile("":"+v"(negm)); } \
    _Pragma("unroll") for(int r=0;r<16;++r)P0[r]=__builtin_amdgcn_exp2f(P0[r]); }while(0)
  #define RESC() do{ if(resc){ asm volatile("s_waitcnt lgkmcnt(0)":::"memory"); \
      _Pragma("unroll") for(int d_=0;d_<2;++d_) _Pragma("unroll") for(int r=0;r<16;++r)o[d_][r]*=wsf[crow(r,hi)]; } }while(0)
  f32x16 pA0,pA1,pB0,pB1;
  int sl_prev=0,sl_cur=0,sl_next=SLOTB;
  #define ROT() do{sl_prev=sl_cur;sl_cur=sl_next;sl_next=(sl_next==(NSLOT-1)*SLOTB)?0:sl_next+SLOTB;}while(0)
  DMA_K(2,2*SLOTB);
  WAIT_BAR(3);
  qkt(pA0,pA1,Kbase,qr,negm,r32,hi);asm volatile("s_nop 15\n\ts_nop 7":"+v"(pA0),"+v"(pA1));CMASK(pA0,pA1,0);
  START(pA0,pA1);
  _Pragma("unroll") for(int r=0;r<16;++r)pA1[r]=__builtin_amdgcn_exp2f(pA1[r]);
  WAIT_BAR(0);
  DMA_K(3,0);DMA_V(1,SLOTB);
  ROT();
  kload8(kf,kp0+sl_cur);
  WAIT_BAR(2);
  s16x4 vlo[8],vhi[8]; u32x4 pw0,pw1,pw2,pw3;
  #define PKW(P,B) cvtpk_s(P[B],P[B+1])
  #define PAF(k) __builtin_bit_cast(bf16x8,pw##k)
  #define VFR(i) (bf16x8){vlo[i][0],vlo[i][1],vlo[i][2],vlo[i][3],vhi[i][0],vhi[i][1],vhi[i][2],vhi[i][3]}
  #define PIN(x) asm volatile("":"+v"(x))
  #define MX3(a,b,c) __builtin_fmaxf(__builtin_fmaxf((a),(b)),(c))
  #define GAPA(MF,A0,A1,A2,A3,W0,W1,PW) do{ MF; sacc+=A0; sacc+=A1; sacc+=A2; sacc+=A3; PIN(sacc); W0; W1; PIN(PW); SBAR(); }while(0)
  #define EX(v) __builtin_amdgcn_exp2f(v)
  #define GAPB(MF,X,B) do{ MF; X[B]=EX(X[B]); X[B+1]=EX(X[B+1]); X[B+2]=EX(X[B+2]); X[B+3]=EX(X[B+3]); PIN(X); SBAR(); }while(0)
  #define VRD(i) do{ vlo[i]=vtr(vp_+(((i)>>2)*4096+((i)&3)*1024)); vhi[i]=vtr(vp_+(((i)>>2)*4096+((i)&3)*1024+512)); }while(0)
  #define KRD(G,j) do{ if(G){ kload2(kf,kp0+sl_next,j); SBAR(); } }while(0)
  #define STEP(C0,C1,P0,P1,t,GK,GV,GL) do{ SBAR(); \
    const lds_cptr vp_=vp0+sl_prev; \
    VRD(0); SBAR(); float sacc=(P0[0]+P0[1]); \
    GAPA(C0=__builtin_amdgcn_mfma_f32_32x32x16_bf16(kf[0],qr[0],negm,0,0,0), P0[2],P0[3],P0[4],P0[5],     pw0[0]=PKW(P0,0), pw0[1]=PKW(P0,2), pw0); \
    VRD(4); SBAR(); GAPA(C1=__builtin_amdgcn_mfma_f32_32x32x16_bf16(kf[1],qr[0],negm,0,0,0), P0[6],P0[7],P0[8],P0[9],     pw0[2]=PKW(P0,4), pw0[3]=PKW(P0,6), pw0); \
    VRD(1); SBAR(); GAPA(C0=__builtin_amdgcn_mfma_f32_32x32x16_bf16(kf[2],qr[1],C0,0,0,0),   P0[10],P0[11],P0[12],P0[13], pw1[0]=PKW(P0,8), pw1[1]=PKW(P0,10), pw1); \
    VRD(5); SBAR(); GAPA(C1=__builtin_amdgcn_mfma_f32_32x32x16_bf16(kf[3],qr[1],C1,0,0,0),   P0[14],P0[15],P1[0],P1[1],   pw1[2]=PKW(P0,12),pw1[3]=PKW(P0,14), pw1); \
    VRD(2); SBAR(); GAPA(C0=__builtin_amdgcn_mfma_f32_32x32x16_bf16(kf[4],qr[2],C0,0,0,0),   P1[2],P1[3],P1[4],P1[5],     pw2[0]=PKW(P1,0), pw2[1]=PKW(P1,2), pw2); \
    VRD(6); SBAR(); GAPA(C1=__builtin_amdgcn_mfma_f32_32x32x16_bf16(kf[5],qr[2],C1,0,0,0),   P1[6],P1[7],P1[8],P1[9],     pw2[2]=PKW(P1,4), pw2[3]=PKW(P1,6), pw2); \
    VRD(3); SBAR(); GAPA(C0=__builtin_amdgcn_mfma_f32_32x32x16_bf16(kf[6],qr[3],C0,0,0,0),   P1[10],P1[11],P1[12],P1[13], pw3[0]=PKW(P1,8), pw3[1]=PKW(P1,10), pw3); \
    VRD(7); SBAR(); GAPA(C1=__builtin_amdgcn_mfma_f32_32x32x16_bf16(kf[7],qr[3],C1,0,0,0),   P1[14],P1[15],0.f,0.f,       pw3[2]=PKW(P1,12),pw3[3]=PKW(P1,14), pw3); \
    l_reg+=sacc; \
    if(GK){DMA_K((t)+3,sl_cur);} if(GV){DMA_V((t)+1,sl_next);} \
    CMASK(C0,C1,t); \
    { float a=MX3(C0[0],C0[1],C1[0]),b=MX3(C0[2],C0[3],C1[1]); a=MX3(a,C1[2],C1[3]); \
      _Pragma("unroll") for(int r=4;r<16;r+=4){a=MX3(a,C0[r],C0[r+1]);b=MX3(b,C0[r+2],C0[r+3]);a=MX3(a,C1[r],C1[r+1]);b=MX3(b,C1[r+2],C1[r+3]);} \
      float rm=__builtin_fmaxf(a,b); { auto rr=__builtin_amdgcn_permlane32_swap(__float_as_uint(rm),__float_as_uint(rm),false,false); rm=__builtin_fmaxf(__uint_as_float(rr[0]),__uint_as_float(rr[1])); } \
      resc=false; \
      if(__builtin_expect(__any(rm>(float)THRL),0)){ const float dl=__builtin_fmaxf(rm,0.f); mhat+=dl; \
        _Pragma("unroll") for(int r=0;r<16;++r){C0[r]-=dl;C1[r]-=dl;} \
        _Pragma("unroll") for(int r=0;r<16;++r)negm[r]=-mhat; asm volatile("":"+v"(negm)); \
        const float f=__builtin_amdgcn_exp2f(-dl); l_reg*=f; if(hi==0)wsf[r32]=f; resc=true; } } \
    SBAR(); \
    GAPB(o[0]=__builtin_amdgcn_mfma_f32_32x32x16_bf16(PAF(0),VFR(0),o[0],0,0,0), C0,0); \
    GAPB(o[1]=__builtin_amdgcn_mfma_f32_32x32x16_bf16(PAF(0),VFR(4),o[1],0,0,0), C0,4); \
    KRD(GL,0); GAPB(o[0]=__builtin_amdgcn_mfma_f32_32x32x16_bf16(PAF(1),VFR(1),o[0],0,0,0), C0,8); \
    KRD(GL,1); GAPB(o[1]=__builtin_amdgcn_mfma_f32_32x32x16_bf16(PAF(1),VFR(5),o[1],0,0,0), C0,12); \
    KRD(GL,2); GAPB(o[0]=__builtin_amdgcn_mfma_f32_32x32x16_bf16(PAF(2),VFR(2),o[0],0,0,0), C1,0); \
    KRD(GL,3); GAPB(o[1]=__builtin_amdgcn_mfma_f32_32x32x16_bf16(PAF(2),VFR(6),o[1],0,0,0), C1,4); \
    GAPB(o[0]=__builtin_amdgcn_mfma_f32_32x32x16_bf16(PAF(3),VFR(3),o[0],0,0,0), C1,8); \
    GAPB(o[1]=__builtin_amdgcn_mfma_f32_32x32x16_bf16(PAF(3),VFR(7),o[1],0,0,0), C1,12); \
    }while(0)
  int t=1;
  #undef CMASK
  #define CMASK(P0,P1,t) do{}while(0)
  for(;t+5<NT;t+=2){
    STEP(pB0,pB1,pA0,pA1,t,true,true,true);     WAIT_BAR(2); RESC(); ROT();
    STEP(pA0,pA1,pB0,pB1,t+1,true,true,true);   WAIT_BAR(2); RESC(); ROT();
  }
  #undef CMASK
  #define CMASK(P0,P1,t) do{int jb_=(t)-(NT-4); if(jb_>=0)cmask(P0,P1,jb_,qrel,hi);}while(0)
  #define ENDW(tt) do{ if((tt)+3<NT){WAIT_BAR(2);} else if((tt)+2<NT){WAIT_BAR(1);} else {WAIT_BAR(0);} }while(0)
  for(;t+1<NT;t+=2){
    STEP(pB0,pB1,pA0,pA1,t,(t+3<NT),(t+1<NT),(t+1<NT));       ENDW(t);   RESC(); ROT();
    STEP(pA0,pA1,pB0,pB1,t+1,(t+4<NT),(t+2<NT),(t+2<NT));     ENDW(t+1); RESC(); ROT();
  }
  STEP(pB0,pB1,pA0,pA1,NT-1,false,false,false); RESC();
  { float sacc=pB0[0]+pB0[1]; _Pragma("unroll") for(int r=2;r<16;++r)sacc+=pB0[r]; _Pragma("unroll") for(int r=0;r<16;++r)sacc+=pB1[r]; l_reg+=sacc;
    pw0=(u32x4){PKW(pB0,0),PKW(pB0,2),PKW(pB0,4),PKW(pB0,6)};pw1=(u32x4){PKW(pB0,8),PKW(pB0,10),PKW(pB0,12),PKW(pB0,14)};pw2=(u32x4){PKW(pB1,0),PKW(pB1,2),PKW(pB1,4),PKW(pB1,6)};pw3=(u32x4){PKW(pB1,8),PKW(pB1,10),PKW(pB1,12),PKW(pB1,14)};
    SBAR(); pv(o,vb0+sl_cur,PAF(0),PAF(1),PAF(2),PAF(3)); }
  #undef PKW
  #undef PAF
  #undef VFR
  #undef PIN
  #undef MX3
  #undef GAPA
  #undef GAPB
  #undef EX
  #undef VRD
  #undef KRD
  #undef STEP
  #undef ENDW
  {auto rr=__builtin_amdgcn_permlane32_swap(__float_as_uint(l_reg),__float_as_uint(l_reg),false,false);l_reg=__uint_as_float(rr[0])+__uint_as_float(rr[1]);}
  if(hi==0)wsf[32+r32]=l_reg;asm volatile("s_waitcnt lgkmcnt(0)":::"memory");
  float rli[16];
  #pragma unroll
  for(int r=0;r<16;++r)rli[r]=__builtin_amdgcn_rcpf(wsf[32+crow(r,hi)]);
  bf16*Ow=O+(rowbase+q0+wid*QBLK)*PO+ocol;
  { bf16*stg=(bf16*)(shm+LDS_OST)+wid*2048;
    #pragma unroll
    for(int r=0;r<16;++r){const int orow=crow(r,hi);
      #pragma unroll
      for(int d0=0;d0<2;++d0)stg[orow*64+d0*32+r32]=__float2bfloat16(o[d0][r]*rli[r]);}
    asm volatile("s_waitcnt lgkmcnt(0)":::"memory");
    #pragma unroll
    for(int i=0;i<4;++i){const int row=i*8+(lane>>3),ch=lane&7; const u32x4 v=*(const u32x4*)(stg+row*64+ch*8); ATTN_STORE16(Ow+(long)row*PO+ch*8,v);} }
  asm volatile("s_waitcnt lgkmcnt(0)\n\ts_barrier":::"memory");
  #undef DMA_K
  #undef DMA_V
  #undef CMASK
  #undef START
  #undef RESC
  #undef ROT
}
constexpr int ATTN_LDS_BYTES=LDS_BYTES;
struct AttnTensors { const bf16* Q; const bf16* K; const bf16* V; bf16* O; };
struct AttnUnit { int bj; int qb; };
struct StaticOrder {
  int vcu;
  __device__ __forceinline__ explicit StaticOrder(int grid,int block):vcu((block%8)*(grid/8)+block/8){}
  __device__ __forceinline__ bool next(int i,AttnUnit&u)const{ if(i>=4)return false; const int s0=2*(vcu&1); u.bj=vcu>>1; u.qb=(i==0)?s0:(i==1)?7-s0:(i==2)?s0+1:6-s0; return true; }
};
template<class Sched,int THRL=8> __device__ __forceinline__ void attn_phase(char*lds,const AttnTensors&T,const Sched&S){
  AttnUnit u;
  for(int i=0;S.next(i,u);++i){ const int b=u.bj>>4,j=u.bj&15,h=j>>2,c=(j>>1)&1,vh=j&1;
    attn_unit<THRL>(b,h*128+c*64,512+h*128+c*64,1024+h*128+vh*64,j*64,u.qb,T.Q,T.K,T.V,T.O,lds); }
}
#undef SBAR
#undef WAIT_BAR
}
constexpr int NWAVES = 8;
constexpr int NB = 8, SEQ = 2048, T = NB * SEQ, D = 1024, DEPTH = 2;
constexpr int NPROJ = 4352, NGATE = 4096, NIN = 8448;
constexpr float EPS = 1e-6f;
constexpr float C2 = 0.125f * 1.4426950408889634f;
constexpr float LOG2E = 1.4426950408889634f;
constexpr int C_AQ = 0, C_AK = 512, C_AV = 1024, C_BB = 1536, C_BC = 2048, C_BX = 2560, C_CZ = 3072, C_DQ = 3584, C_DK = 4096, C_DV = 4224;
enum { I_X = 0, I_C, I_WADA, I_BADA, I_GN1, I_WIN, I_LQ1, I_LK1, I_LQ2, I_LK2, I_GSUB, I_CONVW, I_WPOOL, I_PSCALE, I_SINKS, I_WBR, I_WO, I_GN2, I_WQ, I_SK, I_UE, I_VE, I_GFIN, N_IN };

constexpr size_t MiB = 1u << 20;
constexpr size_t WS_CTL = 0, CTL_ZERO_BYTES = 1 * MiB;
constexpr size_t WS_MOD = 1 * MiB;
constexpr size_t WS_W = 2 * MiB, W_LAYER = 27 * MiB;
constexpr size_t W_WIN = 0, W_WBR = 16 * MiB + MiB / 2, W_WO = W_WBR + 4 * MiB, W_WQ = W_WO + 2 * MiB, W_SK = W_WQ + 4 * MiB, W_WP = W_SK + 65536;
constexpr size_t WS_H = 56 * MiB;
constexpr size_t WS_PROJ = 88 * MiB;
constexpr size_t WS_S32 = WS_PROJ;
constexpr size_t WS_Q2 = WS_PROJ;
#ifndef DBG_ROUTE32
#define DBG_ROUTE32 0
#endif
#if DBG_ROUTE32
constexpr size_t WS_H3 = WS_PROJ;
constexpr size_t WS_Q32 = 224 * MiB;
constexpr size_t WS_IDX = 416 * MiB, WS_WTS = WS_IDX + 8 * MiB;
#else
constexpr size_t WS_IDX = WS_PROJ + 64 * MiB, WS_WTS = WS_IDX + 8 * MiB;
#endif
constexpr size_t WS_GATES = 224 * MiB;
constexpr size_t WS_Y = 352 * MiB;
#ifndef EXP_I8
#define EXP_I8 1
#endif
#define EXP_I8_OWN (EXP_I8 && !DBG_ROUTE32)
#if DBG_ROUTE32
constexpr size_t WS_UE = WS_PROJ, WS_VE = WS_PROJ + 32 * MiB;
constexpr size_t WS_WQ3 = WS_Y;
#else
#if EXP_I8_OWN
constexpr size_t WS_UE = 448 * MiB, WS_VE = 464 * MiB;
#else
constexpr size_t WS_UE = WS_GATES, WS_VE = WS_GATES + 32 * MiB;
#endif
#endif
constexpr size_t WS_US = 480 * MiB, WS_VS = WS_US + 65536;
constexpr size_t WS_O = 416 * MiB;
#ifndef NORM_FOLD
#define NORM_FOLD (!DBG_ROUTE32)
#ifndef EPI_HOIST
#define EPI_HOIST 1
#endif
#ifndef H2C_HOIST
#define H2C_HOIST 1
#endif
#ifndef X1_PREFETCH
#define X1_PREFETCH 1
#endif
#ifndef V_ABID
#define V_ABID 1
#endif
#ifndef ROUTE_SORTNET
#define ROUTE_SORTNET 1
#endif
#ifndef H_PLANES
#define H_PLANES 1
#endif
#ifndef TREE_BANKMASK
#define TREE_BANKMASK 1
#endif
#ifndef ROUTE_BATCH
#define ROUTE_BATCH 4
#endif
#ifndef ROW_OFFS
#define ROW_OFFS 1
#endif
#ifndef DMA_NOMASK
#define DMA_NOMASK 1
#endif
#ifndef ROW_PIPE
#define ROW_PIPE 1
#endif
#ifndef EXP6B
#define EXP6B 1
#endif
#ifndef V_PLANES
#define V_PLANES 1
#endif
constexpr unsigned EROW = EXP6B ? 768u : 1024u;
#ifndef V_MFMA
#define V_MFMA 1
#endif
#endif
constexpr size_t WS_SSQ = 481 * MiB;
constexpr size_t WS_CQ = WS_MOD + 512 * 1024;
constexpr size_t WS_END = (EXP_I8_OWN || NORM_FOLD) ? 482 * MiB : 448 * MiB;
constexpr int CW_PEERQ = 8192;
#ifndef PEER_DYNAMIC
#define PEER_DYNAMIC 0
#endif
constexpr int CW_BAR = 4096;

constexpr int RING_OFF = 0, RING_BYTES = 131072;
constexpr int LDSCTL_OFF = RING_BYTES, MISC_OFF = LDSCTL_OFF + 320;
constexpr int HAND_OFF = LDSCTL_OFF + 1024;
constexpr int LDS_BYTES = HAND_OFF + 8 * 3072;

#define GAS __attribute__((address_space(1)))
#define LAS __attribute__((address_space(3)))
typedef unsigned short bf16;
typedef unsigned v4u __attribute__((ext_vector_type(4)));
typedef unsigned v2u __attribute__((ext_vector_type(2)));
typedef float f32x4 __attribute__((ext_vector_type(4)));
typedef GAS unsigned gu32;
#define LDS_WAIT() asm volatile("s_waitcnt lgkmcnt(0)" ::: "memory")
__device__ __forceinline__ unsigned f2bf(float f) { unsigned u = __builtin_bit_cast(unsigned, f); return (u + 0x7fffu + ((u >> 16) & 1u)) >> 16; }
__device__ __forceinline__ unsigned pk2(float lo, float hi) { return f2bf(lo) | (f2bf(hi) << 16); }
__device__ __forceinline__ float bflo(unsigned w) { return __builtin_bit_cast(float, w << 16); }
__device__ __forceinline__ float bfhi(unsigned w) { return __builtin_bit_cast(float, w & 0xffff0000u); }
__device__ __forceinline__ float bf1(bf16 h) { return __builtin_bit_cast(float, (unsigned)h << 16); }

#define XB_TMO      128
#define XB_XCNT(j)  (256  + 64 * (j))
#define XB_XSUB(j)  (1280 + 64 * (j))
#define XB_XGEN(j)  (2304 + 64 * (j))
#define XB_TOP      3328
#define XB_TOPGEN   3392
#define XCD_BAR_WORDS 3456
#define XB_SPIN_CAP (1u << 18)
__device__ __forceinline__ unsigned xb_ld(unsigned* p)              { return __hip_atomic_load(p, __ATOMIC_RELAXED, __HIP_MEMORY_SCOPE_AGENT); }
__device__ __forceinline__ unsigned xb_add(unsigned* p, unsigned v) { return __hip_atomic_fetch_add(p, v, __ATOMIC_RELAXED, __HIP_MEMORY_SCOPE_AGENT); }
__device__ __forceinline__ unsigned xb_xcc_id() { return (unsigned)__builtin_amdgcn_s_getreg((3 << 11) | 20) & 0xFu; }
#define XB_SPIN(cond, bar) do { unsigned _sp = 0; while (cond) { __builtin_amdgcn_s_sleep(1); \
    if ((++_sp & 255u) == 0u) { if (xb_ld(&(bar)[XB_TMO])) break; if (_sp > XB_SPIN_CAP) { atomicAdd(&(bar)[XB_TMO], 1u); break; } } } } while (0)
struct XcdBarrier { unsigned* bar; unsigned x; volatile LAS unsigned* st; };
__device__ __forceinline__ XcdBarrier xcd_barrier_post(unsigned* bar, volatile LAS unsigned* st) {
    XcdBarrier b; b.bar = bar; b.x = xb_xcc_id(); b.st = st;
    if (threadIdx.x == 0) (void)xb_add(&bar[XB_XCNT(b.x)], 1u);
    return b;
}
__device__ __forceinline__ void xcd_barrier_complete(unsigned* bar, unsigned x, unsigned& nloc, unsigned& nx) {
    const unsigned G = gridDim.x * gridDim.y * gridDim.z;
    unsigned sum, cnt, mine, sp = 0u;
    for (;;) {
        sum = 0u; cnt = 0u; mine = 0u;
#pragma unroll
        for (unsigned j = 0; j < 16; ++j) { const unsigned c = xb_ld(&bar[XB_XCNT(j)]); sum += c; cnt += (c > 0u) ? 1u : 0u; mine = (j == x) ? c : mine; }
        if (sum == G) break;
        __builtin_amdgcn_s_sleep(1);
        if ((++sp & 255u) == 0u) { if (xb_ld(&bar[XB_TMO])) break; if (sp > XB_SPIN_CAP) { atomicAdd(&bar[XB_TMO], 1u); break; } }
    }
    nloc = mine > 0u ? mine : 1u; nx = cnt > 0u ? cnt : 1u;
}
__device__ __forceinline__ void xcd_barrier(const XcdBarrier& b) {
    asm volatile("s_waitcnt vmcnt(0)" ::: "memory");
    __syncthreads();
    if (threadIdx.x == 0) {
        unsigned* bar = b.bar;
        __builtin_amdgcn_s_waitcnt(0);
        unsigned nloc = b.st[0], nx = b.st[1];
        if (nloc == 0u) { xcd_barrier_complete(bar, b.x, nloc, nx); b.st[0] = nloc; b.st[1] = nx; }
        const unsigned old = xb_add(&bar[XB_XSUB(b.x)], 1u);
        const unsigned gen = old / nloc;
        if (old + 1u == (gen + 1u) * nloc) {
            __builtin_amdgcn_fence(__ATOMIC_RELEASE, "agent");
            asm volatile("s_waitcnt vmcnt(0)" ::: "memory");
            const unsigned og = xb_add(&bar[XB_TOP], 1u);
            const unsigned tg = og / nx;
            if (og + 1u == (tg + 1u) * nx) xb_add(&bar[XB_TOPGEN], 1u);
            else XB_SPIN(xb_ld(&bar[XB_TOPGEN]) == tg, bar);
            __builtin_amdgcn_fence(__ATOMIC_ACQUIRE, "agent");
            xb_add(&bar[XB_XGEN(b.x)], 1u);
            asm volatile("s_waitcnt vmcnt(0)" ::: "memory");
        } else {
            XB_SPIN(xb_ld(&bar[XB_XGEN(b.x)]) == gen, bar);
            __builtin_amdgcn_fence(__ATOMIC_ACQUIRE, "agent");
            asm volatile("s_waitcnt vmcnt(0)" ::: "memory");
        }
    }
    __syncthreads();
}

__device__ __forceinline__ float rdlane(float v, int l) { return __builtin_bit_cast(float, __builtin_amdgcn_readlane(__builtin_bit_cast(int, v), l)); }
__device__ __forceinline__ int rdlanei(int v, int l) { return __builtin_amdgcn_readlane(v, l); }
template <int CTRL> __device__ __forceinline__ float dppf(float v) { return __builtin_bit_cast(float, __builtin_amdgcn_mov_dpp(__builtin_bit_cast(int, v), CTRL, 0xF, 0xF, true)); }
template <int CTRL> __device__ __forceinline__ int dppi(int v) { return __builtin_amdgcn_mov_dpp(v, CTRL, 0xF, 0xF, true); }
__device__ __forceinline__ float wave_sum(float v) {
    v += dppf<0xB1>(v); v += dppf<0x4E>(v); v += dppf<0x124>(v); v += dppf<0x128>(v);
    return (rdlane(v, 0) + rdlane(v, 16)) + (rdlane(v, 32) + rdlane(v, 48));
}
__device__ __forceinline__ int wave_sumi(int v) {
    v += dppi<0xB1>(v); v += dppi<0x4E>(v); v += dppi<0x124>(v); v += dppi<0x128>(v);
    return (rdlanei(v, 0) + rdlanei(v, 16)) + (rdlanei(v, 32) + rdlanei(v, 48));
}
__device__ __forceinline__ float wave_max(float v) {
    v = fmaxf(v, dppf<0xB1>(v)); v = fmaxf(v, dppf<0x4E>(v)); v = fmaxf(v, dppf<0x124>(v)); v = fmaxf(v, dppf<0x128>(v));
    return fmaxf(fmaxf(rdlane(v, 0), rdlane(v, 16)), fmaxf(rdlane(v, 32), rdlane(v, 48)));
}

struct Ctx {
    LAS unsigned char* lds;
    int tid, lane, wave, vcu, G, gw, NGW;
};
struct Args { const float* in[N_IN]; float* out; unsigned char* ws; int ph_lo, ph_hi; };
typedef const __attribute__((address_space(4))) Args& KArgs;

template <bool GPERM = false> __device__ __forceinline__ void p0_transpose_item(const float* W, int K, int N, bf16* WT, LAS float* scr, int item, int lane, float scale) {
    const int nblk = N / 32, kb = item / nblk, nb = item % nblk, k0 = 64 * kb, n0 = 32 * nb;
#pragma unroll 8
    for (int i = 0; i < 32; ++i) { const int kk = 2 * i + (lane >> 5); scr[kk * 33 + (lane & 31)] = W[(size_t)(k0 + kk) * N + n0 + (lane & 31)] * scale; }
    LDS_WAIT(); asm volatile("" ::: "memory");
    const int c = lane & 7;
#pragma unroll
    for (int j = 0; j < 4; ++j) { const int n = (lane >> 3) + 8 * j; const LAS float* s = scr + (8 * c) * 33 + n;
        v4u o; o.x = pk2(s[0 * 33], s[1 * 33]); o.y = pk2(s[2 * 33], s[3 * 33]); o.z = pk2(s[4 * 33], s[5 * 33]); o.w = pk2(s[6 * 33], s[7 * 33]);
        int nr = n0 + n; if (GPERM && nr >= 4352) { const int z = (nr - 4352) >> 10, cc = (nr - 4352) & 1023, ch = cc & 63; nr = 4352 + 256 * (cc >> 6) + 64 * (ch >> 4) + 32 * (z >> 1) + 8 * ((ch >> 2) & 3) + 4 * (z & 1) + (ch & 3); }
        *(GAS v4u*)(WT + (size_t)nr * K + k0 + 8 * c) = o; }
    LDS_WAIT(); asm volatile("" ::: "memory");
}

__device__ __forceinline__ void norm_mod_row(int lane, const float* xrow, const float* g, const float* scale, const float* shift, bf16* orow) {
    const f32x4* xr = (const f32x4*)xrow + lane;
    f32x4 v[4]; float s = 0.f;
#pragma unroll
    for (int j = 0; j < 4; ++j) { v[j] = xr[64 * j]; s += (v[j].x * v[j].x + v[j].y * v[j].y) + (v[j].z * v[j].z + v[j].w * v[j].w); }
    const float r = 1.0f / sqrtf(wave_sum(s) * (1.0f / D) + EPS);
    unsigned long long* o8 = (unsigned long long*)orow + lane;
#pragma unroll
    for (int j = 0; j < 4; ++j) {
        const f32x4 gg = ((const f32x4*)g)[lane + 64 * j], sc = ((const f32x4*)scale)[lane + 64 * j], sh = ((const f32x4*)shift)[lane + 64 * j];
        const f32x4 y = (v[j] * r) * gg * (sc + 1.0f) + sh;
        o8[64 * j] = (unsigned long long)pk2(y.x, y.y) | ((unsigned long long)pk2(y.z, y.w) << 32);
    }
}

__device__ __forceinline__ void phase_pre(const Ctx& F, KArgs A) {
    float* mod = (float*)(A.ws + WS_MOD);
    for (int it = F.gw; it < DEPTH * 768; it += F.NGW) {
        const int l = it / 768, j0 = (it % 768) * 8;
        float acc[8][8];
#pragma unroll
        for (int b = 0; b < 8; ++b)
#pragma unroll
            for (int j = 0; j < 8; ++j) acc[b][j] = 0.f;
        for (int i = 0; i < 16; ++i) {
            const int k = F.lane + 64 * i;
            const float* wp = A.in[I_WADA] + ((size_t)l * D + k) * 6144 + j0;
            const f32x4 w0 = *(const f32x4*)wp, w1 = *(const f32x4*)(wp + 4);
#pragma unroll
            for (int b = 0; b < 8; ++b) { const float cv = A.in[I_C][b * D + k]; const float s = cv / (1.0f + __expf(-cv));
                acc[b][0] += s * w0.x; acc[b][1] += s * w0.y; acc[b][2] += s * w0.z; acc[b][3] += s * w0.w;
                acc[b][4] += s * w1.x; acc[b][5] += s * w1.y; acc[b][6] += s * w1.z; acc[b][7] += s * w1.w; }
        }
#pragma unroll
        for (int b = 0; b < 8; ++b) {
            float r[8];
#pragma unroll
            for (int j = 0; j < 8; ++j) r[j] = wave_sum(acc[b][j]);
            if (F.lane == 0) { const float* bp = A.in[I_BADA] + (size_t)l * 6144 + j0; float* mp = mod + ((size_t)l * 8 + b) * 6144 + j0;
                *(f32x4*)mp = (f32x4){r[0] + bp[0], r[1] + bp[1], r[2] + bp[2], r[3] + bp[3]}; *(f32x4*)(mp + 4) = (f32x4){r[4] + bp[4], r[5] + bp[5], r[6] + bp[6], r[7] + bp[7]}; }
        }
    }
    LAS float* scr = (LAS float*)(F.lds + RING_OFF + F.wave * 16384);
    constexpr int I_IN = 16 * 264, I_BR = 8 * 32, I_O = 16 * 32, I_Q = 16 * 64, I_P = 2 * 4;
    constexpr int PER_LAYER = I_IN + 4 * I_BR + I_O + I_Q + 4 * I_P;
    for (int it = F.gw; it < DEPTH * PER_LAYER; it += F.NGW) {
        const int l = it / PER_LAYER; int r = it % PER_LAYER;
        unsigned char* wl = A.ws + WS_W + (size_t)l * W_LAYER;
        if (r < I_IN) { const int n0 = 32 * (r % 264); const float sc = (n0 < 512 || (n0 >= C_DQ && n0 < C_DK)) ? C2 : 1.0f;
            p0_transpose_item<true>(A.in[I_WIN] + (size_t)l * D * NIN, D, NIN, (bf16*)(wl + W_WIN), scr, r, F.lane, sc); continue; }
        r -= I_IN;
        if (r < 4 * I_BR) { const int g = r / I_BR; p0_transpose_item(A.in[I_WBR] + ((size_t)l * 4 + g) * 512 * D, 512, D, (bf16*)(wl + W_WBR) + (size_t)g * D * 512, scr, r % I_BR, F.lane, 1.0f); continue; }
        r -= 4 * I_BR;
        if (r < I_O) { p0_transpose_item(A.in[I_WO] + (size_t)l * D * D, D, D, (bf16*)(wl + W_WO), scr, r, F.lane, 1.0f); continue; }
        r -= I_O;
        if (r < I_Q) { p0_transpose_item(A.in[I_WQ] + (size_t)l * D * 2048, D, 2048, (bf16*)(wl + W_WQ), scr, r, F.lane, 1.0f); continue; }
        r -= I_Q;
        { const int g = r / I_P; p0_transpose_item(A.in[I_WPOOL] + ((size_t)l * 4 + g) * 128 * 128, 128, 128, (bf16*)(wl + W_WP) + (size_t)g * 128 * 128, scr, r % I_P, F.lane, 1.0f); }
    }
    for (int i = F.gw * 64 + F.lane; i < DEPTH * 32768 / 4; i += F.NGW * 64) {
        const int l = i / 8192, e = (i % 8192) * 4;
        const f32x4 v = *(const f32x4*)(A.in[I_SK] + (size_t)l * 32768 + e);
        v2u o; o.x = pk2(v.x, v.y); o.y = pk2(v.z, v.w);
        *(v2u*)((bf16*)(A.ws + WS_W + (size_t)l * W_LAYER + W_SK) + e) = o;
    }
}
__device__ __forceinline__ void phase_h0(const Ctx& F, KArgs A) {
    const float* mod = (const float*)(A.ws + WS_MOD);
#if NORM_FOLD
    {
        float* cq = (float*)(A.ws + WS_CQ);
        for (int it = F.gw; it < DEPTH * 256; it += F.NGW) {
            const int l = it / 256, j0 = (it % 256) * 8;
            float acc[8][8];
#pragma unroll
            for (int b = 0; b < 8; ++b)
#pragma unroll
                for (int j = 0; j < 8; ++j) acc[b][j] = 0.f;
            for (int i = 0; i < 16; ++i) {
                const int k = F.lane + 64 * i;
                const float* wp = A.in[I_WQ] + ((size_t)l * D + k) * 2048 + j0;
                const f32x4 w0 = *(const f32x4*)wp, w1 = *(const f32x4*)(wp + 4);
#pragma unroll
                for (int b = 0; b < 8; ++b) { const float s = mod[((size_t)l * 8 + b) * 6144 + 3072 + k];
                    acc[b][0] += s * w0.x; acc[b][1] += s * w0.y; acc[b][2] += s * w0.z; acc[b][3] += s * w0.w;
                    acc[b][4] += s * w1.x; acc[b][5] += s * w1.y; acc[b][6] += s * w1.z; acc[b][7] += s * w1.w; }
            }
#pragma unroll
            for (int b = 0; b < 8; ++b) {
                float r[8];
#pragma unroll
                for (int j = 0; j < 8; ++j) r[j] = wave_sum(acc[b][j]);
                if (F.lane == 0) { float* cp = cq + ((size_t)l * 8 + b) * 2048 + j0; *(f32x4*)cp = (f32x4){r[0], r[1], r[2], r[3]}; *(f32x4*)(cp + 4) = (f32x4){r[4], r[5], r[6], r[7]}; }
            }
        }
    }
#endif
    bf16* H = (bf16*)(A.ws + WS_H);
    for (int m = F.gw; m < T; m += F.NGW) { const float* mb = mod + (size_t)(m >> 11) * 6144;
        norm_mod_row(F.lane, A.in[I_X] + (size_t)m * D, A.in[I_GN1], mb + 1024, mb, H + (size_t)m * D); }
}
__device__ __forceinline__ void phase_swa_naive(const Ctx& F, KArgs A, int l) {
    const bf16* P = (const bf16*)(A.ws + WS_PROJ); bf16* Y = (bf16*)(A.ws + WS_Y);
    const float* sinks = A.in[I_SINKS] + l * 8;
    for (int it = F.gw; it < T * 8; it += F.NGW) {
        const int t = it >> 3, hq = it & 7, g = hq >> 2, pos = t & (SEQ - 1);
        float q[64];
        { const v4u* qp = (const v4u*)(P + (size_t)t * NPROJ + C_DQ + hq * 64);
#pragma unroll
          for (int i = 0; i < 8; ++i) { const v4u w = qp[i]; q[8 * i] = bflo(w.x); q[8 * i + 1] = bfhi(w.x); q[8 * i + 2] = bflo(w.y); q[8 * i + 3] = bfhi(w.y); q[8 * i + 4] = bflo(w.z); q[8 * i + 5] = bfhi(w.z); q[8 * i + 6] = bflo(w.w); q[8 * i + 7] = bfhi(w.w); } }
        float s[2];
#pragma unroll
        for (int j = 0; j < 2; ++j) { const int kk = F.lane + 64 * j; float a = -1e30f;
            if (pos - kk >= 0) { const v4u* kp = (const v4u*)(P + (size_t)(t - kk) * NPROJ + C_DK + g * 64); a = 0.f;
#pragma unroll
                for (int i = 0; i < 8; ++i) { const v4u w = kp[i]; a += q[8 * i] * bflo(w.x) + q[8 * i + 1] * bfhi(w.x) + q[8 * i + 2] * bflo(w.y) + q[8 * i + 3] * bfhi(w.y) + q[8 * i + 4] * bflo(w.z) + q[8 * i + 5] * bfhi(w.z) + q[8 * i + 6] * bflo(w.w) + q[8 * i + 7] * bfhi(w.w); } }
            s[j] = a; }
        const float sk2 = sinks[hq] * LOG2E;
        const float mx = fmaxf(wave_max(fmaxf(s[0], s[1])), sk2);
        const float p0 = (pos - F.lane >= 0) ? exp2f(s[0] - mx) : 0.f, p1 = (pos - F.lane - 64 >= 0) ? exp2f(s[1] - mx) : 0.f;
        const float den = wave_sum(p0 + p1) + exp2f(sk2 - mx);
        float acc = 0.f;
        const int nk = (pos + 1 < 128) ? pos + 1 : 128;
        const bf16* vp = P + (size_t)t * NPROJ + C_DV + g * 64 + F.lane;
        for (int kk = 0; kk < nk; ++kk) { const float pk = (kk < 64) ? rdlane(p0, kk) : rdlane(p1, kk - 64); acc += pk * bf1(vp[-(long)kk * NPROJ]); }
        Y[(size_t)t * 2048 + 1536 + hq * 64 + F.lane] = (bf16)f2bf(acc / den);
    }
}
__device__ __forceinline__ void phase_conv_naive(const Ctx& F, KArgs A, int l) {
    const bf16* P = (const bf16*)(A.ws + WS_PROJ); bf16* Y = (bf16*)(A.ws + WS_Y);
    const float* cw = A.in[I_CONVW] + (size_t)l * 3 * 512;
    for (int it = F.gw * 64 + F.lane; it < (T / 4) * 64; it += F.NGW * 64) {
        const int t0 = (it >> 6) * 4, c0 = (it & 63) * 8; const bool first = (t0 & (SEQ - 1)) == 0;
        v4u za[6], zb[6], gb[4];
#pragma unroll
        for (int r = 0; r < 6; ++r) { const int row = (first && r < 2) ? t0 : t0 - 2 + r; za[r] = *(const v4u*)(P + (size_t)row * NPROJ + C_BC + c0); zb[r] = *(const v4u*)(P + (size_t)row * NPROJ + C_BX + c0); }
#pragma unroll
        for (int k = 0; k < 4; ++k) gb[k] = *(const v4u*)(P + (size_t)(t0 + k) * NPROJ + C_BB + c0);
        const f32x4 w00 = *(const f32x4*)(cw + c0), w01 = *(const f32x4*)(cw + c0 + 4), w10 = *(const f32x4*)(cw + 512 + c0), w11 = *(const f32x4*)(cw + 512 + c0 + 4), w20 = *(const f32x4*)(cw + 1024 + c0), w21 = *(const f32x4*)(cw + 1024 + c0 + 4);
        float z[6][8];
#pragma unroll
        for (int r = 0; r < 6; ++r) { const float m = (first && r < 2) ? 0.f : 1.f; const v4u a = za[r], b = zb[r];
            z[r][0] = m * bflo(a.x) * bflo(b.x); z[r][1] = m * bfhi(a.x) * bfhi(b.x); z[r][2] = m * bflo(a.y) * bflo(b.y); z[r][3] = m * bfhi(a.y) * bfhi(b.y);
            z[r][4] = m * bflo(a.z) * bflo(b.z); z[r][5] = m * bfhi(a.z) * bfhi(b.z); z[r][6] = m * bflo(a.w) * bflo(b.w); z[r][7] = m * bfhi(a.w) * bfhi(b.w); }
#pragma unroll
        for (int k = 0; k < 4; ++k) { const v4u g = gb[k];
            const float bb[8] = {bflo(g.x), bfhi(g.x), bflo(g.y), bfhi(g.y), bflo(g.z), bfhi(g.z), bflo(g.w), bfhi(g.w)};
            float y[8];
#pragma unroll
            for (int e = 0; e < 4; ++e) { y[e] = bb[e] * (w00[e] * z[k][e] + w10[e] * z[k + 1][e] + w20[e] * z[k + 2][e]); y[4 + e] = bb[4 + e] * (w01[e] * z[k][4 + e] + w11[e] * z[k + 1][4 + e] + w21[e] * z[k + 2][4 + e]); }
            v4u o; o.x = pk2(y[0], y[1]); o.y = pk2(y[2], y[3]); o.z = pk2(y[4], y[5]); o.w = pk2(y[6], y[7]);
            *(v4u*)(Y + (size_t)(t0 + k) * 2048 + 512 + c0) = o; }
    }
}
__device__ __forceinline__ void phase_pool_naive(const Ctx& F, KArgs A, int l) {
    const bf16* P = (const bf16*)(A.ws + WS_PROJ); bf16* Y = (bf16*)(A.ws + WS_Y);
    for (int it = F.gw; it < T * 4; it += F.NGW) {
        const int t = it >> 2, g = it & 3, w = 2 << g, pos = t & (SEQ - 1), cnt = (pos + 1 < w) ? pos + 1 : w;
        float d[2];
#pragma unroll
        for (int j = 0; j < 2; ++j) { const bf16* zp = P + (size_t)t * NPROJ + C_CZ + g * 128 + F.lane + 64 * j; float s = 0.f;
            for (int i = 0; i < cnt; ++i) s += bf1(zp[-(long)i * NPROJ]);
            d[j] = s / (float)cnt - bf1(zp[0]); }
        const float* wp = A.in[I_WPOOL] + ((size_t)l * 4 + g) * 128 * 128;
        float y0 = 0.f, y1 = 0.f;
        for (int c = 0; c < 64; ++c) { const float dc = rdlane(d[0], c); y0 += dc * wp[c * 128 + F.lane]; y1 += dc * wp[c * 128 + 64 + F.lane]; }
        for (int c = 0; c < 64; ++c) { const float dc = rdlane(d[1], c); y0 += dc * wp[(64 + c) * 128 + F.lane]; y1 += dc * wp[(64 + c) * 128 + 64 + F.lane]; }
        const float* ps = A.in[I_PSCALE] + (size_t)l * 512 + g * 128;
        Y[(size_t)t * 2048 + 1024 + g * 128 + F.lane] = (bf16)f2bf(y0 * ps[F.lane]);
        Y[(size_t)t * 2048 + 1024 + g * 128 + 64 + F.lane] = (bf16)f2bf(y1 * ps[64 + F.lane]);
    }
}
typedef float f32x16s __attribute__((ext_vector_type(16)));
typedef short bf16x8s __attribute__((ext_vector_type(8)));
__device__ __forceinline__ void phase_swa(const Ctx& F, KArgs A, int l) {
    const bf16* P = (const bf16*)(A.ws + WS_PROJ); bf16* Y = (bf16*)(A.ws + WS_Y);
    const float* sinks = A.in[I_SINKS] + l * 8;
    const int qi = F.lane & 31, kh = F.lane >> 5;
    for (int u = F.gw; u < (T / 32) * 8; u += F.NGW) {
        const int tq = u >> 3, hq = u & 7, g = hq >> 2, t0 = tq * 32, p0 = t0 & (SEQ - 1);
        bf16x8s qf[4];
        { const bf16* qp = P + (size_t)(t0 + qi) * NPROJ + C_DQ + hq * 64 + 8 * kh;
#pragma unroll
          for (int s = 0; s < 4; ++s) qf[s] = *(const bf16x8s*)(qp + 16 * s); }
        f32x16s acc[5];
#pragma unroll
        for (int kt = 0; kt < 5; ++kt) {
            int kr = t0 - 128 + 32 * kt + qi; if (p0 - 128 + 32 * kt + qi < 0) kr = t0;
            const bf16* kp = P + (size_t)kr * NPROJ + C_DK + g * 64 + 8 * kh;
            f32x16s c = (f32x16s){0.f, 0.f, 0.f, 0.f, 0.f, 0.f, 0.f, 0.f, 0.f, 0.f, 0.f, 0.f, 0.f, 0.f, 0.f, 0.f};
#pragma unroll
            for (int s = 0; s < 4; ++s) c = __builtin_amdgcn_mfma_f32_32x32x16_bf16(*(const bf16x8s*)(kp + 16 * s), qf[s], c, 0, 0, 0);
            acc[kt] = c;
        }
        const float sk2 = sinks[hq] * LOG2E;
        float m = sk2;
#pragma unroll
        for (int kt = 0; kt < 5; ++kt)
#pragma unroll
            for (int r = 0; r < 16; ++r) { const int koff = (r & 3) + 8 * (r >> 2) + 4 * kh, rel = qi + 128 - 32 * kt - koff;
                const bool valid = (rel >= 0) && (rel < 128) && (p0 - 128 + 32 * kt + koff >= 0);
                acc[kt][r] = valid ? acc[kt][r] : -1e30f; m = fmaxf(m, acc[kt][r]); }
        m = fmaxf(m, __shfl_xor(m, 32));
        float ls = 0.f;
#pragma unroll
        for (int kt = 0; kt < 5; ++kt)
#pragma unroll
            for (int r = 0; r < 16; ++r) { const float pv = exp2f(acc[kt][r] - m); acc[kt][r] = pv; ls += pv; }
        ls += __shfl_xor(ls, 32); ls += exp2f(sk2 - m);
        f32x16s o[2];
        o[0] = (f32x16s){0.f, 0.f, 0.f, 0.f, 0.f, 0.f, 0.f, 0.f, 0.f, 0.f, 0.f, 0.f, 0.f, 0.f, 0.f, 0.f}; o[1] = o[0];
#pragma unroll
        for (int kt = 0; kt < 5; ++kt)
#pragma unroll
            for (int s2 = 0; s2 < 2; ++s2) {
                v4u bw; bw.x = pk2(acc[kt][8 * s2 + 0], acc[kt][8 * s2 + 1]); bw.y = pk2(acc[kt][8 * s2 + 2], acc[kt][8 * s2 + 3]); bw.z = pk2(acc[kt][8 * s2 + 4], acc[kt][8 * s2 + 5]); bw.w = pk2(acc[kt][8 * s2 + 6], acc[kt][8 * s2 + 7]);
                const bf16x8s bfr = __builtin_bit_cast(bf16x8s, bw);
                int vr0 = t0 - 128 + 32 * kt + 16 * s2 + 4 * kh; const bool pre = (p0 - 128 + 32 * kt + 16 * s2 + 4 * kh < 0);
                int vr1 = vr0 + 8; const bool pre1 = (p0 - 128 + 32 * kt + 16 * s2 + 4 * kh + 8 < 0);
                if (pre) vr0 = t0; if (pre1) vr1 = t0;
#pragma unroll
                for (int mt = 0; mt < 2; ++mt) {
                    const bf16* v0 = P + (size_t)vr0 * NPROJ + C_DV + g * 64 + 32 * mt + qi; const bf16* v1 = P + (size_t)vr1 * NPROJ + C_DV + g * 64 + 32 * mt + qi;
                    v4u aw; aw.x = (unsigned)v0[0] | ((unsigned)v0[NPROJ] << 16); aw.y = (unsigned)v0[2 * NPROJ] | ((unsigned)v0[3 * NPROJ] << 16);
                    aw.z = (unsigned)v1[0] | ((unsigned)v1[NPROJ] << 16); aw.w = (unsigned)v1[2 * NPROJ] | ((unsigned)v1[3 * NPROJ] << 16);
                    o[mt] = __builtin_amdgcn_mfma_f32_32x32x16_bf16(__builtin_bit_cast(bf16x8s, aw), bfr, o[mt], 0, 0, 0);
                }
            }
        const float rl = 1.0f / ls;
        bf16* yp = Y + (size_t)(t0 + qi) * 2048 + 1536 + hq * 64 + 4 * kh;
#pragma unroll
        for (int mt = 0; mt < 2; ++mt)
#pragma unroll
            for (int q = 0; q < 4; ++q) { v2u w; w.x = pk2(o[mt][4 * q] * rl, o[mt][4 * q + 1] * rl); w.y = pk2(o[mt][4 * q + 2] * rl, o[mt][4 * q + 3] * rl);
                *(v2u*)(yp + 32 * mt + 8 * q) = w; }
    }
}
typedef short s16x4s __attribute__((ext_vector_type(4)));
__device__ __forceinline__ void phase_swa2(const Ctx& F, KArgs A, int l) {
    const bf16* P = (const bf16*)(A.ws + WS_PROJ); bf16* Y = (bf16*)(A.ws + WS_Y);
    const float* sinks = A.in[I_SINKS] + l * 8;
    constexpr int RS = 272, VOFF = 160 * RS;
    LAS unsigned char* kb = F.lds + RING_OFF; LAS unsigned char* vb = kb + VOFF;
    const int qi = F.lane & 31, kh = F.lane >> 5, hq = F.wave, g = hq >> 2;
    for (int tq = F.vcu; tq < T / 32; tq += F.G) {
        const int t0 = tq * 32, p0 = t0 & (SEQ - 1);
        __syncthreads();
#pragma unroll
        for (int c = 0; c < 5; ++c) { const int chunk = F.tid + 512 * c, row = chunk >> 4, ch = chunk & 15;
            const int gr = (p0 - 128 + row < 0) ? t0 : t0 - 128 + row;
            const v4u kv = *(const v4u*)(P + (size_t)gr * NPROJ + C_DK + ch * 8), vv = *(const v4u*)(P + (size_t)gr * NPROJ + C_DV + ch * 8);
            *(LAS v4u*)(kb + row * RS + ch * 16) = kv; *(LAS v4u*)(vb + row * RS + ch * 16) = vv; }
        bf16x8s qf[4];
        { const bf16* qp = P + (size_t)(t0 + qi) * NPROJ + C_DQ + hq * 64 + 8 * kh;
#pragma unroll
          for (int s = 0; s < 4; ++s) qf[s] = *(const bf16x8s*)(qp + 16 * s); }
        __syncthreads();
        f32x16s acc[5];
#pragma unroll
        for (int kt = 0; kt < 5; ++kt) {
            const LAS unsigned char* kp = kb + (32 * kt + qi) * RS + g * 128 + 16 * kh;
            f32x16s c = (f32x16s){0.f, 0.f, 0.f, 0.f, 0.f, 0.f, 0.f, 0.f, 0.f, 0.f, 0.f, 0.f, 0.f, 0.f, 0.f, 0.f};
#pragma unroll
            for (int s = 0; s < 4; ++s) c = __builtin_amdgcn_mfma_f32_32x32x16_bf16(*(const LAS bf16x8s*)(kp + 32 * s), qf[s], c, 0, 0, 0);
            acc[kt] = c;
        }
        const float sk2 = sinks[hq] * LOG2E;
        float m = sk2;
#pragma unroll
        for (int kt = 0; kt < 5; ++kt)
#pragma unroll
            for (int r = 0; r < 16; ++r) { const int koff = (r & 3) + 8 * (r >> 2) + 4 * kh, rel = qi + 128 - 32 * kt - koff;
                const bool valid = (rel >= 0) && (rel < 128) && (p0 - 128 + 32 * kt + koff >= 0);
                acc[kt][r] = valid ? acc[kt][r] : -1e30f; m = fmaxf(m, acc[kt][r]); }
        m = fmaxf(m, __shfl_xor(m, 32));
        float ls = 0.f;
#pragma unroll
        for (int kt = 0; kt < 5; ++kt)
#pragma unroll
            for (int r = 0; r < 16; ++r) { const float pv = exp2f(acc[kt][r] - m); acc[kt][r] = pv; ls += pv; }
        ls += __shfl_xor(ls, 32); ls += exp2f(sk2 - m);
        f32x16s o[2];
        o[0] = (f32x16s){0.f, 0.f, 0.f, 0.f, 0.f, 0.f, 0.f, 0.f, 0.f, 0.f, 0.f, 0.f, 0.f, 0.f, 0.f, 0.f}; o[1] = o[0];
        const LAS unsigned char* vl = vb + (4 * kh + ((F.lane & 15) >> 2)) * RS + (g * 64 + 16 * ((F.lane >> 4) & 1) + 4 * (F.lane & 3)) * 2;
#pragma unroll
        for (int kt = 0; kt < 5; ++kt)
#pragma unroll
            for (int s2 = 0; s2 < 2; ++s2) {
                v4u bw; bw.x = pk2(acc[kt][8 * s2 + 0], acc[kt][8 * s2 + 1]); bw.y = pk2(acc[kt][8 * s2 + 2], acc[kt][8 * s2 + 3]); bw.z = pk2(acc[kt][8 * s2 + 4], acc[kt][8 * s2 + 5]); bw.w = pk2(acc[kt][8 * s2 + 6], acc[kt][8 * s2 + 7]);
                const bf16x8s bfr = __builtin_bit_cast(bf16x8s, bw);
#pragma unroll
                for (int mt = 0; mt < 2; ++mt) {
                    const LAS unsigned char* va = vl + (32 * kt + 16 * s2) * RS + 64 * mt;
                    const s16x4s lo = __builtin_bit_cast(s16x4s, __builtin_amdgcn_ds_read_tr16_b64_v4i16((LAS s16x4s*)va));
                    const s16x4s hi = __builtin_bit_cast(s16x4s, __builtin_amdgcn_ds_read_tr16_b64_v4i16((LAS s16x4s*)(va + 8 * RS)));
                    const bf16x8s afr = (bf16x8s){lo[0], lo[1], lo[2], lo[3], hi[0], hi[1], hi[2], hi[3]};
                    o[mt] = __builtin_amdgcn_mfma_f32_32x32x16_bf16(afr, bfr, o[mt], 0, 0, 0);
                }
            }
        const float rl = 1.0f / ls;
        bf16* yp = Y + (size_t)(t0 + qi) * 2048 + 1536 + hq * 64 + 4 * kh;
#pragma unroll
        for (int mt = 0; mt < 2; ++mt)
#pragma unroll
            for (int q = 0; q < 4; ++q) { v2u w; w.x = pk2(o[mt][4 * q] * rl, o[mt][4 * q + 1] * rl); w.y = pk2(o[mt][4 * q + 2] * rl, o[mt][4 * q + 3] * rl);
                *(v2u*)(yp + 32 * mt + 8 * q) = w; }
    }
    __syncthreads();
}
__device__ __forceinline__ void phase_pool(const Ctx& F, KArgs A, int l) {
    const bf16* P = (const bf16*)(A.ws + WS_PROJ); bf16* Y = (bf16*)(A.ws + WS_Y);
    const bf16* WP = (const bf16*)(A.ws + WS_W + (size_t)l * W_LAYER + W_WP);
    const int ti = F.lane & 31, kh = F.lane >> 5;
    for (int u = F.gw; u < (T / 32) * 4; u += F.NGW) {
        const int tq = u >> 2, g = u & 3, w = 2 << g, t = tq * 32 + ti, pos = t & (SEQ - 1), cnt = (pos + 1 < w) ? pos + 1 : w;
        const float rc = 1.0f / (float)cnt;
        f32x16s acc[4];
#pragma unroll
        for (int mt = 0; mt < 4; ++mt) acc[mt] = (f32x16s){0.f, 0.f, 0.f, 0.f, 0.f, 0.f, 0.f, 0.f, 0.f, 0.f, 0.f, 0.f, 0.f, 0.f, 0.f, 0.f};
        for (int s = 0; s < 8; ++s) {
            const bf16* zp = P + (size_t)t * NPROJ + C_CZ + g * 128 + 16 * s + 8 * kh;
            float sum[8];
#pragma unroll
            for (int e = 0; e < 8; ++e) sum[e] = 0.f;
            auto win = [&](auto WC) { constexpr int W = decltype(WC)::value; v4u zw[W];
#pragma unroll
                for (int i = 0; i < W; ++i) zw[i] = *(const v4u*)(zp - (size_t)((i < cnt) ? i : 0) * NPROJ);
#pragma unroll
                for (int i = 0; i < W; ++i) { const float m = (i < cnt) ? 1.0f : 0.0f;
                    sum[0] += m * bflo(zw[i].x); sum[1] += m * bfhi(zw[i].x); sum[2] += m * bflo(zw[i].y); sum[3] += m * bfhi(zw[i].y); sum[4] += m * bflo(zw[i].z); sum[5] += m * bfhi(zw[i].z); sum[6] += m * bflo(zw[i].w); sum[7] += m * bfhi(zw[i].w); } };
            if (g == 0) win(std::integral_constant<int, 2>{}); else if (g == 1) win(std::integral_constant<int, 4>{}); else if (g == 2) win(std::integral_constant<int, 8>{}); else win(std::integral_constant<int, 16>{});
            bf16x8s afr[4];
#pragma unroll
            for (int mt = 0; mt < 4; ++mt) afr[mt] = *(const bf16x8s*)(WP + ((size_t)g * 128 + 32 * mt + ti) * 128 + 16 * s + 8 * kh);
            const v4u z0 = *(const v4u*)zp;
            v4u dw; dw.x = pk2(sum[0] * rc - bflo(z0.x), sum[1] * rc - bfhi(z0.x)); dw.y = pk2(sum[2] * rc - bflo(z0.y), sum[3] * rc - bfhi(z0.y));
            dw.z = pk2(sum[4] * rc - bflo(z0.z), sum[5] * rc - bfhi(z0.z)); dw.w = pk2(sum[6] * rc - bflo(z0.w), sum[7] * rc - bfhi(z0.w));
            const bf16x8s bfr = __builtin_bit_cast(bf16x8s, dw);
            asm volatile("" : "+v"(afr[0]), "+v"(afr[1]), "+v"(afr[2]), "+v"(afr[3]));
#pragma unroll
            for (int mt = 0; mt < 4; ++mt) acc[mt] = __builtin_amdgcn_mfma_f32_32x32x16_bf16(afr[mt], bfr, acc[mt], 0, 0, 0);
        }
        const float* ps = A.in[I_PSCALE] + (size_t)l * 512 + g * 128;
        bf16* yp = Y + (size_t)t * 2048 + 1024 + g * 128 + 4 * kh;
#pragma unroll
        for (int hb = 0; hb < 2; ++hb) {
            f32x4 scv[8];
#pragma unroll
            for (int i = 0; i < 8; ++i) scv[i] = *(const f32x4*)(ps + 32 * (2 * hb + (i >> 2)) + 8 * (i & 3) + 4 * kh);
#pragma unroll
            for (int m2 = 0; m2 < 2; ++m2)
#pragma unroll
                for (int q = 0; q < 4; ++q) { const int mt = 2 * hb + m2; const f32x4 sc = scv[4 * m2 + q];
                    v2u wv; wv.x = pk2(acc[mt][4 * q] * sc.x, acc[mt][4 * q + 1] * sc.y); wv.y = pk2(acc[mt][4 * q + 2] * sc.z, acc[mt][4 * q + 3] * sc.w);
                    *(v2u*)(yp + 32 * mt + 8 * q) = wv; } }
    }
}
__device__ __forceinline__ void phase_ya(const Ctx& F, KArgs A, int l) {
    const bf16* O = (const bf16*)(A.ws + WS_O); bf16* Y = (bf16*)(A.ws + WS_Y);
    const float lam_init = (l == 0) ? 0.2f : (0.8f - 0.6f * 0.7408182206817179f);
    const float d1 = wave_sum(A.in[I_LQ1][l * 64 + F.lane] * A.in[I_LK1][l * 64 + F.lane]);
    const float d2 = wave_sum(A.in[I_LQ2][l * 64 + F.lane] * A.in[I_LK2][l * 64 + F.lane]);
    const float lam = expf(d1) - expf(d2) + lam_init;
    const int sub = F.lane & 15, grp = F.lane >> 4;
    float gs[8];
#pragma unroll
    for (int e = 0; e < 8; ++e) gs[e] = A.in[I_GSUB][l * 128 + 8 * sub + e] * (1.0f - lam_init);
    static_assert(T % (4 * 256 * NWAVES) == 0, "phase_ya: 4 tokens per trip");
    for (int it0 = F.gw; it0 < T; it0 += 4 * F.NGW) {
        v4u av[4], bv[4];
#pragma unroll
        for (int j = 0; j < 4; ++j) { const int t = it0 + j * F.NGW; av[j] = *(const v4u*)(O + (size_t)t * 1024 + grp * 256 + 8 * sub); bv[j] = *(const v4u*)(O + (size_t)t * 1024 + grp * 256 + 128 + 8 * sub); }
#pragma unroll
      for (int j = 0; j < 4; ++j) {
        const int t = it0 + j * F.NGW, h = grp; const v4u a = av[j], b = bv[j];
        float y[8] = {bflo(a.x) - lam * bflo(b.x), bfhi(a.x) - lam * bfhi(b.x), bflo(a.y) - lam * bflo(b.y), bfhi(a.y) - lam * bfhi(b.y), bflo(a.z) - lam * bflo(b.z), bfhi(a.z) - lam * bfhi(b.z), bflo(a.w) - lam * bflo(b.w), bfhi(a.w) - lam * bfhi(b.w)};
        float ss = 0.f;
#pragma unroll
        for (int e = 0; e < 8; ++e) ss += y[e] * y[e];
        ss += __shfl_xor(ss, 1); ss += __shfl_xor(ss, 2); ss += __shfl_xor(ss, 4); ss += __shfl_xor(ss, 8);
        const float r = 1.0f / sqrtf(ss * (1.0f / 128.0f) + EPS);
        v4u o; o.x = pk2(y[0] * r * gs[0], y[1] * r * gs[1]); o.y = pk2(y[2] * r * gs[2], y[3] * r * gs[3]); o.z = pk2(y[4] * r * gs[4], y[5] * r * gs[5]); o.w = pk2(y[6] * r * gs[6], y[7] * r * gs[7]);
        *(v4u*)(Y + (size_t)t * 2048 + h * 128 + 8 * sub) = o;
      }
    }
}
__device__ __forceinline__ void expert_quant(KArgs A, int l, int lane, int w, int nw) {
    const float* ue = A.in[I_UE] + (size_t)l * 16384 * 1024; const float* ve = A.in[I_VE] + (size_t)l * 16384 * 1024;
    for (int r = w; r < 2 * 16384; r += nw) {
        const bool isv = r >= 16384; const int row = isv ? r - 16384 : r; const float* src = (isv ? ve : ue) + (size_t)row * 1024 + 8 * lane;
        const f32x4 a0 = *(const f32x4*)src, a1 = *(const f32x4*)(src + 4), b0 = *(const f32x4*)(src + 512), b1 = *(const f32x4*)(src + 516);
        float am = 0.f;
#pragma unroll
        for (int e = 0; e < 4; ++e) am = fmaxf(fmaxf(am, fmaxf(fabsf(a0[e]), fabsf(a1[e]))), fmaxf(fabsf(b0[e]), fabsf(b1[e])));
        am = wave_max(am);
#if EXP6B
        { const float inv6 = am > 0.f ? 31.0f / am : 0.f; unsigned X0 = 0, X1 = 0, Y = 0;
#pragma unroll
          for (int i = 0; i < 4; ++i) {
              const unsigned u0 = (unsigned)((int)rintf(a0[i] * inv6) + 32), u2 = (unsigned)((int)rintf(b0[i] * inv6) + 32);
              const unsigned s1 = (unsigned)(int)rintf(a1[i] * inv6) & 63u, s3 = (unsigned)(int)rintf(b1[i] * inv6) & 63u;
              X0 |= ((u0 & 15u) | ((s1 >> 2) << 4)) << (8 * i); X1 |= ((u2 & 15u) | ((s3 >> 2) << 4)) << (8 * i);
              Y |= (((u0 >> 4) << 4) | ((s1 & 3u) << 2) | ((u2 >> 4) << 6) | (s3 & 3u)) << (8 * i); }
          unsigned char* dst = A.ws + (isv ? WS_VE : WS_UE) + (size_t)row * 768;
          *(unsigned long long*)(dst + 8 * lane) = (unsigned long long)X0 | ((unsigned long long)X1 << 32); *(unsigned*)(dst + 512 + 4 * lane) = Y;
          if (lane == 0) ((float*)(A.ws + (isv ? WS_VS : WS_US)))[row] = am * (1.0f / 31.0f);
          continue; }
#endif
        const float inv = am > 0.f ? 127.0f / am : 0.f; const int bias = (isv && !V_MFMA) ? 128 : 0;
        unsigned o[4];
#pragma unroll
        for (int wd = 0; wd < 4; ++wd) { const f32x4 v = wd == 0 ? a0 : wd == 1 ? a1 : wd == 2 ? b0 : b1; unsigned x = 0;
#pragma unroll
            for (int e = 0; e < 4; ++e) x |= ((unsigned)((int)rintf(v[e] * inv) + bias) & 255u) << (8 * e);
            o[wd] = x; }
        *(v4u*)(A.ws + (isv ? WS_VE : WS_UE) + (size_t)row * 1024 + 16 * lane) = (v4u){o[0], o[1], o[2], o[3]};
        if (lane == 0) ((float*)(A.ws + (isv ? WS_VS : WS_US)))[row] = am * (1.0f / 127.0f);
    }
}
__device__ __forceinline__ void phase_h2(const Ctx& F, KArgs A, int l) {
    const float* mod = (const float*)(A.ws + WS_MOD) + (size_t)l * 8 * 6144;
    bf16* H = (bf16*)(A.ws + WS_H);
    for (int m = F.gw; m < T; m += F.NGW) { const float* mb = mod + (size_t)(m >> 11) * 6144;
        norm_mod_row(F.lane, A.out + (size_t)m * D, A.in[I_GN2] + (size_t)l * D, mb + 4096, mb + 3072, H + (size_t)m * D); }
#if DBG_ROUTE32
    {
        bf16* H3 = (bf16*)(A.ws + WS_H3);
        for (int m = F.gw; m < T; m += F.NGW) { const float* mb = mod + (size_t)(m >> 11) * 6144;
            const f32x4* xr = (const f32x4*)(A.out + (size_t)m * D) + F.lane; f32x4 v[4]; float s = 0.f;
#pragma unroll
            for (int j = 0; j < 4; ++j) { v[j] = xr[64 * j]; s += (v[j].x * v[j].x + v[j].y * v[j].y) + (v[j].z * v[j].z + v[j].w * v[j].w); }
            const float r = 1.0f / sqrtf(wave_sum(s) * (1.0f / D) + EPS);
#pragma unroll
            for (int j = 0; j < 4; ++j) {
                const f32x4 gg = ((const f32x4*)(A.in[I_GN2] + (size_t)l * D))[F.lane + 64 * j], sc = ((const f32x4*)(mb + 4096))[F.lane + 64 * j], sh = ((const f32x4*)(mb + 3072))[F.lane + 64 * j];
                const f32x4 y = (v[j] * r) * gg * (sc + 1.0f) + sh;
                unsigned hi[4], lo[4];
#pragma unroll
                for (int e = 0; e < 4; ++e) { hi[e] = f2bf(y[e]); lo[e] = f2bf(y[e] - __builtin_bit_cast(float, hi[e] << 16)); }
                const unsigned long long hw = (unsigned long long)(hi[0] | (hi[1] << 16)) | ((unsigned long long)(hi[2] | (hi[3] << 16)) << 32);
                const unsigned long long lw = (unsigned long long)(lo[0] | (lo[1] << 16)) | ((unsigned long long)(lo[2] | (lo[3] << 16)) << 32);
                unsigned long long* o8 = (unsigned long long*)(H3 + (size_t)m * 3072) + F.lane + 64 * j;
                o8[0] = hw; o8[256] = hw; o8[512] = lw;
            } }
        bf16* W3 = (bf16*)(A.ws + WS_WQ3); const float* W = A.in[I_WQ] + (size_t)l * D * 2048;
        for (size_t i = (size_t)F.gw * 64 + F.lane; i < (size_t)2048 * 1024; i += (size_t)F.NGW * 64) { const int n = (int)(i >> 10), k = (int)(i & 1023);
            const float w = W[(size_t)k * 2048 + n]; const unsigned hi = f2bf(w), lo = f2bf(w - __builtin_bit_cast(float, hi << 16));
            W3[(size_t)n * 3072 + k] = (bf16)hi; W3[(size_t)n * 3072 + 1024 + k] = (bf16)lo; W3[(size_t)n * 3072 + 2048 + k] = (bf16)hi; }
    }
}
__device__ __forceinline__ void phase_expert_convert(const Ctx& F, KArgs A, int l) {
#else
#endif
    const float* ue = A.in[I_UE] + (size_t)l * 16384 * 1024; const float* ve = A.in[I_VE] + (size_t)l * 16384 * 1024;
#if EXP_I8_OWN
    return;
#endif
    bf16* UE = (bf16*)(A.ws + WS_UE); bf16* VE = (bf16*)(A.ws + WS_VE);
    for (size_t i = (size_t)F.gw * 64 + F.lane; i < (size_t)2 * 16384 * 1024 / 8; i += (size_t)F.NGW * 64) {
        const bool isv = i >= (size_t)16384 * 1024 / 8; const size_t e = (isv ? i - (size_t)16384 * 1024 / 8 : i) * 8;
        const float* src = (isv ? ve : ue) + e; const f32x4 a = *(const f32x4*)src, b = *(const f32x4*)(src + 4);
        v4u o; o.x = pk2(a.x, a.y); o.y = pk2(a.z, a.w); o.z = pk2(b.x, b.y); o.w = pk2(b.z, b.w);
        *(v4u*)((isv ? VE : UE) + e) = o;
    }
}
__device__ __forceinline__ void phase_route_naive(const Ctx& F, KArgs A, int l) {
#if DBG_ROUTE32
    const float* Q32 = (const float*)(A.ws + WS_Q32); const float* SKF = A.in[I_SK] + (size_t)l * 32768;
#else
    const bf16* Q2 = (const bf16*)(A.ws + WS_Q2); const bf16* SK = (const bf16*)(A.ws + WS_W + (size_t)l * W_LAYER + W_SK);
#endif
    int* IDX = (int*)(A.ws + WS_IDX); float* WTS = (float*)(A.ws + WS_WTS);
    for (int it = F.gw; it < T * 8; it += F.NGW) {
        const int t = it >> 3, hh = it & 7;
        float ts[2]; int ti[2];
#pragma unroll
        for (int p = 0; p < 2; ++p) {
#if DBG_ROUTE32
            const float* qp = Q32 + (size_t)t * 2048 + hh * 256 + p * 128;
            const float* ka = SKF + ((size_t)p * 128 + F.lane) * 128; const float* kb = ka + 64 * 128;
            float sa = 0.f, sb = 0.f;
            for (int i = 0; i < 32; ++i) { const f32x4 qv = *(const f32x4*)(qp + 4 * i), av = *(const f32x4*)(ka + 4 * i), bv = *(const f32x4*)(kb + 4 * i);
                sa += qv.x * av.x + qv.y * av.y + qv.z * av.z + qv.w * av.w; sb += qv.x * bv.x + qv.y * bv.y + qv.z * bv.z + qv.w * bv.w; }
#else
            const bf16* qp = Q2 + (size_t)t * 2048 + hh * 256 + p * 128;
            const bf16* ka = SK + ((size_t)p * 128 + F.lane) * 128; const bf16* kb = ka + 64 * 128;
            float sa = 0.f, sb = 0.f;
            for (int i = 0; i < 16; ++i) { const v4u qw = *(const v4u*)(qp + 8 * i), aw = *(const v4u*)(ka + 8 * i), bw = *(const v4u*)(kb + 8 * i);
                sa += bflo(qw.x) * bflo(aw.x) + bfhi(qw.x) * bfhi(aw.x) + bflo(qw.y) * bflo(aw.y) + bfhi(qw.y) * bfhi(aw.y) + bflo(qw.z) * bflo(aw.z) + bfhi(qw.z) * bfhi(aw.z) + bflo(qw.w) * bflo(aw.w) + bfhi(qw.w) * bfhi(aw.w);
                sb += bflo(qw.x) * bflo(bw.x) + bfhi(qw.x) * bfhi(bw.x) + bflo(qw.y) * bflo(bw.y) + bfhi(qw.y) * bfhi(bw.y) + bflo(qw.z) * bflo(bw.z) + bfhi(qw.z) * bfhi(bw.z) + bflo(qw.w) * bflo(bw.w) + bfhi(qw.w) * bfhi(bw.w); }
#endif
            float tsv = 0.f; int tiv = 0;
            for (int r = 0; r < 16; ++r) {
                const float m = wave_max(fmaxf(sa, sb));
                const unsigned long long ba = __ballot(sa == m), bb = __ballot(sb == m);
                int idx;
                if (ba) { const int ln = __ffsll((long long)ba) - 1; idx = ln; if (F.lane == ln) sa = -3.0e38f; }
                else { const int ln = __ffsll((long long)bb) - 1; idx = 64 + ln; if (F.lane == ln) sb = -3.0e38f; }
                if (F.lane == r) { tsv = m; tiv = idx; }
            }
            ts[p] = tsv; ti[p] = tiv;
        }
        float cv[4];
#pragma unroll
        for (int k = 0; k < 4; ++k) cv[k] = __shfl(ts[0], (F.lane >> 4) + 4 * k) + __shfl(ts[1], F.lane & 15);
        float bs = 0.f; int bid = 0;
        for (int r = 0; r < 16; ++r) {
            const float m = wave_max(fmaxf(fmaxf(cv[0], cv[1]), fmaxf(cv[2], cv[3])));
            int id = -1;
#pragma unroll
            for (int k = 0; k < 4; ++k) { const unsigned long long bk = __ballot(cv[k] == m);
                if (id < 0 && bk) { const int ln = __ffsll((long long)bk) - 1; id = ln + 64 * k; if (F.lane == ln) cv[k] = -3.0e38f; } }
            if (F.lane == r) { bs = m; bid = id; }
        }
        const int ei = __shfl(ti[0], bid >> 4) * 128 + __shfl(ti[1], bid & 15);
        const float m0 = __shfl(bs, 0);
        const float e = (F.lane < 16) ? expf(bs - m0) : 0.f;
        const float den = wave_sum(e);
        if (F.lane < 16) { IDX[(size_t)t * 128 + hh * 16 + F.lane] = ei; WTS[(size_t)t * 128 + hh * 16 + F.lane] = e / den; }
    }
}
typedef float f32x16r __attribute__((ext_vector_type(16)));
typedef short bf16x8r __attribute__((ext_vector_type(8)));
__device__ __forceinline__ unsigned srt_key(float f) { const unsigned u = __builtin_bit_cast(unsigned, f); return u ^ ((unsigned)((int)u >> 31) | 0x80000000u); }
__device__ __forceinline__ float srt_val(unsigned k) { const unsigned u = (k & 0x80000000u) ? (k ^ 0x80000000u) : ~k; return __builtin_bit_cast(float, u); }
#define INS16(L, x) do { unsigned x_ = (x); _Pragma("unroll") for (int k_ = 0; k_ < 16; ++k_) { const unsigned h_ = L[k_] > x_ ? L[k_] : x_; x_ = L[k_] > x_ ? x_ : L[k_]; L[k_] = h_; } } while (0)
#if ROUTE_SORTNET
#define CE_(a, b) do { const unsigned h_ = (a) > (b) ? (a) : (b); (b) = (a) > (b) ? (b) : (a); (a) = h_; } while (0)
__device__ __forceinline__ void sort16_desc(unsigned (&v)[16]) { CE_(v[0], v[1]); CE_(v[2], v[3]); CE_(v[0], v[2]); CE_(v[1], v[3]); CE_(v[1], v[2]); CE_(v[4], v[5]); CE_(v[6], v[7]); CE_(v[4], v[6]); CE_(v[5], v[7]); CE_(v[5], v[6]); CE_(v[0], v[4]); CE_(v[2], v[6]); CE_(v[2], v[4]); CE_(v[1], v[5]); CE_(v[3], v[7]); CE_(v[3], v[5]); CE_(v[1], v[2]); CE_(v[3], v[4]); CE_(v[5], v[6]); CE_(v[8], v[9]); CE_(v[10], v[11]); CE_(v[8], v[10]); CE_(v[9], v[11]); CE_(v[9], v[10]); CE_(v[12], v[13]); CE_(v[14], v[15]); CE_(v[12], v[14]); CE_(v[13], v[15]); CE_(v[13], v[14]); CE_(v[8], v[12]); CE_(v[10], v[14]); CE_(v[10], v[12]); CE_(v[9], v[13]); CE_(v[11], v[15]); CE_(v[11], v[13]); CE_(v[9], v[10]); CE_(v[11], v[12]); CE_(v[13], v[14]); CE_(v[0], v[8]); CE_(v[4], v[12]); CE_(v[4], v[8]); CE_(v[2], v[10]); CE_(v[6], v[14]); CE_(v[6], v[10]); CE_(v[2], v[4]); CE_(v[6], v[8]); CE_(v[10], v[12]); CE_(v[1], v[9]); CE_(v[5], v[13]); CE_(v[5], v[9]); CE_(v[3], v[11]); CE_(v[7], v[15]); CE_(v[7], v[11]); CE_(v[3], v[5]); CE_(v[7], v[9]); CE_(v[11], v[13]); CE_(v[1], v[2]); CE_(v[3], v[4]); CE_(v[5], v[6]); CE_(v[7], v[8]); CE_(v[9], v[10]); CE_(v[11], v[12]); CE_(v[13], v[14]); }
__device__ __forceinline__ void merge16_top(unsigned (&R)[16], const unsigned (&C)[16]) {
#pragma unroll
    for (int i = 0; i < 16; ++i) R[i] = R[i] > C[15 - i] ? R[i] : C[15 - i];
    CE_(R[0], R[8]); CE_(R[1], R[9]); CE_(R[2], R[10]); CE_(R[3], R[11]); CE_(R[4], R[12]); CE_(R[5], R[13]); CE_(R[6], R[14]); CE_(R[7], R[15]); CE_(R[0], R[4]); CE_(R[1], R[5]); CE_(R[2], R[6]); CE_(R[3], R[7]); CE_(R[8], R[12]); CE_(R[9], R[13]); CE_(R[10], R[14]); CE_(R[11], R[15]); CE_(R[0], R[2]); CE_(R[1], R[3]); CE_(R[4], R[6]); CE_(R[5], R[7]); CE_(R[8], R[10]); CE_(R[9], R[11]); CE_(R[12], R[14]); CE_(R[13], R[15]); CE_(R[0], R[1]); CE_(R[2], R[3]); CE_(R[4], R[5]); CE_(R[6], R[7]); CE_(R[8], R[9]); CE_(R[10], R[11]); CE_(R[12], R[13]); CE_(R[14], R[15]); }
#endif
__device__ __forceinline__ void route_top16(unsigned (&tk)[16], const bf16* qrow, const GAS bf16* skp, int lane) {
    f32x16r acc[4];
#pragma unroll
    for (int mt = 0; mt < 4; ++mt) acc[mt] = (f32x16r){0.f, 0.f, 0.f, 0.f, 0.f, 0.f, 0.f, 0.f, 0.f, 0.f, 0.f, 0.f, 0.f, 0.f, 0.f, 0.f};
#if ROUTE_BATCH
#pragma unroll
    for (int s0 = 0; s0 < 8; s0 += ROUTE_BATCH) { bf16x8r bq[ROUTE_BATCH], a[ROUTE_BATCH][4];
#pragma unroll
        for (int i = 0; i < ROUTE_BATCH; ++i) { bq[i] = *(const bf16x8r*)(qrow + 16 * (s0 + i));
#pragma unroll
            for (int mt = 0; mt < 4; ++mt) a[i][mt] = *(const GAS bf16x8r*)(skp + (size_t)mt * 32 * 128 + 16 * (s0 + i)); }
#pragma unroll
        for (int i = 0; i < ROUTE_BATCH; ++i) asm volatile("" : "+v"(bq[i]), "+v"(a[i][0]), "+v"(a[i][1]), "+v"(a[i][2]), "+v"(a[i][3]));
#pragma unroll
        for (int i = 0; i < ROUTE_BATCH; ++i)
#pragma unroll
            for (int mt = 0; mt < 4; ++mt) acc[mt] = __builtin_amdgcn_mfma_f32_32x32x16_bf16(a[i][mt], bq[i], acc[mt], 0, 0, 0); }
#else
#pragma unroll
    for (int s = 0; s < 8; ++s) { const bf16x8r bq = *(const bf16x8r*)(qrow + 16 * s);
#pragma unroll
        for (int mt = 0; mt < 4; ++mt) { const bf16x8r a = *(const GAS bf16x8r*)(skp + (size_t)mt * 32 * 128 + 16 * s);
            acc[mt] = __builtin_amdgcn_mfma_f32_32x32x16_bf16(a, bq, acc[mt], 0, 0, 0); } }
#endif
    const unsigned lowb = (lane & 32) ? 0u : 4u;
#if ROUTE_SORTNET
#pragma unroll
    for (int mt = 0; mt < 4; ++mt) { unsigned c[16];
#pragma unroll
        for (int r = 0; r < 16; ++r) { const unsigned idx0 = 32u * mt + (r & 3) + 8u * (r >> 2);
            c[r] = (srt_key(acc[mt][r]) & ~127u) | ((127u - idx0) & ~4u) | lowb; }
        sort16_desc(c);
        if (mt == 0) {
#pragma unroll
            for (int k = 0; k < 16; ++k) tk[k] = c[k]; }
        else merge16_top(tk, c); }
    unsigned pk[16];
#pragma unroll
    for (int k = 0; k < 16; ++k) pk[k] = (unsigned)__shfl_xor((int)tk[k], 32);
    merge16_top(tk, pk);
}
#else
#pragma unroll
    for (int k = 0; k < 16; ++k) tk[k] = 0u;
#pragma unroll
    for (int mt = 0; mt < 4; ++mt)
#pragma unroll
        for (int r = 0; r < 16; ++r) { const unsigned idx0 = 32u * mt + (r & 3) + 8u * (r >> 2);
            const unsigned key = (srt_key(acc[mt][r]) & ~127u) | ((127u - idx0) & ~4u) | lowb; INS16(tk, key); }
    unsigned pk[16];
#pragma unroll
    for (int k = 0; k < 16; ++k) pk[k] = (unsigned)__shfl_xor((int)tk[k], 32);
#pragma unroll
    for (int k = 0; k < 16; ++k) INS16(tk, pk[k]);
}
#endif
template <class IP, class WP> __device__ __forceinline__ void route_unit(const Ctx& F, KArgs A, int l, int u, LAS unsigned char* scr, IP IDX, WP WTS, int tbase) {
    const bf16* Q2 = (const bf16*)(A.ws + WS_Q2); const bf16* SK = (const bf16*)(A.ws + WS_W + (size_t)l * W_LAYER + W_SK);
    asm volatile("" : "+s"(SK));
    const int row = F.lane & 31, kh = F.lane >> 5;
    {
        const int t = 4 * u + (row >> 3), hh = row & 7;
        unsigned tk0[16], tk1[16];
        const GAS bf16* SKg = (const GAS bf16*)SK;
        route_top16(tk0, Q2 + (size_t)t * 2048 + hh * 256 + 8 * kh, SKg + (size_t)row * 128 + 8 * kh, F.lane);
        route_top16(tk1, Q2 + (size_t)t * 2048 + hh * 256 + 128 + 8 * kh, SKg + 128 * 128 + (size_t)row * 128 + 8 * kh, F.lane);
        float s0[16], s1[16];
#pragma unroll
        for (int k = 0; k < 16; ++k) { s0[k] = srt_val(tk0[k] & ~127u); s1[k] = srt_val(tk1[k] & ~127u); }
        LAS unsigned* sw = (LAS unsigned*)(scr + F.lane * 36);
#pragma unroll
        for (int k = 0; k < 4; ++k) {
            sw[k] = (127u - (tk0[4 * k] & 127u)) | ((127u - (tk0[4 * k + 1] & 127u)) << 8) | ((127u - (tk0[4 * k + 2] & 127u)) << 16) | ((127u - (tk0[4 * k + 3] & 127u)) << 24);
            sw[4 + k] = (127u - (tk1[4 * k] & 127u)) | ((127u - (tk1[4 * k + 1] & 127u)) << 8) | ((127u - (tk1[4 * k + 2] & 127u)) << 16) | ((127u - (tk1[4 * k + 3] & 127u)) << 24); }
        unsigned bk[16];
#if ROUTE_SORTNET
#define PKEY_(i, j) ((srt_key(s0[i] + s1[j]) & ~255u) | (255u - (unsigned)((i) * 16 + (j))))
        {
            unsigned c[16];
#pragma unroll
            for (int j = 0; j < 16; ++j) bk[j] = PKEY_(0, j);
#pragma unroll
            for (int i = 1; i < 16; ++i) c[i - 1] = PKEY_(i, 0);
            c[15] = 0u;
            merge16_top(bk, c);
            int n = 0;
#pragma unroll
            for (int i = 1; i < 8; ++i)
#pragma unroll
                for (int j = 1; j < 8; ++j) if ((i + 1) * (j + 1) <= 16) { const unsigned key = PKEY_(i, j); if (n < 16) c[n] = key; else INS16(bk, key); ++n; }
            sort16_desc(c);
            merge16_top(bk, c);
        }
#undef PKEY_
#else
#pragma unroll
        for (int k = 0; k < 16; ++k) bk[k] = 0u;
#pragma unroll
        for (int i = 0; i < 16; ++i)
#pragma unroll
            for (int j = 0; j < 16; ++j) if ((i + 1) * (j + 1) <= 16) { const unsigned key = (srt_key(s0[i] + s1[j]) & ~255u) | (255u - (unsigned)(i * 16 + j)); INS16(bk, key); }
#endif
        LDS_WAIT();
        const LAS unsigned char* sb = (const LAS unsigned char*)(scr + F.lane * 36);
        int ei[16]; float wv[16]; float den = 0.f; const float m0 = srt_val(bk[0] & ~255u);
#pragma unroll
        for (int r = 0; r < 16; ++r) { const unsigned ij = 255u - (bk[r] & 255u); ei[r] = (int)sb[ij >> 4] * 128 + (int)sb[16 + (ij & 15)];
            wv[r] = __expf(srt_val(bk[r] & ~255u) - m0); den += wv[r]; }
        const float rden = 1.0f / den;
        if (kh == 0) {
#pragma unroll
            for (int r = 0; r < 16; ++r) IDX[(size_t)(t - tbase) * 128 + hh * 16 + r] = ei[r]; }
        else {
#pragma unroll
            for (int r = 0; r < 16; ++r) WTS[(size_t)(t - tbase) * 128 + hh * 16 + r] = wv[r] * rden; }
        LDS_WAIT();
    }
}
__device__ __forceinline__ void phase_route(const Ctx& F, KArgs A, int l) {
    LAS unsigned char* scr = F.lds + RING_OFF + F.wave * 4096;
    for (int u = F.gw; u < T / 4; u += F.NGW) route_unit(F, A, l, u, scr, (int*)(A.ws + WS_IDX), (float*)(A.ws + WS_WTS), 0);
}
#ifndef PROBE_U_VALU
#define PROBE_U_VALU 0
#endif
#ifndef PROBE_EXP_REP
#define PROBE_EXP_REP 1
#endif
typedef __bf16 bf16x2_t __attribute__((ext_vector_type(2)));
__device__ __forceinline__ float dot2bf(unsigned a, unsigned b, float c) { return __builtin_amdgcn_fdot2_f32_bf16(__builtin_bit_cast(bf16x2_t, a), __builtin_bit_cast(bf16x2_t, b), c, false); }
template <int XM> __device__ __forceinline__ float lane_xchg(float v) {
    const int x = __builtin_bit_cast(int, v);
    if constexpr (XM == 1) return __builtin_bit_cast(float, __builtin_amdgcn_mov_dpp(x, 0xB1, 0xF, 0xF, true));
    else if constexpr (XM == 2) return __builtin_bit_cast(float, __builtin_amdgcn_mov_dpp(x, 0x4E, 0xF, 0xF, true));
    else if constexpr (XM == 4) return __builtin_bit_cast(float, __builtin_amdgcn_ds_swizzle(x, 0x101F));
    else if constexpr (XM == 8) return __builtin_bit_cast(float, __builtin_amdgcn_ds_swizzle(x, 0x201F));
    else if constexpr (XM == 16) return __builtin_bit_cast(float, __builtin_amdgcn_ds_swizzle(x, 0x401F));
    else return __shfl_xor(v, 32);
}
template <int XM> __device__ __forceinline__ int lane_xchg(int x) {
    if constexpr (XM == 1) return __builtin_amdgcn_mov_dpp(x, 0xB1, 0xF, 0xF, true);
    else if constexpr (XM == 2) return __builtin_amdgcn_mov_dpp(x, 0x4E, 0xF, 0xF, true);
    else if constexpr (XM == 4) return __builtin_amdgcn_ds_swizzle(x, 0x101F);
    else if constexpr (XM == 8) return __builtin_amdgcn_ds_swizzle(x, 0x201F);
    else if constexpr (XM == 16) return __builtin_amdgcn_ds_swizzle(x, 0x401F);
    else return __shfl_xor(x, 32);
}
__device__ __forceinline__ float reduce16(const float (&p)[16], int lane) {
    float a[8], b[4], c[2];
    const bool b0 = lane & 1, b1 = lane & 2, b2 = lane & 4, b3 = lane & 8;
#pragma unroll
    for (int i = 0; i < 8; ++i) a[i] = (b0 ? p[2 * i + 1] : p[2 * i]) + lane_xchg<1>(b0 ? p[2 * i] : p[2 * i + 1]);
#pragma unroll
    for (int i = 0; i < 4; ++i) b[i] = (b1 ? a[2 * i + 1] : a[2 * i]) + lane_xchg<2>(b1 ? a[2 * i] : a[2 * i + 1]);
#pragma unroll
    for (int i = 0; i < 2; ++i) c[i] = (b2 ? b[2 * i + 1] : b[2 * i]) + lane_xchg<4>(b2 ? b[2 * i] : b[2 * i + 1]);
    float d = (b3 ? c[1] : c[0]) + lane_xchg<8>(b3 ? c[0] : c[1]);
    d += lane_xchg<16>(d);
    d += lane_xchg<32>(d);
    return d;
}
__device__ __forceinline__ void expert_token(const Ctx& F, KArgs A, int l, int t, const int idx0, const int idx1, const float wt0, const float wt1) {
    const bf16* H = (const bf16*)(A.ws + WS_H); const unsigned char* UE = A.ws + WS_UE; const unsigned char* VE = A.ws + WS_VE;
    const float* mod = (const float*)(A.ws + WS_MOD);
    bf16* Hn = (bf16*)(A.ws + WS_H);
    const unsigned lo16 = (unsigned)F.lane * 16u; (void)lo16;
    {
        const v4u ha = *(const v4u*)(H + (size_t)t * D + 8 * F.lane), hb = *(const v4u*)(H + (size_t)t * D + 512 + 8 * F.lane);
#if EXP_I8 && !DBG_ROUTE32
        const float su0 = ((const float*)(A.ws + WS_US))[idx0], su1 = ((const float*)(A.ws + WS_US))[idx1], sv0 = ((const float*)(A.ws + WS_VS))[idx0], sv1 = ((const float*)(A.ws + WS_VS))[idx1];
        float hv[16];
        hv[0] = bflo(ha.x); hv[1] = bfhi(ha.x); hv[2] = bflo(ha.y); hv[3] = bfhi(ha.y); hv[4] = bflo(ha.z); hv[5] = bfhi(ha.z); hv[6] = bflo(ha.w); hv[7] = bfhi(ha.w);
        hv[8] = bflo(hb.x); hv[9] = bfhi(hb.x); hv[10] = bflo(hb.y); hv[11] = bfhi(hb.y); hv[12] = bflo(hb.z); hv[13] = bfhi(hb.z); hv[14] = bflo(hb.w); hv[15] = bfhi(hb.w);
        float hs = 0.f;
#pragma unroll
        for (int k = 0; k < 16; ++k) hs += hv[k];
        const float hsum = wave_sum(hs);
        const unsigned lo16b = (unsigned)F.lane * 16u;
#define UB(w, i) ((float)(((w) >> (8 * (i))) & 255u))
        float act0 = 0.f, act1 = 0.f;
        for (int b = 0; b < 8 * PROBE_EXP_REP; ++b) {
            const int isel = ((b & 7) < 4) ? idx0 : idx1; const int lb = 16 * (b & 3);
            v4u rr[16];
#pragma unroll
            for (int j = 0; j < 16; ++j) { const unsigned ie = (unsigned)rdlanei(isel, lb + j); rr[j] = *(const v4u*)(UE + (size_t)ie * 1024u + lo16b) ^ 0x80808080u; }
            float p[16];
#pragma unroll
            for (int j = 0; j < 16; ++j) { const v4u r = rr[j];
                float s0 = hv[0] * UB(r.x, 0); s0 += hv[1] * UB(r.x, 1); s0 += hv[2] * UB(r.x, 2); s0 += hv[3] * UB(r.x, 3);
                float s1 = hv[4] * UB(r.y, 0); s1 += hv[5] * UB(r.y, 1); s1 += hv[6] * UB(r.y, 2); s1 += hv[7] * UB(r.y, 3);
                s0 += hv[8] * UB(r.z, 0); s0 += hv[9] * UB(r.z, 1); s0 += hv[10] * UB(r.z, 2); s0 += hv[11] * UB(r.z, 3);
                s1 += hv[12] * UB(r.w, 0); s1 += hv[13] * UB(r.w, 1); s1 += hv[14] * UB(r.w, 2); s1 += hv[15] * UB(r.w, 3);
                p[j] = s0 + s1; }
#if PROBE_U_VALU
            asm volatile("" : "+v"(hv[0]), "+v"(hv[1]), "+v"(hv[2]), "+v"(hv[3]), "+v"(hv[4]), "+v"(hv[5]), "+v"(hv[6]), "+v"(hv[7]));
#pragma unroll
            for (int j = 0; j < 16; ++j) { const v4u r = rr[j];
                float s0 = hv[0] * UB(r.x, 0); s0 += hv[1] * UB(r.x, 1); s0 += hv[2] * UB(r.x, 2); s0 += hv[3] * UB(r.x, 3);
                float s1 = hv[4] * UB(r.y, 0); s1 += hv[5] * UB(r.y, 1); s1 += hv[6] * UB(r.y, 2); s1 += hv[7] * UB(r.y, 3);
                s0 += hv[8] * UB(r.z, 0); s0 += hv[9] * UB(r.z, 1); s0 += hv[10] * UB(r.z, 2); s0 += hv[11] * UB(r.z, 3);
                s1 += hv[12] * UB(r.w, 0); s1 += hv[13] * UB(r.w, 1); s1 += hv[14] * UB(r.w, 2); s1 += hv[15] * UB(r.w, 3);
                p[j] = 0.5f * (p[j] + (s0 + s1)); }
#endif
            const float tot = reduce16(p, F.lane);
            if ((F.lane >> 4) == (b & 3)) { if ((b & 7) < 4) act0 = tot; else act1 = tot; }
        }
        act0 = su0 * (act0 - 128.0f * hsum); act1 = su1 * (act1 - 128.0f * hsum);
        const float w0 = wt0 * sv0 * 0.5f * act0 * (1.0f + erff(act0 * 0.7071067811865476f)), w1 = wt1 * sv1 * 0.5f * act1 * (1.0f + erff(act1 * 0.7071067811865476f));
        const float csum = wave_sum(w0 + w1);
        float o[16];
#pragma unroll
        for (int k = 0; k < 16; ++k) o[k] = 0.f;
        for (int b = 0; b < 8 * PROBE_EXP_REP; ++b) {
            if (b == 8) {
#pragma unroll
                for (int k = 0; k < 16; ++k) o[k] = 0.f; }
            const int isel = ((b & 7) < 4) ? idx0 : idx1; const float wsel = ((b & 7) < 4) ? w0 : w1; const int lb = 16 * (b & 3);
            v4u rr[16];
#pragma unroll
            for (int j = 0; j < 16; ++j) { const unsigned ie = (unsigned)rdlanei(isel, lb + j); rr[j] = *(const v4u*)(VE + (size_t)ie * 1024u + lo16b); }
#pragma unroll
            for (int j = 0; j < 16; ++j) { const float we = rdlane(wsel, lb + j); const v4u r = rr[j];
                o[0] += we * UB(r.x, 0); o[1] += we * UB(r.x, 1); o[2] += we * UB(r.x, 2); o[3] += we * UB(r.x, 3); o[4] += we * UB(r.y, 0); o[5] += we * UB(r.y, 1); o[6] += we * UB(r.y, 2); o[7] += we * UB(r.y, 3);
                o[8] += we * UB(r.z, 0); o[9] += we * UB(r.z, 1); o[10] += we * UB(r.z, 2); o[11] += we * UB(r.z, 3); o[12] += we * UB(r.w, 0); o[13] += we * UB(r.w, 1); o[14] += we * UB(r.w, 2); o[15] += we * UB(r.w, 3); }
        }
#pragma unroll
        for (int k = 0; k < 16; ++k) o[k] -= 128.0f * csum;
#undef UB
#else
        float act0 = 0.f, act1 = 0.f;
        for (int b = 0; b < 8 * PROBE_EXP_REP; ++b) {
            const int isel = ((b & 7) < 4) ? idx0 : idx1; const int lb = 16 * (b & 3);
            v4u ra[16], rb[16];
#pragma unroll
            for (int j = 0; j < 16; ++j) { const unsigned ie = (unsigned)rdlanei(isel, lb + j); const unsigned char* up = UE + (size_t)ie * 2048u + lo16;
                ra[j] = *(const v4u*)up; rb[j] = *(const v4u*)(up + 1024); }
            float p[16];
#pragma unroll
            for (int j = 0; j < 16; ++j) { float s = dot2bf(ha.x, ra[j].x, 0.f); s = dot2bf(ha.y, ra[j].y, s); s = dot2bf(ha.z, ra[j].z, s); s = dot2bf(ha.w, ra[j].w, s);
                s = dot2bf(hb.x, rb[j].x, s); s = dot2bf(hb.y, rb[j].y, s); s = dot2bf(hb.z, rb[j].z, s); s = dot2bf(hb.w, rb[j].w, s); p[j] = s; }
            const float tot = reduce16(p, F.lane);
            if ((F.lane >> 4) == (b & 3)) { if ((b & 7) < 4) act0 = tot; else act1 = tot; }
        }
        const float w0 = wt0 * 0.5f * act0 * (1.0f + erff(act0 * 0.7071067811865476f)), w1 = wt1 * 0.5f * act1 * (1.0f + erff(act1 * 0.7071067811865476f));
        float o[16];
#pragma unroll
        for (int k = 0; k < 16; ++k) o[k] = 0.f;
        for (int b = 0; b < 8 * PROBE_EXP_REP; ++b) {
            if (b == 8) {
#pragma unroll
                for (int k = 0; k < 16; ++k) o[k] = 0.f; }
            const int isel = ((b & 7) < 4) ? idx0 : idx1; const float wsel = ((b & 7) < 4) ? w0 : w1; const int lb = 16 * (b & 3);
            v4u ra[16], rb[16];
#pragma unroll
            for (int j = 0; j < 16; ++j) { const unsigned ie = (unsigned)rdlanei(isel, lb + j); const unsigned char* vp = VE + (size_t)ie * 2048u + lo16;
                ra[j] = *(const v4u*)vp; rb[j] = *(const v4u*)(vp + 1024); }
#pragma unroll
            for (int j = 0; j < 16; ++j) { const float we = rdlane(wsel, lb + j); const v4u a = ra[j], bb = rb[j];
                o[0] += we * bflo(a.x); o[1] += we * bfhi(a.x); o[2] += we * bflo(a.y); o[3] += we * bfhi(a.y); o[4] += we * bflo(a.z); o[5] += we * bfhi(a.z); o[6] += we * bflo(a.w); o[7] += we * bfhi(a.w);
                o[8] += we * bflo(bb.x); o[9] += we * bfhi(bb.x); o[10] += we * bflo(bb.y); o[11] += we * bfhi(bb.y); o[12] += we * bflo(bb.z); o[13] += we * bfhi(bb.z); o[14] += we * bflo(bb.w); o[15] += we * bfhi(bb.w); }
        }
#endif
        const int b = t >> 11; const float* mb = mod + ((size_t)l * 8 + b) * 6144;
        float x2[16]; float ss = 0.f;
#pragma unroll
        for (int hseg = 0; hseg < 2; ++hseg)
#pragma unroll
            for (int q4 = 0; q4 < 2; ++q4) { const int col = hseg * 512 + 8 * F.lane + 4 * q4;
                const f32x4 xv = *(const f32x4*)(A.out + (size_t)t * D + col), gv = *(const f32x4*)(mb + 5120 + col);
#pragma unroll
                for (int e = 0; e < 4; ++e) { const float v = xv[e] + gv[e] * o[hseg * 8 + q4 * 4 + e]; x2[hseg * 8 + q4 * 4 + e] = v; ss += v * v; } }
        const float r = 1.0f / sqrtf(wave_sum(ss) * (1.0f / D) + EPS);
        if (l + 1 < DEPTH) {
            const float* mn = mod + ((size_t)(l + 1) * 8 + b) * 6144; const float* gn = A.in[I_GN1] + (size_t)(l + 1) * D;
#pragma unroll
            for (int hseg = 0; hseg < 2; ++hseg) { const int col = hseg * 512 + 8 * F.lane;
                float hn[8];
#pragma unroll
                for (int q4 = 0; q4 < 2; ++q4) { const f32x4 gg = *(const f32x4*)(gn + col + 4 * q4), sc = *(const f32x4*)(mn + 1024 + col + 4 * q4), sh = *(const f32x4*)(mn + col + 4 * q4);
                    f32x4 xo;
#pragma unroll
                    for (int e = 0; e < 4; ++e) { xo[e] = x2[hseg * 8 + q4 * 4 + e]; hn[q4 * 4 + e] = xo[e] * r * gg[e] * (1.0f + sc[e]) + sh[e]; }
                    *(f32x4*)(A.out + (size_t)t * D + col + 4 * q4) = xo; }
                v4u ov; ov.x = pk2(hn[0], hn[1]); ov.y = pk2(hn[2], hn[3]); ov.z = pk2(hn[4], hn[5]); ov.w = pk2(hn[6], hn[7]);
                *(v4u*)(Hn + (size_t)t * D + col) = ov; }
        } else {
            const float* gf = A.in[I_GFIN];
#pragma unroll
            for (int hseg = 0; hseg < 2; ++hseg)
#pragma unroll
                for (int q4 = 0; q4 < 2; ++q4) { const int col = hseg * 512 + 8 * F.lane + 4 * q4; const f32x4 gg = *(const f32x4*)(gf + col); f32x4 xo;
#pragma unroll
                    for (int e = 0; e < 4; ++e) xo[e] = x2[hseg * 8 + q4 * 4 + e] * r * gg[e];
                    *(f32x4*)(A.out + (size_t)t * D + col) = xo; }
        }
    }
}

struct HQ { int q1[4], q2[4]; float s1, s2; int c1, c2; };
struct NextB { const unsigned char* tab; int isel; int lb; };
template <int N> __device__ __forceinline__ void vm_wait() { asm volatile("s_waitcnt vmcnt(%0)" :: "n"(N) : "memory"); }
__device__ __forceinline__ void dma_row(const NextB& nb, int j, unsigned lo16b, LAS unsigned char* slot) {
    const unsigned ie = (unsigned)rdlanei(nb.isel, nb.lb + j);
#if EXP6B
#if DMA_NOMASK
    const unsigned off = lo16b < (lo16b - 768u) ? lo16b : lo16b - 768u;
#if ROW_OFFS
    __builtin_amdgcn_global_load_lds((const unsigned*)(nb.tab + (size_t)(ie + off)), (LAS unsigned*)slot, 16, 0, 0);
#else
    __builtin_amdgcn_global_load_lds((const unsigned*)(nb.tab + (size_t)ie * 768u + off), (LAS unsigned*)slot, 16, 0, 0);
#endif
#else
    if (lo16b < 768u) __builtin_amdgcn_global_load_lds((const unsigned*)(nb.tab + (size_t)ie * 768u + lo16b), (LAS unsigned*)slot, 16, 0, 0);
#endif
#else
    __builtin_amdgcn_global_load_lds((const unsigned*)(nb.tab + (size_t)ie * 1024u + lo16b), (LAS unsigned*)slot, 16, 0, 0);
#endif
}
#define UBF(w, i) ((float)(((w) >> (8 * (i))) & 255u))
__device__ __forceinline__ v4u ring_row(const LAS unsigned char* slot, unsigned lo16b) {
#if EXP6B
    const v2u X = *(const LAS v2u*)(slot + (lo16b >> 1)); const unsigned Y = *(const LAS unsigned*)(slot + 512 + (lo16b >> 2));
    v4u r;
    r.x = (X.x & 0x0F0F0F0Fu) | (Y & 0x30303030u);
    r.y = (X.x & 0xF0F0F0F0u) | (Y & 0x0C0C0C0Cu);
    r.z = (X.y & 0x0F0F0F0Fu) | ((Y >> 2) & 0x30303030u);
    r.w = (X.y & 0xF0F0F0F0u) | ((Y << 2) & 0x0C0C0C0Cu);
    return r;
#else
    return *(const LAS v4u*)(slot + lo16b);
#endif
}
#if ROW_PIPE
__device__ __forceinline__ void lds_raw(v4u& raw, const LAS unsigned char* slot, unsigned lo16b) {
#if EXP6B
    const v2u X = *(const LAS v2u*)(slot + (lo16b >> 1)); raw.x = X.x; raw.y = X.y; raw.z = *(const LAS unsigned*)(slot + 512 + (lo16b >> 2));
#else
    raw = *(const LAS v4u*)(slot + lo16b);
#endif
}
__device__ __forceinline__ v4u decode_raw(const v4u& raw) {
#if EXP6B
    v4u r;
    r.x = (raw.x & 0x0F0F0F0Fu) | (raw.z & 0x30303030u);
    r.y = (raw.x & 0xF0F0F0F0u) | (raw.z & 0x0C0C0C0Cu);
    r.z = (raw.y & 0x0F0F0F0Fu) | ((raw.z >> 2) & 0x30303030u);
    r.w = (raw.y & 0xF0F0F0F0u) | ((raw.z << 2) & 0x0C0C0C0Cu);
    return r;
#else
    return raw;
#endif
}
__device__ __forceinline__ void vm_wait_n(int n) {
    switch (n) { case 15: vm_wait<15>(); break; case 14: vm_wait<14>(); break; case 13: vm_wait<13>(); break; case 12: vm_wait<12>(); break; case 11: vm_wait<11>(); break; case 10: vm_wait<10>(); break;
        case 9: vm_wait<9>(); break; case 8: vm_wait<8>(); break; case 7: vm_wait<7>(); break; case 6: vm_wait<6>(); break; case 5: vm_wait<5>(); break; case 4: vm_wait<4>(); break;
        case 3: vm_wait<3>(); break; case 2: vm_wait<2>(); break; case 1: vm_wait<1>(); break; case 0: vm_wait<0>(); break; default: break; }
}
__device__ __forceinline__ v4u row_step(LAS unsigned char* ring, v4u& raw, const NextB& nb, unsigned lo16b, int B, bool refill, int waitn) {
    __builtin_amdgcn_sched_barrier(0);
#if EXP6B
    asm volatile("s_waitcnt lgkmcnt(0)" : "+v"(raw.x), "+v"(raw.y), "+v"(raw.z) :: "memory");
#else
    asm volatile("s_waitcnt lgkmcnt(0)" : "+v"(raw.x), "+v"(raw.y), "+v"(raw.z), "+v"(raw.w) :: "memory");
#endif
    if (refill) dma_row(nb, B, lo16b, ring + B * 1024);
    const v4u cur = raw;
    if (waitn >= 0) { vm_wait_n(waitn); lds_raw(raw, ring + ((B + 1) & 15) * 1024, lo16b); __builtin_amdgcn_sched_barrier(0); }
    return decode_raw(cur);
}
#endif
#if EXP6B && H_PLANES == 1
typedef int TreeT;
#else
typedef float TreeT;
#endif
template <int L, int B> __device__ __forceinline__ TreeT rs_tree(LAS unsigned char* ring, const HQ& hq, const NextB& nb, int lane, unsigned lo16b, v4u& raw) {
    if constexpr (L == 0) {
#if ROW_PIPE
        const v4u r = row_step(ring, raw, nb, lo16b, B, true, 15);
#else
        vm_wait<15>();
        const v4u r = ring_row(ring + B * 1024, lo16b);
#endif
#if EXP6B
        int e1 = __builtin_amdgcn_sdot4(hq.q1[0], (int)r.x, 0, false); e1 = __builtin_amdgcn_sdot4(hq.q1[2], (int)r.z, e1, false);
        int d1 = __builtin_amdgcn_sdot4(hq.q1[1], (int)r.y, hq.c1, false); d1 = __builtin_amdgcn_sdot4(hq.q1[3], (int)r.w, d1, false); d1 += e1 << 2;
#if H_PLANES == 2
        int e2 = __builtin_amdgcn_sdot4(hq.q2[0], (int)r.x, 0, false); e2 = __builtin_amdgcn_sdot4(hq.q2[2], (int)r.z, e2, false);
        int d2 = __builtin_amdgcn_sdot4(hq.q2[1], (int)r.y, hq.c2, false); d2 = __builtin_amdgcn_sdot4(hq.q2[3], (int)r.w, d2, false); d2 += e2 << 2;
#endif
#else
        int d1 = __builtin_amdgcn_sdot4(hq.q1[0], (int)r.x, 0, false); d1 = __builtin_amdgcn_sdot4(hq.q1[1], (int)r.y, d1, false); d1 = __builtin_amdgcn_sdot4(hq.q1[2], (int)r.z, d1, false); d1 = __builtin_amdgcn_sdot4(hq.q1[3], (int)r.w, d1, false);
        int d2 = __builtin_amdgcn_sdot4(hq.q2[0], (int)r.x, 0, false); d2 = __builtin_amdgcn_sdot4(hq.q2[1], (int)r.y, d2, false); d2 = __builtin_amdgcn_sdot4(hq.q2[2], (int)r.z, d2, false); d2 = __builtin_amdgcn_sdot4(hq.q2[3], (int)r.w, d2, false);
#endif
#if H_PLANES == 2
        const float p = (float)d1 * hq.s1 + (float)d2 * hq.s2;
#else
        const int p = d1;
#endif
#if !ROW_PIPE
        asm volatile("s_waitcnt lgkmcnt(0)" :: "v"(p) : "memory");
        dma_row(nb, B, lo16b, ring + B * 1024);
#endif
        return p;
    } else {
        constexpr int HS = 1 << (L - 1);
        const TreeT lo = rs_tree<L - 1, B>(ring, hq, nb, lane, lo16b, raw), hi = rs_tree<L - 1, B + HS>(ring, hq, nb, lane, lo16b, raw);
#if TREE_BANKMASK && EXP6B && H_PLANES == 1
        if constexpr (HS >= 4) {
            int t;
            if constexpr (HS == 4) { t = lo + __builtin_amdgcn_mov_dpp(lo, 0x104, 0xF, 0xF, true);
                asm volatile("s_nop 1\n\tv_add_u32_dpp %0, %1, %1 row_shr:4 row_mask:0xf bank_mask:0xa" : "+v"(t) : "v"(hi)); }
            else { t = lo + __builtin_amdgcn_mov_dpp(lo, 0x128, 0xF, 0xF, true);
                asm volatile("s_nop 1\n\tv_add_u32_dpp %0, %1, %1 row_ror:8 row_mask:0xf bank_mask:0xc" : "+v"(t) : "v"(hi)); }
            return t;
        }
#endif
        const bool up = lane & HS;
        return (up ? hi : lo) + lane_xchg<HS>(up ? lo : hi);
    }
}
__device__ __forceinline__ float consume_u(LAS unsigned char* ring, const HQ& hq, const NextB& nb, int lane, unsigned lo16b, v4u& raw) {
    TreeT d = rs_tree<4, 0>(ring, hq, nb, lane, lo16b, raw);
    d += lane_xchg<16>(d);
    d += lane_xchg<32>(d);
#if EXP6B && H_PLANES == 1
    return (float)d * hq.s1;
#else
    return d;
#endif
}
template <bool LASTB> __device__ __forceinline__ void consume_v(LAS unsigned char* ring, float (&o)[16], float wsel, int lb, const NextB& nb, unsigned lo16b) {
#pragma unroll
    for (int j = 0; j < 16; ++j) {
        if constexpr (LASTB) { switch (j) { case 0: vm_wait<15>(); break; case 1: vm_wait<14>(); break; case 2: vm_wait<13>(); break; case 3: vm_wait<12>(); break; case 4: vm_wait<11>(); break; case 5: vm_wait<10>(); break; case 6: vm_wait<9>(); break; case 7: vm_wait<8>(); break;
            case 8: vm_wait<7>(); break; case 9: vm_wait<6>(); break; case 10: vm_wait<5>(); break; case 11: vm_wait<4>(); break; case 12: vm_wait<3>(); break; case 13: vm_wait<2>(); break; case 14: vm_wait<1>(); break; default: vm_wait<0>(); break; } }
        else vm_wait<15>();
        const float we = rdlane(wsel, lb + j); const v4u r = *(const LAS v4u*)(ring + j * 1024 + lo16b);
        o[0] += we * UBF(r.x, 0); o[1] += we * UBF(r.x, 1); o[2] += we * UBF(r.x, 2); o[3] += we * UBF(r.x, 3); o[4] += we * UBF(r.y, 0); o[5] += we * UBF(r.y, 1); o[6] += we * UBF(r.y, 2); o[7] += we * UBF(r.y, 3);
        o[8] += we * UBF(r.z, 0); o[9] += we * UBF(r.z, 1); o[10] += we * UBF(r.z, 2); o[11] += we * UBF(r.z, 3); o[12] += we * UBF(r.w, 0); o[13] += we * UBF(r.w, 1); o[14] += we * UBF(r.w, 2); o[15] += we * UBF(r.w, 3);
        if constexpr (!LASTB) { asm volatile("s_waitcnt lgkmcnt(0)" :: "v"(o[0]), "v"(o[5]), "v"(o[10]), "v"(o[15]) : "memory"); dma_row(nb, j, lo16b, ring + j * 1024); }
    }
}
#if V_MFMA
typedef int v4i __attribute__((ext_vector_type(4)));
#if V_ABID
template <bool LASTB, int J> __device__ __forceinline__ void vm_row(LAS unsigned char* ring, v4i (&a1)[4], int aq, const NextB& nb, unsigned lo16b, v4u& raw) {
    const v4u r = row_step(ring, raw, nb, lo16b, J, !LASTB, LASTB ? 14 - J : 15);
    a1[0] = __builtin_amdgcn_mfma_i32_4x4x4i8(aq, (int)r.x, a1[0], 4, J, 0); a1[1] = __builtin_amdgcn_mfma_i32_4x4x4i8(aq, (int)r.y, a1[1], 4, J, 0);
    a1[2] = __builtin_amdgcn_mfma_i32_4x4x4i8(aq, (int)r.z, a1[2], 4, J, 0); a1[3] = __builtin_amdgcn_mfma_i32_4x4x4i8(aq, (int)r.w, a1[3], 4, J, 0);
}
template <bool LASTB> __device__ __forceinline__ void consume_vm(LAS unsigned char* ring, v4i (&a1)[4], v4i (&a2)[4], int cqsel, int lb, const NextB& nb, unsigned lo16b, unsigned sh8, v4u& raw) {
    static_assert(ROW_PIPE && V_PLANES == 1, "V_ABID: pipelined rows, one c plane");
    const int aq = (__shfl(cqsel, lb + (int)(lo16b >> 6)) & 255) << sh8;
    vm_row<LASTB, 0>(ring, a1, aq, nb, lo16b, raw); vm_row<LASTB, 1>(ring, a1, aq, nb, lo16b, raw); vm_row<LASTB, 2>(ring, a1, aq, nb, lo16b, raw); vm_row<LASTB, 3>(ring, a1, aq, nb, lo16b, raw);
    vm_row<LASTB, 4>(ring, a1, aq, nb, lo16b, raw); vm_row<LASTB, 5>(ring, a1, aq, nb, lo16b, raw); vm_row<LASTB, 6>(ring, a1, aq, nb, lo16b, raw); vm_row<LASTB, 7>(ring, a1, aq, nb, lo16b, raw);
    vm_row<LASTB, 8>(ring, a1, aq, nb, lo16b, raw); vm_row<LASTB, 9>(ring, a1, aq, nb, lo16b, raw); vm_row<LASTB, 10>(ring, a1, aq, nb, lo16b, raw); vm_row<LASTB, 11>(ring, a1, aq, nb, lo16b, raw);
    vm_row<LASTB, 12>(ring, a1, aq, nb, lo16b, raw); vm_row<LASTB, 13>(ring, a1, aq, nb, lo16b, raw); vm_row<LASTB, 14>(ring, a1, aq, nb, lo16b, raw); vm_row<LASTB, 15>(ring, a1, aq, nb, lo16b, raw);
    (void)a2;
}
#else
template <bool LASTB> __device__ __forceinline__ void consume_vm(LAS unsigned char* ring, v4i (&a1)[4], v4i (&a2)[4], int cqsel, int lb, const NextB& nb, unsigned lo16b, unsigned sh8, v4u& raw) {
#pragma unroll
    for (int j = 0; j < 16; ++j) {
#if ROW_PIPE
        const v4u r = row_step(ring, raw, nb, lo16b, j, !LASTB, LASTB ? 14 - j : 15); const int cs = rdlanei(cqsel, lb + j);
#else
        if constexpr (LASTB) { switch (j) { case 0: vm_wait<15>(); break; case 1: vm_wait<14>(); break; case 2: vm_wait<13>(); break; case 3: vm_wait<12>(); break; case 4: vm_wait<11>(); break; case 5: vm_wait<10>(); break; case 6: vm_wait<9>(); break; case 7: vm_wait<8>(); break;
            case 8: vm_wait<7>(); break; case 9: vm_wait<6>(); break; case 10: vm_wait<5>(); break; case 11: vm_wait<4>(); break; case 12: vm_wait<3>(); break; case 13: vm_wait<2>(); break; case 14: vm_wait<1>(); break; default: vm_wait<0>(); break; } }
        else vm_wait<15>();
        const int cs = rdlanei(cqsel, lb + j); const v4u r = ring_row(ring + j * 1024, lo16b);
#endif
        const int c1 = (cs & 255) << sh8, c2 = ((cs >> 8) & 255) << sh8;
#if V_PLANES == 2
        a1[0] = __builtin_amdgcn_mfma_i32_4x4x4i8(c1, (int)r.x, a1[0], 0, 0, 0); a2[0] = __builtin_amdgcn_mfma_i32_4x4x4i8(c2, (int)r.x, a2[0], 0, 0, 0);
        a1[1] = __builtin_amdgcn_mfma_i32_4x4x4i8(c1, (int)r.y, a1[1], 0, 0, 0); a2[1] = __builtin_amdgcn_mfma_i32_4x4x4i8(c2, (int)r.y, a2[1], 0, 0, 0);
        a1[2] = __builtin_amdgcn_mfma_i32_4x4x4i8(c1, (int)r.z, a1[2], 0, 0, 0); a2[2] = __builtin_amdgcn_mfma_i32_4x4x4i8(c2, (int)r.z, a2[2], 0, 0, 0);
        a1[3] = __builtin_amdgcn_mfma_i32_4x4x4i8(c1, (int)r.w, a1[3], 0, 0, 0); a2[3] = __builtin_amdgcn_mfma_i32_4x4x4i8(c2, (int)r.w, a2[3], 0, 0, 0);
#else
        a1[0] = __builtin_amdgcn_mfma_i32_4x4x4i8(c1, (int)r.x, a1[0], 0, 0, 0); a1[1] = __builtin_amdgcn_mfma_i32_4x4x4i8(c1, (int)r.y, a1[1], 0, 0, 0);
        a1[2] = __builtin_amdgcn_mfma_i32_4x4x4i8(c1, (int)r.z, a1[2], 0, 0, 0); a1[3] = __builtin_amdgcn_mfma_i32_4x4x4i8(c1, (int)r.w, a1[3], 0, 0, 0); (void)c2;
#endif
#if !ROW_PIPE
        if constexpr (!LASTB) { asm volatile("s_waitcnt lgkmcnt(0)" :: "v"(r.x), "v"(r.y), "v"(r.z), "v"(r.w) : "memory"); dma_row(nb, j, lo16b, ring + j * 1024); }
#endif
    }
}
#endif
#endif
template <bool HAVE_X1> __device__ __forceinline__ void expert_epilogue(const Ctx& F, KArgs A, int l, int t, const float (&o)[16], const float (&x1v)[16]) {
    const float* mod = (const float*)(A.ws + WS_MOD); bf16* Hn = (bf16*)(A.ws + WS_H);
    const int b = t >> 11; const float* mb = mod + ((size_t)l * 8 + b) * 6144;
    float x2[16]; float ss = 0.f;
#pragma unroll
    for (int hseg = 0; hseg < 2; ++hseg)
#pragma unroll
        for (int q4 = 0; q4 < 2; ++q4) { const int col = hseg * 512 + 8 * F.lane + 4 * q4;
            f32x4 xv; if constexpr (HAVE_X1) xv = (f32x4){x1v[hseg * 8 + q4 * 4], x1v[hseg * 8 + q4 * 4 + 1], x1v[hseg * 8 + q4 * 4 + 2], x1v[hseg * 8 + q4 * 4 + 3]}; else xv = *(const f32x4*)(A.out + (size_t)t * D + col);
            const f32x4 gv = *(const f32x4*)(mb + 5120 + col);
#pragma unroll
            for (int e = 0; e < 4; ++e) { const float v = xv[e] + gv[e] * o[hseg * 8 + q4 * 4 + e]; x2[hseg * 8 + q4 * 4 + e] = v; ss += v * v; } }
    const float r = 1.0f / sqrtf(wave_sum(ss) * (1.0f / D) + EPS);
    if (l + 1 < DEPTH) {
        const float* mn = mod + ((size_t)(l + 1) * 8 + b) * 6144; const float* gn = A.in[I_GN1] + (size_t)(l + 1) * D;
#pragma unroll
        for (int hseg = 0; hseg < 2; ++hseg) { const int col = hseg * 512 + 8 * F.lane;
            float hn[8];
#pragma unroll
            for (int q4 = 0; q4 < 2; ++q4) { const f32x4 gg = *(const f32x4*)(gn + col + 4 * q4), sc = *(const f32x4*)(mn + 1024 + col + 4 * q4), sh = *(const f32x4*)(mn + col + 4 * q4);
                f32x4 xo;
#pragma unroll
                for (int e = 0; e < 4; ++e) { xo[e] = x2[hseg * 8 + q4 * 4 + e]; hn[q4 * 4 + e] = xo[e] * r * gg[e] * (1.0f + sc[e]) + sh[e]; }
                *(f32x4*)(A.out + (size_t)t * D + col + 4 * q4) = xo; }
            v4u ov; ov.x = pk2(hn[0], hn[1]); ov.y = pk2(hn[2], hn[3]); ov.z = pk2(hn[4], hn[5]); ov.w = pk2(hn[6], hn[7]);
            *(v4u*)(Hn + (size_t)t * D + col) = ov; }
    } else {
        const float* gf = A.in[I_GFIN];
#pragma unroll
        for (int hseg = 0; hseg < 2; ++hseg)
#pragma unroll
            for (int q4 = 0; q4 < 2; ++q4) { const int col = hseg * 512 + 8 * F.lane + 4 * q4; const f32x4 gg = *(const f32x4*)(gf + col); f32x4 xo;
#pragma unroll
                for (int e = 0; e < 4; ++e) xo[e] = x2[hseg * 8 + q4 * 4 + e] * r * gg[e];
                *(f32x4*)(A.out + (size_t)t * D + col) = xo; }
    }
}
#if EPI_HOIST
struct EpiC { float g2[16], cn[16], shn[16]; };
__device__ __forceinline__ void epi_coeffs(EpiC& C, const Ctx& F, KArgs A, int l, int t0) {
    const float* mod = (const float*)(A.ws + WS_MOD); const int b = t0 >> 11; const float* mb = mod + ((size_t)l * 8 + b) * 6144;
#pragma unroll
    for (int i = 0; i < 4; ++i) { const int col = (i >> 1) * 512 + 8 * F.lane + 4 * (i & 1);
        const f32x4 gv = *(const f32x4*)(mb + 5120 + col);
        f32x4 gg, sc, sh;
        if (l + 1 < DEPTH) { const float* mn = mod + ((size_t)(l + 1) * 8 + b) * 6144; gg = *(const f32x4*)(A.in[I_GN1] + (size_t)(l + 1) * D + col); sc = *(const f32x4*)(mn + 1024 + col); sh = *(const f32x4*)(mn + col); }
        else { gg = *(const f32x4*)(A.in[I_GFIN] + col); sc = (f32x4){0.f, 0.f, 0.f, 0.f}; sh = sc; }
#pragma unroll
        for (int e = 0; e < 4; ++e) { C.g2[4 * i + e] = gv[e]; C.cn[4 * i + e] = gg[e] * (1.0f + sc[e]); C.shn[4 * i + e] = sh[e]; } }
}
__device__ __forceinline__ void expert_epilogue_c(const Ctx& F, KArgs A, int l, int t, const float (&o)[16], const float (&x1v)[16], const EpiC& C) {
    bf16* Hn = (bf16*)(A.ws + WS_H);
    float x2[16]; float ss = 0.f;
#pragma unroll
    for (int e = 0; e < 16; ++e) { const float v = x1v[e] + C.g2[e] * o[e]; x2[e] = v; ss += v * v; }
    const float r = 1.0f / sqrtf(wave_sum(ss) * (1.0f / D) + EPS);
    if (l + 1 < DEPTH) {
#pragma unroll
        for (int hseg = 0; hseg < 2; ++hseg) { const int col = hseg * 512 + 8 * F.lane;
            float hn[8];
#pragma unroll
            for (int q4 = 0; q4 < 2; ++q4) { f32x4 xo;
#pragma unroll
                for (int e = 0; e < 4; ++e) { xo[e] = x2[hseg * 8 + q4 * 4 + e]; hn[q4 * 4 + e] = xo[e] * r * C.cn[hseg * 8 + q4 * 4 + e] + C.shn[hseg * 8 + q4 * 4 + e]; }
                *(f32x4*)(A.out + (size_t)t * D + col + 4 * q4) = xo; }
            v4u ov; ov.x = pk2(hn[0], hn[1]); ov.y = pk2(hn[2], hn[3]); ov.z = pk2(hn[4], hn[5]); ov.w = pk2(hn[6], hn[7]);
            *(v4u*)(Hn + (size_t)t * D + col) = ov; }
    } else {
#pragma unroll
        for (int hseg = 0; hseg < 2; ++hseg)
#pragma unroll
            for (int q4 = 0; q4 < 2; ++q4) { const int col = hseg * 512 + 8 * F.lane + 4 * q4; f32x4 xo;
#pragma unroll
                for (int e = 0; e < 4; ++e) xo[e] = x2[hseg * 8 + q4 * 4 + e] * r * C.cn[hseg * 8 + q4 * 4 + e];
                *(f32x4*)(A.out + (size_t)t * D + col) = xo; }
    }
}
#endif
__device__ __forceinline__ void experts_unit4(const Ctx& F, KArgs A, int l, int t0, LAS unsigned char* ring, const LAS unsigned short* il, const LAS float* wl) {
    const bf16* H = (const bf16*)(A.ws + WS_H); const unsigned char* UE = A.ws + WS_UE; const unsigned char* VE = A.ws + WS_VE;
    const float* US = (const float*)(A.ws + WS_US); const float* VS = (const float*)(A.ws + WS_VS);
    const unsigned lo16b = (unsigned)F.lane * 16u;
#if EPI_HOIST
    static_assert(NORM_FOLD, "EPI_HOIST: x1 comes from the token loop");
    EpiC EC; epi_coeffs(EC, F, A, l, t0);
#endif
#if H2C_HOIST
    float cg[16], csh[16];
    { const float* mb = (const float*)(A.ws + WS_MOD) + ((size_t)l * 8 + (t0 >> 11)) * 6144; const float* g2 = A.in[I_GN2] + (size_t)l * D;
#pragma unroll
      for (int i = 0; i < 4; ++i) { const int col = (i >> 1) * 512 + 8 * F.lane + 4 * (i & 1);
          const f32x4 gg = *(const f32x4*)(g2 + col), sc = *(const f32x4*)(mb + 4096 + col), sh = *(const f32x4*)(mb + 3072 + col);
#pragma unroll
          for (int e = 0; e < 4; ++e) { cg[4 * i + e] = gg[e] * (1.0f + sc[e]); csh[4 * i + e] = sh[e]; } } }
#endif
#if X1_PREFETCH
    f32x4 xn[4];
    { const float* xr = A.out + (size_t)t0 * D;
#pragma unroll
      for (int i = 0; i < 4; ++i) xn[i] = *(const f32x4*)(xr + (i >> 1) * 512 + 8 * F.lane + 4 * (i & 1)); }
#endif
    int nidx0 = il[F.lane];
#if ROW_OFFS
    int nro0 = nidx0 * (int)EROW;
#else
#define nro0 nidx0
#define ro0 idx0
#define ro1 idx1
#endif
    { NextB nb{UE, nro0, 0};
#pragma unroll
      for (int j = 0; j < 16; ++j) dma_row(nb, j, lo16b, ring + j * 1024); }
    v4u raw = (v4u){0u, 0u, 0u, 0u};
#pragma unroll 1
    for (int k = 0; k < 4; ++k) {
        const int t = t0 + k; const int idx0 = nidx0, idx1 = il[k * 128 + 64 + F.lane]; const float wx0k = wl[k * 128 + F.lane], wx1k = wl[k * 128 + 64 + F.lane];
#if ROW_OFFS
        const int ro0 = nro0, ro1 = idx1 * (int)EROW;
#endif
        nidx0 = il[(k < 3 ? k + 1 : 3) * 128 + F.lane];
#if ROW_OFFS
        nro0 = nidx0 * (int)EROW;
#endif
        const float su0 = US[idx0], su1 = US[idx1], sv0 = VS[idx0], sv1 = VS[idx1];
        HQ hq; float x1v[16];
        { float hv[16];
#if NORM_FOLD
          {
              const float* xr = A.out + (size_t)t * D; const float* mb = (const float*)(A.ws + WS_MOD) + ((size_t)l * 8 + (t >> 11)) * 6144; const float* g2 = A.in[I_GN2] + (size_t)l * D;
              float ss = 0.f;
#pragma unroll
              for (int hseg = 0; hseg < 2; ++hseg)
#pragma unroll
                  for (int q4 = 0; q4 < 2; ++q4) {
#if X1_PREFETCH
                      const f32x4 xv = xn[hseg * 2 + q4];
#else
                      const f32x4 xv = *(const f32x4*)(xr + hseg * 512 + 8 * F.lane + 4 * q4);
#endif
#pragma unroll
                      for (int e = 0; e < 4; ++e) { hv[hseg * 8 + q4 * 4 + e] = xv[e]; x1v[hseg * 8 + q4 * 4 + e] = xv[e]; ss += xv[e] * xv[e]; } }
#if X1_PREFETCH
              { const float* xq = xr + (k < 3 ? D : 0);
#pragma unroll
                for (int i = 0; i < 4; ++i) xn[i] = *(const f32x4*)(xq + (i >> 1) * 512 + 8 * F.lane + 4 * (i & 1)); }
#endif
              const float r = 1.0f / sqrtf(wave_sum(ss) * (1.0f / D) + EPS);
#pragma unroll
              for (int hseg = 0; hseg < 2; ++hseg)
#pragma unroll
#if H2C_HOIST
                  for (int q4 = 0; q4 < 2; ++q4) {
#pragma unroll
                      for (int e = 0; e < 4; ++e) hv[hseg * 8 + q4 * 4 + e] = hv[hseg * 8 + q4 * 4 + e] * r * cg[hseg * 8 + q4 * 4 + e] + csh[hseg * 8 + q4 * 4 + e]; }
#else
                  for (int q4 = 0; q4 < 2; ++q4) { const int col = hseg * 512 + 8 * F.lane + 4 * q4;
                      const f32x4 gg = *(const f32x4*)(g2 + col), sc = *(const f32x4*)(mb + 4096 + col), sh = *(const f32x4*)(mb + 3072 + col);
#pragma unroll
                      for (int e = 0; e < 4; ++e) hv[hseg * 8 + q4 * 4 + e] = hv[hseg * 8 + q4 * 4 + e] * r * gg[e] * (1.0f + sc[e]) + sh[e]; }
#endif
          }
#else
          const v4u ha = *(const v4u*)(H + (size_t)t * D + 8 * F.lane), hb = *(const v4u*)(H + (size_t)t * D + 512 + 8 * F.lane);
          hv[0] = bflo(ha.x); hv[1] = bfhi(ha.x); hv[2] = bflo(ha.y); hv[3] = bfhi(ha.y); hv[4] = bflo(ha.z); hv[5] = bfhi(ha.z); hv[6] = bflo(ha.w); hv[7] = bfhi(ha.w);
          hv[8] = bflo(hb.x); hv[9] = bfhi(hb.x); hv[10] = bflo(hb.y); hv[11] = bfhi(hb.y); hv[12] = bflo(hb.z); hv[13] = bfhi(hb.z); hv[14] = bflo(hb.w); hv[15] = bfhi(hb.w);
#endif
          float am = 0.f;
#pragma unroll
          for (int e = 0; e < 16; ++e) am = fmaxf(am, fabsf(hv[e]));
          am = wave_max(am);
          const float inv1 = am > 0.f ? 127.0f / am : 0.f; hq.s1 = am * (1.0f / 127.0f); hq.s2 = hq.s1 * (1.0f / 254.0f); const float inv2 = inv1 * 254.0f;
#pragma unroll
          for (int w = 0; w < 4; ++w) { unsigned p1 = 0, p2 = 0;
#pragma unroll
              for (int e = 0; e < 4; ++e) { const float h = hv[4 * w + e]; const float a = rintf(h * inv1); const float b = fminf(fmaxf(rintf((h - a * hq.s1) * inv2), -127.f), 127.f);
                  p1 |= ((unsigned)(int)a & 255u) << (8 * e); p2 |= ((unsigned)(int)b & 255u) << (8 * e); }
              hq.q1[w] = (int)p1; hq.q2[w] = (int)p2; }
#if EXP6B
          hq.c1 = -128 * __builtin_amdgcn_sdot4(hq.q1[0], 0x01010101, __builtin_amdgcn_sdot4(hq.q1[2], 0x01010101, 0, false), false);
          hq.c2 = -128 * __builtin_amdgcn_sdot4(hq.q2[0], 0x01010101, __builtin_amdgcn_sdot4(hq.q2[2], 0x01010101, 0, false), false);
          hq.s1 *= 0.25f; hq.s2 *= 0.25f;
#else
          hq.c1 = 0; hq.c2 = 0;
#endif
        }
#if ROW_PIPE
        if (k == 0) { vm_wait<15>(); lds_raw(raw, ring, lo16b); }
#endif
        float act0 = 0.f, act1 = 0.f;
#pragma unroll 1
        for (int q = 0; q < 8; ++q) {
            const int qn = (q + 1) & 7; NextB nb{q < 7 ? UE : VE, qn < 4 ? ro0 : ro1, 16 * (qn & 3)};
            const float tot = consume_u(ring, hq, nb, F.lane, lo16b, raw);
            if ((F.lane >> 4) == (q & 3)) { if (q < 4) act0 = tot; else act1 = tot; }
        }
        act0 *= su0; act1 *= su1;
        const float w0 = wx0k * sv0 * 0.5f * act0 * (1.0f + erff(act0 * 0.7071067811865476f)), w1 = wx1k * sv1 * 0.5f * act1 * (1.0f + erff(act1 * 0.7071067811865476f));
#if V_MFMA
        float o[16];
        { const float cam = wave_max(fmaxf(fabsf(w0), fabsf(w1)));
          const float ci1 = cam > 0.f ? 127.0f / cam : 0.f, S1 = cam * (1.0f / 127.0f), S2 = S1 * (1.0f / 254.0f), ci2 = ci1 * 254.0f;
          int cq0, cq1;
          { const float a = rintf(w0 * ci1), b = fminf(fmaxf(rintf((w0 - a * S1) * ci2), -127.f), 127.f); cq0 = ((int)a & 255) | (((int)b & 255) << 8); }
          { const float a = rintf(w1 * ci1), b = fminf(fmaxf(rintf((w1 - a * S1) * ci2), -127.f), 127.f); cq1 = ((int)a & 255) | (((int)b & 255) << 8); }
          const unsigned sh8 = 8u * ((unsigned)F.lane & 3u);
          v4i a1[4], a2[4];
#pragma unroll
          for (int e = 0; e < 4; ++e) { a1[e] = (v4i){0, 0, 0, 0}; a2[e] = (v4i){0, 0, 0, 0}; }
#pragma unroll 1
          for (int q = 0; q < 7; ++q) {
              const int qn = q + 1; NextB nb{VE, qn < 4 ? ro0 : ro1, 16 * (qn & 3)};
              consume_vm<false>(ring, a1, a2, q < 4 ? cq0 : cq1, 16 * (q & 3), nb, lo16b, sh8, raw);
          }
          if (k < 3) { NextB nb{UE, nro0, 0}; consume_vm<false>(ring, a1, a2, cq1, 48, nb, lo16b, sh8, raw); }
          else { NextB nb{UE, 0, 0}; consume_vm<true>(ring, a1, a2, cq1, 48, nb, lo16b, sh8, raw); }
#if EXP6B
          static_assert(V_PLANES == 1, "6-bit rows: one c plane");
          { const int csum = wave_sumi((int)(signed char)(cq0 & 255) + (int)(signed char)(cq1 & 255));
#pragma unroll
            for (int e = 0; e < 16; ++e) o[e] = ((e >> 2) & 1) ? (0.25f * S1) * (float)a1[e >> 2][e & 3] : S1 * (float)(a1[e >> 2][e & 3] - 32 * csum); }
#else
#pragma unroll
          for (int e = 0; e < 16; ++e) o[e] = S1 * (float)a1[e >> 2][e & 3] + S2 * (float)a2[e >> 2][e & 3];
#endif
        }
#else
        const float csum = wave_sum(w0 + w1);
        float o[16];
#pragma unroll
        for (int e = 0; e < 16; ++e) o[e] = 0.f;
#pragma unroll 1
        for (int q = 0; q < 7; ++q) {
            const int qn = q + 1; NextB nb{VE, qn < 4 ? idx0 : idx1, 16 * (qn & 3)};
            consume_v<false>(ring, o, q < 4 ? w0 : w1, 16 * (q & 3), nb, lo16b);
        }
        if (k < 3) { NextB nb{UE, nidx0, 0}; consume_v<false>(ring, o, w1, 48, nb, lo16b); }
        else { NextB nb{UE, 0, 0}; consume_v<true>(ring, o, w1, 48, nb, lo16b); }
#pragma unroll
        for (int e = 0; e < 16; ++e) o[e] -= 128.0f * csum;
#endif
#if EPI_HOIST
        expert_epilogue_c(F, A, l, t, o, x1v, EC);
#else
        expert_epilogue<(NORM_FOLD) != 0>(F, A, l, t, o, x1v);
#endif
    }
}
#undef UBF
__device__ __forceinline__ void phase_experts(const Ctx& F, KArgs A, int l) {
    const int* IDX = (const int*)(A.ws + WS_IDX); const float* WTS = (const float*)(A.ws + WS_WTS);
    for (int t = F.gw; t < T; t += F.NGW)
        expert_token(F, A, l, t, IDX[(size_t)t * 128 + F.lane], IDX[(size_t)t * 128 + 64 + F.lane], WTS[(size_t)t * 128 + F.lane], WTS[(size_t)t * 128 + 64 + F.lane]);
}
__device__ __forceinline__ void phase_peer(const Ctx& F, KArgs A, int l) {
    LAS unsigned char* scr = F.lds + RING_OFF + F.wave * 16384;
    LAS unsigned short* il = (LAS unsigned short*)(F.lds + HAND_OFF + F.wave * 3072); LAS float* wl = (LAS float*)(F.lds + HAND_OFF + F.wave * 3072 + 1024);
#ifndef PROBE_PEER_CUS
#define PROBE_PEER_CUS 256
#endif
    if (F.vcu >= PROBE_PEER_CUS) return;
#if PEER_DYNAMIC
    unsigned* ctr = (unsigned*)(A.ws + WS_CTL) + CW_PEERQ + 64 * l;
    for (int u = F.gw; u < T / 4; ) {
#else
    for (int u = F.gw; u < T / 4; u += PROBE_PEER_CUS * NWAVES) {
#endif
        Ctx G = F; asm volatile("" : "+v"(G.lane));
        route_unit(G, A, l, u, scr, il, wl, 4 * u);
        LDS_WAIT();
#if EXP_I8 && !DBG_ROUTE32
        asm volatile("" : "+v"(G.lane));
        __builtin_amdgcn_s_setprio(2);
        experts_unit4(G, A, l, 4 * u, scr, il, wl);
        __builtin_amdgcn_s_setprio(0);
#if PEER_DYNAMIC
        { unsigned nu = 0; if (F.lane == 0) nu = __hip_atomic_fetch_add(ctr, 1u, __ATOMIC_RELAXED, __HIP_MEMORY_SCOPE_AGENT); u = (int)__builtin_amdgcn_readfirstlane(nu) + F.NGW; }
#endif
#else
#pragma unroll 1
        for (int k = 0; k < 4; ++k) expert_token(F, A, l, 4 * u + k, il[k * 128 + F.lane], il[k * 128 + 64 + F.lane], wl[k * 128 + F.lane], wl[k * 128 + 64 + F.lane]);
#endif
        LDS_WAIT();
    }
}
__device__ __forceinline__ bool ph_in_range(int k) {
    const __attribute__((address_space(4))) Args* ap_ = (const __attribute__((address_space(4))) Args*)__builtin_amdgcn_kernarg_segment_ptr(); asm volatile("" : "+s"(ap_));
    return ap_->ph_lo <= k && k < ap_->ph_hi;
}
#ifndef FUSE_PEER
#define FUSE_PEER (!DBG_ROUTE32)
#endif
constexpr int PPL = (FUSE_PEER ? 8 : 9) - ((NORM_FOLD) ? 1 : 0);
constexpr int N_PHASES = 2 + PPL * DEPTH;
#ifndef ONLY_MASK
#define ONLY_MASK 0xffffffffu
#endif
#ifndef REP_MASK
#define REP_MASK 0u
#endif
#define ONLY(k, stmt) do { if constexpr ((ONLY_MASK >> (k)) & 1u) { for (int rep_ = 0; rep_ < (((REP_MASK >> (k)) & 1u) ? 2 : 1); ++rep_) { stmt; } } } while (0)
__global__ void __launch_bounds__(NWAVES * 64, 2) mega_fwd(Args args) {
    extern __shared__ __attribute__((aligned(16))) unsigned char lds[];
#define MKARGS() const __attribute__((address_space(4))) Args* ap_ = (const __attribute__((address_space(4))) Args*)__builtin_amdgcn_kernarg_segment_ptr(); asm volatile("" : "+s"(ap_)); KArgs A = *ap_
#define MKCTX() MKARGS(); Ctx F; { int tid_ = threadIdx.x; asm volatile("" : "+v"(tid_)); int bx_ = blockIdx.x; asm volatile("" : "+s"(bx_)); \
        F.lds = (LAS unsigned char*)lds; F.tid = tid_; F.lane = tid_ & 63; F.wave = __builtin_amdgcn_readfirstlane(tid_ >> 6); F.G = gridDim.x; \
        F.vcu = (F.G % 8 == 0) ? (bx_ % 8) * (F.G / 8) + bx_ / 8 : bx_; F.gw = F.vcu * NWAVES + F.wave; F.NGW = F.G * NWAVES; }
    for (int u = threadIdx.x; u < (LDS_BYTES - LDSCTL_OFF) / 4; u += NWAVES * 64) ((LAS unsigned*)((LAS unsigned char*)lds + LDSCTL_OFF))[u] = 0u;
    __syncthreads();
    { MKARGS();
      if (A.ph_hi - A.ph_lo > 1) (void)xcd_barrier_post((unsigned*)(A.ws + WS_CTL) + CW_BAR, (volatile LAS unsigned*)((LAS unsigned char*)lds + MISC_OFF) + 8); }

#define IN(k) ph_in_range(k)
#define SEAM(k) do { if (IN(k) && IN((k) + 1)) { MKARGS(); XcdBarrier b_; b_.bar = (unsigned*)(A.ws + WS_CTL) + CW_BAR; b_.x = xb_xcc_id(); b_.st = (volatile LAS unsigned*)((LAS unsigned char*)lds + MISC_OFF) + 8; xcd_barrier(b_); } } while (0)
    if (IN(0)) { MKCTX(); ONLY(0, phase_pre(F, A)); } SEAM(0);
    if (IN(1)) { MKCTX(); ONLY(1, phase_h0(F, A)); } SEAM(1);
#if DBG_ROUTE32
#define QGEMM(l) do { pg8::Gemm g{(const bf16*)(A.ws + WS_H3), (const bf16*)(A.ws + WS_WQ3), 3072, 3072, 3072, 0, 0}; pg8::StaticOrder S; S.init(T, 2048, F.G, (int)blockIdx.x); \
        pg8::EpiF32 E{(float*)(A.ws + WS_Q32), 2048}; pg8::gemm_phase<pg8::EpiF32, pg8::StaticOrder, true, true>(F.lds + RING_OFF, g, S, E); } while (0)
#define ROUTE_EXTRA(l) phase_expert_convert(F, A, (l))
#define ROUTE(l) phase_route_naive(F, A, (l))
#else
#define QGEMM(l) do { unsigned char* wl = A.ws + WS_W + (size_t)(l) * W_LAYER; \
        pg8::Gemm g{(const bf16*)(A.ws + WS_H), (const bf16*)(wl + W_WQ), D, D, D, 0, 0}; pg8::StaticOrder S; S.init(T, 2048, F.G, (int)blockIdx.x); \
        QEPI(l); } while (0)
#define ROUTE_EXTRA(l) do {} while (0)
#if NORM_FOLD
#define WOEPI(l) pg8::EpiWoN E{(l) == 0 ? A.in[I_X] : A.out, A.out, (const float*)(A.ws + WS_MOD) + (size_t)(l) * 8 * 6144, A.in[I_GN2] + (size_t)(l) * D, (bf16*)(A.ws + WS_H), (float*)(A.ws + WS_SSQ)}; \
        ONLY(9, (pg8::gemm_phase<pg8::EpiWoN, pg8::StaticOrder, true, true>(F.lds + RING_OFF, g, S, E)))
#else
#define WOEPI(l) pg8::EpiWo E{(l) == 0 ? A.in[I_X] : A.out, A.out, (const float*)(A.ws + WS_MOD) + (size_t)(l) * 8 * 6144 + 2048}; \
        ONLY(9, (pg8::gemm_phase<pg8::EpiWo, pg8::StaticOrder, true, true>(F.lds + RING_OFF, g, S, E)))
#endif
#if NORM_FOLD
#define QEPI(l) pg8::EpiQN E{(bf16*)(A.ws + WS_Q2), (const float*)(A.ws + WS_SSQ), (const float*)(A.ws + WS_CQ) + (size_t)(l) * 8 * 2048, EPS}; \
        pg8::gemm_phase<pg8::EpiQN, pg8::StaticOrder, true, true>(F.lds + RING_OFF, g, S, E)
#else
#define QEPI(l) pg8::EpiBf16 E{(bf16*)(A.ws + WS_Q2), 2048}; \
        pg8::gemm_phase<pg8::EpiBf16, pg8::StaticOrder, true, true>(F.lds + RING_OFF, g, S, E)
#endif
#define ROUTE(l) phase_route(F, A, (l))
#endif
#ifndef NAIVE_MIX
#define NAIVE_MIX 0
#endif
#if NAIVE_MIX & 1
#define MIX_SWA(l) phase_swa_naive(F, A, (l))
#else
#define MIX_SWA(l) phase_swa2(F, A, (l))
#endif
#if NAIVE_MIX & 2
#define MIX_POOL(l) phase_pool_naive(F, A, (l))
#else
#define MIX_POOL(l) phase_pool(F, A, (l))
#endif
#define LAYER(l) do { \
    constexpr int P0_ = 2 + PPL * (l); \
    if (IN(P0_ + 0)) { MKCTX(); unsigned char* wl = A.ws + WS_W + (size_t)(l) * W_LAYER; \
        pg8::Gemm g{(const bf16*)(A.ws + WS_H), (const bf16*)(wl + W_WIN), D, D, D, 0, 0}; pg8::StaticOrder S; S.init(T, NIN, F.G, (int)blockIdx.x); \
        pg8::EpiProj E{(bf16*)(A.ws + WS_PROJ), (bf16*)(A.ws + WS_GATES)}; \
        ONLY(2, (pg8::gemm_phase<pg8::EpiProj, pg8::StaticOrder, true, true>(F.lds + RING_OFF, g, S, E))); \
        if (EXP_I8_OWN && (int)blockIdx.x >= 64) expert_quant(A, (l), F.lane, ((int)blockIdx.x - 64) * NWAVES + F.wave, (F.G - 64) * NWAVES);     \
        } \
    SEAM(P0_ + 0); \
    if (IN(P0_ + 1)) { { MKARGS(); \
        const attn_body::AttnTensors AT{(const attn_body::bf16*)(A.ws + WS_PROJ), (const attn_body::bf16*)(A.ws + WS_PROJ), (const attn_body::bf16*)(A.ws + WS_PROJ), (attn_body::bf16*)(A.ws + WS_O)}; \
        const attn_body::StaticOrder S((int)gridDim.x, (int)blockIdx.x); \
        ONLY(3, attn_body::attn_phase<attn_body::StaticOrder>((char*)lds + RING_OFF, AT, S)); } \
        { MKCTX(); ONLY(4, MIX_SWA(l)); ONLY(5, phase_conv_naive(F, A, (l))); ONLY(6, MIX_POOL(l)); } } \
    SEAM(P0_ + 1); \
    if (IN(P0_ + 2)) { MKCTX(); ONLY(7, phase_ya(F, A, (l))); } \
    SEAM(P0_ + 2); \
    if (IN(P0_ + 3)) { MKCTX(); unsigned char* wl = A.ws + WS_W + (size_t)(l) * W_LAYER; \
        pg8::Gemm g{(const bf16*)(A.ws + WS_Y), (const bf16*)(wl + W_WBR), 2048, 512, 512, (size_t)512 * 2, (size_t)D * 512 * 2}; pg8::ZOrder<4> S; S.init(T, D, F.G, (int)blockIdx.x); \
        pg8::EpiMergeK E{(const bf16*)(A.ws + WS_GATES), (bf16*)(A.ws + WS_O)}; \
        ONLY(8, (pg8::gemm_phase<pg8::EpiMergeK, pg8::ZOrder<4>, true, true>(F.lds + RING_OFF, g, S, E))); } \
    SEAM(P0_ + 3); \
    if (IN(P0_ + 4)) { MKCTX(); unsigned char* wl = A.ws + WS_W + (size_t)(l) * W_LAYER; \
        pg8::Gemm g{(const bf16*)(A.ws + WS_O), (const bf16*)(wl + W_WO), D, D, D, 0, 0}; pg8::StaticOrder S; S.init(T, D, F.G, (int)blockIdx.x); \
        WOEPI(l); } \
    SEAM(P0_ + 4); \
    if constexpr (!(NORM_FOLD)) { \
        if (IN(P0_ + 5)) { MKCTX(); ONLY(10, phase_h2(F, A, (l))); } \
        SEAM(P0_ + 5); \
    } \
    constexpr int PQ_ = P0_ + ((NORM_FOLD) ? 5 : 6); \
    if (IN(PQ_)) { MKCTX(); ONLY(11, QGEMM(l)); } \
    SEAM(PQ_); \
    if constexpr (FUSE_PEER) { \
        if (IN(PQ_ + 1)) { MKCTX(); ONLY(13, phase_peer(F, A, (l))); } \
        SEAM(PQ_ + 1); \
    } else { \
        if (IN(PQ_ + 1)) { MKCTX(); ONLY(12, ROUTE(l)); ROUTE_EXTRA(l); } \
        SEAM(PQ_ + 1); \
        if (IN(PQ_ + 2)) { MKCTX(); ONLY(13, phase_experts(F, A, (l))); } \
        SEAM(PQ_ + 2); \
    } \
} while (0)
    LAYER(0);
    LAYER(1);
#undef LAYER
#undef IN
#undef SEAM
}

#ifndef MK_SINGLE
#define MK_SINGLE 1
#endif
extern "C" void kernel_launch(void* const* d_in, const int* in_sizes, int n_in, void* d_out, int out_size, void* d_ws, size_t ws_size, hipStream_t stream) {
    static int grid = 0;
    if (grid == 0) {
        if (n_in != N_IN || in_sizes[0] != T * D || out_size != T * D || ws_size < WS_END) { fprintf(stderr, "kernel_launch: unexpected shapes: n_in %d in0 %d out %d ws %zu\n", n_in, n_in > 0 ? in_sizes[0] : -1, out_size, ws_size); grid = -1; return; }
        int dev = 0, cus = 0;
        if (hipGetDevice(&dev) != hipSuccess || hipDeviceGetAttribute(&cus, hipDeviceAttributeMultiprocessorCount, dev) != hipSuccess) { grid = -1; return; }
        if (hipFuncSetAttribute((const void*)mega_fwd, hipFuncAttributeMaxDynamicSharedMemorySize, LDS_BYTES) != hipSuccess) { fprintf(stderr, "kernel_launch: hipFuncSetAttribute failed\n"); grid = -1; return; }
        (void)hipGetLastError();
        grid = cus;
        if (grid != 256) fprintf(stderr, "kernel_launch: %d CUs; this kernel is built for 256\n", grid);
    }
    if (grid < 0) return;
    if (hipMemsetAsync((char*)d_ws + WS_CTL, 0, CTL_ZERO_BYTES, stream) != hipSuccess) return;
    Args a{};
    for (int i = 0; i < N_IN; ++i) a.in[i] = (const float*)d_in[i];
    a.out = (float*)d_out; a.ws = (unsigned char*)d_ws;
#if MK_SINGLE
    a.ph_lo = 0; a.ph_hi = N_PHASES;
    hipLaunchKernelGGL(mega_fwd, dim3(grid), dim3(NWAVES * 64), LDS_BYTES, stream, a);
#else
    for (int ph = 0; ph < N_PHASES; ++ph) { a.ph_lo = ph; a.ph_hi = ph + 1; hipLaunchKernelGGL(mega_fwd, dim3(grid), dim3(NWAVES * 64), LDS_BYTES, stream, a); }
#endif
}
```

```cpp
#include <hip/hip_runtime.h>
#include <cstdio>
#include <cstdint>
#include <type_traits>
namespace pg8 {
#define PG8_LAS __attribute__((address_space(3)))
typedef unsigned short bf16_t;
typedef short bf16x8 __attribute__((ext_vector_type(8)));
typedef float f32x4 __attribute__((ext_vector_type(4)));
typedef unsigned u32x4 __attribute__((ext_vector_type(4)));
constexpr int BM = 256, BK = 64, HALF = 128, HTB = HALF * BK * 2  , STAGE_BYTES = 8 * HTB, NXCD = 8, WGM = 8;

__host__ __device__ __forceinline__ int lds_byte(int r, int c) { const int st = (r >> 4) * 2 + (c >> 5), rr = r & 15, cc = c & 31, ob = rr * 64 + cc * 2; return st * 1024 + (ob ^ (((ob >> 9) & 1) << 5)); }
__host__ __device__ __forceinline__ void stage_rc(int b, int& R, int& C) { const int st = b / 1024, sb = b % 1024, swz = sb ^ (((sb >> 9) & 1) << 5); R = (st >> 1) * 16 + swz / 64; C = (st & 1) * 32 + (swz % 64) / 2; }
__host__ __device__ __forceinline__ int perm32(int rho) { const int n = rho >> 4, i = rho & 15; return 8 * (i >> 2) + 4 * n + (i & 3); }

struct Unit { int pm, pn, z; };
struct Gemm { const bf16_t* A; const bf16_t* Bt; int lda, ldb, K; size_t zA, zB; };

struct StaticOrder {
    int nM, nN, nwg, G, c;
    __host__ __device__ void init(int M, int N, int G_, int c_) { nM = M / BM; nN = N / BM; nwg = nM * nN; G = G_; c = c_; }
    __host__ __device__ bool next(int i, Unit& u) const {
        const long L = (long)i * G + c; if (L >= nwg) return false;
        int wgid = (int)L; { const int q = nwg / NXCD, r = nwg % NXCD, xcd = wgid % NXCD, off = wgid / NXCD; wgid = (xcd < r ? xcd * (q + 1) : r * (q + 1) + (xcd - r) * q) + off; }
        const int nig = WGM * nN, gid = wgid / nig, fm = gid * WGM, gsz = (nM - fm) < WGM ? (nM - fm) : WGM;
        u.pm = fm + ((wgid % nig) % gsz); u.pn = (wgid % nig) / gsz; u.z = 0; return true;
    }
    __device__ __forceinline__ void a_ready(const Unit&) const {}
    __device__ __forceinline__ void done(const Unit&) const {}
};
template <int NZ> struct ZOrder {
    StaticOrder S;
    __host__ __device__ void init(int M, int N, int G_, int c_) { S.init(M, N, G_, c_); }
    __host__ __device__ bool next(int i, Unit& u) const { if (!S.next(i / NZ, u)) return false; u.z = i % NZ; return true; }
    __device__ __forceinline__ void a_ready(const Unit&) const {}
    __device__ __forceinline__ void done(const Unit&) const {}
};

__device__ __forceinline__ unsigned cvt_pk_bf16(float lo, float hi) { unsigned r; asm volatile("v_cvt_pk_bf16_f32 %0, %1, %2" : "=v"(r) : "v"(lo), "v"(hi)); return r; }
__device__ __forceinline__ float bf_lo(unsigned w) { return __builtin_bit_cast(float, w << 16); }
__device__ __forceinline__ float bf_hi(unsigned w) { return __builtin_bit_cast(float, w & 0xffff0000u); }
__device__ __forceinline__ float sigmoidf_(float x) { return __builtin_amdgcn_rcpf(1.0f + __expf(-x)); }

__device__ __forceinline__ void store_lines(bf16_t* p, size_t ldc_rows8  , int fr, u32x4 w0, u32x4 w1) {
    const bool up = fr & 8;
    u32x4 x = up ? w0 : w1, r;
    r.x = (unsigned)__builtin_amdgcn_mov_dpp((int)x.x, 0x128, 0xF, 0xF, true); r.y = (unsigned)__builtin_amdgcn_mov_dpp((int)x.y, 0x128, 0xF, 0xF, true);
    r.z = (unsigned)__builtin_amdgcn_mov_dpp((int)x.z, 0x128, 0xF, 0xF, true); r.w = (unsigned)__builtin_amdgcn_mov_dpp((int)x.w, 0x128, 0xF, 0xF, true);
    bf16_t* pa = up ? p - ldc_rows8 + 32 : p; bf16_t* pb = up ? p + 32 : p + ldc_rows8;
    *(u32x4*)pa = up ? r : w0;
    *(u32x4*)pb = up ? w1 : r;
}
struct EpiBf16 {
    static constexpr bool PERM = true, AFTER_DRAIN = false;
    static __device__ __forceinline__ bool keeps_acc(const Unit&) { return false; }
    bf16_t* O; int ldc;
    __device__ __forceinline__ void operator()(const f32x4 (&acc)[2][2][4][2], const Unit& u, int wr, int wc, int fr, int fq) const {
        const int row0 = u.pm * BM + wr * 64 + fr, col0 = u.pn * BM + wc * 64 + 8 * fq;
#pragma unroll
        for (int ai = 0; ai < 2; ++ai)
#pragma unroll
            for (int m = 0; m < 4; ++m) { bf16_t* rowp = O + (size_t)(row0 + ai * HALF + m * 16) * ldc + col0;
                u32x4 w[2];
#pragma unroll
                for (int bj = 0; bj < 2; ++bj) { const f32x4 v0 = acc[ai][bj][m][0], v1 = acc[ai][bj][m][1];
                    w[bj].x = cvt_pk_bf16(v0[0], v0[1]); w[bj].y = cvt_pk_bf16(v0[2], v0[3]); w[bj].z = cvt_pk_bf16(v1[0], v1[1]); w[bj].w = cvt_pk_bf16(v1[2], v1[3]); }
                store_lines(rowp, (size_t)8 * ldc, fr, w[0], w[1]); }
    }
};
struct EpiProj {
    static constexpr bool PERM = true, AFTER_DRAIN = false;
    static __device__ __forceinline__ bool keeps_acc(const Unit&) { return false; }
    bf16_t* proj; bf16_t* gates;
    __device__ __forceinline__ void operator()(const f32x4 (&acc)[2][2][4][2], const Unit& u, int wr, int wc, int fr, int fq) const {
        const bool isg = u.pn >= 17; bf16_t* base = isg ? gates : proj; const int ldc = isg ? 4096 : 4352;
        const int row0 = u.pm * BM + wr * 64 + fr, col0 = (isg ? u.pn - 17 : u.pn) * BM + wc * 64 + 8 * fq;
#pragma unroll
        for (int ai = 0; ai < 2; ++ai)
#pragma unroll
            for (int m = 0; m < 4; ++m) { bf16_t* rowp = base + (size_t)(row0 + ai * HALF + m * 16) * ldc + col0;
                if (isg) {
                    f32x4 E[4];
#pragma unroll
                    for (int z = 0; z < 4; ++z)
#pragma unroll
                        for (int e = 0; e < 4; ++e) E[z][e] = 1.0f + __expf(-acc[ai][z >> 1][m][z & 1][e]);
                    bf16_t* gp = gates + (size_t)(row0 + ai * HALF + m * 16) * 4096 + (u.pn - 17) * 64 + wc * 16 + 4 * fq;
#pragma unroll
                    for (int z = 0; z < 4; ++z) { f32x4 f;
#pragma unroll
                        for (int e = 0; e < 4; ++e) f[e] = (z < 3 ? E[z + 1][e] : 1.0f) * __builtin_amdgcn_rcpf(E[z][e]);
                        typedef unsigned u32x2 __attribute__((ext_vector_type(2)));
                        u32x2 w; w.x = cvt_pk_bf16(f[0], f[1]); w.y = cvt_pk_bf16(f[2], f[3]); *(u32x2*)(gp + z * 1024) = w; }
                } else {
                { u32x4 w[2];
#pragma unroll
                for (int bj = 0; bj < 2; ++bj) { const f32x4 v0 = acc[ai][bj][m][0], v1 = acc[ai][bj][m][1];
                    w[bj].x = cvt_pk_bf16(v0[0], v0[1]); w[bj].y = cvt_pk_bf16(v0[2], v0[3]); w[bj].z = cvt_pk_bf16(v1[0], v1[1]); w[bj].w = cvt_pk_bf16(v1[2], v1[3]); }
                store_lines(rowp, (size_t)8 * ldc, fr, w[0], w[1]); } } }
    }
};
struct EpiMerge {
    static constexpr bool PERM = true, AFTER_DRAIN = false;
    static __device__ __forceinline__ bool keeps_acc(const Unit&) { return false; }
    const bf16_t* gates; float* s32; bf16_t* s16;
    __device__ __forceinline__ void operator()(const f32x4 (&acc)[2][2][4][2], const Unit& u, int wr, int wc, int fr, int fq) const {
        const int row0 = u.pm * BM + wr * 64 + fr, col0 = u.pn * BM + wc * 64 + 8 * fq, z = u.z;
#pragma unroll
        for (int ai = 0; ai < 2; ++ai)
#pragma unroll
            for (int m = 0; m < 4; ++m) { const size_t row = (size_t)(row0 + ai * HALF + m * 16);
#pragma unroll
                for (int bj = 0; bj < 2; ++bj) { const int col = col0 + bj * 32;
                    const u32x4 gw = *(const u32x4*)(gates + row * 4096 + (size_t)z * 1024 + col);
                    f32x4 v0 = acc[ai][bj][m][0], v1 = acc[ai][bj][m][1];
                    v0[0] *= bf_lo(gw.x); v0[1] *= bf_hi(gw.x); v0[2] *= bf_lo(gw.y); v0[3] *= bf_hi(gw.y);
                    v1[0] *= bf_lo(gw.z); v1[1] *= bf_hi(gw.z); v1[2] *= bf_lo(gw.w); v1[3] *= bf_hi(gw.w);
                    float* sp = s32 + row * 1024 + col;
                    if (z > 0) { v0 += *(const f32x4*)sp; v1 += *(const f32x4*)(sp + 4); }
                    if (z < 3) { *(f32x4*)sp = v0; *(f32x4*)(sp + 4) = v1; }
                    else { u32x4 w; w.x = cvt_pk_bf16(v0[0], v0[1]); w.y = cvt_pk_bf16(v0[2], v0[3]); w.z = cvt_pk_bf16(v1[0], v1[1]); w.w = cvt_pk_bf16(v1[2], v1[3]);
                        *(u32x4*)(s16 + row * 1024 + col) = w; } } }
    }
};
struct EpiWo {
    static constexpr bool PERM = false, AFTER_DRAIN = false;
    static __device__ __forceinline__ bool keeps_acc(const Unit&) { return false; }
    const float* xin; float* out; const float* gate;
    __device__ __forceinline__ void operator()(const f32x4 (&acc)[2][2][4][2], const Unit& u, int wr, int wc, int fr, int fq) const {
        const int row0 = u.pm * BM + wr * 64 + fr, col0 = u.pn * BM + wc * 32 + 4 * fq; const float* gb = gate + (size_t)(u.pm >> 3) * 6144;
#pragma unroll
        for (int bj = 0; bj < 2; ++bj)
#pragma unroll
            for (int n = 0; n < 2; ++n) { const int col = col0 + bj * HALF + n * 16; const f32x4 gv = *(const f32x4*)(gb + col);
#pragma unroll
                for (int ai = 0; ai < 2; ++ai)
#pragma unroll
                    for (int m = 0; m < 4; ++m) { const size_t off = (size_t)(row0 + ai * HALF + m * 16) * 1024 + col;
                        const f32x4 o = *(const f32x4*)(xin + off) + gv * acc[ai][bj][m][n]; *(f32x4*)(out + off) = o; } }
    }
};

struct EpiF32 {
    static constexpr bool PERM = false, AFTER_DRAIN = false;
    static __device__ __forceinline__ bool keeps_acc(const Unit&) { return false; }
    float* O; int ldc;
    __device__ __forceinline__ void operator()(const f32x4 (&acc)[2][2][4][2], const Unit& u, int wr, int wc, int fr, int fq) const {
        const int row0 = u.pm * BM + wr * 64 + fr, col0 = u.pn * BM + wc * 32 + 4 * fq;
#pragma unroll
        for (int bj = 0; bj < 2; ++bj)
#pragma unroll
            for (int n = 0; n < 2; ++n)
#pragma unroll
                for (int ai = 0; ai < 2; ++ai)
#pragma unroll
                    for (int m = 0; m < 4; ++m) *(f32x4*)(O + (size_t)(row0 + ai * HALF + m * 16) * ldc + col0 + bj * HALF + n * 16) = acc[ai][bj][m][n];
    }
};

template <bool XB> struct EpiWoN {
    static constexpr bool PERM = false, AFTER_DRAIN = false;
    static __device__ __forceinline__ bool keeps_acc(const Unit&) { return false; }
    const float* xin; const bf16_t* xinb; bf16_t* x1b; const float* modl; const float* g2; bf16_t* hb; float* ssq;
    __device__ __forceinline__ void operator()(const f32x4 (&acc)[2][2][4][2], const Unit& u, int wr, int wc, int fr, int fq) const {
        typedef unsigned u32x2 __attribute__((ext_vector_type(2)));
        const int row0 = u.pm * BM + wr * 64 + fr, col0 = u.pn * BM + wc * 32 + 4 * fq; const float* mb = modl + (size_t)(u.pm >> 3) * 6144;
        float sq[2][4];
#pragma unroll
        for (int ai = 0; ai < 2; ++ai)
#pragma unroll
            for (int m = 0; m < 4; ++m) sq[ai][m] = 0.f;
#pragma unroll
        for (int bj = 0; bj < 2; ++bj)
#pragma unroll
            for (int n = 0; n < 2; ++n) { const int col = col0 + bj * HALF + n * 16; const f32x4 gv = *(const f32x4*)(mb + 2048 + col);
                const f32x4 gm = *(const f32x4*)(g2 + col) * (*(const f32x4*)(mb + 4096 + col) + 1.0f);
#pragma unroll
                for (int ai = 0; ai < 2; ++ai)
#pragma unroll
                    for (int m = 0; m < 4; ++m) { const size_t off = (size_t)(row0 + ai * HALF + m * 16) * 1024 + col;
                        f32x4 xv;
                        if constexpr (XB) { const u32x2 xw = *(const u32x2*)(xinb + off); xv = (f32x4){bf_lo(xw.x), bf_hi(xw.x), bf_lo(xw.y), bf_hi(xw.y)}; }
                        else xv = *(const f32x4*)(xin + off);
                        const f32x4 o = xv + gv * acc[ai][bj][m][n];
                        { u32x2 w; w.x = cvt_pk_bf16(o[0], o[1]); w.y = cvt_pk_bf16(o[2], o[3]); *(u32x2*)(x1b + off) = w; }
                        sq[ai][m] += (o[0] * o[0] + o[1] * o[1]) + (o[2] * o[2] + o[3] * o[3]);
                        const f32x4 a = o * gm;
                        u32x2 w; w.x = cvt_pk_bf16(a[0], a[1]); w.y = cvt_pk_bf16(a[2], a[3]); *(u32x2*)(hb + off) = w; } }
#pragma unroll
        for (int ai = 0; ai < 2; ++ai)
#pragma unroll
            for (int m = 0; m < 4; ++m) { float s = sq[ai][m]; s += __shfl_xor(s, 16); s += __shfl_xor(s, 32);
                if (fq == 0) ssq[(size_t)(row0 + ai * HALF + m * 16) * 16 + u.pn * 4 + wc] = s; }
    }
};
struct EpiQN {
    static constexpr bool PERM = true, AFTER_DRAIN = false;
    static __device__ __forceinline__ bool keeps_acc(const Unit&) { return false; }
    bf16_t* O; const float* ssq; const float* cq; float eps;
    __device__ __forceinline__ void operator()(const f32x4 (&acc)[2][2][4][2], const Unit& u, int wr, int wc, int fr, int fq) const {
        const int row0 = u.pm * BM + wr * 64 + fr, col0 = u.pn * BM + wc * 64 + 8 * fq; const float* cb = cq + (size_t)(u.pm >> 3) * 2048 + col0;
        f32x4 c[2][2];
#pragma unroll
        for (int bj = 0; bj < 2; ++bj) { c[bj][0] = *(const f32x4*)(cb + bj * 32); c[bj][1] = *(const f32x4*)(cb + bj * 32 + 4); }
#pragma unroll
        for (int ai = 0; ai < 2; ++ai)
#pragma unroll
            for (int m = 0; m < 4; ++m) { const int row = row0 + ai * HALF + m * 16; const f32x4* sp = (const f32x4*)(ssq + (size_t)row * 16);
                const f32x4 s0 = sp[0], s1 = sp[1], s2 = sp[2], s3 = sp[3];
                const float ss = ((((s0[0] + s0[1]) + (s0[2] + s0[3])) + ((s1[0] + s1[1]) + (s1[2] + s1[3]))) + (((s2[0] + s2[1]) + (s2[2] + s2[3])) + ((s3[0] + s3[1]) + (s3[2] + s3[3]))));
                const float r = 1.0f / sqrtf(ss * (1.0f / 1024.0f) + eps);
                bf16_t* rowp = O + (size_t)row * 2048 + col0;
                u32x4 w[2];
#pragma unroll
                for (int bj = 0; bj < 2; ++bj) { const f32x4 v0 = acc[ai][bj][m][0] * r + c[bj][0], v1 = acc[ai][bj][m][1] * r + c[bj][1];
                    w[bj].x = cvt_pk_bf16(v0[0], v0[1]); w[bj].y = cvt_pk_bf16(v0[2], v0[3]); w[bj].z = cvt_pk_bf16(v1[0], v1[1]); w[bj].w = cvt_pk_bf16(v1[2], v1[3]); }
                store_lines(rowp, (size_t)8 * 2048, fr, w[0], w[1]); }
    }
};

struct EpiMergeK {
    static constexpr bool PERM = true, AFTER_DRAIN = false;
    static __device__ __forceinline__ bool keeps_acc(const Unit& u) { return u.z < 3; }
    const bf16_t* gates; bf16_t* s16;
    __device__ __forceinline__ void operator()(f32x4 (&acc)[2][2][4][2], const Unit& u, int wr, int wc, int fr, int fq) const {
        const int row0 = u.pm * BM + wr * 64 + fr, col0 = u.pn * BM + wc * 64 + 8 * fq, z = u.z;
#pragma unroll
        for (int ai = 0; ai < 2; ++ai)
#pragma unroll
            for (int m = 0; m < 4; ++m) { const size_t row = (size_t)(row0 + ai * HALF + m * 16);
#pragma unroll
                for (int bj = 0; bj < 2; ++bj) { const int col = col0 + bj * 32;
                    const u32x4 gw = *(const u32x4*)(gates + row * 4096 + (size_t)z * 1024 + col);
                    const float g[8] = {bf_lo(gw.x), bf_hi(gw.x), bf_lo(gw.y), bf_hi(gw.y), bf_lo(gw.z), bf_hi(gw.z), bf_lo(gw.w), bf_hi(gw.w)};
                    f32x4 v0 = acc[ai][bj][m][0], v1 = acc[ai][bj][m][1];
                    v0[0] *= g[0]; v0[1] *= g[1]; v0[2] *= g[2]; v0[3] *= g[3]; v1[0] *= g[4]; v1[1] *= g[5]; v1[2] *= g[6]; v1[3] *= g[7];
                    if (z < 3) { acc[ai][bj][m][0] = v0; acc[ai][bj][m][1] = v1; }
                    else { u32x4 w; w.x = cvt_pk_bf16(v0[0], v0[1]); w.y = cvt_pk_bf16(v0[2], v0[3]); w.z = cvt_pk_bf16(v1[0], v1[1]); w.w = cvt_pk_bf16(v1[2], v1[3]);
                        *(u32x4*)(s16 + row * 1024 + col) = w; } } }
    }
};

template <class Epi, class Sched, bool ALIGN_EPI = false, bool SP2 = false>
__device__ __forceinline__ void gemm_phase(PG8_LAS unsigned char* lds, const Gemm g, const Sched& S, const Epi& E) {
    const int tid = threadIdx.x, wid = __builtin_amdgcn_readfirstlane(tid >> 6), lane = tid & 63, wr = wid >> 2, wc = wid & 3, fr = lane & 15, fq = lane >> 4;
    const int K = g.K, nt = K / BK;
    unsigned voffA[2], voffB[2];
#pragma unroll
    for (int i = 0; i < 2; ++i) { int R, C; stage_rc(tid * 16 + i * 8192, R, C); const int Rb = Epi::PERM ? (64 * (R >> 5) + perm32(R & 31)) : R;
        voffA[i] = (unsigned)(R * g.lda + C) * 2u; voffB[i] = (unsigned)(Rb * g.ldb + C) * 2u; }
    const size_t kstep = (size_t)(BK * 2);
    const size_t hstepA = (size_t)HALF * g.lda * 2, hstepB = (size_t)(Epi::PERM ? 32 : HALF) * g.ldb * 2;
    const size_t tstepA = 2 * hstepA, tstepB = (size_t)BM * g.ldb * 2;
    const unsigned ldsw = (unsigned)wid * 1024u;
    const int aoff = lds_byte(wr * 64 + fr, fq * 8), boff = lds_byte(wc * 32 + fr, fq * 8);
#define PG8_SA(b, h) (((b) * 2 + (h)) * HTB)
#define PG8_SB(b, h) ((4 + (b) * 2 + (h)) * HTB)
#define PG8_STAGE(bufoff, gbase, voff) do { _Pragma("unroll") for (int _i = 0; _i < 2; ++_i) \
        __builtin_amdgcn_global_load_lds((const unsigned*)((const char*)(gbase) + (voff)[_i]), (PG8_LAS unsigned*)(lds + (bufoff) + ldsw + _i * 8192), 16, 0, 0); } while (0)
#define PG8_LDA(dst, b, h) do { _Pragma("unroll") for (int m = 0; m < 4; ++m) _Pragma("unroll") for (int k = 0; k < 2; ++k) dst[m][k] = *(const PG8_LAS bf16x8*)(lds + PG8_SA(b, h) + aoff + m * 2048 + k * 1024); } while (0)
#define PG8_LDB(dst, b, h) do { _Pragma("unroll") for (int n = 0; n < 2; ++n) _Pragma("unroll") for (int k = 0; k < 2; ++k) dst[n][k] = *(const PG8_LAS bf16x8*)(lds + PG8_SB(b, h) + boff + n * 2048 + k * 1024); } while (0)
#define PG8_MMA(ai, bj, At, Bt) do { __builtin_amdgcn_s_setprio(1); _Pragma("unroll") for (int m = 0; m < 4; ++m) _Pragma("unroll") for (int n = 0; n < 2; ++n) _Pragma("unroll") for (int k = 0; k < 2; ++k) \
        acc[ai][bj][m][n] = __builtin_amdgcn_mfma_f32_16x16x32_bf16(Bt[n][k], At[m][k], acc[ai][bj][m][n], 0, 0, 0); __builtin_amdgcn_s_setprio(0); } while (0)
#define PG8_WAIT_V(n) asm volatile("s_waitcnt vmcnt(" #n ")" ::: "memory")
#define PG8_WAIT_L(n) asm volatile("s_waitcnt lgkmcnt(" #n ")" ::: "memory")
#define PG8_BAR __builtin_amdgcn_s_barrier()
#define PG8_SCHED __builtin_amdgcn_sched_barrier(0)
    Unit cur, nxt; int ui = 0;
    if (!S.next(0, cur)) return;
    f32x4 acc[2][2][4][2];
#pragma unroll
    for (int a = 0; a < 2; ++a)
#pragma unroll
        for (int b = 0; b < 2; ++b)
#pragma unroll
            for (int m = 0; m < 4; ++m)
#pragma unroll
                for (int n = 0; n < 2; ++n) acc[a][b][m][n] = (f32x4){0.f, 0.f, 0.f, 0.f};
    bf16x8 At[4][2], B0[2][2], B1[2][2];
    const char* cA = (const char*)g.A + (size_t)cur.pm * tstepA + (size_t)cur.z * g.zA; const char* cB = (const char*)g.Bt + (size_t)cur.pn * tstepB + (size_t)cur.z * g.zB;
    S.a_ready(cur);
    if constexpr (SP2) {
        PG8_STAGE(PG8_SB(0, 0), cB, voffB); PG8_STAGE(PG8_SB(0, 1), cB + hstepB, voffB); PG8_STAGE(PG8_SA(0, 0), cA, voffA); PG8_STAGE(PG8_SA(0, 1), cA + hstepA, voffA);
        if (wr == 1) PG8_BAR;
        PG8_WAIT_V(2); PG8_BAR;
        PG8_STAGE(PG8_SB(1, 0), cB + kstep, voffB); PG8_STAGE(PG8_SA(1, 0), cA + kstep, voffA); PG8_STAGE(PG8_SB(1, 1), cB + hstepB + kstep, voffB);
        PG8_WAIT_V(6); PG8_BAR;
    } else {
        PG8_STAGE(PG8_SB(0, 0), cB, voffB); PG8_STAGE(PG8_SA(0, 0), cA, voffA); PG8_STAGE(PG8_SB(0, 1), cB + hstepB, voffB); PG8_STAGE(PG8_SA(0, 1), cA + hstepA, voffA);
        if (wr == 1) PG8_BAR;
        PG8_WAIT_V(4); PG8_BAR;
        PG8_STAGE(PG8_SB(1, 0), cB + kstep, voffB); PG8_STAGE(PG8_SA(1, 0), cA + kstep, voffA); PG8_STAGE(PG8_SB(1, 1), cB + hstepB + kstep, voffB);
        PG8_WAIT_V(6); PG8_BAR;
    }
    for (;;) {
        const bool has_next = S.next(ui + 1, nxt);
        const char* nA = has_next ? (const char*)g.A + (size_t)nxt.pm * tstepA + (size_t)nxt.z * g.zA : cA; const char* nB = has_next ? (const char*)g.Bt + (size_t)nxt.pn * tstepB + (size_t)nxt.z * g.zB : cB;
        for (int t = 0; t < nt; t += 2) {
            const bool last = (t == nt - 2);
            const char* a1 = cA + (size_t)(t + 1) * kstep;
            const char* a2 = last ? nA : cA + (size_t)(t + 2) * kstep; const char* b2 = last ? nB : cB + (size_t)(t + 2) * kstep;
            const char* a3 = a2 + kstep; const char* b3 = b2 + kstep;
            if (last && has_next) S.a_ready(nxt);
            if constexpr (SP2) {
            PG8_LDB(B0, 0, 0); PG8_LDB(B1, 0, 1); PG8_SCHED; PG8_LDA(At, 0, 0); PG8_STAGE(PG8_SA(1, 1), a1 + hstepA, voffA);
            PG8_WAIT_V(8); PG8_WAIT_L(0); PG8_BAR; PG8_MMA(0, 0, At, B0); PG8_MMA(0, 1, At, B1); PG8_BAR; PG8_SCHED;
            PG8_LDA(At, 0, 1); PG8_STAGE(PG8_SB(0, 0), b2, voffB); PG8_STAGE(PG8_SB(0, 1), b2 + hstepB, voffB); PG8_STAGE(PG8_SA(0, 0), a2, voffA);
            PG8_WAIT_V(8); PG8_WAIT_L(0); PG8_BAR; PG8_MMA(1, 0, At, B0); PG8_MMA(1, 1, At, B1); PG8_BAR; PG8_SCHED;
            PG8_LDB(B0, 1, 0); PG8_LDB(B1, 1, 1); PG8_SCHED; PG8_LDA(At, 1, 0); PG8_STAGE(PG8_SA(0, 1), a2 + hstepA, voffA);
            PG8_WAIT_V(8); PG8_WAIT_L(0); PG8_BAR; PG8_MMA(0, 0, At, B0); PG8_MMA(0, 1, At, B1); PG8_BAR; PG8_SCHED;
            PG8_LDA(At, 1, 1); PG8_STAGE(PG8_SB(1, 0), b3, voffB); PG8_STAGE(PG8_SB(1, 1), b3 + hstepB, voffB); PG8_STAGE(PG8_SA(1, 0), a3, voffA);
            PG8_WAIT_V(8); PG8_WAIT_L(0); PG8_BAR; PG8_MMA(1, 0, At, B0); PG8_MMA(1, 1, At, B1); PG8_BAR; PG8_SCHED;
            } else {
            PG8_LDB(B0, 0, 0); PG8_SCHED; PG8_LDA(At, 0, 0); PG8_STAGE(PG8_SA(1, 1), a1 + hstepA, voffA);
            PG8_WAIT_L(8); PG8_BAR; PG8_WAIT_L(0); PG8_MMA(0, 0, At, B0); PG8_BAR; PG8_SCHED;
            PG8_LDB(B1, 0, 1); PG8_STAGE(PG8_SB(0, 0), b2, voffB);
            PG8_BAR; PG8_WAIT_L(0); PG8_MMA(0, 1, At, B1); PG8_BAR;
            PG8_LDA(At, 0, 1); PG8_STAGE(PG8_SA(0, 0), a2, voffA);
            PG8_BAR; PG8_WAIT_L(0); PG8_MMA(1, 0, At, B0); PG8_BAR; PG8_SCHED;
            PG8_STAGE(PG8_SB(0, 1), b2 + hstepB, voffB);
            PG8_WAIT_V(6); PG8_BAR; PG8_MMA(1, 1, At, B1); PG8_BAR;
            PG8_LDB(B0, 1, 0); PG8_SCHED; PG8_LDA(At, 1, 0); PG8_STAGE(PG8_SA(0, 1), a2 + hstepA, voffA);
            PG8_WAIT_L(8); PG8_BAR; PG8_WAIT_L(0); PG8_MMA(0, 0, At, B0); PG8_BAR; PG8_SCHED;
            PG8_LDB(B1, 1, 1); PG8_STAGE(PG8_SB(1, 0), b3, voffB);
            PG8_BAR; PG8_WAIT_L(0); PG8_MMA(0, 1, At, B1); PG8_BAR;
            PG8_LDA(At, 1, 1); PG8_STAGE(PG8_SA(1, 0), a3, voffA);
            PG8_BAR; PG8_WAIT_L(0); PG8_MMA(1, 0, At, B0); PG8_BAR; PG8_SCHED;
            PG8_STAGE(PG8_SB(1, 1), b3 + hstepB, voffB);
            PG8_WAIT_V(6); PG8_BAR; PG8_MMA(1, 1, At, B1); PG8_BAR;
            }
        }
        if constexpr (ALIGN_EPI) { if (wr == 0) PG8_BAR; }
        if constexpr (!Epi::AFTER_DRAIN) { E(acc, cur, wr, wc, fr, fq); S.done(cur); }
        if (!has_next) break;
        if (!Epi::keeps_acc(cur)) {
#pragma unroll
        for (int a = 0; a < 2; ++a)
#pragma unroll
            for (int b = 0; b < 2; ++b)
#pragma unroll
                for (int m = 0; m < 4; ++m)
#pragma unroll
                    for (int n = 0; n < 2; ++n) acc[a][b][m][n] = (f32x4){0.f, 0.f, 0.f, 0.f};
        }
        cur = nxt; cA = nA; cB = nB; ++ui;
        if constexpr (ALIGN_EPI) { if (wr == 1) PG8_BAR; }
    }
    PG8_WAIT_V(0);
    if constexpr (!ALIGN_EPI) { if (wr == 0) PG8_BAR; }
    PG8_BAR;
    if constexpr (Epi::AFTER_DRAIN) { E.fused(acc, cur, wr, wc, fr, fq, lds, wid, lane); S.done(cur); }
#undef PG8_SA
#undef PG8_SB
#undef PG8_STAGE
#undef PG8_LDA
#undef PG8_LDB
#undef PG8_MMA
#undef PG8_WAIT_V
#undef PG8_WAIT_L
#undef PG8_BAR
#undef PG8_SCHED
}
}

#ifndef PG8_SP2
#define PG8_SP2 true
#endif
#ifndef PG8_ALIGN
#define PG8_ALIGN true
#endif
#include <hip/hip_bf16.h>
#include <cmath>
namespace attn_body {
using bf16=__hip_bfloat16;
using bf16x8=__attribute__((ext_vector_type(8)))short;
using s16x4=__attribute__((ext_vector_type(4)))short;
using f32x16=__attribute__((ext_vector_type(16)))float;
using u32x4=__attribute__((ext_vector_type(4)))unsigned;
constexpr int SEQ=2048,D=64,PQ=4352,PK=4352,PV=4352,PO=1024;
constexpr int NW=8,QBLK=32,QB=QBLK*NW,KVBLK=64,NQB=SEQ/QB;
constexpr int ATTN_UNIT_ROWS=QB;
__device__ __forceinline__ int crow(int r,int hi){return (r&3)+8*(r>>2)+4*hi;}
#define SBAR() __builtin_amdgcn_sched_barrier(0)
__device__ __forceinline__ void cmask(f32x16&p0,f32x16&p1,int jb,int qrel,int hi){
  const float NEG=-INFINITY; int kb=64*jb+4*hi;
  #pragma unroll
  for(int r=0;r<16;++r){int kv=kb+(r&3)+8*(r>>2); if(kv>qrel)p0[r]=NEG; if(kv+32>qrel)p1[r]=NEG;}
}

constexpr int NSLOT=3, SLOTB=8192;
constexpr int LDS_K=0, LDS_V=NSLOT*SLOTB, LDS_WS=2*NSLOT*SLOTB, LDS_OST=LDS_WS+NW*64*4, LDS_BYTES=LDS_OST+NW*4096;
constexpr float C2=0.125f*1.4426950408889634f;
__device__ __forceinline__ void glds16(const void*gsrc,unsigned lds_dst){unsigned keep;
  asm volatile("s_mov_b32 %0, m0\n\ts_mov_b32 m0, %2\n\ts_nop 0\n\tglobal_load_lds_dwordx4 %1, off\n\ts_mov_b32 m0, %0":"=&s"(keep):"v"(gsrc),"s"(lds_dst):"memory");}
__device__ __forceinline__ float max3f(float a,float b,float c){float r;asm("v_max3_f32 %0, %1, %2, %3":"=v"(r):"v"(a),"v"(b),"v"(c));return r;}
__device__ __forceinline__ float max2f(float a,float b){float r;asm("v_max_f32_e32 %0, %1, %2":"=v"(r):"v"(a),"v"(b));return r;}
__device__ __forceinline__ float fadd_s(float a,float b){float r;asm("v_add_f32_e32 %0, %1, %2":"=v"(r):"v"(a),"v"(b));return r;}
__device__ __forceinline__ float fsub_s(float a,float b){float r;asm("v_sub_f32_e32 %0, %1, %2":"=v"(r):"v"(a),"v"(b));return r;}
typedef float f32x2_t __attribute__((ext_vector_type(2))); typedef __bf16 bf16x2_t __attribute__((ext_vector_type(2)));
__device__ __forceinline__ unsigned cvtpk_s(float lo,float hi){f32x2_t v={lo,hi};bf16x2_t b=__builtin_convertvector(v,bf16x2_t);return __builtin_bit_cast(unsigned,b);}
#define WAIT_BAR(N) asm volatile("s_waitcnt vmcnt(" #N ") lgkmcnt(0)\n\ts_barrier":::"memory")

__device__ __forceinline__ void qkt(f32x16&p0,f32x16&p1,const char*Kslot,const bf16x8*qr,const f32x16&negm,int r32,int hi){
  const char*kb=Kslot+hi*1024+r32*16;
  #pragma unroll
  for(int d0=0;d0<4;++d0){
    const bf16x8 b0=*reinterpret_cast<const bf16x8*>(kb+d0*2048);
    const bf16x8 b1=*reinterpret_cast<const bf16x8*>(kb+d0*2048+512);
    if(d0==0){p0=__builtin_amdgcn_mfma_f32_32x32x16_bf16(b0,qr[0],negm,0,0,0);p1=__builtin_amdgcn_mfma_f32_32x32x16_bf16(b1,qr[0],negm,0,0,0);}
    else{p0=__builtin_amdgcn_mfma_f32_32x32x16_bf16(b0,qr[d0],p0,0,0,0);p1=__builtin_amdgcn_mfma_f32_32x32x16_bf16(b1,qr[d0],p1,0,0,0);}}
}
typedef __attribute__((address_space(3))) const char* lds_cptr;
typedef short v4i16_t __attribute__((ext_vector_type(4)));
__device__ __forceinline__ void kload8(bf16x8*kf,lds_cptr kp){
  kf[0]=*(const __attribute__((address_space(3))) bf16x8*)(kp);      kf[1]=*(const __attribute__((address_space(3))) bf16x8*)(kp+512);
  kf[2]=*(const __attribute__((address_space(3))) bf16x8*)(kp+2048); kf[3]=*(const __attribute__((address_space(3))) bf16x8*)(kp+2560);
  kf[4]=*(const __attribute__((address_space(3))) bf16x8*)(kp+4096); kf[5]=*(const __attribute__((address_space(3))) bf16x8*)(kp+4608);
  kf[6]=*(const __attribute__((address_space(3))) bf16x8*)(kp+6144); kf[7]=*(const __attribute__((address_space(3))) bf16x8*)(kp+6656);
}
__device__ __forceinline__ void kload2(bf16x8*kf,lds_cptr kp,int j){ kf[2*j]=*(const __attribute__((address_space(3))) bf16x8*)(kp+j*2048); kf[2*j+1]=*(const __attribute__((address_space(3))) bf16x8*)(kp+j*2048+512); }
__device__ __forceinline__ s16x4 vtr(lds_cptr p){ return __builtin_bit_cast(s16x4,__builtin_amdgcn_ds_read_tr16_b64_v4i16((__attribute__((address_space(3))) v4i16_t*)p)); }
__device__ __forceinline__ float rowmax(const f32x16&p0,const f32x16&p1){
  float a=max3f(p0[0],p0[1],p1[0]),b=max3f(p0[2],p0[3],p1[1]);a=max3f(a,p1[2],p1[3]);
  #pragma unroll
  for(int r=4;r<16;r+=4){a=max3f(a,p0[r],p0[r+1]);b=max3f(b,p0[r+2],p0[r+3]);a=max3f(a,p1[r],p1[r+1]);b=max3f(b,p1[r+2],p1[r+3]);}
  const float m=max2f(a,b);
  auto rr=__builtin_amdgcn_permlane32_swap(__float_as_uint(m),__float_as_uint(m),false,false);
  return max2f(__uint_as_float(rr[0]),__uint_as_float(rr[1]));
}
__device__ __forceinline__ void pv(f32x16*o,int vb,bf16x8 pa0,bf16x8 pa1,bf16x8 pa2,bf16x8 pa3){
  #pragma unroll
  for(int d0=0;d0<2;++d0){s16x4 lo[4],hi[4];
    #pragma unroll
    for(int ks=0;ks<4;++ks){
      asm volatile("ds_read_b64_tr_b16 %0,%1 offset:%c2":"=&v"(lo[ks]):"v"(vb),"i"(d0*4096+ks*1024):"memory");
      asm volatile("ds_read_b64_tr_b16 %0,%1 offset:%c2":"=&v"(hi[ks]):"v"(vb),"i"(d0*4096+ks*1024+512):"memory");}
    asm volatile("s_waitcnt lgkmcnt(0)":::"memory");SBAR();
    #define PK(k) (bf16x8){lo[k][0],lo[k][1],lo[k][2],lo[k][3],hi[k][0],hi[k][1],hi[k][2],hi[k][3]}
    o[d0]=__builtin_amdgcn_mfma_f32_32x32x16_bf16(pa0,PK(0),o[d0],0,0,0);
    o[d0]=__builtin_amdgcn_mfma_f32_32x32x16_bf16(pa1,PK(1),o[d0],0,0,0);
    o[d0]=__builtin_amdgcn_mfma_f32_32x32x16_bf16(pa2,PK(2),o[d0],0,0,0);
    o[d0]=__builtin_amdgcn_mfma_f32_32x32x16_bf16(pa3,PK(3),o[d0],0,0,0);
    #undef PK
  }
}

#ifndef ATTN_STORE16
#define ATTN_STORE16(p,v) (*(u32x4*)(p)=(v))
#endif
template<int THRL> __device__ __forceinline__ void attn_unit(int b,int qcol,int kcol,int vcol,int ocol,int qb,const bf16*Q,const bf16*__restrict__ K,const bf16*__restrict__ V,bf16*O,char*shm){
  const int tid=threadIdx.x,lane=tid&63,r32=lane&31,hi=lane>>5; const int wid=__builtin_amdgcn_readfirstlane(tid>>6);
  const long rowbase=(long)b*SEQ; const int q0=qb*QB;
  const bf16*Qw=Q+(rowbase+q0+wid*QBLK)*PQ+qcol;
  const bf16*Kh=K+rowbase*PK+kcol,*Vh=V+rowbase*PV+vcol;
  const unsigned lds0=(unsigned)(uintptr_t)shm;
  float*wsf=(float*)(shm+LDS_WS)+wid*64;
  const bf16*ksrc=Kh+(long)lane*PK+wid*8;
  const bf16*vsrc=Vh+(long)(16*(wid&3)+(lane>>2))*PV+(wid>>2)*32+(lane&3)*8;
  const unsigned kdst=lds0+LDS_K+wid*1024, vdst=lds0+LDS_V+wid*1024;
  #define DMA_K(t,slot) glds16(ksrc+(long)(t)*KVBLK*PK,(unsigned)__builtin_amdgcn_readfirstlane(kdst+(slot)))
  #define DMA_V(t,slot) glds16(vsrc+(long)(t)*KVBLK*PV,(unsigned)__builtin_amdgcn_readfirstlane(vdst+(slot)))
  const int vb0=(int)(lds0+LDS_V)+((lane>>4)&1)*32+(lane&3)*8+(4*hi+((lane&15)>>2))*64;
  const char*Kbase=shm+LDS_K; bf16x8 kf[8];
  const lds_cptr shm3=(lds_cptr)shm; const lds_cptr kp0=shm3+LDS_K+hi*1024+r32*16; const lds_cptr vp0=shm3+LDS_V+((lane>>4)&1)*32+(lane&3)*8+(4*hi+((lane&15)>>2))*64;
  const int NT=(q0+QB)/KVBLK;
  DMA_K(0,0);DMA_V(0,0);DMA_K(1,SLOTB);
  bf16x8 qr[4];
  #pragma unroll
  for(int d0=0;d0<4;++d0)qr[d0]=*reinterpret_cast<const bf16x8*>(&Qw[(long)r32*PQ+d0*16+hi*8]);
  float mhat=0.f,l_reg=0.f;f32x16 o[2];o[0]=f32x16{};o[1]=f32x16{};f32x16 negm=f32x16{};asm volatile("":"+v"(negm));
  const int qrel=wid*QBLK+r32;
  #define CMASK(P0,P1,t) do{int jb_=(t)-(NT-4); if(jb_>=0)cmask(P0,P1,jb_,qrel,hi);}while(0)
  bool resc=false;
  #define START(P0,P1) do{ const float rm=rowmax(P0,P1); resc=false; \
    { const float dl=rm; mhat=fadd_s(mhat,dl); \
      _Pragma("unroll") for(int r=0;r<16;++r){P0[r]=fsub_s(P0[r],dl);P1[r]=fsub_s(P1[r],dl);} \
      _Pragma("unroll") for(int r=0;r<16;++r)negm[r]=-mhat; asm volatile("":"+v"(negm)); } \
    _Pragma("unroll") for(int r=0;r<16;++r)P0[r]=__builtin_amdgcn_exp2f(P0[r]); }while(0)
  #define RESC() do{ if(resc){ asm volatile("s_waitcnt lgkmcnt(0)":::"memory"); \
      _Pragma("unroll") for(int d_=0;d_<2;++d_) _Pragma("unroll") for(int r=0;r<16;++r)o[d_][r]*=wsf[crow(r,hi)]; } }while(0)
  f32x16 pA0,pA1,pB0,pB1;
  int sl_prev=0,sl_cur=0,sl_next=SLOTB;
  #define ROT() do{sl_prev=sl_cur;sl_cur=sl_next;sl_next=(sl_next==(NSLOT-1)*SLOTB)?0:sl_next+SLOTB;}while(0)
  DMA_K(2,2*SLOTB);
  WAIT_BAR(3);
  qkt(pA0,pA1,Kbase,qr,negm,r32,hi);asm volatile("s_nop 15\n\ts_nop 7":"+v"(pA0),"+v"(pA1));CMASK(pA0,pA1,0);
  START(pA0,pA1);
  _Pragma("unroll") for(int r=0;r<16;++r)pA1[r]=__builtin_amdgcn_exp2f(pA1[r]);
  WAIT_BAR(0);
  DMA_K(3,0);DMA_V(1,SLOTB);
  ROT();
  kload8(kf,kp0+sl_cur);
  WAIT_BAR(2);
  s16x4 vlo[8],vhi[8]; u32x4 pw0,pw1,pw2,pw3;
  #define PKW(P,B) cvtpk_s(P[B],P[B+1])
  #define PAF(k) __builtin_bit_cast(bf16x8,pw##k)
  #define VFR(i) (bf16x8){vlo[i][0],vlo[i][1],vlo[i][2],vlo[i][3],vhi[i][0],vhi[i][1],vhi[i][2],vhi[i][3]}
  #define PIN(x) asm volatile("":"+v"(x))
  #define MX3(a,b,c) __builtin_fmaxf(__builtin_fmaxf((a),(b)),(c))
  #define GAPA(MF,A0,A1,A2,A3,W0,W1,PW) do{ MF; sacc+=A0; sacc+=A1; sacc+=A2; sacc+=A3; PIN(sacc); W0; W1; PIN(PW); SBAR(); }while(0)
  #define EX(v) __builtin_amdgcn_exp2f(v)
  #define GAPB(MF,X,B) do{ MF; X[B]=EX(X[B]); X[B+1]=EX(X[B+1]); X[B+2]=EX(X[B+2]); X[B+3]=EX(X[B+3]); PIN(X); SBAR(); }while(0)
  #define VRD(i) do{ vlo[i]=vtr(vp_+(((i)>>2)*4096+((i)&3)*1024)); vhi[i]=vtr(vp_+(((i)>>2)*4096+((i)&3)*1024+512)); }while(0)
  #define KRD(G,j) do{ if(G){ kload2(kf,kp0+sl_next,j); SBAR(); } }while(0)
  #define STEP(C0,C1,P0,P1,t,GK,GV,GL) do{ SBAR(); \
    const lds_cptr vp_=vp0+sl_prev; \
    VRD(0); SBAR(); float sacc=(P0[0]+P0[1]); \
    GAPA(C0=__builtin_amdgcn_mfma_f32_32x32x16_bf16(kf[0],qr[0],negm,0,0,0), P0[2],P0[3],P0[4],P0[5],     pw0[0]=PKW(P0,0), pw0[1]=PKW(P0,2), pw0); \
    VRD(4); SBAR(); GAPA(C1=__builtin_amdgcn_mfma_f32_32x32x16_bf16(kf[1],qr[0],negm,0,0,0), P0[6],P0[7],P0[8],P0[9],     pw0[2]=PKW(P0,4), pw0[3]=PKW(P0,6), pw0); \
    VRD(1); SBAR(); GAPA(C0=__builtin_amdgcn_mfma_f32_32x32x16_bf16(kf[2],qr[1],C0,0,0,0),   P0[10],P0[11],P0[12],P0[13], pw1[0]=PKW(P0,8), pw1[1]=PKW(P0,10), pw1); \
    VRD(5); SBAR(); GAPA(C1=__builtin_amdgcn_mfma_f32_32x32x16_bf16(kf[3],qr[1],C1,0,0,0),   P0[14],P0[15],P1[0],P1[1],   pw1[2]=PKW(P0,12),pw1[3]=PKW(P0,14), pw1); \
    VRD(2); SBAR(); GAPA(C0=__builtin_amdgcn_mfma_f32_32x32x16_bf16(kf[4],qr[2],C0,0,0,0),   P1[2],P1[3],P1[4],P1[5],     pw2[0]=PKW(P1,0), pw2[1]=PKW(P1,2), pw2); \
    VRD(6); SBAR(); GAPA(C1=__builtin_amdgcn_mfma_f32_32x32x16_bf16(kf[5],qr[2],C1,0,0,0),   P1[6],P1[7],P1[8],P1[9],     pw2[2]=PKW(P1,4), pw2[3]=PKW(P1,6), pw2); \
    VRD(3); SBAR(); GAPA(C0=__builtin_amdgcn_mfma_f32_32x32x16_bf16(kf[6],qr[3],C0,0,0,0),   P1[10],P1[11],P1[12],P1[13], pw3[0]=PKW(P1,8), pw3[1]=PKW(P1,10), pw3); \
    VRD(7); SBAR(); GAPA(C1=__builtin_amdgcn_mfma_f32_32x32x16_bf16(kf[7],qr[3],C1,0,0,0),   P1[14],P1[15],0.f,0.f,       pw3[2]=PKW(P1,12),pw3[3]=PKW(P1,14), pw3); \
    l_reg+=sacc; \
    if(GK){DMA_K((t)+3,sl_cur);} if(GV){DMA_V((t)+1,sl_next);} \
    CMASK(C0,C1,t); \
    { float a=MX3(C0[0],C0[1],C1[0]),b=MX3(C0[2],C0[3],C1[1]); a=MX3(a,C1[2],C1[3]); \
      _Pragma("unroll") for(int r=4;r<16;r+=4){a=MX3(a,C0[r],C0[r+1]);b=MX3(b,C0[r+2],C0[r+3]);a=MX3(a,C1[r],C1[r+1]);b=MX3(b,C1[r+2],C1[r+3]);} \
      float rm=__builtin_fmaxf(a,b); { auto rr=__builtin_amdgcn_permlane32_swap(__float_as_uint(rm),__float_as_uint(rm),false,false); rm=__builtin_fmaxf(__uint_as_float(rr[0]),__uint_as_float(rr[1])); } \
      resc=false; \
      if(__builtin_expect(__any(rm>(float)THRL),0)){ const float dl=__builtin_fmaxf(rm,0.f); mhat+=dl; \
        _Pragma("unroll") for(int r=0;r<16;++r){C0[r]-=dl;C1[r]-=dl;} \
        _Pragma("unroll") for(int r=0;r<16;++r)negm[r]=-mhat; asm volatile("":"+v"(negm)); \
        const float f=__builtin_amdgcn_exp2f(-dl); l_reg*=f; if(hi==0)wsf[r32]=f; resc=true; } } \
    SBAR(); \
    GAPB(o[0]=__builtin_amdgcn_mfma_f32_32x32x16_bf16(PAF(0),VFR(0),o[0],0,0,0), C0,0); \
    GAPB(o[1]=__builtin_amdgcn_mfma_f32_32x32x16_bf16(PAF(0),VFR(4),o[1],0,0,0), C0,4); \
    KRD(GL,0); GAPB(o[0]=__builtin_amdgcn_mfma_f32_32x32x16_bf16(PAF(1),VFR(1),o[0],0,0,0), C0,8); \
    KRD(GL,1); GAPB(o[1]=__builtin_amdgcn_mfma_f32_32x32x16_bf16(PAF(1),VFR(5),o[1],0,0,0), C0,12); \
    KRD(GL,2); GAPB(o[0]=__builtin_amdgcn_mfma_f32_32x32x16_bf16(PAF(2),VFR(2),o[0],0,0,0), C1,0); \
    KRD(GL,3); GAPB(o[1]=__builtin_amdgcn_mfma_f32_32x32x16_bf16(PAF(2),VFR(6),o[1],0,0,0), C1,4); \
    GAPB(o[0]=__builtin_amdgcn_mfma_f32_32x32x16_bf16(PAF(3),VFR(3),o[0],0,0,0), C1,8); \
    GAPB(o[1]=__builtin_amdgcn_mfma_f32_32x32x16_bf16(PAF(3),VFR(7),o[1],0,0,0), C1,12); \
    }while(0)
  int t=1;
  #undef CMASK
  #define CMASK(P0,P1,t) do{}while(0)
  for(;t+5<NT;t+=2){
    STEP(pB0,pB1,pA0,pA1,t,true,true,true);     WAIT_BAR(2); RESC(); ROT();
    STEP(pA0,pA1,pB0,pB1,t+1,true,true,true);   WAIT_BAR(2); RESC(); ROT();
  }
  #undef CMASK
  #define CMASK(P0,P1,t) do{int jb_=(t)-(NT-4); if(jb_>=0)cmask(P0,P1,jb_,qrel,hi);}while(0)
  #define ENDW(tt) do{ if((tt)+3<NT){WAIT_BAR(2);} else if((tt)+2<NT){WAIT_BAR(1);} else {WAIT_BAR(0);} }while(0)
  for(;t+1<NT;t+=2){
    STEP(pB0,pB1,pA0,pA1,t,(t+3<NT),(t+1<NT),(t+1<NT));       ENDW(t);   RESC(); ROT();
    STEP(pA0,pA1,pB0,pB1,t+1,(t+4<NT),(t+2<NT),(t+2<NT));     ENDW(t+1); RESC(); ROT();
  }
  STEP(pB0,pB1,pA0,pA1,NT-1,false,false,false); RESC();
  { float sacc=pB0[0]+pB0[1]; _Pragma("unroll") for(int r=2;r<16;++r)sacc+=pB0[r]; _Pragma("unroll") for(int r=0;r<16;++r)sacc+=pB1[r]; l_reg+=sacc;
    pw0=(u32x4){PKW(pB0,0),PKW(pB0,2),PKW(pB0,4),PKW(pB0,6)};pw1=(u32x4){PKW(pB0,8),PKW(pB0,10),PKW(pB0,12),PKW(pB0,14)};pw2=(u32x4){PKW(pB1,0),PKW(pB1,2),PKW(pB1,4),PKW(pB1,6)};pw3=(u32x4){PKW(pB1,8),PKW(pB1,10),PKW(pB1,12),PKW(pB1,14)};
    SBAR(); pv(o,vb0+sl_cur,PAF(0),PAF(1),PAF(2),PAF(3)); }
  #undef PKW
  #undef PAF
  #undef VFR
  #undef PIN
  #undef MX3
  #undef GAPA
  #undef GAPB
  #undef EX
  #undef VRD
  #undef KRD
  #undef STEP
  #undef ENDW
  {auto rr=__builtin_amdgcn_permlane32_swap(__float_as_uint(l_reg),__float_as_uint(l_reg),false,false);l_reg=__uint_as_float(rr[0])+__uint_as_float(rr[1]);}
  if(hi==0)wsf[32+r32]=l_reg;asm volatile("s_waitcnt lgkmcnt(0)":::"memory");
  float rli[16];
  #pragma unroll
  for(int r=0;r<16;++r)rli[r]=__builtin_amdgcn_rcpf(wsf[32+crow(r,hi)]);
  bf16*Ow=O+(rowbase+q0+wid*QBLK)*PO+ocol;
  { bf16*stg=(bf16*)(shm+LDS_OST)+wid*2048;
    #pragma unroll
    for(int r=0;r<16;++r){const int orow=crow(r,hi);
      #pragma unroll
      for(int d0=0;d0<2;++d0)stg[orow*64+d0*32+r32]=__float2bfloat16(o[d0][r]*rli[r]);}
    asm volatile("s_waitcnt lgkmcnt(0)":::"memory");
    #pragma unroll
    for(int i=0;i<4;++i){const int row=i*8+(lane>>3),ch=lane&7; const u32x4 v=*(const u32x4*)(stg+row*64+ch*8); ATTN_STORE16(Ow+(long)row*PO+ch*8,v);} }
  asm volatile("s_waitcnt lgkmcnt(0)\n\ts_barrier":::"memory");
  #undef DMA_K
  #undef DMA_V
  #undef CMASK
  #undef START
  #undef RESC
  #undef ROT
}
constexpr int ATTN_LDS_BYTES=LDS_BYTES;
struct AttnTensors { const bf16* Q; const bf16* K; const bf16* V; bf16* O; };
struct AttnUnit { int bj; int qb; };
struct StaticOrder {
  int vcu;
  __device__ __forceinline__ explicit StaticOrder(int grid,int block):vcu((block%8)*(grid/8)+block/8){}
  __device__ __forceinline__ bool next(int i,AttnUnit&u)const{ if(i>=4)return false; const int s0=2*(vcu&1); u.bj=vcu>>1; u.qb=(i==0)?s0:(i==1)?7-s0:(i==2)?s0+1:6-s0; return true; }
};
template<class Sched,int THRL=8> __device__ __forceinline__ void attn_phase(char*lds,const AttnTensors&T,const Sched&S){
  AttnUnit u;
  for(int i=0;S.next(i,u);++i){ const int b=u.bj>>4,j=u.bj&15,h=j>>2,c=(j>>1)&1,vh=j&1;
    attn_unit<THRL>(b,h*128+c*64,512+h*128+c*64,1024+h*128+vh*64,j*64,u.qb,T.Q,T.K,T.V,T.O,lds); }
}
#undef SBAR
#undef WAIT_BAR
}
constexpr int NWAVES = 8;
constexpr int NB = 8, SEQ = 2048, T = NB * SEQ, D = 1024, DEPTH = 2;
constexpr int NPROJ = 4352, NGATE = 4096, NIN = 8448;
constexpr float EPS = 1e-6f;
constexpr float C2 = 0.125f * 1.4426950408889634f;
constexpr float LOG2E = 1.4426950408889634f;
constexpr int C_AQ = 0, C_AK = 512, C_AV = 1024, C_BB = 1536, C_BC = 2048, C_BX = 2560, C_CZ = 3072, C_DQ = 3584, C_DK = 4096, C_DV = 4224;
enum { I_X = 0, I_C, I_WADA, I_BADA, I_GN1, I_WIN, I_LQ1, I_LK1, I_LQ2, I_LK2, I_GSUB, I_CONVW, I_WPOOL, I_PSCALE, I_SINKS, I_WBR, I_WO, I_GN2, I_WQ, I_SK, I_UE, I_VE, I_GFIN, N_IN };

constexpr size_t MiB = 1u << 20;
constexpr size_t WS_CTL = 0, CTL_ZERO_BYTES = 1 * MiB;
constexpr size_t WS_MOD = 1 * MiB;
constexpr size_t WS_W = 2 * MiB, W_LAYER = 27 * MiB;
constexpr size_t W_WIN = 0, W_WBR = 16 * MiB + MiB / 2, W_WO = W_WBR + 4 * MiB, W_WQ = W_WO + 2 * MiB, W_SK = W_WQ + 4 * MiB, W_WP = W_SK + 65536;
constexpr size_t WS_H = 56 * MiB;
constexpr size_t WS_PROJ = 88 * MiB;
constexpr size_t WS_S32 = WS_PROJ;
constexpr size_t WS_Q2 = WS_PROJ;
#ifndef DBG_ROUTE32
#define DBG_ROUTE32 0
#endif
#if DBG_ROUTE32
constexpr size_t WS_H3 = WS_PROJ;
constexpr size_t WS_Q32 = 224 * MiB;
constexpr size_t WS_IDX = 416 * MiB, WS_WTS = WS_IDX + 8 * MiB;
#else
constexpr size_t WS_IDX = WS_PROJ + 64 * MiB, WS_WTS = WS_IDX + 8 * MiB;
#endif
constexpr size_t WS_GATES = 224 * MiB;
constexpr size_t WS_Y = 352 * MiB;
constexpr size_t WS_X1B = WS_Y;
#ifndef EXP_I8
#define EXP_I8 1
#endif
#define EXP_I8_OWN (EXP_I8 && !DBG_ROUTE32)
#if DBG_ROUTE32
constexpr size_t WS_UE = WS_PROJ, WS_VE = WS_PROJ + 32 * MiB;
constexpr size_t WS_WQ3 = WS_Y;
#else
#if EXP_I8_OWN
constexpr size_t WS_UE = 448 * MiB, WS_VE = 464 * MiB;
#else
constexpr size_t WS_UE = WS_GATES, WS_VE = WS_GATES + 32 * MiB;
#endif
#endif
constexpr size_t WS_US = 480 * MiB, WS_VS = WS_US + 65536;
constexpr size_t WS_O = 416 * MiB;
#ifndef NORM_FOLD
#define NORM_FOLD (!DBG_ROUTE32)
#ifndef EPI_HOIST
#define EPI_HOIST 1
#endif
#ifndef H2C_HOIST
#define H2C_HOIST 1
#endif
#ifndef X1_PREFETCH
#define X1_PREFETCH 1
#endif
#ifndef V_ABID
#define V_ABID 1
#endif
#ifndef ROUTE_SORTNET
#define ROUTE_SORTNET 1
#endif
#ifndef H_PLANES
#define H_PLANES 1
#endif
#ifndef TREE_BANKMASK
#define TREE_BANKMASK 1
#endif
#ifndef ROUTE_BATCH
#define ROUTE_BATCH 4
#endif
#ifndef ROW_OFFS
#define ROW_OFFS 1
#endif
#ifndef DMA_NOMASK
#define DMA_NOMASK 1
#endif
#ifndef ROW_PIPE
#define ROW_PIPE 1
#endif
#ifndef EXP6B
#define EXP6B 1
#endif
#ifndef V_PLANES
#define V_PLANES 1
#endif
constexpr unsigned EROW = EXP6B ? 768u : 1024u;
#ifndef V_MFMA
#define V_MFMA 1
#endif
#endif
constexpr size_t WS_SSQ = 481 * MiB;
constexpr size_t WS_CQ = WS_MOD + 512 * 1024;
constexpr size_t WS_END = (EXP_I8_OWN || NORM_FOLD) ? 482 * MiB : 448 * MiB;
constexpr int CW_PEERQ = 8192;
#ifndef PEER_DYNAMIC
#define PEER_DYNAMIC 0
#endif
constexpr int CW_BAR = 4096;

constexpr int RING_OFF = 0, RING_BYTES = 131072;
constexpr int LDSCTL_OFF = RING_BYTES, MISC_OFF = LDSCTL_OFF + 320;
constexpr int HAND_OFF = LDSCTL_OFF + 1024;
constexpr int LDS_BYTES = HAND_OFF + 8 * 3072;

#define GAS __attribute__((address_space(1)))
#define LAS __attribute__((address_space(3)))
typedef unsigned short bf16;
typedef unsigned v4u __attribute__((ext_vector_type(4)));
typedef unsigned v2u __attribute__((ext_vector_type(2)));
typedef float f32x4 __attribute__((ext_vector_type(4)));
typedef GAS unsigned gu32;
#define LDS_WAIT() asm volatile("s_waitcnt lgkmcnt(0)" ::: "memory")
__device__ __forceinline__ unsigned f2bf(float f) { unsigned u = __builtin_bit_cast(unsigned, f); return (u + 0x7fffu + ((u >> 16) & 1u)) >> 16; }
__device__ __forceinline__ unsigned pk2(float lo, float hi) { return f2bf(lo) | (f2bf(hi) << 16); }
__device__ __forceinline__ float bflo(unsigned w) { return __builtin_bit_cast(float, w << 16); }
__device__ __forceinline__ float bfhi(unsigned w) { return __builtin_bit_cast(float, w & 0xffff0000u); }
__device__ __forceinline__ float bf1(bf16 h) { return __builtin_bit_cast(float, (unsigned)h << 16); }

#define XB_TMO      128
#define XB_XCNT(j)  (256  + 64 * (j))
#define XB_XSUB(j)  (1280 + 64 * (j))
#define XB_XGEN(j)  (2304 + 64 * (j))
#define XB_TOP      3328
#define XB_TOPGEN   3392
#define XCD_BAR_WORDS 3456
#define XB_SPIN_CAP (1u << 18)
__device__ __forceinline__ unsigned xb_ld(unsigned* p)              { return __hip_atomic_load(p, __ATOMIC_RELAXED, __HIP_MEMORY_SCOPE_AGENT); }
__device__ __forceinline__ unsigned xb_add(unsigned* p, unsigned v) { return __hip_atomic_fetch_add(p, v, __ATOMIC_RELAXED, __HIP_MEMORY_SCOPE_AGENT); }
__device__ __forceinline__ unsigned xb_xcc_id() { return (unsigned)__builtin_amdgcn_s_getreg((3 << 11) | 20) & 0xFu; }
#define XB_SPIN(cond, bar) do { unsigned _sp = 0; while (cond) { __builtin_amdgcn_s_sleep(1); \
    if ((++_sp & 255u) == 0u) { if (xb_ld(&(bar)[XB_TMO])) break; if (_sp > XB_SPIN_CAP) { atomicAdd(&(bar)[XB_TMO], 1u); break; } } } } while (0)
struct XcdBarrier { unsigned* bar; unsigned x; volatile LAS unsigned* st; };
__device__ __forceinline__ XcdBarrier xcd_barrier_post(unsigned* bar, volatile LAS unsigned* st) {
    XcdBarrier b; b.bar = bar; b.x = xb_xcc_id(); b.st = st;
    if (threadIdx.x == 0) (void)xb_add(&bar[XB_XCNT(b.x)], 1u);
    return b;
}
__device__ __forceinline__ void xcd_barrier_complete(unsigned* bar, unsigned x, unsigned& nloc, unsigned& nx) {
    const unsigned G = gridDim.x * gridDim.y * gridDim.z;
    unsigned sum, cnt, mine, sp = 0u;
    for (;;) {
        sum = 0u; cnt = 0u; mine = 0u;
#pragma unroll
        for (unsigned j = 0; j < 16; ++j) { const unsigned c = xb_ld(&bar[XB_XCNT(j)]); sum += c; cnt += (c > 0u) ? 1u : 0u; mine = (j == x) ? c : mine; }
        if (sum == G) break;
        __builtin_amdgcn_s_sleep(1);
        if ((++sp & 255u) == 0u) { if (xb_ld(&bar[XB_TMO])) break; if (sp > XB_SPIN_CAP) { atomicAdd(&bar[XB_TMO], 1u); break; } }
    }
    nloc = mine > 0u ? mine : 1u; nx = cnt > 0u ? cnt : 1u;
}
__device__ __forceinline__ void xcd_barrier(const XcdBarrier& b) {
    asm volatile("s_waitcnt vmcnt(0)" ::: "memory");
    __syncthreads();
    if (threadIdx.x == 0) {
        unsigned* bar = b.bar;
        __builtin_amdgcn_s_waitcnt(0);
        unsigned nloc = b.st[0], nx = b.st[1];
        if (nloc == 0u) { xcd_barrier_complete(bar, b.x, nloc, nx); b.st[0] = nloc; b.st[1] = nx; }
        const unsigned old = xb_add(&bar[XB_XSUB(b.x)], 1u);
        const unsigned gen = old / nloc;
        if (old + 1u == (gen + 1u) * nloc) {
            __builtin_amdgcn_fence(__ATOMIC_RELEASE, "agent");
            asm volatile("s_waitcnt vmcnt(0)" ::: "memory");
            const unsigned og = xb_add(&bar[XB_TOP], 1u);
            const unsigned tg = og / nx;
            if (og + 1u == (tg + 1u) * nx) xb_add(&bar[XB_TOPGEN], 1u);
            else XB_SPIN(xb_ld(&bar[XB_TOPGEN]) == tg, bar);
            __builtin_amdgcn_fence(__ATOMIC_ACQUIRE, "agent");
            xb_add(&bar[XB_XGEN(b.x)], 1u);
            asm volatile("s_waitcnt vmcnt(0)" ::: "memory");
        } else {
            XB_SPIN(xb_ld(&bar[XB_XGEN(b.x)]) == gen, bar);
            __builtin_amdgcn_fence(__ATOMIC_ACQUIRE, "agent");
            asm volatile("s_waitcnt vmcnt(0)" ::: "memory");
        }
    }
    __syncthreads();
}

__device__ __forceinline__ float rdlane(float v, int l) { return __builtin_bit_cast(float, __builtin_amdgcn_readlane(__builtin_bit_cast(int, v), l)); }
__device__ __forceinline__ int rdlanei(int v, int l) { return __builtin_amdgcn_readlane(v, l); }
template <int CTRL> __device__ __forceinline__ float dppf(float v) { return __builtin_bit_cast(float, __builtin_amdgcn_mov_dpp(__builtin_bit_cast(int, v), CTRL, 0xF, 0xF, true)); }
template <int CTRL> __device__ __forceinline__ int dppi(int v) { return __builtin_amdgcn_mov_dpp(v, CTRL, 0xF, 0xF, true); }
__device__ __forceinline__ float wave_sum(float v) {
    v += dppf<0xB1>(v); v += dppf<0x4E>(v); v += dppf<0x124>(v); v += dppf<0x128>(v);
    return (rdlane(v, 0) + rdlane(v, 16)) + (rdlane(v, 32) + rdlane(v, 48));
}
__device__ __forceinline__ int wave_sumi(int v) {
    v += dppi<0xB1>(v); v += dppi<0x4E>(v); v += dppi<0x124>(v); v += dppi<0x128>(v);
    return (rdlanei(v, 0) + rdlanei(v, 16)) + (rdlanei(v, 32) + rdlanei(v, 48));
}
__device__ __forceinline__ float wave_max(float v) {
    v = fmaxf(v, dppf<0xB1>(v)); v = fmaxf(v, dppf<0x4E>(v)); v = fmaxf(v, dppf<0x124>(v)); v = fmaxf(v, dppf<0x128>(v));
    return fmaxf(fmaxf(rdlane(v, 0), rdlane(v, 16)), fmaxf(rdlane(v, 32), rdlane(v, 48)));
}

struct Ctx {
    LAS unsigned char* lds;
    int tid, lane, wave, vcu, G, gw, NGW;
};
struct Args { const float* in[N_IN]; float* out; unsigned char* ws; int ph_lo, ph_hi; };
typedef const __attribute__((address_space(4))) Args& KArgs;

template <bool GPERM = false> __device__ __forceinline__ void p0_transpose_item(const float* W, int K, int N, bf16* WT, LAS float* scr, int item, int lane, float scale) {
    const int nblk = N / 32, kb = item / nblk, nb = item % nblk, k0 = 64 * kb, n0 = 32 * nb;
#pragma unroll 8
    for (int i = 0; i < 32; ++i) { const int kk = 2 * i + (lane >> 5); scr[kk * 33 + (lane & 31)] = W[(size_t)(k0 + kk) * N + n0 + (lane & 31)] * scale; }
    LDS_WAIT(); asm volatile("" ::: "memory");
    const int c = lane & 7;
#pragma unroll
    for (int j = 0; j < 4; ++j) { const int n = (lane >> 3) + 8 * j; const LAS float* s = scr + (8 * c) * 33 + n;
        v4u o; o.x = pk2(s[0 * 33], s[1 * 33]); o.y = pk2(s[2 * 33], s[3 * 33]); o.z = pk2(s[4 * 33], s[5 * 33]); o.w = pk2(s[6 * 33], s[7 * 33]);
        int nr = n0 + n; if (GPERM && nr >= 4352) { const int z = (nr - 4352) >> 10, cc = (nr - 4352) & 1023, ch = cc & 63; nr = 4352 + 256 * (cc >> 6) + 64 * (ch >> 4) + 32 * (z >> 1) + 8 * ((ch >> 2) & 3) + 4 * (z & 1) + (ch & 3); }
        *(GAS v4u*)(WT + (size_t)nr * K + k0 + 8 * c) = o; }
    LDS_WAIT(); asm volatile("" ::: "memory");
}

__device__ __forceinline__ void norm_mod_row(int lane, const float* xrow, const float* g, const float* scale, const float* shift, bf16* orow) {
    const f32x4* xr = (const f32x4*)xrow + lane;
    f32x4 v[4]; float s = 0.f;
#pragma unroll
    for (int j = 0; j < 4; ++j) { v[j] = xr[64 * j]; s += (v[j].x * v[j].x + v[j].y * v[j].y) + (v[j].z * v[j].z + v[j].w * v[j].w); }
    const float r = 1.0f / sqrtf(wave_sum(s) * (1.0f / D) + EPS);
    unsigned long long* o8 = (unsigned long long*)orow + lane;
#pragma unroll
    for (int j = 0; j < 4; ++j) {
        const f32x4 gg = ((const f32x4*)g)[lane + 64 * j], sc = ((const f32x4*)scale)[lane + 64 * j], sh = ((const f32x4*)shift)[lane + 64 * j];
        const f32x4 y = (v[j] * r) * gg * (sc + 1.0f) + sh;
        o8[64 * j] = (unsigned long long)pk2(y.x, y.y) | ((unsigned long long)pk2(y.z, y.w) << 32);
    }
}

__device__ __forceinline__ void phase_pre(const Ctx& F, KArgs A) {
    float* mod = (float*)(A.ws + WS_MOD);
    for (int it = F.gw; it < DEPTH * 768; it += F.NGW) {
        const int l = it / 768, j0 = (it % 768) * 8;
        float acc[8][8];
#pragma unroll
        for (int b = 0; b < 8; ++b)
#pragma unroll
            for (int j = 0; j < 8; ++j) acc[b][j] = 0.f;
        for (int i = 0; i < 16; ++i) {
            const int k = F.lane + 64 * i;
            const float* wp = A.in[I_WADA] + ((size_t)l * D + k) * 6144 + j0;
            const f32x4 w0 = *(const f32x4*)wp, w1 = *(const f32x4*)(wp + 4);
#pragma unroll
            for (int b = 0; b < 8; ++b) { const float cv = A.in[I_C][b * D + k]; const float s = cv / (1.0f + __expf(-cv));
                acc[b][0] += s * w0.x; acc[b][1] += s * w0.y; acc[b][2] += s * w0.z; acc[b][3] += s * w0.w;
                acc[b][4] += s * w1.x; acc[b][5] += s * w1.y; acc[b][6] += s * w1.z; acc[b][7] += s * w1.w; }
        }
#pragma unroll
        for (int b = 0; b < 8; ++b) {
            float r[8];
#pragma unroll
            for (int j = 0; j < 8; ++j) r[j] = wave_sum(acc[b][j]);
            if (F.lane == 0) { const float* bp = A.in[I_BADA] + (size_t)l * 6144 + j0; float* mp = mod + ((size_t)l * 8 + b) * 6144 + j0;
                *(f32x4*)mp = (f32x4){r[0] + bp[0], r[1] + bp[1], r[2] + bp[2], r[3] + bp[3]}; *(f32x4*)(mp + 4) = (f32x4){r[4] + bp[4], r[5] + bp[5], r[6] + bp[6], r[7] + bp[7]}; }
        }
    }
    LAS float* scr = (LAS float*)(F.lds + RING_OFF + F.wave * 16384);
    constexpr int I_IN = 16 * 264, I_BR = 8 * 32, I_O = 16 * 32, I_Q = 16 * 64, I_P = 2 * 4;
    constexpr int PER_LAYER = I_IN + 4 * I_BR + I_O + I_Q + 4 * I_P;
    for (int it = F.gw; it < DEPTH * PER_LAYER; it += F.NGW) {
        const int l = it / PER_LAYER; int r = it % PER_LAYER;
        unsigned char* wl = A.ws + WS_W + (size_t)l * W_LAYER;
        if (r < I_IN) { const int n0 = 32 * (r % 264); const float sc = (n0 < 512 || (n0 >= C_DQ && n0 < C_DK)) ? C2 : 1.0f;
            p0_transpose_item<true>(A.in[I_WIN] + (size_t)l * D * NIN, D, NIN, (bf16*)(wl + W_WIN), scr, r, F.lane, sc); continue; }
        r -= I_IN;
        if (r < 4 * I_BR) { const int g = r / I_BR; p0_transpose_item(A.in[I_WBR] + ((size_t)l * 4 + g) * 512 * D, 512, D, (bf16*)(wl + W_WBR) + (size_t)g * D * 512, scr, r % I_BR, F.lane, 1.0f); continue; }
        r -= 4 * I_BR;
        if (r < I_O) { p0_transpose_item(A.in[I_WO] + (size_t)l * D * D, D, D, (bf16*)(wl + W_WO), scr, r, F.lane, 1.0f); continue; }
        r -= I_O;
        if (r < I_Q) { p0_transpose_item(A.in[I_WQ] + (size_t)l * D * 2048, D, 2048, (bf16*)(wl + W_WQ), scr, r, F.lane, 1.0f); continue; }
        r -= I_Q;
        { const int g = r / I_P; p0_transpose_item(A.in[I_WPOOL] + ((size_t)l * 4 + g) * 128 * 128, 128, 128, (bf16*)(wl + W_WP) + (size_t)g * 128 * 128, scr, r % I_P, F.lane, 1.0f); }
    }
    for (int i = F.gw * 64 + F.lane; i < DEPTH * 32768 / 4; i += F.NGW * 64) {
        const int l = i / 8192, e = (i % 8192) * 4;
        const f32x4 v = *(const f32x4*)(A.in[I_SK] + (size_t)l * 32768 + e);
        v2u o; o.x = pk2(v.x, v.y); o.y = pk2(v.z, v.w);
        *(v2u*)((bf16*)(A.ws + WS_W + (size_t)l * W_LAYER + W_SK) + e) = o;
    }
}
__device__ __forceinline__ void phase_h0(const Ctx& F, KArgs A) {
    const float* mod = (const float*)(A.ws + WS_MOD);
#if NORM_FOLD
    {
        float* cq = (float*)(A.ws + WS_CQ);
        for (int it = F.gw; it < DEPTH * 256; it += F.NGW) {
            const int l = it / 256, j0 = (it % 256) * 8;
            float acc[8][8];
#pragma unroll
            for (int b = 0; b < 8; ++b)
#pragma unroll
                for (int j = 0; j < 8; ++j) acc[b][j] = 0.f;
            for (int i = 0; i < 16; ++i) {
                const int k = F.lane + 64 * i;
                const float* wp = A.in[I_WQ] + ((size_t)l * D + k) * 2048 + j0;
                const f32x4 w0 = *(const f32x4*)wp, w1 = *(const f32x4*)(wp + 4);
#pragma unroll
                for (int b = 0; b < 8; ++b) { const float s = mod[((size_t)l * 8 + b) * 6144 + 3072 + k];
                    acc[b][0] += s * w0.x; acc[b][1] += s * w0.y; acc[b][2] += s * w0.z; acc[b][3] += s * w0.w;
                    acc[b][4] += s * w1.x; acc[b][5] += s * w1.y; acc[b][6] += s * w1.z; acc[b][7] += s * w1.w; }
            }
#pragma unroll
            for (int b = 0; b < 8; ++b) {
                float r[8];
#pragma unroll
                for (int j = 0; j < 8; ++j) r[j] = wave_sum(acc[b][j]);
                if (F.lane == 0) { float* cp = cq + ((size_t)l * 8 + b) * 2048 + j0; *(f32x4*)cp = (f32x4){r[0], r[1], r[2], r[3]}; *(f32x4*)(cp + 4) = (f32x4){r[4], r[5], r[6], r[7]}; }
            }
        }
    }
#endif
    bf16* H = (bf16*)(A.ws + WS_H);
    for (int m = F.gw; m < T; m += F.NGW) { const float* mb = mod + (size_t)(m >> 11) * 6144;
        norm_mod_row(F.lane, A.in[I_X] + (size_t)m * D, A.in[I_GN1], mb + 1024, mb, H + (size_t)m * D); }
}
__device__ __forceinline__ void phase_swa_naive(const Ctx& F, KArgs A, int l) {
    const bf16* P = (const bf16*)(A.ws + WS_PROJ); bf16* Y = (bf16*)(A.ws + WS_Y);
    const float* sinks = A.in[I_SINKS] + l * 8;
    for (int it = F.gw; it < T * 8; it += F.NGW) {
        const int t = it >> 3, hq = it & 7, g = hq >> 2, pos = t & (SEQ - 1);
        float q[64];
        { const v4u* qp = (const v4u*)(P + (size_t)t * NPROJ + C_DQ + hq * 64);
#pragma unroll
          for (int i = 0; i < 8; ++i) { const v4u w = qp[i]; q[8 * i] = bflo(w.x); q[8 * i + 1] = bfhi(w.x); q[8 * i + 2] = bflo(w.y); q[8 * i + 3] = bfhi(w.y); q[8 * i + 4] = bflo(w.z); q[8 * i + 5] = bfhi(w.z); q[8 * i + 6] = bflo(w.w); q[8 * i + 7] = bfhi(w.w); } }
        float s[2];
#pragma unroll
        for (int j = 0; j < 2; ++j) { const int kk = F.lane + 64 * j; float a = -1e30f;
            if (pos - kk >= 0) { const v4u* kp = (const v4u*)(P + (size_t)(t - kk) * NPROJ + C_DK + g * 64); a = 0.f;
#pragma unroll
                for (int i = 0; i < 8; ++i) { const v4u w = kp[i]; a += q[8 * i] * bflo(w.x) + q[8 * i + 1] * bfhi(w.x) + q[8 * i + 2] * bflo(w.y) + q[8 * i + 3] * bfhi(w.y) + q[8 * i + 4] * bflo(w.z) + q[8 * i + 5] * bfhi(w.z) + q[8 * i + 6] * bflo(w.w) + q[8 * i + 7] * bfhi(w.w); } }
            s[j] = a; }
        const float sk2 = sinks[hq] * LOG2E;
        const float mx = fmaxf(wave_max(fmaxf(s[0], s[1])), sk2);
        const float p0 = (pos - F.lane >= 0) ? exp2f(s[0] - mx) : 0.f, p1 = (pos - F.lane - 64 >= 0) ? exp2f(s[1] - mx) : 0.f;
        const float den = wave_sum(p0 + p1) + exp2f(sk2 - mx);
        float acc = 0.f;
        const int nk = (pos + 1 < 128) ? pos + 1 : 128;
        const bf16* vp = P + (size_t)t * NPROJ + C_DV + g * 64 + F.lane;
        for (int kk = 0; kk < nk; ++kk) { const float pk = (kk < 64) ? rdlane(p0, kk) : rdlane(p1, kk - 64); acc += pk * bf1(vp[-(long)kk * NPROJ]); }
        Y[(size_t)t * 2048 + 1536 + hq * 64 + F.lane] = (bf16)f2bf(acc / den);
    }
}
__device__ __forceinline__ void phase_conv_naive(const Ctx& F, KArgs A, int l) {
    const bf16* P = (const bf16*)(A.ws + WS_PROJ); bf16* Y = (bf16*)(A.ws + WS_Y);
    const float* cw = A.in[I_CONVW] + (size_t)l * 3 * 512;
    for (int it = F.gw * 64 + F.lane; it < (T / 4) * 64; it += F.NGW * 64) {
        const int t0 = (it >> 6) * 4, c0 = (it & 63) * 8; const bool first = (t0 & (SEQ - 1)) == 0;
        v4u za[6], zb[6], gb[4];
#pragma unroll
        for (int r = 0; r < 6; ++r) { const int row = (first && r < 2) ? t0 : t0 - 2 + r; za[r] = *(const v4u*)(P + (size_t)row * NPROJ + C_BC + c0); zb[r] = *(const v4u*)(P + (size_t)row * NPROJ + C_BX + c0); }
#pragma unroll
        for (int k = 0; k < 4; ++k) gb[k] = *(const v4u*)(P + (size_t)(t0 + k) * NPROJ + C_BB + c0);
        const f32x4 w00 = *(const f32x4*)(cw + c0), w01 = *(const f32x4*)(cw + c0 + 4), w10 = *(const f32x4*)(cw + 512 + c0), w11 = *(const f32x4*)(cw + 512 + c0 + 4), w20 = *(const f32x4*)(cw + 1024 + c0), w21 = *(const f32x4*)(cw + 1024 + c0 + 4);
        float z[6][8];
#pragma unroll
        for (int r = 0; r < 6; ++r) { const float m = (first && r < 2) ? 0.f : 1.f; const v4u a = za[r], b = zb[r];
            z[r][0] = m * bflo(a.x) * bflo(b.x); z[r][1] = m * bfhi(a.x) * bfhi(b.x); z[r][2] = m * bflo(a.y) * bflo(b.y); z[r][3] = m * bfhi(a.y) * bfhi(b.y);
            z[r][4] = m * bflo(a.z) * bflo(b.z); z[r][5] = m * bfhi(a.z) * bfhi(b.z); z[r][6] = m * bflo(a.w) * bflo(b.w); z[r][7] = m * bfhi(a.w) * bfhi(b.w); }
#pragma unroll
        for (int k = 0; k < 4; ++k) { const v4u g = gb[k];
            const float bb[8] = {bflo(g.x), bfhi(g.x), bflo(g.y), bfhi(g.y), bflo(g.z), bfhi(g.z), bflo(g.w), bfhi(g.w)};
            float y[8];
#pragma unroll
            for (int e = 0; e < 4; ++e) { y[e] = bb[e] * (w00[e] * z[k][e] + w10[e] * z[k + 1][e] + w20[e] * z[k + 2][e]); y[4 + e] = bb[4 + e] * (w01[e] * z[k][4 + e] + w11[e] * z[k + 1][4 + e] + w21[e] * z[k + 2][4 + e]); }
            v4u o; o.x = pk2(y[0], y[1]); o.y = pk2(y[2], y[3]); o.z = pk2(y[4], y[5]); o.w = pk2(y[6], y[7]);
            *(v4u*)(Y + (size_t)(t0 + k) * 2048 + 512 + c0) = o; }
    }
}
__device__ __forceinline__ void phase_pool_naive(const Ctx& F, KArgs A, int l) {
    const bf16* P = (const bf16*)(A.ws + WS_PROJ); bf16* Y = (bf16*)(A.ws + WS_Y);
    for (int it = F.gw; it < T * 4; it += F.NGW) {
        const int t = it >> 2, g = it & 3, w = 2 << g, pos = t & (SEQ - 1), cnt = (pos + 1 < w) ? pos + 1 : w;
        float d[2];
#pragma unroll
        for (int j = 0; j < 2; ++j) { const bf16* zp = P + (size_t)t * NPROJ + C_CZ + g * 128 + F.lane + 64 * j; float s = 0.f;
            for (int i = 0; i < cnt; ++i) s += bf1(zp[-(long)i * NPROJ]);
            d[j] = s / (float)cnt - bf1(zp[0]); }
        const float* wp = A.in[I_WPOOL] + ((size_t)l * 4 + g) * 128 * 128;
        float y0 = 0.f, y1 = 0.f;
        for (int c = 0; c < 64; ++c) { const float dc = rdlane(d[0], c); y0 += dc * wp[c * 128 + F.lane]; y1 += dc * wp[c * 128 + 64 + F.lane]; }
        for (int c = 0; c < 64; ++c) { const float dc = rdlane(d[1], c); y0 += dc * wp[(64 + c) * 128 + F.lane]; y1 += dc * wp[(64 + c) * 128 + 64 + F.lane]; }
        const float* ps = A.in[I_PSCALE] + (size_t)l * 512 + g * 128;
        Y[(size_t)t * 2048 + 1024 + g * 128 + F.lane] = (bf16)f2bf(y0 * ps[F.lane]);
        Y[(size_t)t * 2048 + 1024 + g * 128 + 64 + F.lane] = (bf16)f2bf(y1 * ps[64 + F.lane]);
    }
}
typedef float f32x16s __attribute__((ext_vector_type(16)));
typedef short bf16x8s __attribute__((ext_vector_type(8)));
__device__ __forceinline__ void phase_swa(const Ctx& F, KArgs A, int l) {
    const bf16* P = (const bf16*)(A.ws + WS_PROJ); bf16* Y = (bf16*)(A.ws + WS_Y);
    const float* sinks = A.in[I_SINKS] + l * 8;
    const int qi = F.lane & 31, kh = F.lane >> 5;
    for (int u = F.gw; u < (T / 32) * 8; u += F.NGW) {
        const int tq = u >> 3, hq = u & 7, g = hq >> 2, t0 = tq * 32, p0 = t0 & (SEQ - 1);
        bf16x8s qf[4];
        { const bf16* qp = P + (size_t)(t0 + qi) * NPROJ + C_DQ + hq * 64 + 8 * kh;
#pragma unroll
          for (int s = 0; s < 4; ++s) qf[s] = *(const bf16x8s*)(qp + 16 * s); }
        f32x16s acc[5];
#pragma unroll
        for (int kt = 0; kt < 5; ++kt) {
            int kr = t0 - 128 + 32 * kt + qi; if (p0 - 128 + 32 * kt + qi < 0) kr = t0;
            const bf16* kp = P + (size_t)kr * NPROJ + C_DK + g * 64 + 8 * kh;
            f32x16s c = (f32x16s){0.f, 0.f, 0.f, 0.f, 0.f, 0.f, 0.f, 0.f, 0.f, 0.f, 0.f, 0.f, 0.f, 0.f, 0.f, 0.f};
#pragma unroll
            for (int s = 0; s < 4; ++s) c = __builtin_amdgcn_mfma_f32_32x32x16_bf16(*(const bf16x8s*)(kp + 16 * s), qf[s], c, 0, 0, 0);
            acc[kt] = c;
        }
        const float sk2 = sinks[hq] * LOG2E;
        float m = sk2;
#pragma unroll
        for (int kt = 0; kt < 5; ++kt)
#pragma unroll
            for (int r = 0; r < 16; ++r) { const int koff = (r & 3) + 8 * (r >> 2) + 4 * kh, rel = qi + 128 - 32 * kt - koff;
                const bool valid = (rel >= 0) && (rel < 128) && (p0 - 128 + 32 * kt + koff >= 0);
                acc[kt][r] = valid ? acc[kt][r] : -1e30f; m = fmaxf(m, acc[kt][r]); }
        m = fmaxf(m, __shfl_xor(m, 32));
        float ls = 0.f;
#pragma unroll
        for (int kt = 0; kt < 5; ++kt)
#pragma unroll
            for (int r = 0; r < 16; ++r) { const float pv = exp2f(acc[kt][r] - m); acc[kt][r] = pv; ls += pv; }
        ls += __shfl_xor(ls, 32); ls += exp2f(sk2 - m);
        f32x16s o[2];
        o[0] = (f32x16s){0.f, 0.f, 0.f, 0.f, 0.f, 0.f, 0.f, 0.f, 0.f, 0.f, 0.f, 0.f, 0.f, 0.f, 0.f, 0.f}; o[1] = o[0];
#pragma unroll
        for (int kt = 0; kt < 5; ++kt)
#pragma unroll
            for (int s2 = 0; s2 < 2; ++s2) {
                v4u bw; bw.x = pk2(acc[kt][8 * s2 + 0], acc[kt][8 * s2 + 1]); bw.y = pk2(acc[kt][8 * s2 + 2], acc[kt][8 * s2 + 3]); bw.z = pk2(acc[kt][8 * s2 + 4], acc[kt][8 * s2 + 5]); bw.w = pk2(acc[kt][8 * s2 + 6], acc[kt][8 * s2 + 7]);
                const bf16x8s bfr = __builtin_bit_cast(bf16x8s, bw);
                int vr0 = t0 - 128 + 32 * kt + 16 * s2 + 4 * kh; const bool pre = (p0 - 128 + 32 * kt + 16 * s2 + 4 * kh < 0);
                int vr1 = vr0 + 8; const bool pre1 = (p0 - 128 + 32 * kt + 16 * s2 + 4 * kh + 8 < 0);
                if (pre) vr0 = t0; if (pre1) vr1 = t0;
#pragma unroll
                for (int mt = 0; mt < 2; ++mt) {
                    const bf16* v0 = P + (size_t)vr0 * NPROJ + C_DV + g * 64 + 32 * mt + qi; const bf16* v1 = P + (size_t)vr1 * NPROJ + C_DV + g * 64 + 32 * mt + qi;
                    v4u aw; aw.x = (unsigned)v0[0] | ((unsigned)v0[NPROJ] << 16); aw.y = (unsigned)v0[2 * NPROJ] | ((unsigned)v0[3 * NPROJ] << 16);
                    aw.z = (unsigned)v1[0] | ((unsigned)v1[NPROJ] << 16); aw.w = (unsigned)v1[2 * NPROJ] | ((unsigned)v1[3 * NPROJ] << 16);
                    o[mt] = __builtin_amdgcn_mfma_f32_32x32x16_bf16(__builtin_bit_cast(bf16x8s, aw), bfr, o[mt], 0, 0, 0);
                }
            }
        const float rl = 1.0f / ls;
        bf16* yp = Y + (size_t)(t0 + qi) * 2048 + 1536 + hq * 64 + 4 * kh;
#pragma unroll
        for (int mt = 0; mt < 2; ++mt)
#pragma unroll
            for (int q = 0; q < 4; ++q) { v2u w; w.x = pk2(o[mt][4 * q] * rl, o[mt][4 * q + 1] * rl); w.y = pk2(o[mt][4 * q + 2] * rl, o[mt][4 * q + 3] * rl);
                *(v2u*)(yp + 32 * mt + 8 * q) = w; }
    }
}
typedef short s16x4s __attribute__((ext_vector_type(4)));
__device__ __forceinline__ void phase_swa2(const Ctx& F, KArgs A, int l) {
    const bf16* P = (const bf16*)(A.ws + WS_PROJ); bf16* Y = (bf16*)(A.ws + WS_Y);
    const float* sinks = A.in[I_SINKS] + l * 8;
    constexpr int RS = 272, VOFF = 160 * RS;
    LAS unsigned char* kb = F.lds + RING_OFF; LAS unsigned char* vb = kb + VOFF;
    const int qi = F.lane & 31, kh = F.lane >> 5, hq = F.wave, g = hq >> 2;
    for (int tq = F.vcu; tq < T / 32; tq += F.G) {
        const int t0 = tq * 32, p0 = t0 & (SEQ - 1);
        __syncthreads();
#pragma unroll
        for (int c = 0; c < 5; ++c) { const int chunk = F.tid + 512 * c, row = chunk >> 4, ch = chunk & 15;
            const int gr = (p0 - 128 + row < 0) ? t0 : t0 - 128 + row;
            const v4u kv = *(const v4u*)(P + (size_t)gr * NPROJ + C_DK + ch * 8), vv = *(const v4u*)(P + (size_t)gr * NPROJ + C_DV + ch * 8);
            *(LAS v4u*)(kb + row * RS + ch * 16) = kv; *(LAS v4u*)(vb + row * RS + ch * 16) = vv; }
        bf16x8s qf[4];
        { const bf16* qp = P + (size_t)(t0 + qi) * NPROJ + C_DQ + hq * 64 + 8 * kh;
#pragma unroll
          for (int s = 0; s < 4; ++s) qf[s] = *(const bf16x8s*)(qp + 16 * s); }
        __syncthreads();
        f32x16s acc[5];
#pragma unroll
        for (int kt = 0; kt < 5; ++kt) {
            const LAS unsigned char* kp = kb + (32 * kt + qi) * RS + g * 128 + 16 * kh;
            f32x16s c = (f32x16s){0.f, 0.f, 0.f, 0.f, 0.f, 0.f, 0.f, 0.f, 0.f, 0.f, 0.f, 0.f, 0.f, 0.f, 0.f, 0.f};
#pragma unroll
            for (int s = 0; s < 4; ++s) c = __builtin_amdgcn_mfma_f32_32x32x16_bf16(*(const LAS bf16x8s*)(kp + 32 * s), qf[s], c, 0, 0, 0);
            acc[kt] = c;
        }
        const float sk2 = sinks[hq] * LOG2E;
        float m = sk2;
#pragma unroll
        for (int kt = 0; kt < 5; ++kt)
#pragma unroll
            for (int r = 0; r < 16; ++r) { const int koff = (r & 3) + 8 * (r >> 2) + 4 * kh, rel = qi + 128 - 32 * kt - koff;
                const bool valid = (rel >= 0) && (rel < 128) && (p0 - 128 + 32 * kt + koff >= 0);
                acc[kt][r] = valid ? acc[kt][r] : -1e30f; m = fmaxf(m, acc[kt][r]); }
        m = fmaxf(m, __shfl_xor(m, 32));
        float ls = 0.f;
#pragma unroll
        for (int kt = 0; kt < 5; ++kt)
#pragma unroll
            for (int r = 0; r < 16; ++r) { const float pv = exp2f(acc[kt][r] - m); acc[kt][r] = pv; ls += pv; }
        ls += __shfl_xor(ls, 32); ls += exp2f(sk2 - m);
        f32x16s o[2];
        o[0] = (f32x16s){0.f, 0.f, 0.f, 0.f, 0.f, 0.f, 0.f, 0.f, 0.f, 0.f, 0.f, 0.f, 0.f, 0.f, 0.f, 0.f}; o[1] = o[0];
        const LAS unsigned char* vl = vb + (4 * kh + ((F.lane & 15) >> 2)) * RS + (g * 64 + 16 * ((F.lane >> 4) & 1) + 4 * (F.lane & 3)) * 2;
#pragma unroll
        for (int kt = 0; kt < 5; ++kt)
#pragma unroll
            for (int s2 = 0; s2 < 2; ++s2) {
                v4u bw; bw.x = pk2(acc[kt][8 * s2 + 0], acc[kt][8 * s2 + 1]); bw.y = pk2(acc[kt][8 * s2 + 2], acc[kt][8 * s2 + 3]); bw.z = pk2(acc[kt][8 * s2 + 4], acc[kt][8 * s2 + 5]); bw.w = pk2(acc[kt][8 * s2 + 6], acc[kt][8 * s2 + 7]);
                const bf16x8s bfr = __builtin_bit_cast(bf16x8s, bw);
#pragma unroll
                for (int mt = 0; mt < 2; ++mt) {
                    const LAS unsigned char* va = vl + (32 * kt + 16 * s2) * RS + 64 * mt;
                    const s16x4s lo = __builtin_bit_cast(s16x4s, __builtin_amdgcn_ds_read_tr16_b64_v4i16((LAS s16x4s*)va));
                    const s16x4s hi = __builtin_bit_cast(s16x4s, __builtin_amdgcn_ds_read_tr16_b64_v4i16((LAS s16x4s*)(va + 8 * RS)));
                    const bf16x8s afr = (bf16x8s){lo[0], lo[1], lo[2], lo[3], hi[0], hi[1], hi[2], hi[3]};
                    o[mt] = __builtin_amdgcn_mfma_f32_32x32x16_bf16(afr, bfr, o[mt], 0, 0, 0);
                }
            }
        const float rl = 1.0f / ls;
        bf16* yp = Y + (size_t)(t0 + qi) * 2048 + 1536 + hq * 64 + 4 * kh;
#pragma unroll
        for (int mt = 0; mt < 2; ++mt)
#pragma unroll
            for (int q = 0; q < 4; ++q) { v2u w; w.x = pk2(o[mt][4 * q] * rl, o[mt][4 * q + 1] * rl); w.y = pk2(o[mt][4 * q + 2] * rl, o[mt][4 * q + 3] * rl);
                *(v2u*)(yp + 32 * mt + 8 * q) = w; }
    }
    __syncthreads();
}
__device__ __forceinline__ void phase_pool(const Ctx& F, KArgs A, int l) {
    const bf16* P = (const bf16*)(A.ws + WS_PROJ); bf16* Y = (bf16*)(A.ws + WS_Y);
    const bf16* WP = (const bf16*)(A.ws + WS_W + (size_t)l * W_LAYER + W_WP);
    const int ti = F.lane & 31, kh = F.lane >> 5;
    for (int u = F.gw; u < (T / 32) * 4; u += F.NGW) {
        const int tq = u >> 2, g = u & 3, w = 2 << g, t = tq * 32 + ti, pos = t & (SEQ - 1), cnt = (pos + 1 < w) ? pos + 1 : w;
        const float rc = 1.0f / (float)cnt;
        f32x16s acc[4];
#pragma unroll
        for (int mt = 0; mt < 4; ++mt) acc[mt] = (f32x16s){0.f, 0.f, 0.f, 0.f, 0.f, 0.f, 0.f, 0.f, 0.f, 0.f, 0.f, 0.f, 0.f, 0.f, 0.f, 0.f};
        for (int s = 0; s < 8; ++s) {
            const bf16* zp = P + (size_t)t * NPROJ + C_CZ + g * 128 + 16 * s + 8 * kh;
            float sum[8];
#pragma unroll
            for (int e = 0; e < 8; ++e) sum[e] = 0.f;
            auto win = [&](auto WC) { constexpr int W = decltype(WC)::value; v4u zw[W];
#pragma unroll
                for (int i = 0; i < W; ++i) zw[i] = *(const v4u*)(zp - (size_t)((i < cnt) ? i : 0) * NPROJ);
#pragma unroll
                for (int i = 0; i < W; ++i) { const float m = (i < cnt) ? 1.0f : 0.0f;
                    sum[0] += m * bflo(zw[i].x); sum[1] += m * bfhi(zw[i].x); sum[2] += m * bflo(zw[i].y); sum[3] += m * bfhi(zw[i].y); sum[4] += m * bflo(zw[i].z); sum[5] += m * bfhi(zw[i].z); sum[6] += m * bflo(zw[i].w); sum[7] += m * bfhi(zw[i].w); } };
            if (g == 0) win(std::integral_constant<int, 2>{}); else if (g == 1) win(std::integral_constant<int, 4>{}); else if (g == 2) win(std::integral_constant<int, 8>{}); else win(std::integral_constant<int, 16>{});
            bf16x8s afr[4];
#pragma unroll
            for (int mt = 0; mt < 4; ++mt) afr[mt] = *(const bf16x8s*)(WP + ((size_t)g * 128 + 32 * mt + ti) * 128 + 16 * s + 8 * kh);
            const v4u z0 = *(const v4u*)zp;
            v4u dw; dw.x = pk2(sum[0] * rc - bflo(z0.x), sum[1] * rc - bfhi(z0.x)); dw.y = pk2(sum[2] * rc - bflo(z0.y), sum[3] * rc - bfhi(z0.y));
            dw.z = pk2(sum[4] * rc - bflo(z0.z), sum[5] * rc - bfhi(z0.z)); dw.w = pk2(sum[6] * rc - bflo(z0.w), sum[7] * rc - bfhi(z0.w));
            const bf16x8s bfr = __builtin_bit_cast(bf16x8s, dw);
            asm volatile("" : "+v"(afr[0]), "+v"(afr[1]), "+v"(afr[2]), "+v"(afr[3]));
#pragma unroll
            for (int mt = 0; mt < 4; ++mt) acc[mt] = __builtin_amdgcn_mfma_f32_32x32x16_bf16(afr[mt], bfr, acc[mt], 0, 0, 0);
        }
        const float* ps = A.in[I_PSCALE] + (size_t)l * 512 + g * 128;
        bf16* yp = Y + (size_t)t * 2048 + 1024 + g * 128 + 4 * kh;
#pragma unroll
        for (int hb = 0; hb < 2; ++hb) {
            f32x4 scv[8];
#pragma unroll
            for (int i = 0; i < 8; ++i) scv[i] = *(const f32x4*)(ps + 32 * (2 * hb + (i >> 2)) + 8 * (i & 3) + 4 * kh);
#pragma unroll
            for (int m2 = 0; m2 < 2; ++m2)
#pragma unroll
                for (int q = 0; q < 4; ++q) { const int mt = 2 * hb + m2; const f32x4 sc = scv[4 * m2 + q];
                    v2u wv; wv.x = pk2(acc[mt][4 * q] * sc.x, acc[mt][4 * q + 1] * sc.y); wv.y = pk2(acc[mt][4 * q + 2] * sc.z, acc[mt][4 * q + 3] * sc.w);
                    *(v2u*)(yp + 32 * mt + 8 * q) = wv; } }
    }
}
__device__ __forceinline__ void phase_ya(const Ctx& F, KArgs A, int l) {
    const bf16* O = (const bf16*)(A.ws + WS_O); bf16* Y = (bf16*)(A.ws + WS_Y);
    const float lam_init = (l == 0) ? 0.2f : (0.8f - 0.6f * 0.7408182206817179f);
    const float d1 = wave_sum(A.in[I_LQ1][l * 64 + F.lane] * A.in[I_LK1][l * 64 + F.lane]);
    const float d2 = wave_sum(A.in[I_LQ2][l * 64 + F.lane] * A.in[I_LK2][l * 64 + F.lane]);
    const float lam = expf(d1) - expf(d2) + lam_init;
    const int sub = F.lane & 15, grp = F.lane >> 4;
    float gs[8];
#pragma unroll
    for (int e = 0; e < 8; ++e) gs[e] = A.in[I_GSUB][l * 128 + 8 * sub + e] * (1.0f - lam_init);
    static_assert(T % (4 * 256 * NWAVES) == 0, "phase_ya: 4 tokens per trip");
    for (int it0 = F.gw; it0 < T; it0 += 4 * F.NGW) {
        v4u av[4], bv[4];
#pragma unroll
        for (int j = 0; j < 4; ++j) { const int t = it0 + j * F.NGW; av[j] = *(const v4u*)(O + (size_t)t * 1024 + grp * 256 + 8 * sub); bv[j] = *(const v4u*)(O + (size_t)t * 1024 + grp * 256 + 128 + 8 * sub); }
#pragma unroll
      for (int j = 0; j < 4; ++j) {
        const int t = it0 + j * F.NGW, h = grp; const v4u a = av[j], b = bv[j];
        float y[8] = {bflo(a.x) - lam * bflo(b.x), bfhi(a.x) - lam * bfhi(b.x), bflo(a.y) - lam * bflo(b.y), bfhi(a.y) - lam * bfhi(b.y), bflo(a.z) - lam * bflo(b.z), bfhi(a.z) - lam * bfhi(b.z), bflo(a.w) - lam * bflo(b.w), bfhi(a.w) - lam * bfhi(b.w)};
        float ss = 0.f;
#pragma unroll
        for (int e = 0; e < 8; ++e) ss += y[e] * y[e];
        ss += __shfl_xor(ss, 1); ss += __shfl_xor(ss, 2); ss += __shfl_xor(ss, 4); ss += __shfl_xor(ss, 8);
        const float r = 1.0f / sqrtf(ss * (1.0f / 128.0f) + EPS);
        v4u o; o.x = pk2(y[0] * r * gs[0], y[1] * r * gs[1]); o.y = pk2(y[2] * r * gs[2], y[3] * r * gs[3]); o.z = pk2(y[4] * r * gs[4], y[5] * r * gs[5]); o.w = pk2(y[6] * r * gs[6], y[7] * r * gs[7]);
        *(v4u*)(Y + (size_t)t * 2048 + h * 128 + 8 * sub) = o;
      }
    }
}
__device__ __forceinline__ void expert_quant(KArgs A, int l, int lane, int w, int nw) {
    const float* ue = A.in[I_UE] + (size_t)l * 16384 * 1024; const float* ve = A.in[I_VE] + (size_t)l * 16384 * 1024;
    for (int r = w; r < 2 * 16384; r += nw) {
        const bool isv = r >= 16384; const int row = isv ? r - 16384 : r; const float* src = (isv ? ve : ue) + (size_t)row * 1024 + 8 * lane;
        const f32x4 a0 = *(const f32x4*)src, a1 = *(const f32x4*)(src + 4), b0 = *(const f32x4*)(src + 512), b1 = *(const f32x4*)(src + 516);
        float am = 0.f;
#pragma unroll
        for (int e = 0; e < 4; ++e) am = fmaxf(fmaxf(am, fmaxf(fabsf(a0[e]), fabsf(a1[e]))), fmaxf(fabsf(b0[e]), fabsf(b1[e])));
        am = wave_max(am);
#if EXP6B
        { const float inv6 = am > 0.f ? 31.0f / am : 0.f; unsigned X0 = 0, X1 = 0, Y = 0;
#pragma unroll
          for (int i = 0; i < 4; ++i) {
              const unsigned u0 = (unsigned)((int)rintf(a0[i] * inv6) + 32), u2 = (unsigned)((int)rintf(b0[i] * inv6) + 32);
              const unsigned s1 = (unsigned)(int)rintf(a1[i] * inv6) & 63u, s3 = (unsigned)(int)rintf(b1[i] * inv6) & 63u;
              X0 |= ((u0 & 15u) | ((s1 >> 2) << 4)) << (8 * i); X1 |= ((u2 & 15u) | ((s3 >> 2) << 4)) << (8 * i);
              Y |= (((u0 >> 4) << 4) | ((s1 & 3u) << 2) | ((u2 >> 4) << 6) | (s3 & 3u)) << (8 * i); }
          unsigned char* dst = A.ws + (isv ? WS_VE : WS_UE) + (size_t)row * 768;
          *(unsigned long long*)(dst + 8 * lane) = (unsigned long long)X0 | ((unsigned long long)X1 << 32); *(unsigned*)(dst + 512 + 4 * lane) = Y;
          if (lane == 0) ((float*)(A.ws + (isv ? WS_VS : WS_US)))[row] = am * (1.0f / 31.0f);
          continue; }
#endif
        const float inv = am > 0.f ? 127.0f / am : 0.f; const int bias = (isv && !V_MFMA) ? 128 : 0;
        unsigned o[4];
#pragma unroll
        for (int wd = 0; wd < 4; ++wd) { const f32x4 v = wd == 0 ? a0 : wd == 1 ? a1 : wd == 2 ? b0 : b1; unsigned x = 0;
#pragma unroll
            for (int e = 0; e < 4; ++e) x |= ((unsigned)((int)rintf(v[e] * inv) + bias) & 255u) << (8 * e);
            o[wd] = x; }
        *(v4u*)(A.ws + (isv ? WS_VE : WS_UE) + (size_t)row * 1024 + 16 * lane) = (v4u){o[0], o[1], o[2], o[3]};
        if (lane == 0) ((float*)(A.ws + (isv ? WS_VS : WS_US)))[row] = am * (1.0f / 127.0f);
    }
}
__device__ __forceinline__ void phase_h2(const Ctx& F, KArgs A, int l) {
    const float* mod = (const float*)(A.ws + WS_MOD) + (size_t)l * 8 * 6144;
    bf16* H = (bf16*)(A.ws + WS_H);
    for (int m = F.gw; m < T; m += F.NGW) { const float* mb = mod + (size_t)(m >> 11) * 6144;
        norm_mod_row(F.lane, A.out + (size_t)m * D, A.in[I_GN2] + (size_t)l * D, mb + 4096, mb + 3072, H + (size_t)m * D); }
#if DBG_ROUTE32
    {
        bf16* H3 = (bf16*)(A.ws + WS_H3);
        for (int m = F.gw; m < T; m += F.NGW) { const float* mb = mod + (size_t)(m >> 11) * 6144;
            const f32x4* xr = (const f32x4*)(A.out + (size_t)m * D) + F.lane; f32x4 v[4]; float s = 0.f;
#pragma unroll
            for (int j = 0; j < 4; ++j) { v[j] = xr[64 * j]; s += (v[j].x * v[j].x + v[j].y * v[j].y) + (v[j].z * v[j].z + v[j].w * v[j].w); }
            const float r = 1.0f / sqrtf(wave_sum(s) * (1.0f / D) + EPS);
#pragma unroll
            for (int j = 0; j < 4; ++j) {
                const f32x4 gg = ((const f32x4*)(A.in[I_GN2] + (size_t)l * D))[F.lane + 64 * j], sc = ((const f32x4*)(mb + 4096))[F.lane + 64 * j], sh = ((const f32x4*)(mb + 3072))[F.lane + 64 * j];
                const f32x4 y = (v[j] * r) * gg * (sc + 1.0f) + sh;
                unsigned hi[4], lo[4];
#pragma unroll
                for (int e = 0; e < 4; ++e) { hi[e] = f2bf(y[e]); lo[e] = f2bf(y[e] - __builtin_bit_cast(float, hi[e] << 16)); }
                const unsigned long long hw = (unsigned long long)(hi[0] | (hi[1] << 16)) | ((unsigned long long)(hi[2] | (hi[3] << 16)) << 32);
                const unsigned long long lw = (unsigned long long)(lo[0] | (lo[1] << 16)) | ((unsigned long long)(lo[2] | (lo[3] << 16)) << 32);
                unsigned long long* o8 = (unsigned long long*)(H3 + (size_t)m * 3072) + F.lane + 64 * j;
                o8[0] = hw; o8[256] = hw; o8[512] = lw;
            } }
        bf16* W3 = (bf16*)(A.ws + WS_WQ3); const float* W = A.in[I_WQ] + (size_t)l * D * 2048;
        for (size_t i = (size_t)F.gw * 64 + F.lane; i < (size_t)2048 * 1024; i += (size_t)F.NGW * 64) { const int n = (int)(i >> 10), k = (int)(i & 1023);
            const float w = W[(size_t)k * 2048 + n]; const unsigned hi = f2bf(w), lo = f2bf(w - __builtin_bit_cast(float, hi << 16));
            W3[(size_t)n * 3072 + k] = (bf16)hi; W3[(size_t)n * 3072 + 1024 + k] = (bf16)lo; W3[(size_t)n * 3072 + 2048 + k] = (bf16)hi; }
    }
}
__device__ __forceinline__ void phase_expert_convert(const Ctx& F, KArgs A, int l) {
#else
#endif
    const float* ue = A.in[I_UE] + (size_t)l * 16384 * 1024; const float* ve = A.in[I_VE] + (size_t)l * 16384 * 1024;
#if EXP_I8_OWN
    return;
#endif
    bf16* UE = (bf16*)(A.ws + WS_UE); bf16* VE = (bf16*)(A.ws + WS_VE);
    for (size_t i = (size_t)F.gw * 64 + F.lane; i < (size_t)2 * 16384 * 1024 / 8; i += (size_t)F.NGW * 64) {
        const bool isv = i >= (size_t)16384 * 1024 / 8; const size_t e = (isv ? i - (size_t)16384 * 1024 / 8 : i) * 8;
        const float* src = (isv ? ve : ue) + e; const f32x4 a = *(const f32x4*)src, b = *(const f32x4*)(src + 4);
        v4u o; o.x = pk2(a.x, a.y); o.y = pk2(a.z, a.w); o.z = pk2(b.x, b.y); o.w = pk2(b.z, b.w);
        *(v4u*)((isv ? VE : UE) + e) = o;
    }
}
__device__ __forceinline__ void phase_route_naive(const Ctx& F, KArgs A, int l) {
#if DBG_ROUTE32
    const float* Q32 = (const float*)(A.ws + WS_Q32); const float* SKF = A.in[I_SK] + (size_t)l * 32768;
#else
    const bf16* Q2 = (const bf16*)(A.ws + WS_Q2); const bf16* SK = (const bf16*)(A.ws + WS_W + (size_t)l * W_LAYER + W_SK);
#endif
    int* IDX = (int*)(A.ws + WS_IDX); float* WTS = (float*)(A.ws + WS_WTS);
    for (int it = F.gw; it < T * 8; it += F.NGW) {
        const int t = it >> 3, hh = it & 7;
        float ts[2]; int ti[2];
#pragma unroll
        for (int p = 0; p < 2; ++p) {
#if DBG_ROUTE32
            const float* qp = Q32 + (size_t)t * 2048 + hh * 256 + p * 128;
            const float* ka = SKF + ((size_t)p * 128 + F.lane) * 128; const float* kb = ka + 64 * 128;
            float sa = 0.f, sb = 0.f;
            for (int i = 0; i < 32; ++i) { const f32x4 qv = *(const f32x4*)(qp + 4 * i), av = *(const f32x4*)(ka + 4 * i), bv = *(const f32x4*)(kb + 4 * i);
                sa += qv.x * av.x + qv.y * av.y + qv.z * av.z + qv.w * av.w; sb += qv.x * bv.x + qv.y * bv.y + qv.z * bv.z + qv.w * bv.w; }
#else
            const bf16* qp = Q2 + (size_t)t * 2048 + hh * 256 + p * 128;
            const bf16* ka = SK + ((size_t)p * 128 + F.lane) * 128; const bf16* kb = ka + 64 * 128;
            float sa = 0.f, sb = 0.f;
            for (int i = 0; i < 16; ++i) { const v4u qw = *(const v4u*)(qp + 8 * i), aw = *(const v4u*)(ka + 8 * i), bw = *(const v4u*)(kb + 8 * i);
                sa += bflo(qw.x) * bflo(aw.x) + bfhi(qw.x) * bfhi(aw.x) + bflo(qw.y) * bflo(aw.y) + bfhi(qw.y) * bfhi(aw.y) + bflo(qw.z) * bflo(aw.z) + bfhi(qw.z) * bfhi(aw.z) + bflo(qw.w) * bflo(aw.w) + bfhi(qw.w) * bfhi(aw.w);
                sb += bflo(qw.x) * bflo(bw.x) + bfhi(qw.x) * bfhi(bw.x) + bflo(qw.y) * bflo(bw.y) + bfhi(qw.y) * bfhi(bw.y) + bflo(qw.z) * bflo(bw.z) + bfhi(qw.z) * bfhi(bw.z) + bflo(qw.w) * bflo(bw.w) + bfhi(qw.w) * bfhi(bw.w); }
#endif
            float tsv = 0.f; int tiv = 0;
            for (int r = 0; r < 16; ++r) {
                const float m = wave_max(fmaxf(sa, sb));
                const unsigned long long ba = __ballot(sa == m), bb = __ballot(sb == m);
                int idx;
                if (ba) { const int ln = __ffsll((long long)ba) - 1; idx = ln; if (F.lane == ln) sa = -3.0e38f; }
                else { const int ln = __ffsll((long long)bb) - 1; idx = 64 + ln; if (F.lane == ln) sb = -3.0e38f; }
                if (F.lane == r) { tsv = m; tiv = idx; }
            }
            ts[p] = tsv; ti[p] = tiv;
        }
        float cv[4];
#pragma unroll
        for (int k = 0; k < 4; ++k) cv[k] = __shfl(ts[0], (F.lane >> 4) + 4 * k) + __shfl(ts[1], F.lane & 15);
        float bs = 0.f; int bid = 0;
        for (int r = 0; r < 16; ++r) {
            const float m = wave_max(fmaxf(fmaxf(cv[0], cv[1]), fmaxf(cv[2], cv[3])));
            int id = -1;
#pragma unroll
            for (int k = 0; k < 4; ++k) { const unsigned long long bk = __ballot(cv[k] == m);
                if (id < 0 && bk) { const int ln = __ffsll((long long)bk) - 1; id = ln + 64 * k; if (F.lane == ln) cv[k] = -3.0e38f; } }
            if (F.lane == r) { bs = m; bid = id; }
        }
        const int ei = __shfl(ti[0], bid >> 4) * 128 + __shfl(ti[1], bid & 15);
        const float m0 = __shfl(bs, 0);
        const float e = (F.lane < 16) ? expf(bs - m0) : 0.f;
        const float den = wave_sum(e);
        if (F.lane < 16) { IDX[(size_t)t * 128 + hh * 16 + F.lane] = ei; WTS[(size_t)t * 128 + hh * 16 + F.lane] = e / den; }
    }
}
typedef float f32x16r __attribute__((ext_vector_type(16)));
typedef short bf16x8r __attribute__((ext_vector_type(8)));
__device__ __forceinline__ unsigned srt_key(float f) { const unsigned u = __builtin_bit_cast(unsigned, f); return u ^ ((unsigned)((int)u >> 31) | 0x80000000u); }
__device__ __forceinline__ float srt_val(unsigned k) { const unsigned u = (k & 0x80000000u) ? (k ^ 0x80000000u) : ~k; return __builtin_bit_cast(float, u); }
#define INS16(L, x) do { unsigned x_ = (x); _Pragma("unroll") for (int k_ = 0; k_ < 16; ++k_) { const unsigned h_ = L[k_] > x_ ? L[k_] : x_; x_ = L[k_] > x_ ? x_ : L[k_]; L[k_] = h_; } } while (0)
#if ROUTE_SORTNET
#define CE_(a, b) do { const unsigned h_ = (a) > (b) ? (a) : (b); (b) = (a) > (b) ? (b) : (a); (a) = h_; } while (0)
__device__ __forceinline__ void sort16_desc(unsigned (&v)[16]) { CE_(v[0], v[1]); CE_(v[2], v[3]); CE_(v[0], v[2]); CE_(v[1], v[3]); CE_(v[1], v[2]); CE_(v[4], v[5]); CE_(v[6], v[7]); CE_(v[4], v[6]); CE_(v[5], v[7]); CE_(v[5], v[6]); CE_(v[0], v[4]); CE_(v[2], v[6]); CE_(v[2], v[4]); CE_(v[1], v[5]); CE_(v[3], v[7]); CE_(v[3], v[5]); CE_(v[1], v[2]); CE_(v[3], v[4]); CE_(v[5], v[6]); CE_(v[8], v[9]); CE_(v[10], v[11]); CE_(v[8], v[10]); CE_(v[9], v[11]); CE_(v[9], v[10]); CE_(v[12], v[13]); CE_(v[14], v[15]); CE_(v[12], v[14]); CE_(v[13], v[15]); CE_(v[13], v[14]); CE_(v[8], v[12]); CE_(v[10], v[14]); CE_(v[10], v[12]); CE_(v[9], v[13]); CE_(v[11], v[15]); CE_(v[11], v[13]); CE_(v[9], v[10]); CE_(v[11], v[12]); CE_(v[13], v[14]); CE_(v[0], v[8]); CE_(v[4], v[12]); CE_(v[4], v[8]); CE_(v[2], v[10]); CE_(v[6], v[14]); CE_(v[6], v[10]); CE_(v[2], v[4]); CE_(v[6], v[8]); CE_(v[10], v[12]); CE_(v[1], v[9]); CE_(v[5], v[13]); CE_(v[5], v[9]); CE_(v[3], v[11]); CE_(v[7], v[15]); CE_(v[7], v[11]); CE_(v[3], v[5]); CE_(v[7], v[9]); CE_(v[11], v[13]); CE_(v[1], v[2]); CE_(v[3], v[4]); CE_(v[5], v[6]); CE_(v[7], v[8]); CE_(v[9], v[10]); CE_(v[11], v[12]); CE_(v[13], v[14]); }
__device__ __forceinline__ void merge16_top(unsigned (&R)[16], const unsigned (&C)[16]) {
#pragma unroll
    for (int i = 0; i < 16; ++i) R[i] = R[i] > C[15 - i] ? R[i] : C[15 - i];
    CE_(R[0], R[8]); CE_(R[1], R[9]); CE_(R[2], R[10]); CE_(R[3], R[11]); CE_(R[4], R[12]); CE_(R[5], R[13]); CE_(R[6], R[14]); CE_(R[7], R[15]); CE_(R[0], R[4]); CE_(R[1], R[5]); CE_(R[2], R[6]); CE_(R[3], R[7]); CE_(R[8], R[12]); CE_(R[9], R[13]); CE_(R[10], R[14]); CE_(R[11], R[15]); CE_(R[0], R[2]); CE_(R[1], R[3]); CE_(R[4], R[6]); CE_(R[5], R[7]); CE_(R[8], R[10]); CE_(R[9], R[11]); CE_(R[12], R[14]); CE_(R[13], R[15]); CE_(R[0], R[1]); CE_(R[2], R[3]); CE_(R[4], R[5]); CE_(R[6], R[7]); CE_(R[8], R[9]); CE_(R[10], R[11]); CE_(R[12], R[13]); CE_(R[14], R[15]); }
#endif
__device__ __forceinline__ void route_top16(unsigned (&tk)[16], const bf16* qrow, const GAS bf16* skp, int lane) {
    f32x16r acc[4];
#pragma unroll
    for (int mt = 0; mt < 4; ++mt) acc[mt] = (f32x16r){0.f, 0.f, 0.f, 0.f, 0.f, 0.f, 0.f, 0.f, 0.f, 0.f, 0.f, 0.f, 0.f, 0.f, 0.f, 0.f};
#if ROUTE_BATCH
#pragma unroll
    for (int s0 = 0; s0 < 8; s0 += ROUTE_BATCH) { bf16x8r bq[ROUTE_BATCH], a[ROUTE_BATCH][4];
#pragma unroll
        for (int i = 0; i < ROUTE_BATCH; ++i) { bq[i] = *(const bf16x8r*)(qrow + 16 * (s0 + i));
#pragma unroll
            for (int mt = 0; mt < 4; ++mt) a[i][mt] = *(const GAS bf16x8r*)(skp + (size_t)mt * 32 * 128 + 16 * (s0 + i)); }
#pragma unroll
        for (int i = 0; i < ROUTE_BATCH; ++i) asm volatile("" : "+v"(bq[i]), "+v"(a[i][0]), "+v"(a[i][1]), "+v"(a[i][2]), "+v"(a[i][3]));
#pragma unroll
        for (int i = 0; i < ROUTE_BATCH; ++i)
#pragma unroll
            for (int mt = 0; mt < 4; ++mt) acc[mt] = __builtin_amdgcn_mfma_f32_32x32x16_bf16(a[i][mt], bq[i], acc[mt], 0, 0, 0); }
#else
#pragma unroll
    for (int s = 0; s < 8; ++s) { const bf16x8r bq = *(const bf16x8r*)(qrow + 16 * s);
#pragma unroll
        for (int mt = 0; mt < 4; ++mt) { const bf16x8r a = *(const GAS bf16x8r*)(skp + (size_t)mt * 32 * 128 + 16 * s);
            acc[mt] = __builtin_amdgcn_mfma_f32_32x32x16_bf16(a, bq, acc[mt], 0, 0, 0); } }
#endif
    const unsigned lowb = (lane & 32) ? 0u : 4u;
#if ROUTE_SORTNET
#pragma unroll
    for (int mt = 0; mt < 4; ++mt) { unsigned c[16];
#pragma unroll
        for (int r = 0; r < 16; ++r) { const unsigned idx0 = 32u * mt + (r & 3) + 8u * (r >> 2);
            c[r] = (srt_key(acc[mt][r]) & ~127u) | ((127u - idx0) & ~4u) | lowb; }
        sort16_desc(c);
        if (mt == 0) {
#pragma unroll
            for (int k = 0; k < 16; ++k) tk[k] = c[k]; }
        else merge16_top(tk, c); }
    unsigned pk[16];
#pragma unroll
    for (int k = 0; k < 16; ++k) pk[k] = (unsigned)__shfl_xor((int)tk[k], 32);
    merge16_top(tk, pk);
}
#else
#pragma unroll
    for (int k = 0; k < 16; ++k) tk[k] = 0u;
#pragma unroll
    for (int mt = 0; mt < 4; ++mt)
#pragma unroll
        for (int r = 0; r < 16; ++r) { const unsigned idx0 = 32u * mt + (r & 3) + 8u * (r >> 2);
            const unsigned key = (srt_key(acc[mt][r]) & ~127u) | ((127u - idx0) & ~4u) | lowb; INS16(tk, key); }
    unsigned pk[16];
#pragma unroll
    for (int k = 0; k < 16; ++k) pk[k] = (unsigned)__shfl_xor((int)tk[k], 32);
#pragma unroll
    for (int k = 0; k < 16; ++k) INS16(tk, pk[k]);
}
#endif
template <class IP, class WP> __device__ __forceinline__ void route_unit(const Ctx& F, KArgs A, int l, int u, LAS unsigned char* scr, IP IDX, WP WTS, int tbase) {
    const bf16* Q2 = (const bf16*)(A.ws + WS_Q2); const bf16* SK = (const bf16*)(A.ws + WS_W + (size_t)l * W_LAYER + W_SK);
    asm volatile("" : "+s"(SK));
    const int row = F.lane & 31, kh = F.lane >> 5;
    {
        const int t = 4 * u + (row >> 3), hh = row & 7;
        unsigned tk0[16], tk1[16];
        const GAS bf16* SKg = (const GAS bf16*)SK;
        route_top16(tk0, Q2 + (size_t)t * 2048 + hh * 256 + 8 * kh, SKg + (size_t)row * 128 + 8 * kh, F.lane);
        route_top16(tk1, Q2 + (size_t)t * 2048 + hh * 256 + 128 + 8 * kh, SKg + 128 * 128 + (size_t)row * 128 + 8 * kh, F.lane);
        float s0[16], s1[16];
#pragma unroll
        for (int k = 0; k < 16; ++k) { s0[k] = srt_val(tk0[k] & ~127u); s1[k] = srt_val(tk1[k] & ~127u); }
        LAS unsigned* sw = (LAS unsigned*)(scr + F.lane * 36);
#pragma unroll
        for (int k = 0; k < 4; ++k) {
            sw[k] = (127u - (tk0[4 * k] & 127u)) | ((127u - (tk0[4 * k + 1] & 127u)) << 8) | ((127u - (tk0[4 * k + 2] & 127u)) << 16) | ((127u - (tk0[4 * k + 3] & 127u)) << 24);
            sw[4 + k] = (127u - (tk1[4 * k] & 127u)) | ((127u - (tk1[4 * k + 1] & 127u)) << 8) | ((127u - (tk1[4 * k + 2] & 127u)) << 16) | ((127u - (tk1[4 * k + 3] & 127u)) << 24); }
        unsigned bk[16];
#if ROUTE_SORTNET
#define PKEY_(i, j) ((srt_key(s0[i] + s1[j]) & ~255u) | (255u - (unsigned)((i) * 16 + (j))))
        {
            unsigned c[16];
#pragma unroll
            for (int j = 0; j < 16; ++j) bk[j] = PKEY_(0, j);
#pragma unroll
            for (int i = 1; i < 16; ++i) c[i - 1] = PKEY_(i, 0);
            c[15] = 0u;
            merge16_top(bk, c);
            int n = 0;
#pragma unroll
            for (int i = 1; i < 8; ++i)
#pragma unroll
                for (int j = 1; j < 8; ++j) if ((i + 1) * (j + 1) <= 16) { const unsigned key = PKEY_(i, j); if (n < 16) c[n] = key; else INS16(bk, key); ++n; }
            sort16_desc(c);
            merge16_top(bk, c);
        }
#undef PKEY_
#else
#pragma unroll
        for (int k = 0; k < 16; ++k) bk[k] = 0u;
#pragma unroll
        for (int i = 0; i < 16; ++i)
#pragma unroll
            for (int j = 0; j < 16; ++j) if ((i + 1) * (j + 1) <= 16) { const unsigned key = (srt_key(s0[i] + s1[j]) & ~255u) | (255u - (unsigned)(i * 16 + j)); INS16(bk, key); }
#endif
        LDS_WAIT();
        const LAS unsigned char* sb = (const LAS unsigned char*)(scr + F.lane * 36);
        int ei[16]; float wv[16]; float den = 0.f; const float m0 = srt_val(bk[0] & ~255u);
#pragma unroll
        for (int r = 0; r < 16; ++r) { const unsigned ij = 255u - (bk[r] & 255u); ei[r] = (int)sb[ij >> 4] * 128 + (int)sb[16 + (ij & 15)];
            wv[r] = __expf(srt_val(bk[r] & ~255u) - m0); den += wv[r]; }
        const float rden = 1.0f / den;
        if (kh == 0) {
#pragma unroll
            for (int r = 0; r < 16; ++r) IDX[(size_t)(t - tbase) * 128 + hh * 16 + r] = ei[r]; }
        else {
#pragma unroll
            for (int r = 0; r < 16; ++r) WTS[(size_t)(t - tbase) * 128 + hh * 16 + r] = wv[r] * rden; }
        LDS_WAIT();
    }
}
__device__ __forceinline__ void phase_route(const Ctx& F, KArgs A, int l) {
    LAS unsigned char* scr = F.lds + RING_OFF + F.wave * 4096;
    for (int u = F.gw; u < T / 4; u += F.NGW) route_unit(F, A, l, u, scr, (int*)(A.ws + WS_IDX), (float*)(A.ws + WS_WTS), 0);
}
#ifndef PROBE_U_VALU
#define PROBE_U_VALU 0
#endif
#ifndef PROBE_EXP_REP
#define PROBE_EXP_REP 1
#endif
typedef __bf16 bf16x2_t __attribute__((ext_vector_type(2)));
__device__ __forceinline__ float dot2bf(unsigned a, unsigned b, float c) { return __builtin_amdgcn_fdot2_f32_bf16(__builtin_bit_cast(bf16x2_t, a), __builtin_bit_cast(bf16x2_t, b), c, false); }
template <int XM> __device__ __forceinline__ float lane_xchg(float v) {
    const int x = __builtin_bit_cast(int, v);
    if constexpr (XM == 1) return __builtin_bit_cast(float, __builtin_amdgcn_mov_dpp(x, 0xB1, 0xF, 0xF, true));
    else if constexpr (XM == 2) return __builtin_bit_cast(float, __builtin_amdgcn_mov_dpp(x, 0x4E, 0xF, 0xF, true));
    else if constexpr (XM == 4) return __builtin_bit_cast(float, __builtin_amdgcn_ds_swizzle(x, 0x101F));
    else if constexpr (XM == 8) return __builtin_bit_cast(float, __builtin_amdgcn_ds_swizzle(x, 0x201F));
    else if constexpr (XM == 16) return __builtin_bit_cast(float, __builtin_amdgcn_ds_swizzle(x, 0x401F));
    else return __shfl_xor(v, 32);
}
template <int XM> __device__ __forceinline__ int lane_xchg(int x) {
    if constexpr (XM == 1) return __builtin_amdgcn_mov_dpp(x, 0xB1, 0xF, 0xF, true);
    else if constexpr (XM == 2) return __builtin_amdgcn_mov_dpp(x, 0x4E, 0xF, 0xF, true);
    else if constexpr (XM == 4) return __builtin_amdgcn_ds_swizzle(x, 0x101F);
    else if constexpr (XM == 8) return __builtin_amdgcn_ds_swizzle(x, 0x201F);
    else if constexpr (XM == 16) return __builtin_amdgcn_ds_swizzle(x, 0x401F);
    else return __shfl_xor(x, 32);
}
__device__ __forceinline__ float reduce16(const float (&p)[16], int lane) {
    float a[8], b[4], c[2];
    const bool b0 = lane & 1, b1 = lane & 2, b2 = lane & 4, b3 = lane & 8;
#pragma unroll
    for (int i = 0; i < 8; ++i) a[i] = (b0 ? p[2 * i + 1] : p[2 * i]) + lane_xchg<1>(b0 ? p[2 * i] : p[2 * i + 1]);
#pragma unroll
    for (int i = 0; i < 4; ++i) b[i] = (b1 ? a[2 * i + 1] : a[2 * i]) + lane_xchg<2>(b1 ? a[2 * i] : a[2 * i + 1]);
#pragma unroll
    for (int i = 0; i < 2; ++i) c[i] = (b2 ? b[2 * i + 1] : b[2 * i]) + lane_xchg<4>(b2 ? b[2 * i] : b[2 * i + 1]);
    float d = (b3 ? c[1] : c[0]) + lane_xchg<8>(b3 ? c[0] : c[1]);
    d += lane_xchg<16>(d);
    d += lane_xchg<32>(d);
    return d;
}
__device__ __forceinline__ void expert_token(const Ctx& F, KArgs A, int l, int t, const int idx0, const int idx1, const float wt0, const float wt1) {
    const bf16* H = (const bf16*)(A.ws + WS_H); const unsigned char* UE = A.ws + WS_UE; const unsigned char* VE = A.ws + WS_VE;
    const float* mod = (const float*)(A.ws + WS_MOD);
    bf16* Hn = (bf16*)(A.ws + WS_H);
    const unsigned lo16 = (unsigned)F.lane * 16u; (void)lo16;
    {
        const v4u ha = *(const v4u*)(H + (size_t)t * D + 8 * F.lane), hb = *(const v4u*)(H + (size_t)t * D + 512 + 8 * F.lane);
#if EXP_I8 && !DBG_ROUTE32
        const float su0 = ((const float*)(A.ws + WS_US))[idx0], su1 = ((const float*)(A.ws + WS_US))[idx1], sv0 = ((const float*)(A.ws + WS_VS))[idx0], sv1 = ((const float*)(A.ws + WS_VS))[idx1];
        float hv[16];
        hv[0] = bflo(ha.x); hv[1] = bfhi(ha.x); hv[2] = bflo(ha.y); hv[3] = bfhi(ha.y); hv[4] = bflo(ha.z); hv[5] = bfhi(ha.z); hv[6] = bflo(ha.w); hv[7] = bfhi(ha.w);
        hv[8] = bflo(hb.x); hv[9] = bfhi(hb.x); hv[10] = bflo(hb.y); hv[11] = bfhi(hb.y); hv[12] = bflo(hb.z); hv[13] = bfhi(hb.z); hv[14] = bflo(hb.w); hv[15] = bfhi(hb.w);
        float hs = 0.f;
#pragma unroll
        for (int k = 0; k < 16; ++k) hs += hv[k];
        const float hsum = wave_sum(hs);
        const unsigned lo16b = (unsigned)F.lane * 16u;
#define UB(w, i) ((float)(((w) >> (8 * (i))) & 255u))
        float act0 = 0.f, act1 = 0.f;
        for (int b = 0; b < 8 * PROBE_EXP_REP; ++b) {
            const int isel = ((b & 7) < 4) ? idx0 : idx1; const int lb = 16 * (b & 3);
            v4u rr[16];
#pragma unroll
            for (int j = 0; j < 16; ++j) { const unsigned ie = (unsigned)rdlanei(isel, lb + j); rr[j] = *(const v4u*)(UE + (size_t)ie * 1024u + lo16b) ^ 0x80808080u; }
            float p[16];
#pragma unroll
            for (int j = 0; j < 16; ++j) { const v4u r = rr[j];
                float s0 = hv[0] * UB(r.x, 0); s0 += hv[1] * UB(r.x, 1); s0 += hv[2] * UB(r.x, 2); s0 += hv[3] * UB(r.x, 3);
                float s1 = hv[4] * UB(r.y, 0); s1 += hv[5] * UB(r.y, 1); s1 += hv[6] * UB(r.y, 2); s1 += hv[7] * UB(r.y, 3);
                s0 += hv[8] * UB(r.z, 0); s0 += hv[9] * UB(r.z, 1); s0 += hv[10] * UB(r.z, 2); s0 += hv[11] * UB(r.z, 3);
                s1 += hv[12] * UB(r.w, 0); s1 += hv[13] * UB(r.w, 1); s1 += hv[14] * UB(r.w, 2); s1 += hv[15] * UB(r.w, 3);
                p[j] = s0 + s1; }
#if PROBE_U_VALU
            asm volatile("" : "+v"(hv[0]), "+v"(hv[1]), "+v"(hv[2]), "+v"(hv[3]), "+v"(hv[4]), "+v"(hv[5]), "+v"(hv[6]), "+v"(hv[7]));
#pragma unroll
            for (int j = 0; j < 16; ++j) { const v4u r = rr[j];
                float s0 = hv[0] * UB(r.x, 0); s0 += hv[1] * UB(r.x, 1); s0 += hv[2] * UB(r.x, 2); s0 += hv[3] * UB(r.x, 3);
                float s1 = hv[4] * UB(r.y, 0); s1 += hv[5] * UB(r.y, 1); s1 += hv[6] * UB(r.y, 2); s1 += hv[7] * UB(r.y, 3);
                s0 += hv[8] * UB(r.z, 0); s0 += hv[9] * UB(r.z, 1); s0 += hv[10] * UB(r.z, 2); s0 += hv[11] * UB(r.z, 3);
                s1 += hv[12] * UB(r.w, 0); s1 += hv[13] * UB(r.w, 1); s1 += hv[14] * UB(r.w, 2); s1 += hv[15] * UB(r.w, 3);
                p[j] = 0.5f * (p[j] + (s0 + s1)); }
#endif
            const float tot = reduce16(p, F.lane);
            if ((F.lane >> 4) == (b & 3)) { if ((b & 7) < 4) act0 = tot; else act1 = tot; }
        }
        act0 = su0 * (act0 - 128.0f * hsum); act1 = su1 * (act1 - 128.0f * hsum);
        const float w0 = wt0 * sv0 * 0.5f * act0 * (1.0f + erff(act0 * 0.7071067811865476f)), w1 = wt1 * sv1 * 0.5f * act1 * (1.0f + erff(act1 * 0.7071067811865476f));
        const float csum = wave_sum(w0 + w1);
        float o[16];
#pragma unroll
        for (int k = 0; k < 16; ++k) o[k] = 0.f;
        for (int b = 0; b < 8 * PROBE_EXP_REP; ++b) {
            if (b == 8) {
#pragma unroll
                for (int k = 0; k < 16; ++k) o[k] = 0.f; }
            const int isel = ((b & 7) < 4) ? idx0 : idx1; const float wsel = ((b & 7) < 4) ? w0 : w1; const int lb = 16 * (b & 3);
            v4u rr[16];
#pragma unroll
            for (int j = 0; j < 16; ++j) { const unsigned ie = (unsigned)rdlanei(isel, lb + j); rr[j] = *(const v4u*)(VE + (size_t)ie * 1024u + lo16b); }
#pragma unroll
            for (int j = 0; j < 16; ++j) { const float we = rdlane(wsel, lb + j); const v4u r = rr[j];
                o[0] += we * UB(r.x, 0); o[1] += we * UB(r.x, 1); o[2] += we * UB(r.x, 2); o[3] += we * UB(r.x, 3); o[4] += we * UB(r.y, 0); o[5] += we * UB(r.y, 1); o[6] += we * UB(r.y, 2); o[7] += we * UB(r.y, 3);
                o[8] += we * UB(r.z, 0); o[9] += we * UB(r.z, 1); o[10] += we * UB(r.z, 2); o[11] += we * UB(r.z, 3); o[12] += we * UB(r.w, 0); o[13] += we * UB(r.w, 1); o[14] += we * UB(r.w, 2); o[15] += we * UB(r.w, 3); }
        }
#pragma unroll
        for (int k = 0; k < 16; ++k) o[k] -= 128.0f * csum;
#undef UB
#else
        float act0 = 0.f, act1 = 0.f;
        for (int b = 0; b < 8 * PROBE_EXP_REP; ++b) {
            const int isel = ((b & 7) < 4) ? idx0 : idx1; const int lb = 16 * (b & 3);
            v4u ra[16], rb[16];
#pragma unroll
            for (int j = 0; j < 16; ++j) { const unsigned ie = (unsigned)rdlanei(isel, lb + j); const unsigned char* up = UE + (size_t)ie * 2048u + lo16;
                ra[j] = *(const v4u*)up; rb[j] = *(const v4u*)(up + 1024); }
            float p[16];
#pragma unroll
            for (int j = 0; j < 16; ++j) { float s = dot2bf(ha.x, ra[j].x, 0.f); s = dot2bf(ha.y, ra[j].y, s); s = dot2bf(ha.z, ra[j].z, s); s = dot2bf(ha.w, ra[j].w, s);
                s = dot2bf(hb.x, rb[j].x, s); s = dot2bf(hb.y, rb[j].y, s); s = dot2bf(hb.z, rb[j].z, s); s = dot2bf(hb.w, rb[j].w, s); p[j] = s; }
            const float tot = reduce16(p, F.lane);
            if ((F.lane >> 4) == (b & 3)) { if ((b & 7) < 4) act0 = tot; else act1 = tot; }
        }
        const float w0 = wt0 * 0.5f * act0 * (1.0f + erff(act0 * 0.7071067811865476f)), w1 = wt1 * 0.5f * act1 * (1.0f + erff(act1 * 0.7071067811865476f));
        float o[16];
#pragma unroll
        for (int k = 0; k < 16; ++k) o[k] = 0.f;
        for (int b = 0; b < 8 * PROBE_EXP_REP; ++b) {
            if (b == 8) {
#pragma unroll
                for (int k = 0; k < 16; ++k) o[k] = 0.f; }
            const int isel = ((b & 7) < 4) ? idx0 : idx1; const float wsel = ((b & 7) < 4) ? w0 : w1; const int lb = 16 * (b & 3);
            v4u ra[16], rb[16];
#pragma unroll
            for (int j = 0; j < 16; ++j) { const unsigned ie = (unsigned)rdlanei(isel, lb + j); const unsigned char* vp = VE + (size_t)ie * 2048u + lo16;
                ra[j] = *(const v4u*)vp; rb[j] = *(const v4u*)(vp + 1024); }
#pragma unroll
            for (int j = 0; j < 16; ++j) { const float we = rdlane(wsel, lb + j); const v4u a = ra[j], bb = rb[j];
                o[0] += we * bflo(a.x); o[1] += we * bfhi(a.x); o[2] += we * bflo(a.y); o[3] += we * bfhi(a.y); o[4] += we * bflo(a.z); o[5] += we * bfhi(a.z); o[6] += we * bflo(a.w); o[7] += we * bfhi(a.w);
                o[8] += we * bflo(bb.x); o[9] += we * bfhi(bb.x); o[10] += we * bflo(bb.y); o[11] += we * bfhi(bb.y); o[12] += we * bflo(bb.z); o[13] += we * bfhi(bb.z); o[14] += we * bflo(bb.w); o[15] += we * bfhi(bb.w); }
        }
#endif
        const int b = t >> 11; const float* mb = mod + ((size_t)l * 8 + b) * 6144;
        float x2[16]; float ss = 0.f;
#pragma unroll
        for (int hseg = 0; hseg < 2; ++hseg)
#pragma unroll
            for (int q4 = 0; q4 < 2; ++q4) { const int col = hseg * 512 + 8 * F.lane + 4 * q4;
                const f32x4 xv = *(const f32x4*)(A.out + (size_t)t * D + col), gv = *(const f32x4*)(mb + 5120 + col);
#pragma unroll
                for (int e = 0; e < 4; ++e) { const float v = xv[e] + gv[e] * o[hseg * 8 + q4 * 4 + e]; x2[hseg * 8 + q4 * 4 + e] = v; ss += v * v; } }
        const float r = 1.0f / sqrtf(wave_sum(ss) * (1.0f / D) + EPS);
        if (l + 1 < DEPTH) {
            const float* mn = mod + ((size_t)(l + 1) * 8 + b) * 6144; const float* gn = A.in[I_GN1] + (size_t)(l + 1) * D;
#pragma unroll
            for (int hseg = 0; hseg < 2; ++hseg) { const int col = hseg * 512 + 8 * F.lane;
                float hn[8];
#pragma unroll
                for (int q4 = 0; q4 < 2; ++q4) { const f32x4 gg = *(const f32x4*)(gn + col + 4 * q4), sc = *(const f32x4*)(mn + 1024 + col + 4 * q4), sh = *(const f32x4*)(mn + col + 4 * q4);
                    f32x4 xo;
#pragma unroll
                    for (int e = 0; e < 4; ++e) { xo[e] = x2[hseg * 8 + q4 * 4 + e]; hn[q4 * 4 + e] = xo[e] * r * gg[e] * (1.0f + sc[e]) + sh[e]; }
                    *(f32x4*)(A.out + (size_t)t * D + col + 4 * q4) = xo; }
                v4u ov; ov.x = pk2(hn[0], hn[1]); ov.y = pk2(hn[2], hn[3]); ov.z = pk2(hn[4], hn[5]); ov.w = pk2(hn[6], hn[7]);
                *(v4u*)(Hn + (size_t)t * D + col) = ov; }
        } else {
            const float* gf = A.in[I_GFIN];
#pragma unroll
            for (int hseg = 0; hseg < 2; ++hseg)
#pragma unroll
                for (int q4 = 0; q4 < 2; ++q4) { const int col = hseg * 512 + 8 * F.lane + 4 * q4; const f32x4 gg = *(const f32x4*)(gf + col); f32x4 xo;
#pragma unroll
                    for (int e = 0; e < 4; ++e) xo[e] = x2[hseg * 8 + q4 * 4 + e] * r * gg[e];
                    *(f32x4*)(A.out + (size_t)t * D + col) = xo; }
        }
    }
}

struct HQ { int q1[4], q2[4]; float s1, s2; int c1, c2; };
struct NextB { const unsigned char* tab; int isel; int lb; };
template <int N> __device__ __forceinline__ void vm_wait() { asm volatile("s_waitcnt vmcnt(%0)" :: "n"(N) : "memory"); }
__device__ __forceinline__ void dma_row(const NextB& nb, int j, unsigned lo16b, LAS unsigned char* slot) {
    const unsigned ie = (unsigned)rdlanei(nb.isel, nb.lb + j);
#if EXP6B
#if DMA_NOMASK
    const unsigned off = lo16b < (lo16b - 768u) ? lo16b : lo16b - 768u;
#if ROW_OFFS
    __builtin_amdgcn_global_load_lds((const unsigned*)(nb.tab + (size_t)(ie + off)), (LAS unsigned*)slot, 16, 0, 0);
#else
    __builtin_amdgcn_global_load_lds((const unsigned*)(nb.tab + (size_t)ie * 768u + off), (LAS unsigned*)slot, 16, 0, 0);
#endif
#else
    if (lo16b < 768u) __builtin_amdgcn_global_load_lds((const unsigned*)(nb.tab + (size_t)ie * 768u + lo16b), (LAS unsigned*)slot, 16, 0, 0);
#endif
#else
    __builtin_amdgcn_global_load_lds((const unsigned*)(nb.tab + (size_t)ie * 1024u + lo16b), (LAS unsigned*)slot, 16, 0, 0);
#endif
}
#define UBF(w, i) ((float)(((w) >> (8 * (i))) & 255u))
__device__ __forceinline__ v4u ring_row(const LAS unsigned char* slot, unsigned lo16b) {
#if EXP6B
    const v2u X = *(const LAS v2u*)(slot + (lo16b >> 1)); const unsigned Y = *(const LAS unsigned*)(slot + 512 + (lo16b >> 2));
    v4u r;
    r.x = (X.x & 0x0F0F0F0Fu) | (Y & 0x30303030u);
    r.y = (X.x & 0xF0F0F0F0u) | (Y & 0x0C0C0C0Cu);
    r.z = (X.y & 0x0F0F0F0Fu) | ((Y >> 2) & 0x30303030u);
    r.w = (X.y & 0xF0F0F0F0u) | ((Y << 2) & 0x0C0C0C0Cu);
    return r;
#else
    return *(const LAS v4u*)(slot + lo16b);
#endif
}
#if ROW_PIPE
__device__ __forceinline__ void lds_raw(v4u& raw, const LAS unsigned char* slot, unsigned lo16b) {
#if EXP6B
    const v2u X = *(const LAS v2u*)(slot + (lo16b >> 1)); raw.x = X.x; raw.y = X.y; raw.z = *(const LAS unsigned*)(slot + 512 + (lo16b >> 2));
#else
    raw = *(const LAS v4u*)(slot + lo16b);
#endif
}
__device__ __forceinline__ v4u decode_raw(const v4u& raw) {
#if EXP6B
    v4u r;
    r.x = (raw.x & 0x0F0F0F0Fu) | (raw.z & 0x30303030u);
    r.y = (raw.x & 0xF0F0F0F0u) | (raw.z & 0x0C0C0C0Cu);
    r.z = (raw.y & 0x0F0F0F0Fu) | ((raw.z >> 2) & 0x30303030u);
    r.w = (raw.y & 0xF0F0F0F0u) | ((raw.z << 2) & 0x0C0C0C0Cu);
    return r;
#else
    return raw;
#endif
}
__device__ __forceinline__ void vm_wait_n(int n) {
    switch (n) { case 15: vm_wait<15>(); break; case 14: vm_wait<14>(); break; case 13: vm_wait<13>(); break; case 12: vm_wait<12>(); break; case 11: vm_wait<11>(); break; case 10: vm_wait<10>(); break;
        case 9: vm_wait<9>(); break; case 8: vm_wait<8>(); break; case 7: vm_wait<7>(); break; case 6: vm_wait<6>(); break; case 5: vm_wait<5>(); break; case 4: vm_wait<4>(); break;
        case 3: vm_wait<3>(); break; case 2: vm_wait<2>(); break; case 1: vm_wait<1>(); break; case 0: vm_wait<0>(); break; default: break; }
}
__device__ __forceinline__ v4u row_step(LAS unsigned char* ring, v4u& raw, const NextB& nb, unsigned lo16b, int B, bool refill, int waitn) {
    __builtin_amdgcn_sched_barrier(0);
#if EXP6B
    asm volatile("s_waitcnt lgkmcnt(0)" : "+v"(raw.x), "+v"(raw.y), "+v"(raw.z) :: "memory");
#else
    asm volatile("s_waitcnt lgkmcnt(0)" : "+v"(raw.x), "+v"(raw.y), "+v"(raw.z), "+v"(raw.w) :: "memory");
#endif
    if (refill) dma_row(nb, B, lo16b, ring + B * 1024);
    const v4u cur = raw;
    if (waitn >= 0) { vm_wait_n(waitn); lds_raw(raw, ring + ((B + 1) & 15) * 1024, lo16b); __builtin_amdgcn_sched_barrier(0); }
    return decode_raw(cur);
}
#endif
#if EXP6B && H_PLANES == 1
typedef int TreeT;
#else
typedef float TreeT;
#endif
template <int L, int B> __device__ __forceinline__ TreeT rs_tree(LAS unsigned char* ring, const HQ& hq, const NextB& nb, int lane, unsigned lo16b, v4u& raw) {
    if constexpr (L == 0) {
#if ROW_PIPE
        const v4u r = row_step(ring, raw, nb, lo16b, B, true, 15);
#else
        vm_wait<15>();
        const v4u r = ring_row(ring + B * 1024, lo16b);
#endif
#if EXP6B
        int e1 = __builtin_amdgcn_sdot4(hq.q1[0], (int)r.x, 0, false); e1 = __builtin_amdgcn_sdot4(hq.q1[2], (int)r.z, e1, false);
        int d1 = __builtin_amdgcn_sdot4(hq.q1[1], (int)r.y, hq.c1, false); d1 = __builtin_amdgcn_sdot4(hq.q1[3], (int)r.w, d1, false); d1 += e1 << 2;
#if H_PLANES == 2
        int e2 = __builtin_amdgcn_sdot4(hq.q2[0], (int)r.x, 0, false); e2 = __builtin_amdgcn_sdot4(hq.q2[2], (int)r.z, e2, false);
        int d2 = __builtin_amdgcn_sdot4(hq.q2[1], (int)r.y, hq.c2, false); d2 = __builtin_amdgcn_sdot4(hq.q2[3], (int)r.w, d2, false); d2 += e2 << 2;
#endif
#else
        int d1 = __builtin_amdgcn_sdot4(hq.q1[0], (int)r.x, 0, false); d1 = __builtin_amdgcn_sdot4(hq.q1[1], (int)r.y, d1, false); d1 = __builtin_amdgcn_sdot4(hq.q1[2], (int)r.z, d1, false); d1 = __builtin_amdgcn_sdot4(hq.q1[3], (int)r.w, d1, false);
        int d2 = __builtin_amdgcn_sdot4(hq.q2[0], (int)r.x, 0, false); d2 = __builtin_amdgcn_sdot4(hq.q2[1], (int)r.y, d2, false); d2 = __builtin_amdgcn_sdot4(hq.q2[2], (int)r.z, d2, false); d2 = __builtin_amdgcn_sdot4(hq.q2[3], (int)r.w, d2, false);
#endif
#if H_PLANES == 2
        const float p = (float)d1 * hq.s1 + (float)d2 * hq.s2;
#else
        const int p = d1;
#endif
#if !ROW_PIPE
        asm volatile("s_waitcnt lgkmcnt(0)" :: "v"(p) : "memory");
        dma_row(nb, B, lo16b, ring + B * 1024);
#endif
        return p;
    } else {
        constexpr int HS = 1 << (L - 1);
        const TreeT lo = rs_tree<L - 1, B>(ring, hq, nb, lane, lo16b, raw), hi = rs_tree<L - 1, B + HS>(ring, hq, nb, lane, lo16b, raw);
#if TREE_BANKMASK && EXP6B && H_PLANES == 1
        if constexpr (HS >= 4) {
            int t;
            if constexpr (HS == 4) { t = lo + __builtin_amdgcn_mov_dpp(lo, 0x104, 0xF, 0xF, true);
                asm volatile("s_nop 1\n\tv_add_u32_dpp %0, %1, %1 row_shr:4 row_mask:0xf bank_mask:0xa" : "+v"(t) : "v"(hi)); }
            else { t = lo + __builtin_amdgcn_mov_dpp(lo, 0x128, 0xF, 0xF, true);
                asm volatile("s_nop 1\n\tv_add_u32_dpp %0, %1, %1 row_ror:8 row_mask:0xf bank_mask:0xc" : "+v"(t) : "v"(hi)); }
            return t;
        }
#endif
        const bool up = lane & HS;
        return (up ? hi : lo) + lane_xchg<HS>(up ? lo : hi);
    }
}
__device__ __forceinline__ float consume_u(LAS unsigned char* ring, const HQ& hq, const NextB& nb, int lane, unsigned lo16b, v4u& raw) {
    TreeT d = rs_tree<4, 0>(ring, hq, nb, lane, lo16b, raw);
    d += lane_xchg<16>(d);
    d += lane_xchg<32>(d);
#if EXP6B && H_PLANES == 1
    return (float)d * hq.s1;
#else
    return d;
#endif
}
template <bool LASTB> __device__ __forceinline__ void consume_v(LAS unsigned char* ring, float (&o)[16], float wsel, int lb, const NextB& nb, unsigned lo16b) {
#pragma unroll
    for (int j = 0; j < 16; ++j) {
        if constexpr (LASTB) { switch (j) { case 0: vm_wait<15>(); break; case 1: vm_wait<14>(); break; case 2: vm_wait<13>(); break; case 3: vm_wait<12>(); break; case 4: vm_wait<11>(); break; case 5: vm_wait<10>(); break; case 6: vm_wait<9>(); break; case 7: vm_wait<8>(); break;
            case 8: vm_wait<7>(); break; case 9: vm_wait<6>(); break; case 10: vm_wait<5>(); break; case 11: vm_wait<4>(); break; case 12: vm_wait<3>(); break; case 13: vm_wait<2>(); break; case 14: vm_wait<1>(); break; default: vm_wait<0>(); break; } }
        else vm_wait<15>();
        const float we = rdlane(wsel, lb + j); const v4u r = *(const LAS v4u*)(ring + j * 1024 + lo16b);
        o[0] += we * UBF(r.x, 0); o[1] += we * UBF(r.x, 1); o[2] += we * UBF(r.x, 2); o[3] += we * UBF(r.x, 3); o[4] += we * UBF(r.y, 0); o[5] += we * UBF(r.y, 1); o[6] += we * UBF(r.y, 2); o[7] += we * UBF(r.y, 3);
        o[8] += we * UBF(r.z, 0); o[9] += we * UBF(r.z, 1); o[10] += we * UBF(r.z, 2); o[11] += we * UBF(r.z, 3); o[12] += we * UBF(r.w, 0); o[13] += we * UBF(r.w, 1); o[14] += we * UBF(r.w, 2); o[15] += we * UBF(r.w, 3);
        if constexpr (!LASTB) { asm volatile("s_waitcnt lgkmcnt(0)" :: "v"(o[0]), "v"(o[5]), "v"(o[10]), "v"(o[15]) : "memory"); dma_row(nb, j, lo16b, ring + j * 1024); }
    }
}
#if V_MFMA
typedef int v4i __attribute__((ext_vector_type(4)));
#if V_ABID
template <bool LASTB, int J> __device__ __forceinline__ void vm_row(LAS unsigned char* ring, v4i (&a1)[4], int aq, const NextB& nb, unsigned lo16b, v4u& raw) {
    const v4u r = row_step(ring, raw, nb, lo16b, J, !LASTB, LASTB ? 14 - J : 15);
    a1[0] = __builtin_amdgcn_mfma_i32_4x4x4i8(aq, (int)r.x, a1[0], 4, J, 0); a1[1] = __builtin_amdgcn_mfma_i32_4x4x4i8(aq, (int)r.y, a1[1], 4, J, 0);
    a1[2] = __builtin_amdgcn_mfma_i32_4x4x4i8(aq, (int)r.z, a1[2], 4, J, 0); a1[3] = __builtin_amdgcn_mfma_i32_4x4x4i8(aq, (int)r.w, a1[3], 4, J, 0);
}
template <bool LASTB> __device__ __forceinline__ void consume_vm(LAS unsigned char* ring, v4i (&a1)[4], v4i (&a2)[4], int cqsel, int lb, const NextB& nb, unsigned lo16b, unsigned sh8, v4u& raw) {
    static_assert(ROW_PIPE && V_PLANES == 1, "V_ABID: pipelined rows, one c plane");
    const int aq = (__shfl(cqsel, lb + (int)(lo16b >> 6)) & 255) << sh8;
    vm_row<LASTB, 0>(ring, a1, aq, nb, lo16b, raw); vm_row<LASTB, 1>(ring, a1, aq, nb, lo16b, raw); vm_row<LASTB, 2>(ring, a1, aq, nb, lo16b, raw); vm_row<LASTB, 3>(ring, a1, aq, nb, lo16b, raw);
    vm_row<LASTB, 4>(ring, a1, aq, nb, lo16b, raw); vm_row<LASTB, 5>(ring, a1, aq, nb, lo16b, raw); vm_row<LASTB, 6>(ring, a1, aq, nb, lo16b, raw); vm_row<LASTB, 7>(ring, a1, aq, nb, lo16b, raw);
    vm_row<LASTB, 8>(ring, a1, aq, nb, lo16b, raw); vm_row<LASTB, 9>(ring, a1, aq, nb, lo16b, raw); vm_row<LASTB, 10>(ring, a1, aq, nb, lo16b, raw); vm_row<LASTB, 11>(ring, a1, aq, nb, lo16b, raw);
    vm_row<LASTB, 12>(ring, a1, aq, nb, lo16b, raw); vm_row<LASTB, 13>(ring, a1, aq, nb, lo16b, raw); vm_row<LASTB, 14>(ring, a1, aq, nb, lo16b, raw); vm_row<LASTB, 15>(ring, a1, aq, nb, lo16b, raw);
    (void)a2;
}
#else
template <bool LASTB> __device__ __forceinline__ void consume_vm(LAS unsigned char* ring, v4i (&a1)[4], v4i (&a2)[4], int cqsel, int lb, const NextB& nb, unsigned lo16b, unsigned sh8, v4u& raw) {
#pragma unroll
    for (int j = 0; j < 16; ++j) {
#if ROW_PIPE
        const v4u r = row_step(ring, raw, nb, lo16b, j, !LASTB, LASTB ? 14 - j : 15); const int cs = rdlanei(cqsel, lb + j);
#else
        if constexpr (LASTB) { switch (j) { case 0: vm_wait<15>(); break; case 1: vm_wait<14>(); break; case 2: vm_wait<13>(); break; case 3: vm_wait<12>(); break; case 4: vm_wait<11>(); break; case 5: vm_wait<10>(); break; case 6: vm_wait<9>(); break; case 7: vm_wait<8>(); break;
            case 8: vm_wait<7>(); break; case 9: vm_wait<6>(); break; case 10: vm_wait<5>(); break; case 11: vm_wait<4>(); break; case 12: vm_wait<3>(); break; case 13: vm_wait<2>(); break; case 14: vm_wait<1>(); break; default: vm_wait<0>(); break; } }
        else vm_wait<15>();
        const int cs = rdlanei(cqsel, lb + j); const v4u r = ring_row(ring + j * 1024, lo16b);
#endif
        const int c1 = (cs & 255) << sh8, c2 = ((cs >> 8) & 255) << sh8;
#if V_PLANES == 2
        a1[0] = __builtin_amdgcn_mfma_i32_4x4x4i8(c1, (int)r.x, a1[0], 0, 0, 0); a2[0] = __builtin_amdgcn_mfma_i32_4x4x4i8(c2, (int)r.x, a2[0], 0, 0, 0);
        a1[1] = __builtin_amdgcn_mfma_i32_4x4x4i8(c1, (int)r.y, a1[1], 0, 0, 0); a2[1] = __builtin_amdgcn_mfma_i32_4x4x4i8(c2, (int)r.y, a2[1], 0, 0, 0);
        a1[2] = __builtin_amdgcn_mfma_i32_4x4x4i8(c1, (int)r.z, a1[2], 0, 0, 0); a2[2] = __builtin_amdgcn_mfma_i32_4x4x4i8(c2, (int)r.z, a2[2], 0, 0, 0);
        a1[3] = __builtin_amdgcn_mfma_i32_4x4x4i8(c1, (int)r.w, a1[3], 0, 0, 0); a2[3] = __builtin_amdgcn_mfma_i32_4x4x4i8(c2, (int)r.w, a2[3], 0, 0, 0);
#else
        a1[0] = __builtin_amdgcn_mfma_i32_4x4x4i8(c1, (int)r.x, a1[0], 0, 0, 0); a1[1] = __builtin_amdgcn_mfma_i32_4x4x4i8(c1, (int)r.y, a1[1], 0, 0, 0);
        a1[2] = __builtin_amdgcn_mfma_i32_4x4x4i8(c1, (int)r.z, a1[2], 0, 0, 0); a1[3] = __builtin_amdgcn_mfma_i32_4x4x4i8(c1, (int)r.w, a1[3], 0, 0, 0); (void)c2;
#endif
#if !ROW_PIPE
        if constexpr (!LASTB) { asm volatile("s_waitcnt lgkmcnt(0)" :: "v"(r.x), "v"(r.y), "v"(r.z), "v"(r.w) : "memory"); dma_row(nb, j, lo16b, ring + j * 1024); }
#endif
    }
}
#endif
#endif
template <bool HAVE_X1> __device__ __forceinline__ void expert_epilogue(const Ctx& F, KArgs A, int l, int t, const float (&o)[16], const float (&x1v)[16]) {
    const float* mod = (const float*)(A.ws + WS_MOD); bf16* Hn = (bf16*)(A.ws + WS_H);
    const int b = t >> 11; const float* mb = mod + ((size_t)l * 8 + b) * 6144;
    float x2[16]; float ss = 0.f;
#pragma unroll
    for (int hseg = 0; hseg < 2; ++hseg)
#pragma unroll
        for (int q4 = 0; q4 < 2; ++q4) { const int col = hseg * 512 + 8 * F.lane + 4 * q4;
            f32x4 xv; if constexpr (HAVE_X1) xv = (f32x4){x1v[hseg * 8 + q4 * 4], x1v[hseg * 8 + q4 * 4 + 1], x1v[hseg * 8 + q4 * 4 + 2], x1v[hseg * 8 + q4 * 4 + 3]}; else xv = *(const f32x4*)(A.out + (size_t)t * D + col);
            const f32x4 gv = *(const f32x4*)(mb + 5120 + col);
#pragma unroll
            for (int e = 0; e < 4; ++e) { const float v = xv[e] + gv[e] * o[hseg * 8 + q4 * 4 + e]; x2[hseg * 8 + q4 * 4 + e] = v; ss += v * v; } }
    const float r = 1.0f / sqrtf(wave_sum(ss) * (1.0f / D) + EPS);
    if (l + 1 < DEPTH) {
        const float* mn = mod + ((size_t)(l + 1) * 8 + b) * 6144; const float* gn = A.in[I_GN1] + (size_t)(l + 1) * D;
#pragma unroll
        for (int hseg = 0; hseg < 2; ++hseg) { const int col = hseg * 512 + 8 * F.lane;
            float hn[8];
#pragma unroll
            for (int q4 = 0; q4 < 2; ++q4) { const f32x4 gg = *(const f32x4*)(gn + col + 4 * q4), sc = *(const f32x4*)(mn + 1024 + col + 4 * q4), sh = *(const f32x4*)(mn + col + 4 * q4);
                f32x4 xo;
#pragma unroll
                for (int e = 0; e < 4; ++e) { xo[e] = x2[hseg * 8 + q4 * 4 + e]; hn[q4 * 4 + e] = xo[e] * r * gg[e] * (1.0f + sc[e]) + sh[e]; }
                *(f32x4*)(A.out + (size_t)t * D + col + 4 * q4) = xo; }
            v4u ov; ov.x = pk2(hn[0], hn[1]); ov.y = pk2(hn[2], hn[3]); ov.z = pk2(hn[4], hn[5]); ov.w = pk2(hn[6], hn[7]);
            *(v4u*)(Hn + (size_t)t * D + col) = ov; }
    } else {
        const float* gf = A.in[I_GFIN];
#pragma unroll
        for (int hseg = 0; hseg < 2; ++hseg)
#pragma unroll
            for (int q4 = 0; q4 < 2; ++q4) { const int col = hseg * 512 + 8 * F.lane + 4 * q4; const f32x4 gg = *(const f32x4*)(gf + col); f32x4 xo;
#pragma unroll
                for (int e = 0; e < 4; ++e) xo[e] = x2[hseg * 8 + q4 * 4 + e] * r * gg[e];
                *(f32x4*)(A.out + (size_t)t * D + col) = xo; }
    }
}
#if EPI_HOIST
struct EpiC { float g2[16], cn[16], shn[16]; };
__device__ __forceinline__ void epi_coeffs(EpiC& C, const Ctx& F, KArgs A, int l, int t0) {
    const float* mod = (const float*)(A.ws + WS_MOD); const int b = t0 >> 11; const float* mb = mod + ((size_t)l * 8 + b) * 6144;
#pragma unroll
    for (int i = 0; i < 4; ++i) { const int col = (i >> 1) * 512 + 8 * F.lane + 4 * (i & 1);
        const f32x4 gv = *(const f32x4*)(mb + 5120 + col);
        f32x4 gg, sc, sh;
        if (l + 1 < DEPTH) { const float* mn = mod + ((size_t)(l + 1) * 8 + b) * 6144; gg = *(const f32x4*)(A.in[I_GN1] + (size_t)(l + 1) * D + col); sc = *(const f32x4*)(mn + 1024 + col); sh = *(const f32x4*)(mn + col); }
        else { gg = *(const f32x4*)(A.in[I_GFIN] + col); sc = (f32x4){0.f, 0.f, 0.f, 0.f}; sh = sc; }
#pragma unroll
        for (int e = 0; e < 4; ++e) { C.g2[4 * i + e] = gv[e]; C.cn[4 * i + e] = gg[e] * (1.0f + sc[e]); C.shn[4 * i + e] = sh[e]; } }
}
__device__ __forceinline__ void expert_epilogue_c(const Ctx& F, KArgs A, int l, int t, const float (&o)[16], const float (&x1v)[16], const EpiC& C) {
    bf16* Hn = (bf16*)(A.ws + WS_H);
    float x2[16]; float ss = 0.f;
#pragma unroll
    for (int e = 0; e < 16; ++e) { const float v = x1v[e] + C.g2[e] * o[e]; x2[e] = v; ss += v * v; }
    const float r = 1.0f / sqrtf(wave_sum(ss) * (1.0f / D) + EPS);
    if (l + 1 < DEPTH) {
#pragma unroll
        for (int hseg = 0; hseg < 2; ++hseg) { const int col = hseg * 512 + 8 * F.lane;
            float hn[8];
#pragma unroll
            for (int q4 = 0; q4 < 2; ++q4) {
#pragma unroll
                for (int e = 0; e < 4; ++e) hn[q4 * 4 + e] = x2[hseg * 8 + q4 * 4 + e] * r * C.cn[hseg * 8 + q4 * 4 + e] + C.shn[hseg * 8 + q4 * 4 + e]; }
            { v4u xo; xo.x = pk2(x2[hseg * 8 + 0], x2[hseg * 8 + 1]); xo.y = pk2(x2[hseg * 8 + 2], x2[hseg * 8 + 3]); xo.z = pk2(x2[hseg * 8 + 4], x2[hseg * 8 + 5]); xo.w = pk2(x2[hseg * 8 + 6], x2[hseg * 8 + 7]);
              *(v4u*)((bf16*)A.out + (size_t)t * D + col) = xo; }
            v4u ov; ov.x = pk2(hn[0], hn[1]); ov.y = pk2(hn[2], hn[3]); ov.z = pk2(hn[4], hn[5]); ov.w = pk2(hn[6], hn[7]);
            *(v4u*)(Hn + (size_t)t * D + col) = ov; }
    } else {
#pragma unroll
        for (int hseg = 0; hseg < 2; ++hseg)
#pragma unroll
            for (int q4 = 0; q4 < 2; ++q4) { const int col = hseg * 512 + 8 * F.lane + 4 * q4; f32x4 xo;
#pragma unroll
                for (int e = 0; e < 4; ++e) xo[e] = x2[hseg * 8 + q4 * 4 + e] * r * C.cn[hseg * 8 + q4 * 4 + e];
                *(f32x4*)(A.out + (size_t)t * D + col) = xo; }
    }
}
#endif
__device__ __forceinline__ void experts_unit4(const Ctx& F, KArgs A, int l, int t0, LAS unsigned char* ring, const LAS unsigned short* il, const LAS float* wl) {
    const bf16* H = (const bf16*)(A.ws + WS_H); const unsigned char* UE = A.ws + WS_UE; const unsigned char* VE = A.ws + WS_VE;
    const float* US = (const float*)(A.ws + WS_US); const float* VS = (const float*)(A.ws + WS_VS);
    const unsigned lo16b = (unsigned)F.lane * 16u;
#if EPI_HOIST
    static_assert(NORM_FOLD, "EPI_HOIST: x1 comes from the token loop");
    EpiC EC; epi_coeffs(EC, F, A, l, t0);
#endif
#if H2C_HOIST
    float cg[16], csh[16];
    { const float* mb = (const float*)(A.ws + WS_MOD) + ((size_t)l * 8 + (t0 >> 11)) * 6144; const float* g2 = A.in[I_GN2] + (size_t)l * D;
#pragma unroll
      for (int i = 0; i < 4; ++i) { const int col = (i >> 1) * 512 + 8 * F.lane + 4 * (i & 1);
          const f32x4 gg = *(const f32x4*)(g2 + col), sc = *(const f32x4*)(mb + 4096 + col), sh = *(const f32x4*)(mb + 3072 + col);
#pragma unroll
          for (int e = 0; e < 4; ++e) { cg[4 * i + e] = gg[e] * (1.0f + sc[e]); csh[4 * i + e] = sh[e]; } } }
#endif
#if X1_PREFETCH
    f32x4 xn[4];
    auto ldx1 = [&](f32x4 (&xv)[4], int tok) {
        const bf16* xr = (const bf16*)(A.ws + WS_X1B) + (size_t)tok * D + 8 * F.lane; const v4u a = *(const v4u*)xr, b = *(const v4u*)(xr + 512);
        xv[0] = (f32x4){bflo(a.x), bfhi(a.x), bflo(a.y), bfhi(a.y)}; xv[1] = (f32x4){bflo(a.z), bfhi(a.z), bflo(a.w), bfhi(a.w)};
        xv[2] = (f32x4){bflo(b.x), bfhi(b.x), bflo(b.y), bfhi(b.y)}; xv[3] = (f32x4){bflo(b.z), bfhi(b.z), bflo(b.w), bfhi(b.w)}; };
    ldx1(xn, t0);
#endif
    int nidx0 = il[F.lane];
#if ROW_OFFS
    int nro0 = nidx0 * (int)EROW;
#else
#define nro0 nidx0
#define ro0 idx0
#define ro1 idx1
#endif
    { NextB nb{UE, nro0, 0};
#pragma unroll
      for (int j = 0; j < 16; ++j) dma_row(nb, j, lo16b, ring + j * 1024); }
    v4u raw = (v4u){0u, 0u, 0u, 0u};
#pragma unroll 1
    for (int k = 0; k < 4; ++k) {
        const int t = t0 + k; const int idx0 = nidx0, idx1 = il[k * 128 + 64 + F.lane]; const float wx0k = wl[k * 128 + F.lane], wx1k = wl[k * 128 + 64 + F.lane];
#if ROW_OFFS
        const int ro0 = nro0, ro1 = idx1 * (int)EROW;
#endif
        nidx0 = il[(k < 3 ? k + 1 : 3) * 128 + F.lane];
#if ROW_OFFS
        nro0 = nidx0 * (int)EROW;
#endif
        const float su0 = US[idx0], su1 = US[idx1], sv0 = VS[idx0], sv1 = VS[idx1];
        HQ hq; float x1v[16];
        { float hv[16];
#if NORM_FOLD
          {
              const float* xr = A.out + (size_t)t * D; const float* mb = (const float*)(A.ws + WS_MOD) + ((size_t)l * 8 + (t >> 11)) * 6144; const float* g2 = A.in[I_GN2] + (size_t)l * D;
              float ss = 0.f;
#pragma unroll
              for (int hseg = 0; hseg < 2; ++hseg)
#pragma unroll
                  for (int q4 = 0; q4 < 2; ++q4) {
#if X1_PREFETCH
                      const f32x4 xv = xn[hseg * 2 + q4];
#else
                      const f32x4 xv = *(const f32x4*)(xr + hseg * 512 + 8 * F.lane + 4 * q4);
#endif
#pragma unroll
                      for (int e = 0; e < 4; ++e) { hv[hseg * 8 + q4 * 4 + e] = xv[e]; x1v[hseg * 8 + q4 * 4 + e] = xv[e]; ss += xv[e] * xv[e]; } }
#if X1_PREFETCH
              ldx1(xn, t + (k < 3 ? 1 : 0));
#endif
              const float r = 1.0f / sqrtf(wave_sum(ss) * (1.0f / D) + EPS);
#pragma unroll
              for (int hseg = 0; hseg < 2; ++hseg)
#pragma unroll
#if H2C_HOIST
                  for (int q4 = 0; q4 < 2; ++q4) {
#pragma unroll
                      for (int e = 0; e < 4; ++e) hv[hseg * 8 + q4 * 4 + e] = hv[hseg * 8 + q4 * 4 + e] * r * cg[hseg * 8 + q4 * 4 + e] + csh[hseg * 8 + q4 * 4 + e]; }
#else
                  for (int q4 = 0; q4 < 2; ++q4) { const int col = hseg * 512 + 8 * F.lane + 4 * q4;
                      const f32x4 gg = *(const f32x4*)(g2 + col), sc = *(const f32x4*)(mb + 4096 + col), sh = *(const f32x4*)(mb + 3072 + col);
#pragma unroll
                      for (int e = 0; e < 4; ++e) hv[hseg * 8 + q4 * 4 + e] = hv[hseg * 8 + q4 * 4 + e] * r * gg[e] * (1.0f + sc[e]) + sh[e]; }
#endif
          }
#else
          const v4u ha = *(const v4u*)(H + (size_t)t * D + 8 * F.lane), hb = *(const v4u*)(H + (size_t)t * D + 512 + 8 * F.lane);
          hv[0] = bflo(ha.x); hv[1] = bfhi(ha.x); hv[2] = bflo(ha.y); hv[3] = bfhi(ha.y); hv[4] = bflo(ha.z); hv[5] = bfhi(ha.z); hv[6] = bflo(ha.w); hv[7] = bfhi(ha.w);
          hv[8] = bflo(hb.x); hv[9] = bfhi(hb.x); hv[10] = bflo(hb.y); hv[11] = bfhi(hb.y); hv[12] = bflo(hb.z); hv[13] = bfhi(hb.z); hv[14] = bflo(hb.w); hv[15] = bfhi(hb.w);
#endif
          float am = 0.f;
#pragma unroll
          for (int e = 0; e < 16; ++e) am = fmaxf(am, fabsf(hv[e]));
          am = wave_max(am);
          const float inv1 = am > 0.f ? 127.0f / am : 0.f; hq.s1 = am * (1.0f / 127.0f); hq.s2 = hq.s1 * (1.0f / 254.0f); const float inv2 = inv1 * 254.0f;
#pragma unroll
          for (int w = 0; w < 4; ++w) { unsigned p1 = 0, p2 = 0;
#pragma unroll
              for (int e = 0; e < 4; ++e) { const float h = hv[4 * w + e]; const float a = rintf(h * inv1); const float b = fminf(fmaxf(rintf((h - a * hq.s1) * inv2), -127.f), 127.f);
                  p1 |= ((unsigned)(int)a & 255u) << (8 * e); p2 |= ((unsigned)(int)b & 255u) << (8 * e); }
              hq.q1[w] = (int)p1; hq.q2[w] = (int)p2; }
#if EXP6B
          hq.c1 = -128 * __builtin_amdgcn_sdot4(hq.q1[0], 0x01010101, __builtin_amdgcn_sdot4(hq.q1[2], 0x01010101, 0, false), false);
          hq.c2 = -128 * __builtin_amdgcn_sdot4(hq.q2[0], 0x01010101, __builtin_amdgcn_sdot4(hq.q2[2], 0x01010101, 0, false), false);
          hq.s1 *= 0.25f; hq.s2 *= 0.25f;
#else
          hq.c1 = 0; hq.c2 = 0;
#endif
        }
#if ROW_PIPE
        if (k == 0) { vm_wait<15>(); lds_raw(raw, ring, lo16b); }
#endif
        float act0 = 0.f, act1 = 0.f;
#pragma unroll 1
        for (int q = 0; q < 8; ++q) {
            const int qn = (q + 1) & 7; NextB nb{q < 7 ? UE : VE, qn < 4 ? ro0 : ro1, 16 * (qn & 3)};
            const float tot = consume_u(ring, hq, nb, F.lane, lo16b, raw);
            if ((F.lane >> 4) == (q & 3)) { if (q < 4) act0 = tot; else act1 = tot; }
        }
        act0 *= su0; act1 *= su1;
        const float w0 = wx0k * sv0 * 0.5f * act0 * (1.0f + erff(act0 * 0.7071067811865476f)), w1 = wx1k * sv1 * 0.5f * act1 * (1.0f + erff(act1 * 0.7071067811865476f));
#if V_MFMA
        float o[16];
        { const float cam = wave_max(fmaxf(fabsf(w0), fabsf(w1)));
          const float ci1 = cam > 0.f ? 127.0f / cam : 0.f, S1 = cam * (1.0f / 127.0f), S2 = S1 * (1.0f / 254.0f), ci2 = ci1 * 254.0f;
          int cq0, cq1;
          { const float a = rintf(w0 * ci1), b = fminf(fmaxf(rintf((w0 - a * S1) * ci2), -127.f), 127.f); cq0 = ((int)a & 255) | (((int)b & 255) << 8); }
          { const float a = rintf(w1 * ci1), b = fminf(fmaxf(rintf((w1 - a * S1) * ci2), -127.f), 127.f); cq1 = ((int)a & 255) | (((int)b & 255) << 8); }
          const unsigned sh8 = 8u * ((unsigned)F.lane & 3u);
          v4i a1[4], a2[4];
#pragma unroll
          for (int e = 0; e < 4; ++e) { a1[e] = (v4i){0, 0, 0, 0}; a2[e] = (v4i){0, 0, 0, 0}; }
#pragma unroll 1
          for (int q = 0; q < 7; ++q) {
              const int qn = q + 1; NextB nb{VE, qn < 4 ? ro0 : ro1, 16 * (qn & 3)};
              consume_vm<false>(ring, a1, a2, q < 4 ? cq0 : cq1, 16 * (q & 3), nb, lo16b, sh8, raw);
          }
          if (k < 3) { NextB nb{UE, nro0, 0}; consume_vm<false>(ring, a1, a2, cq1, 48, nb, lo16b, sh8, raw); }
          else { NextB nb{UE, 0, 0}; consume_vm<true>(ring, a1, a2, cq1, 48, nb, lo16b, sh8, raw); }
#if EXP6B
          static_assert(V_PLANES == 1, "6-bit rows: one c plane");
          { const int csum = wave_sumi((int)(signed char)(cq0 & 255) + (int)(signed char)(cq1 & 255));
#pragma unroll
            for (int e = 0; e < 16; ++e) o[e] = ((e >> 2) & 1) ? (0.25f * S1) * (float)a1[e >> 2][e & 3] : S1 * (float)(a1[e >> 2][e & 3] - 32 * csum); }
#else
#pragma unroll
          for (int e = 0; e < 16; ++e) o[e] = S1 * (float)a1[e >> 2][e & 3] + S2 * (float)a2[e >> 2][e & 3];
#endif
        }
#else
        const float csum = wave_sum(w0 + w1);
        float o[16];
#pragma unroll
        for (int e = 0; e < 16; ++e) o[e] = 0.f;
#pragma unroll 1
        for (int q = 0; q < 7; ++q) {
            const int qn = q + 1; NextB nb{VE, qn < 4 ? idx0 : idx1, 16 * (qn & 3)};
            consume_v<false>(ring, o, q < 4 ? w0 : w1, 16 * (q & 3), nb, lo16b);
        }
        if (k < 3) { NextB nb{UE, nidx0, 0}; consume_v<false>(ring, o, w1, 48, nb, lo16b); }
        else { NextB nb{UE, 0, 0}; consume_v<true>(ring, o, w1, 48, nb, lo16b); }
#pragma unroll
        for (int e = 0; e < 16; ++e) o[e] -= 128.0f * csum;
#endif
#if EPI_HOIST
        expert_epilogue_c(F, A, l, t, o, x1v, EC);
#else
        expert_epilogue<(NORM_FOLD) != 0>(F, A, l, t, o, x1v);
#endif
    }
}
#undef UBF
__device__ __forceinline__ void phase_experts(const Ctx& F, KArgs A, int l) {
    const int* IDX = (const int*)(A.ws + WS_IDX); const float* WTS = (const float*)(A.ws + WS_WTS);
    for (int t = F.gw; t < T; t += F.NGW)
        expert_token(F, A, l, t, IDX[(size_t)t * 128 + F.lane], IDX[(size_t)t * 128 + 64 + F.lane], WTS[(size_t)t * 128 + F.lane], WTS[(size_t)t * 128 + 64 + F.lane]);
}
__device__ __forceinline__ void phase_peer(const Ctx& F, KArgs A, int l) {
    LAS unsigned char* scr = F.lds + RING_OFF + F.wave * 16384;
    LAS unsigned short* il = (LAS unsigned short*)(F.lds + HAND_OFF + F.wave * 3072); LAS float* wl = (LAS float*)(F.lds + HAND_OFF + F.wave * 3072 + 1024);
#ifndef PROBE_PEER_CUS
#define PROBE_PEER_CUS 256
#endif
    if (F.vcu >= PROBE_PEER_CUS) return;
#if PEER_DYNAMIC
    unsigned* ctr = (unsigned*)(A.ws + WS_CTL) + CW_PEERQ + 64 * l;
    for (int u = F.gw; u < T / 4; ) {
#else
    for (int u = F.gw; u < T / 4; u += PROBE_PEER_CUS * NWAVES) {
#endif
        Ctx G = F; asm volatile("" : "+v"(G.lane));
        route_unit(G, A, l, u, scr, il, wl, 4 * u);
        LDS_WAIT();
#if EXP_I8 && !DBG_ROUTE32
        asm volatile("" : "+v"(G.lane));
        __builtin_amdgcn_s_setprio(2);
        experts_unit4(G, A, l, 4 * u, scr, il, wl);
        __builtin_amdgcn_s_setprio(0);
#if PEER_DYNAMIC
        { unsigned nu = 0; if (F.lane == 0) nu = __hip_atomic_fetch_add(ctr, 1u, __ATOMIC_RELAXED, __HIP_MEMORY_SCOPE_AGENT); u = (int)__builtin_amdgcn_readfirstlane(nu) + F.NGW; }
#endif
#else
#pragma unroll 1
        for (int k = 0; k < 4; ++k) expert_token(F, A, l, 4 * u + k, il[k * 128 + F.lane], il[k * 128 + 64 + F.lane], wl[k * 128 + F.lane], wl[k * 128 + 64 + F.lane]);
#endif
        LDS_WAIT();
    }
}
__device__ __forceinline__ bool ph_in_range(int k) {
    const __attribute__((address_space(4))) Args* ap_ = (const __attribute__((address_space(4))) Args*)__builtin_amdgcn_kernarg_segment_ptr(); asm volatile("" : "+s"(ap_));
    return ap_->ph_lo <= k && k < ap_->ph_hi;
}
#ifndef FUSE_PEER
#define FUSE_PEER (!DBG_ROUTE32)
#endif
constexpr int PPL = (FUSE_PEER ? 8 : 9) - ((NORM_FOLD) ? 1 : 0);
constexpr int N_PHASES = 2 + PPL * DEPTH;
#ifndef ONLY_MASK
#define ONLY_MASK 0xffffffffu
#endif
#ifndef REP_MASK
#define REP_MASK 0u
#endif
#define ONLY(k, stmt) do { if constexpr ((ONLY_MASK >> (k)) & 1u) { for (int rep_ = 0; rep_ < (((REP_MASK >> (k)) & 1u) ? 2 : 1); ++rep_) { stmt; } } } while (0)
__global__ void __launch_bounds__(NWAVES * 64, 2) mega_fwd(Args args) {
    extern __shared__ __attribute__((aligned(16))) unsigned char lds[];
#define MKARGS() const __attribute__((address_space(4))) Args* ap_ = (const __attribute__((address_space(4))) Args*)__builtin_amdgcn_kernarg_segment_ptr(); asm volatile("" : "+s"(ap_)); KArgs A = *ap_
#define MKCTX() MKARGS(); Ctx F; { int tid_ = threadIdx.x; asm volatile("" : "+v"(tid_)); int bx_ = blockIdx.x; asm volatile("" : "+s"(bx_)); \
        F.lds = (LAS unsigned char*)lds; F.tid = tid_; F.lane = tid_ & 63; F.wave = __builtin_amdgcn_readfirstlane(tid_ >> 6); F.G = gridDim.x; \
        F.vcu = (F.G % 8 == 0) ? (bx_ % 8) * (F.G / 8) + bx_ / 8 : bx_; F.gw = F.vcu * NWAVES + F.wave; F.NGW = F.G * NWAVES; }
    for (int u = threadIdx.x; u < (LDS_BYTES - LDSCTL_OFF) / 4; u += NWAVES * 64) ((LAS unsigned*)((LAS unsigned char*)lds + LDSCTL_OFF))[u] = 0u;
    __syncthreads();
    { MKARGS();
      if (A.ph_hi - A.ph_lo > 1) (void)xcd_barrier_post((unsigned*)(A.ws + WS_CTL) + CW_BAR, (volatile LAS unsigned*)((LAS unsigned char*)lds + MISC_OFF) + 8); }

#define IN(k) ph_in_range(k)
#define SEAM(k) do { if (IN(k) && IN((k) + 1)) { MKARGS(); XcdBarrier b_; b_.bar = (unsigned*)(A.ws + WS_CTL) + CW_BAR; b_.x = xb_xcc_id(); b_.st = (volatile LAS unsigned*)((LAS unsigned char*)lds + MISC_OFF) + 8; xcd_barrier(b_); } } while (0)
    if (IN(0)) { MKCTX(); ONLY(0, phase_pre(F, A)); } SEAM(0);
    if (IN(1)) { MKCTX(); ONLY(1, phase_h0(F, A)); } SEAM(1);
#if DBG_ROUTE32
#define QGEMM(l) do { pg8::Gemm g{(const bf16*)(A.ws + WS_H3), (const bf16*)(A.ws + WS_WQ3), 3072, 3072, 3072, 0, 0}; pg8::StaticOrder S; S.init(T, 2048, F.G, (int)blockIdx.x); \
        pg8::EpiF32 E{(float*)(A.ws + WS_Q32), 2048}; pg8::gemm_phase<pg8::EpiF32, pg8::StaticOrder, true, true>(F.lds + RING_OFF, g, S, E); } while (0)
#define ROUTE_EXTRA(l) phase_expert_convert(F, A, (l))
#define ROUTE(l) phase_route_naive(F, A, (l))
#else
#define QGEMM(l) do { unsigned char* wl = A.ws + WS_W + (size_t)(l) * W_LAYER; \
        pg8::Gemm g{(const bf16*)(A.ws + WS_H), (const bf16*)(wl + W_WQ), D, D, D, 0, 0}; pg8::StaticOrder S; S.init(T, 2048, F.G, (int)blockIdx.x); \
        QEPI(l); } while (0)
#define ROUTE_EXTRA(l) do {} while (0)
#if NORM_FOLD
#define WOEPI(l) pg8::EpiWoN<((l) != 0)> E{A.in[I_X], (const bf16*)A.out, (bf16*)(A.ws + WS_X1B), (const float*)(A.ws + WS_MOD) + (size_t)(l) * 8 * 6144, A.in[I_GN2] + (size_t)(l) * D, (bf16*)(A.ws + WS_H), (float*)(A.ws + WS_SSQ)}; \
        ONLY(9, (pg8::gemm_phase<pg8::EpiWoN<((l) != 0)>, pg8::StaticOrder, true, true>(F.lds + RING_OFF, g, S, E)))
#else
#define WOEPI(l) pg8::EpiWo E{(l) == 0 ? A.in[I_X] : A.out, A.out, (const float*)(A.ws + WS_MOD) + (size_t)(l) * 8 * 6144 + 2048}; \
        ONLY(9, (pg8::gemm_phase<pg8::EpiWo, pg8::StaticOrder, true, true>(F.lds + RING_OFF, g, S, E)))
#endif
#if NORM_FOLD
#define QEPI(l) pg8::EpiQN E{(bf16*)(A.ws + WS_Q2), (const float*)(A.ws + WS_SSQ), (const float*)(A.ws + WS_CQ) + (size_t)(l) * 8 * 2048, EPS}; \
        pg8::gemm_phase<pg8::EpiQN, pg8::StaticOrder, true, true>(F.lds + RING_OFF, g, S, E)
#else
#define QEPI(l) pg8::EpiBf16 E{(bf16*)(A.ws + WS_Q2), 2048}; \
        pg8::gemm_phase<pg8::EpiBf16, pg8::StaticOrder, true, true>(F.lds + RING_OFF, g, S, E)
#endif
#define ROUTE(l) phase_route(F, A, (l))
#endif
#ifndef NAIVE_MIX
#define NAIVE_MIX 0
#endif
#if NAIVE_MIX & 1
#define MIX_SWA(l) phase_swa_naive(F, A, (l))
#else
#define MIX_SWA(l) phase_swa2(F, A, (l))
#endif
#if NAIVE_MIX & 2
#define MIX_POOL(l) phase_pool_naive(F, A, (l))
#else
#define MIX_POOL(l) phase_pool(F, A, (l))
#endif
#define LAYER(l) do { \
    constexpr int P0_ = 2 + PPL * (l); \
    if (IN(P0_ + 0)) { MKCTX(); unsigned char* wl = A.ws + WS_W + (size_t)(l) * W_LAYER; \
        pg8::Gemm g{(const bf16*)(A.ws + WS_H), (const bf16*)(wl + W_WIN), D, D, D, 0, 0}; pg8::StaticOrder S; S.init(T, NIN, F.G, (int)blockIdx.x); \
        pg8::EpiProj E{(bf16*)(A.ws + WS_PROJ), (bf16*)(A.ws + WS_GATES)}; \
        ONLY(2, (pg8::gemm_phase<pg8::EpiProj, pg8::StaticOrder, true, true>(F.lds + RING_OFF, g, S, E))); \
        if (EXP_I8_OWN && (int)blockIdx.x >= 64) expert_quant(A, (l), F.lane, ((int)blockIdx.x - 64) * NWAVES + F.wave, (F.G - 64) * NWAVES);     \
        } \
    SEAM(P0_ + 0); \
    if (IN(P0_ + 1)) { { MKARGS(); \
        const attn_body::AttnTensors AT{(const attn_body::bf16*)(A.ws + WS_PROJ), (const attn_body::bf16*)(A.ws + WS_PROJ), (const attn_body::bf16*)(A.ws + WS_PROJ), (attn_body::bf16*)(A.ws + WS_O)}; \
        const attn_body::StaticOrder S((int)gridDim.x, (int)blockIdx.x); \
        ONLY(3, attn_body::attn_phase<attn_body::StaticOrder>((char*)lds + RING_OFF, AT, S)); } \
        { MKCTX(); ONLY(4, MIX_SWA(l)); ONLY(5, phase_conv_naive(F, A, (l))); ONLY(6, MIX_POOL(l)); } } \
    SEAM(P0_ + 1); \
    if (IN(P0_ + 2)) { MKCTX(); ONLY(7, phase_ya(F, A, (l))); } \
    SEAM(P0_ + 2); \
    if (IN(P0_ + 3)) { MKCTX(); unsigned char* wl = A.ws + WS_W + (size_t)(l) * W_LAYER; \
        pg8::Gemm g{(const bf16*)(A.ws + WS_Y), (const bf16*)(wl + W_WBR), 2048, 512, 512, (size_t)512 * 2, (size_t)D * 512 * 2}; pg8::ZOrder<4> S; S.init(T, D, F.G, (int)blockIdx.x); \
        pg8::EpiMergeK E{(const bf16*)(A.ws + WS_GATES), (bf16*)(A.ws + WS_O)}; \
        ONLY(8, (pg8::gemm_phase<pg8::EpiMergeK, pg8::ZOrder<4>, true, true>(F.lds + RING_OFF, g, S, E))); } \
    SEAM(P0_ + 3); \
    if (IN(P0_ + 4)) { MKCTX(); unsigned char* wl = A.ws + WS_W + (size_t)(l) * W_LAYER; \
        pg8::Gemm g{(const bf16*)(A.ws + WS_O), (const bf16*)(wl + W_WO), D, D, D, 0, 0}; pg8::StaticOrder S; S.init(T, D, F.G, (int)blockIdx.x); \
        WOEPI(l); } \
    SEAM(P0_ + 4); \
    if constexpr (!(NORM_FOLD)) { \
        if (IN(P0_ + 5)) { MKCTX(); ONLY(10, phase_h2(F, A, (l))); } \
        SEAM(P0_ + 5); \
    } \
    constexpr int PQ_ = P0_ + ((NORM_FOLD) ? 5 : 6); \
    if (IN(PQ_)) { MKCTX(); ONLY(11, QGEMM(l)); } \
    SEAM(PQ_); \
    if constexpr (FUSE_PEER) { \
        if (IN(PQ_ + 1)) { MKCTX(); ONLY(13, phase_peer(F, A, (l))); } \
        SEAM(PQ_ + 1); \
    } else { \
        if (IN(PQ_ + 1)) { MKCTX(); ONLY(12, ROUTE(l)); ROUTE_EXTRA(l); } \
        SEAM(PQ_ + 1); \
        if (IN(PQ_ + 2)) { MKCTX(); ONLY(13, phase_experts(F, A, (l))); } \
        SEAM(PQ_ + 2); \
    } \
} while (0)
    LAYER(0);
    LAYER(1);
#undef LAYER
#undef IN
#undef SEAM
}

#ifndef MK_SINGLE
#define MK_SINGLE 1
#endif
extern "C" void kernel_launch(void* const* d_in, const int* in_sizes, int n_in, void* d_out, int out_size, void* d_ws, size_t ws_size, hipStream_t stream) {
    static int grid = 0;
    if (grid == 0) {
        if (n_in != N_IN || in_sizes[0] != T * D || out_size != T * D || ws_size < WS_END) { fprintf(stderr, "kernel_launch: unexpected shapes: n_in %d in0 %d out %d ws %zu\n", n_in, n_in > 0 ? in_sizes[0] : -1, out_size, ws_size); grid = -1; return; }
        int dev = 0, cus = 0;
        if (hipGetDevice(&dev) != hipSuccess || hipDeviceGetAttribute(&cus, hipDeviceAttributeMultiprocessorCount, dev) != hipSuccess) { grid = -1; return; }
        if (hipFuncSetAttribute((const void*)mega_fwd, hipFuncAttributeMaxDynamicSharedMemorySize, LDS_BYTES) != hipSuccess) { fprintf(stderr, "kernel_launch: hipFuncSetAttribute failed\n"); grid = -1; return; }
        (void)hipGetLastError();
        grid = cus;
        if (grid != 256) fprintf(stderr, "kernel_launch: %d CUs; this kernel is built for 256\n", grid);
    }
    if (grid < 0) return;
    if (hipMemsetAsync((char*)d_ws + WS_CTL, 0, CTL_ZERO_BYTES, stream) != hipSuccess) return;
    Args a{};
    for (int i = 0; i < N_IN; ++i) a.in[i] = (const float*)d_in[i];
    a.out = (float*)d_out; a.ws = (unsigned char*)d_ws;
#if MK_SINGLE
    a.ph_lo = 0; a.ph_hi = N_PHASES;
    hipLaunchKernelGGL(mega_fwd, dim3(grid), dim3(NWAVES * 64), LDS_BYTES, stream, a);
#else
    for (int ph = 0; ph < N_PHASES; ++ph) { a.ph_lo = ph; a.ph_hi = ph + 1; hipLaunchKernelGGL(mega_fwd, dim3(grid), dim3(NWAVES * 64), LDS_BYTES, stream, a); }
#endif
}
```

```cpp
#include <hip/hip_runtime.h>
#include <cstdio>
#include <cstdint>
#include <type_traits>
namespace pg8 {
#define PG8_LAS __attribute__((address_space(3)))
typedef unsigned short bf16_t;
typedef short bf16x8 __attribute__((ext_vector_type(8)));
typedef float f32x4 __attribute__((ext_vector_type(4)));
typedef unsigned u32x4 __attribute__((ext_vector_type(4)));
constexpr int BM = 256, BK = 64, HALF = 128, HTB = HALF * BK * 2  , STAGE_BYTES = 8 * HTB, NXCD = 8, WGM = 8;

__host__ __device__ __forceinline__ int lds_byte(int r, int c) { const int st = (r >> 4) * 2 + (c >> 5), rr = r & 15, cc = c & 31, ob = rr * 64 + cc * 2; return st * 1024 + (ob ^ (((ob >> 9) & 1) << 5)); }
__host__ __device__ __forceinline__ void stage_rc(int b, int& R, int& C) { const int st = b / 1024, sb = b % 1024, swz = sb ^ (((sb >> 9) & 1) << 5); R = (st >> 1) * 16 + swz / 64; C = (st & 1) * 32 + (swz % 64) / 2; }
__host__ __device__ __forceinline__ int perm32(int rho) { const int n = rho >> 4, i = rho & 15; return 8 * (i >> 2) + 4 * n + (i & 3); }

struct Unit { int pm, pn, z; };
struct Gemm { const bf16_t* A; const bf16_t* Bt; int lda, ldb, K; size_t zA, zB; };

struct StaticOrder {
    int nM, nN, nwg, G, c;
    __host__ __device__ void init(int M, int N, int G_, int c_) { nM = M / BM; nN = N / BM; nwg = nM * nN; G = G_; c = c_; }
    __host__ __device__ bool next(int i, Unit& u) const {
        const long L = (long)i * G + c; if (L >= nwg) return false;
        int wgid = (int)L; { const int q = nwg / NXCD, r = nwg % NXCD, xcd = wgid % NXCD, off = wgid / NXCD; wgid = (xcd < r ? xcd * (q + 1) : r * (q + 1) + (xcd - r) * q) + off; }
        const int nig = WGM * nN, gid = wgid / nig, fm = gid * WGM, gsz = (nM - fm) < WGM ? (nM - fm) : WGM;
        u.pm = fm + ((wgid % nig) % gsz); u.pn = (wgid % nig) / gsz; u.z = 0; return true;
    }
    __device__ __forceinline__ void a_ready(const Unit&) const {}
    __device__ __forceinline__ void done(const Unit&) const {}
};
template <int NZ> struct ZOrder {
    StaticOrder S;
    __host__ __device__ void init(int M, int N, int G_, int c_) { S.init(M, N, G_, c_); }
    __host__ __device__ bool next(int i, Unit& u) const { if (!S.next(i / NZ, u)) return false; u.z = i % NZ; return true; }
    __device__ __forceinline__ void a_ready(const Unit&) const {}
    __device__ __forceinline__ void done(const Unit&) const {}
};

__device__ __forceinline__ unsigned cvt_pk_bf16(float lo, float hi) { unsigned r; asm volatile("v_cvt_pk_bf16_f32 %0, %1, %2" : "=v"(r) : "v"(lo), "v"(hi)); return r; }
__device__ __forceinline__ float bf_lo(unsigned w) { return __builtin_bit_cast(float, w << 16); }
__device__ __forceinline__ float bf_hi(unsigned w) { return __builtin_bit_cast(float, w & 0xffff0000u); }
__device__ __forceinline__ float sigmoidf_(float x) { return __builtin_amdgcn_rcpf(1.0f + __expf(-x)); }

__device__ __forceinline__ void store_lines(bf16_t* p, size_t ldc_rows8  , int fr, u32x4 w0, u32x4 w1) {
    const bool up = fr & 8;
    u32x4 x = up ? w0 : w1, r;
    r.x = (unsigned)__builtin_amdgcn_mov_dpp((int)x.x, 0x128, 0xF, 0xF, true); r.y = (unsigned)__builtin_amdgcn_mov_dpp((int)x.y, 0x128, 0xF, 0xF, true);
    r.z = (unsigned)__builtin_amdgcn_mov_dpp((int)x.z, 0x128, 0xF, 0xF, true); r.w = (unsigned)__builtin_amdgcn_mov_dpp((int)x.w, 0x128, 0xF, 0xF, true);
    bf16_t* pa = up ? p - ldc_rows8 + 32 : p; bf16_t* pb = up ? p + 32 : p + ldc_rows8;
    *(u32x4*)pa = up ? r : w0;
    *(u32x4*)pb = up ? w1 : r;
}
struct EpiBf16 {
    static constexpr bool PERM = true, AFTER_DRAIN = false;
    static __device__ __forceinline__ bool keeps_acc(const Unit&) { return false; }
    bf16_t* O; int ldc;
    __device__ __forceinline__ void operator()(const f32x4 (&acc)[2][2][4][2], const Unit& u, int wr, int wc, int fr, int fq) const {
        const int row0 = u.pm * BM + wr * 64 + fr, col0 = u.pn * BM + wc * 64 + 8 * fq;
#pragma unroll
        for (int ai = 0; ai < 2; ++ai)
#pragma unroll
            for (int m = 0; m < 4; ++m) { bf16_t* rowp = O + (size_t)(row0 + ai * HALF + m * 16) * ldc + col0;
                u32x4 w[2];
#pragma unroll
                for (int bj = 0; bj < 2; ++bj) { const f32x4 v0 = acc[ai][bj][m][0], v1 = acc[ai][bj][m][1];
                    w[bj].x = cvt_pk_bf16(v0[0], v0[1]); w[bj].y = cvt_pk_bf16(v0[2], v0[3]); w[bj].z = cvt_pk_bf16(v1[0], v1[1]); w[bj].w = cvt_pk_bf16(v1[2], v1[3]); }
                store_lines(rowp, (size_t)8 * ldc, fr, w[0], w[1]); }
    }
};
struct EpiProj {
    static constexpr bool PERM = true, AFTER_DRAIN = false;
    static __device__ __forceinline__ bool keeps_acc(const Unit&) { return false; }
    bf16_t* proj; bf16_t* gates;
    __device__ __forceinline__ void operator()(const f32x4 (&acc)[2][2][4][2], const Unit& u, int wr, int wc, int fr, int fq) const {
        const bool isg = u.pn >= 17; bf16_t* base = isg ? gates : proj; const int ldc = isg ? 4096 : 4352;
        const int row0 = u.pm * BM + wr * 64 + fr, col0 = (isg ? u.pn - 17 : u.pn) * BM + wc * 64 + 8 * fq;
#pragma unroll
        for (int ai = 0; ai < 2; ++ai)
#pragma unroll
            for (int m = 0; m < 4; ++m) { bf16_t* rowp = base + (size_t)(row0 + ai * HALF + m * 16) * ldc + col0;
                if (isg) {
                    f32x4 E[4];
#pragma unroll
                    for (int z = 0; z < 4; ++z)
#pragma unroll
                        for (int e = 0; e < 4; ++e) E[z][e] = 1.0f + __expf(-acc[ai][z >> 1][m][z & 1][e]);
                    bf16_t* gp = gates + (size_t)(row0 + ai * HALF + m * 16) * 4096 + (u.pn - 17) * 64 + wc * 16 + 4 * fq;
#pragma unroll
                    for (int z = 0; z < 4; ++z) { f32x4 f;
#pragma unroll
                        for (int e = 0; e < 4; ++e) f[e] = (z < 3 ? E[z + 1][e] : 1.0f) * __builtin_amdgcn_rcpf(E[z][e]);
                        typedef unsigned u32x2 __attribute__((ext_vector_type(2)));
                        u32x2 w; w.x = cvt_pk_bf16(f[0], f[1]); w.y = cvt_pk_bf16(f[2], f[3]); *(u32x2*)(gp + z * 1024) = w; }
                } else {
                { u32x4 w[2];
#pragma unroll
                for (int bj = 0; bj < 2; ++bj) { const f32x4 v0 = acc[ai][bj][m][0], v1 = acc[ai][bj][m][1];
                    w[bj].x = cvt_pk_bf16(v0[0], v0[1]); w[bj].y = cvt_pk_bf16(v0[2], v0[3]); w[bj].z = cvt_pk_bf16(v1[0], v1[1]); w[bj].w = cvt_pk_bf16(v1[2], v1[3]); }
                store_lines(rowp, (size_t)8 * ldc, fr, w[0], w[1]); } } }
    }
};
struct EpiMerge {
    static constexpr bool PERM = true, AFTER_DRAIN = false;
    static __device__ __forceinline__ bool keeps_acc(const Unit&) { return false; }
    const bf16_t* gates; float* s32; bf16_t* s16;
    __device__ __forceinline__ void operator()(const f32x4 (&acc)[2][2][4][2], const Unit& u, int wr, int wc, int fr, int fq) const {
        const int row0 = u.pm * BM + wr * 64 + fr, col0 = u.pn * BM + wc * 64 + 8 * fq, z = u.z;
#pragma unroll
        for (int ai = 0; ai < 2; ++ai)
#pragma unroll
            for (int m = 0; m < 4; ++m) { const size_t row = (size_t)(row0 + ai * HALF + m * 16);
#pragma unroll
                for (int bj = 0; bj < 2; ++bj) { const int col = col0 + bj * 32;
                    const u32x4 gw = *(const u32x4*)(gates + row * 4096 + (size_t)z * 1024 + col);
                    f32x4 v0 = acc[ai][bj][m][0], v1 = acc[ai][bj][m][1];
                    v0[0] *= bf_lo(gw.x); v0[1] *= bf_hi(gw.x); v0[2] *= bf_lo(gw.y); v0[3] *= bf_hi(gw.y);
                    v1[0] *= bf_lo(gw.z); v1[1] *= bf_hi(gw.z); v1[2] *= bf_lo(gw.w); v1[3] *= bf_hi(gw.w);
                    float* sp = s32 + row * 1024 + col;
                    if (z > 0) { v0 += *(const f32x4*)sp; v1 += *(const f32x4*)(sp + 4); }
                    if (z < 3) { *(f32x4*)sp = v0; *(f32x4*)(sp + 4) = v1; }
                    else { u32x4 w; w.x = cvt_pk_bf16(v0[0], v0[1]); w.y = cvt_pk_bf16(v0[2], v0[3]); w.z = cvt_pk_bf16(v1[0], v1[1]); w.w = cvt_pk_bf16(v1[2], v1[3]);
                        *(u32x4*)(s16 + row * 1024 + col) = w; } } }
    }
};
struct EpiWo {
    static constexpr bool PERM = false, AFTER_DRAIN = false;
    static __device__ __forceinline__ bool keeps_acc(const Unit&) { return false; }
    const float* xin; float* out; const float* gate;
    __device__ __forceinline__ void operator()(const f32x4 (&acc)[2][2][4][2], const Unit& u, int wr, int wc, int fr, int fq) const {
        const int row0 = u.pm * BM + wr * 64 + fr, col0 = u.pn * BM + wc * 32 + 4 * fq; const float* gb = gate + (size_t)(u.pm >> 3) * 6144;
#pragma unroll
        for (int bj = 0; bj < 2; ++bj)
#pragma unroll
            for (int n = 0; n < 2; ++n) { const int col = col0 + bj * HALF + n * 16; const f32x4 gv = *(const f32x4*)(gb + col);
#pragma unroll
                for (int ai = 0; ai < 2; ++ai)
#pragma unroll
                    for (int m = 0; m < 4; ++m) { const size_t off = (size_t)(row0 + ai * HALF + m * 16) * 1024 + col;
                        const f32x4 o = *(const f32x4*)(xin + off) + gv * acc[ai][bj][m][n]; *(f32x4*)(out + off) = o; } }
    }
};

struct EpiF32 {
    static constexpr bool PERM = false, AFTER_DRAIN = false;
    static __device__ __forceinline__ bool keeps_acc(const Unit&) { return false; }
    float* O; int ldc;
    __device__ __forceinline__ void operator()(const f32x4 (&acc)[2][2][4][2], const Unit& u, int wr, int wc, int fr, int fq) const {
        const int row0 = u.pm * BM + wr * 64 + fr, col0 = u.pn * BM + wc * 32 + 4 * fq;
#pragma unroll
        for (int bj = 0; bj < 2; ++bj)
#pragma unroll
            for (int n = 0; n < 2; ++n)
#pragma unroll
                for (int ai = 0; ai < 2; ++ai)
#pragma unroll
                    for (int m = 0; m < 4; ++m) *(f32x4*)(O + (size_t)(row0 + ai * HALF + m * 16) * ldc + col0 + bj * HALF + n * 16) = acc[ai][bj][m][n];
    }
};

template <bool XB> struct EpiWoN {
    static constexpr bool PERM = true, AFTER_DRAIN = false;
    static __device__ __forceinline__ bool keeps_acc(const Unit&) { return false; }
    const float* xin; const bf16_t* xinb; bf16_t* x1b; const float* modl; const float* g2; bf16_t* hb; float* ssq;
    __device__ __forceinline__ void operator()(const f32x4 (&acc)[2][2][4][2], const Unit& u, int wr, int wc, int fr, int fq) const {
        const int row0 = u.pm * BM + wr * 64 + fr, col0 = u.pn * BM + wc * 64 + 8 * fq; const float* mb = modl + (size_t)(u.pm >> 3) * 6144;
        f32x4 gv[2][2], gm[2][2];
#pragma unroll
        for (int bj = 0; bj < 2; ++bj)
#pragma unroll
            for (int n = 0; n < 2; ++n) { const int col = col0 + bj * 32 + 4 * n; gv[bj][n] = *(const f32x4*)(mb + 2048 + col); gm[bj][n] = *(const f32x4*)(g2 + col) * (*(const f32x4*)(mb + 4096 + col) + 1.0f); }
#pragma unroll
        for (int ai = 0; ai < 2; ++ai)
#pragma unroll
            for (int m = 0; m < 4; ++m) { const size_t rowoff = (size_t)(row0 + ai * HALF + m * 16) * 1024 + col0; float sq = 0.f;
                u32x4 wx[2], wh[2];
#pragma unroll
                for (int bj = 0; bj < 2; ++bj) { f32x4 x0, x1;
                    if constexpr (XB) { const u32x4 xw = *(const u32x4*)(xinb + rowoff + bj * 32); x0 = (f32x4){bf_lo(xw.x), bf_hi(xw.x), bf_lo(xw.y), bf_hi(xw.y)}; x1 = (f32x4){bf_lo(xw.z), bf_hi(xw.z), bf_lo(xw.w), bf_hi(xw.w)}; }
                    else { x0 = *(const f32x4*)(xin + rowoff + bj * 32); x1 = *(const f32x4*)(xin + rowoff + bj * 32 + 4); }
                    const f32x4 o0 = x0 + gv[bj][0] * acc[ai][bj][m][0], o1 = x1 + gv[bj][1] * acc[ai][bj][m][1];
                    sq += ((o0[0] * o0[0] + o0[1] * o0[1]) + (o0[2] * o0[2] + o0[3] * o0[3])) + ((o1[0] * o1[0] + o1[1] * o1[1]) + (o1[2] * o1[2] + o1[3] * o1[3]));
                    wx[bj].x = cvt_pk_bf16(o0[0], o0[1]); wx[bj].y = cvt_pk_bf16(o0[2], o0[3]); wx[bj].z = cvt_pk_bf16(o1[0], o1[1]); wx[bj].w = cvt_pk_bf16(o1[2], o1[3]);
                    const f32x4 a0 = o0 * gm[bj][0], a1 = o1 * gm[bj][1];
                    wh[bj].x = cvt_pk_bf16(a0[0], a0[1]); wh[bj].y = cvt_pk_bf16(a0[2], a0[3]); wh[bj].z = cvt_pk_bf16(a1[0], a1[1]); wh[bj].w = cvt_pk_bf16(a1[2], a1[3]); }
                store_lines(x1b + rowoff, (size_t)8 * 1024, fr, wx[0], wx[1]);
                store_lines(hb + rowoff, (size_t)8 * 1024, fr, wh[0], wh[1]);
                sq += __shfl_xor(sq, 16); sq += __shfl_xor(sq, 32);
                if (fq == 0) ssq[(size_t)(row0 + ai * HALF + m * 16) * 16 + u.pn * 4 + wc] = sq; }
    }
};
struct EpiQN {
    static constexpr bool PERM = true, AFTER_DRAIN = false;
    static __device__ __forceinline__ bool keeps_acc(const Unit&) { return false; }
    bf16_t* O; const float* ssq; const float* cq; float eps;
    __device__ __forceinline__ void operator()(const f32x4 (&acc)[2][2][4][2], const Unit& u, int wr, int wc, int fr, int fq) const {
        const int row0 = u.pm * BM + wr * 64 + fr, col0 = u.pn * BM + wc * 64 + 8 * fq; const float* cb = cq + (size_t)(u.pm >> 3) * 2048 + col0;
        f32x4 c[2][2];
#pragma unroll
        for (int bj = 0; bj < 2; ++bj) { c[bj][0] = *(const f32x4*)(cb + bj * 32); c[bj][1] = *(const f32x4*)(cb + bj * 32 + 4); }
#pragma unroll
        for (int ai = 0; ai < 2; ++ai)
#pragma unroll
            for (int m = 0; m < 4; ++m) { const int row = row0 + ai * HALF + m * 16; const f32x4* sp = (const f32x4*)(ssq + (size_t)row * 16);
                const f32x4 s0 = sp[0], s1 = sp[1], s2 = sp[2], s3 = sp[3];
                const float ss = ((((s0[0] + s0[1]) + (s0[2] + s0[3])) + ((s1[0] + s1[1]) + (s1[2] + s1[3]))) + (((s2[0] + s2[1]) + (s2[2] + s2[3])) + ((s3[0] + s3[1]) + (s3[2] + s3[3]))));
                const float r = 1.0f / sqrtf(ss * (1.0f / 1024.0f) + eps);
                bf16_t* rowp = O + (size_t)row * 2048 + col0;
                u32x4 w[2];
#pragma unroll
                for (int bj = 0; bj < 2; ++bj) { const f32x4 v0 = acc[ai][bj][m][0] * r + c[bj][0], v1 = acc[ai][bj][m][1] * r + c[bj][1];
                    w[bj].x = cvt_pk_bf16(v0[0], v0[1]); w[bj].y = cvt_pk_bf16(v0[2], v0[3]); w[bj].z = cvt_pk_bf16(v1[0], v1[1]); w[bj].w = cvt_pk_bf16(v1[2], v1[3]); }
                store_lines(rowp, (size_t)8 * 2048, fr, w[0], w[1]); }
    }
};

struct EpiMergeK {
    static constexpr bool PERM = true, AFTER_DRAIN = false;
    static __device__ __forceinline__ bool keeps_acc(const Unit& u) { return u.z < 3; }
    const bf16_t* gates; bf16_t* s16;
    __device__ __forceinline__ void operator()(f32x4 (&acc)[2][2][4][2], const Unit& u, int wr, int wc, int fr, int fq) const {
        const int row0 = u.pm * BM + wr * 64 + fr, col0 = u.pn * BM + wc * 64 + 8 * fq, z = u.z;
#pragma unroll
        for (int ai = 0; ai < 2; ++ai)
#pragma unroll
            for (int m = 0; m < 4; ++m) { const size_t row = (size_t)(row0 + ai * HALF + m * 16);
#pragma unroll
                for (int bj = 0; bj < 2; ++bj) { const int col = col0 + bj * 32;
                    const u32x4 gw = *(const u32x4*)(gates + row * 4096 + (size_t)z * 1024 + col);
                    const float g[8] = {bf_lo(gw.x), bf_hi(gw.x), bf_lo(gw.y), bf_hi(gw.y), bf_lo(gw.z), bf_hi(gw.z), bf_lo(gw.w), bf_hi(gw.w)};
                    f32x4 v0 = acc[ai][bj][m][0], v1 = acc[ai][bj][m][1];
                    v0[0] *= g[0]; v0[1] *= g[1]; v0[2] *= g[2]; v0[3] *= g[3]; v1[0] *= g[4]; v1[1] *= g[5]; v1[2] *= g[6]; v1[3] *= g[7];
                    if (z < 3) { acc[ai][bj][m][0] = v0; acc[ai][bj][m][1] = v1; }
                    else { u32x4 w; w.x = cvt_pk_bf16(v0[0], v0[1]); w.y = cvt_pk_bf16(v0[2], v0[3]); w.z = cvt_pk_bf16(v1[0], v1[1]); w.w = cvt_pk_bf16(v1[2], v1[3]);
                        *(u32x4*)(s16 + row * 1024 + col) = w; } } }
    }
};

template <class Epi, class Sched, bool ALIGN_EPI = false, bool SP2 = false>
__device__ __forceinline__ void gemm_phase(PG8_LAS unsigned char* lds, const Gemm g, const Sched& S, const Epi& E) {
    const int tid = threadIdx.x, wid = __builtin_amdgcn_readfirstlane(tid >> 6), lane = tid & 63, wr = wid >> 2, wc = wid & 3, fr = lane & 15, fq = lane >> 4;
    const int K = g.K, nt = K / BK;
    unsigned voffA[2], voffB[2];
#pragma unroll
    for (int i = 0; i < 2; ++i) { int R, C; stage_rc(tid * 16 + i * 8192, R, C); const int Rb = Epi::PERM ? (64 * (R >> 5) + perm32(R & 31)) : R;
        voffA[i] = (unsigned)(R * g.lda + C) * 2u; voffB[i] = (unsigned)(Rb * g.ldb + C) * 2u; }
    const size_t kstep = (size_t)(BK * 2);
    const size_t hstepA = (size_t)HALF * g.lda * 2, hstepB = (size_t)(Epi::PERM ? 32 : HALF) * g.ldb * 2;
    const size_t tstepA = 2 * hstepA, tstepB = (size_t)BM * g.ldb * 2;
    const unsigned ldsw = (unsigned)wid * 1024u;
    const int aoff = lds_byte(wr * 64 + fr, fq * 8), boff = lds_byte(wc * 32 + fr, fq * 8);
#define PG8_SA(b, h) (((b) * 2 + (h)) * HTB)
#define PG8_SB(b, h) ((4 + (b) * 2 + (h)) * HTB)
#define PG8_STAGE(bufoff, gbase, voff) do { _Pragma("unroll") for (int _i = 0; _i < 2; ++_i) \
        __builtin_amdgcn_global_load_lds((const unsigned*)((const char*)(gbase) + (voff)[_i]), (PG8_LAS unsigned*)(lds + (bufoff) + ldsw + _i * 8192), 16, 0, 0); } while (0)
#define PG8_LDA(dst, b, h) do { _Pragma("unroll") for (int m = 0; m < 4; ++m) _Pragma("unroll") for (int k = 0; k < 2; ++k) dst[m][k] = *(const PG8_LAS bf16x8*)(lds + PG8_SA(b, h) + aoff + m * 2048 + k * 1024); } while (0)
#define PG8_LDB(dst, b, h) do { _Pragma("unroll") for (int n = 0; n < 2; ++n) _Pragma("unroll") for (int k = 0; k < 2; ++k) dst[n][k] = *(const PG8_LAS bf16x8*)(lds + PG8_SB(b, h) + boff + n * 2048 + k * 1024); } while (0)
#define PG8_MMA(ai, bj, At, Bt) do { __builtin_amdgcn_s_setprio(1); _Pragma("unroll") for (int m = 0; m < 4; ++m) _Pragma("unroll") for (int n = 0; n < 2; ++n) _Pragma("unroll") for (int k = 0; k < 2; ++k) \
        acc[ai][bj][m][n] = __builtin_amdgcn_mfma_f32_16x16x32_bf16(Bt[n][k], At[m][k], acc[ai][bj][m][n], 0, 0, 0); __builtin_amdgcn_s_setprio(0); } while (0)
#define PG8_WAIT_V(n) asm volatile("s_waitcnt vmcnt(" #n ")" ::: "memory")
#define PG8_WAIT_L(n) asm volatile("s_waitcnt lgkmcnt(" #n ")" ::: "memory")
#define PG8_BAR __builtin_amdgcn_s_barrier()
#define PG8_SCHED __builtin_amdgcn_sched_barrier(0)
    Unit cur, nxt; int ui = 0;
    if (!S.next(0, cur)) return;
    f32x4 acc[2][2][4][2];
#pragma unroll
    for (int a = 0; a < 2; ++a)
#pragma unroll
        for (int b = 0; b < 2; ++b)
#pragma unroll
            for (int m = 0; m < 4; ++m)
#pragma unroll
                for (int n = 0; n < 2; ++n) acc[a][b][m][n] = (f32x4){0.f, 0.f, 0.f, 0.f};
    bf16x8 At[4][2], B0[2][2], B1[2][2];
    const char* cA = (const char*)g.A + (size_t)cur.pm * tstepA + (size_t)cur.z * g.zA; const char* cB = (const char*)g.Bt + (size_t)cur.pn * tstepB + (size_t)cur.z * g.zB;
    S.a_ready(cur);
    if constexpr (SP2) {
        PG8_STAGE(PG8_SB(0, 0), cB, voffB); PG8_STAGE(PG8_SB(0, 1), cB + hstepB, voffB); PG8_STAGE(PG8_SA(0, 0), cA, voffA); PG8_STAGE(PG8_SA(0, 1), cA + hstepA, voffA);
        if (wr == 1) PG8_BAR;
        PG8_WAIT_V(2); PG8_BAR;
        PG8_STAGE(PG8_SB(1, 0), cB + kstep, voffB); PG8_STAGE(PG8_SA(1, 0), cA + kstep, voffA); PG8_STAGE(PG8_SB(1, 1), cB + hstepB + kstep, voffB);
        PG8_WAIT_V(6); PG8_BAR;
    } else {
        PG8_STAGE(PG8_SB(0, 0), cB, voffB); PG8_STAGE(PG8_SA(0, 0), cA, voffA); PG8_STAGE(PG8_SB(0, 1), cB + hstepB, voffB); PG8_STAGE(PG8_SA(0, 1), cA + hstepA, voffA);
        if (wr == 1) PG8_BAR;
        PG8_WAIT_V(4); PG8_BAR;
        PG8_STAGE(PG8_SB(1, 0), cB + kstep, voffB); PG8_STAGE(PG8_SA(1, 0), cA + kstep, voffA); PG8_STAGE(PG8_SB(1, 1), cB + hstepB + kstep, voffB);
        PG8_WAIT_V(6); PG8_BAR;
    }
    for (;;) {
        const bool has_next = S.next(ui + 1, nxt);
        const char* nA = has_next ? (const char*)g.A + (size_t)nxt.pm * tstepA + (size_t)nxt.z * g.zA : cA; const char* nB = has_next ? (const char*)g.Bt + (size_t)nxt.pn * tstepB + (size_t)nxt.z * g.zB : cB;
        for (int t = 0; t < nt; t += 2) {
            const bool last = (t == nt - 2);
            const char* a1 = cA + (size_t)(t + 1) * kstep;
            const char* a2 = last ? nA : cA + (size_t)(t + 2) * kstep; const char* b2 = last ? nB : cB + (size_t)(t + 2) * kstep;
            const char* a3 = a2 + kstep; const char* b3 = b2 + kstep;
            if (last && has_next) S.a_ready(nxt);
            if constexpr (SP2) {
            PG8_LDB(B0, 0, 0); PG8_LDB(B1, 0, 1); PG8_SCHED; PG8_LDA(At, 0, 0); PG8_STAGE(PG8_SA(1, 1), a1 + hstepA, voffA);
            PG8_WAIT_V(8); PG8_WAIT_L(0); PG8_BAR; PG8_MMA(0, 0, At, B0); PG8_MMA(0, 1, At, B1); PG8_BAR; PG8_SCHED;
            PG8_LDA(At, 0, 1); PG8_STAGE(PG8_SB(0, 0), b2, voffB); PG8_STAGE(PG8_SB(0, 1), b2 + hstepB, voffB); PG8_STAGE(PG8_SA(0, 0), a2, voffA);
            PG8_WAIT_V(8); PG8_WAIT_L(0); PG8_BAR; PG8_MMA(1, 0, At, B0); PG8_MMA(1, 1, At, B1); PG8_BAR; PG8_SCHED;
            PG8_LDB(B0, 1, 0); PG8_LDB(B1, 1, 1); PG8_SCHED; PG8_LDA(At, 1, 0); PG8_STAGE(PG8_SA(0, 1), a2 + hstepA, voffA);
            PG8_WAIT_V(8); PG8_WAIT_L(0); PG8_BAR; PG8_MMA(0, 0, At, B0); PG8_MMA(0, 1, At, B1); PG8_BAR; PG8_SCHED;
            PG8_LDA(At, 1, 1); PG8_STAGE(PG8_SB(1, 0), b3, voffB); PG8_STAGE(PG8_SB(1, 1), b3 + hstepB, voffB); PG8_STAGE(PG8_SA(1, 0), a3, voffA);
            PG8_WAIT_V(8); PG8_WAIT_L(0); PG8_BAR; PG8_MMA(1, 0, At, B0); PG8_MMA(1, 1, At, B1); PG8_BAR; PG8_SCHED;
            } else {
            PG8_LDB(B0, 0, 0); PG8_SCHED; PG8_LDA(At, 0, 0); PG8_STAGE(PG8_SA(1, 1), a1 + hstepA, voffA);
            PG8_WAIT_L(8); PG8_BAR; PG8_WAIT_L(0); PG8_MMA(0, 0, At, B0); PG8_BAR; PG8_SCHED;
            PG8_LDB(B1, 0, 1); PG8_STAGE(PG8_SB(0, 0), b2, voffB);
            PG8_BAR; PG8_WAIT_L(0); PG8_MMA(0, 1, At, B1); PG8_BAR;
            PG8_LDA(At, 0, 1); PG8_STAGE(PG8_SA(0, 0), a2, voffA);
            PG8_BAR; PG8_WAIT_L(0); PG8_MMA(1, 0, At, B0); PG8_BAR; PG8_SCHED;
            PG8_STAGE(PG8_SB(0, 1), b2 + hstepB, voffB);
            PG8_WAIT_V(6); PG8_BAR; PG8_MMA(1, 1, At, B1); PG8_BAR;
            PG8_LDB(B0, 1, 0); PG8_SCHED; PG8_LDA(At, 1, 0); PG8_STAGE(PG8_SA(0, 1), a2 + hstepA, voffA);
            PG8_WAIT_L(8); PG8_BAR; PG8_WAIT_L(0); PG8_MMA(0, 0, At, B0); PG8_BAR; PG8_SCHED;
            PG8_LDB(B1, 1, 1); PG8_STAGE(PG8_SB(1, 0), b3, voffB);
            PG8_BAR; PG8_WAIT_L(0); PG8_MMA(0, 1, At, B1); PG8_BAR;
            PG8_LDA(At, 1, 1); PG8_STAGE(PG8_SA(1, 0), a3, voffA);
            PG8_BAR; PG8_WAIT_L(0); PG8_MMA(1, 0, At, B0); PG8_BAR; PG8_SCHED;
            PG8_STAGE(PG8_SB(1, 1), b3 + hstepB, voffB);
            PG8_WAIT_V(6); PG8_BAR; PG8_MMA(1, 1, At, B1); PG8_BAR;
            }
        }
        if constexpr (ALIGN_EPI) { if (wr == 0) PG8_BAR; }
        if constexpr (!Epi::AFTER_DRAIN) { E(acc, cur, wr, wc, fr, fq); S.done(cur); }
        if (!has_next) break;
        if (!Epi::keeps_acc(cur)) {
#pragma unroll
        for (int a = 0; a < 2; ++a)
#pragma unroll
            for (int b = 0; b < 2; ++b)
#pragma unroll
                for (int m = 0; m < 4; ++m)
#pragma unroll
                    for (int n = 0; n < 2; ++n) acc[a][b][m][n] = (f32x4){0.f, 0.f, 0.f, 0.f};
        }
        cur = nxt; cA = nA; cB = nB; ++ui;
        if constexpr (ALIGN_EPI) { if (wr == 1) PG8_BAR; }
    }
    PG8_WAIT_V(0);
    if constexpr (!ALIGN_EPI) { if (wr == 0) PG8_BAR; }
    PG8_BAR;
    if constexpr (Epi::AFTER_DRAIN) { E.fused(acc, cur, wr, wc, fr, fq, lds, wid, lane); S.done(cur); }
#undef PG8_SA
#undef PG8_SB
#undef PG8_STAGE
#undef PG8_LDA
#undef PG8_LDB
#undef PG8_MMA
#undef PG8_WAIT_V
#undef PG8_WAIT_L
#undef PG8_BAR
#undef PG8_SCHED
}
}

#ifndef PG8_SP2
#define PG8_SP2 true
#endif
#ifndef PG8_ALIGN
#define PG8_ALIGN true
#endif
#include <hip/hip_bf16.h>
#include <cmath>
namespace attn_body {
using bf16=__hip_bfloat16;
using bf16x8=__attribute__((ext_vector_type(8)))short;
using s16x4=__attribute__((ext_vector_type(4)))short;
using f32x16=__attribute__((ext_vector_type(16)))float;
using u32x4=__attribute__((ext_vector_type(4)))unsigned;
constexpr int SEQ=2048,D=64,PQ=4352,PK=4352,PV=4352,PO=1024;
constexpr int NW=8,QBLK=32,QB=QBLK*NW,KVBLK=64,NQB=SEQ/QB;
constexpr int ATTN_UNIT_ROWS=QB;
__device__ __forceinline__ int crow(int r,int hi){return (r&3)+8*(r>>2)+4*hi;}
#define SBAR() __builtin_amdgcn_sched_barrier(0)
__device__ __forceinline__ void cmask(f32x16&p0,f32x16&p1,int jb,int qrel,int hi){
  const float NEG=-INFINITY; int kb=64*jb+4*hi;
  #pragma unroll
  for(int r=0;r<16;++r){int kv=kb+(r&3)+8*(r>>2); if(kv>qrel)p0[r]=NEG; if(kv+32>qrel)p1[r]=NEG;}
}

constexpr int NSLOT=3, SLOTB=8192;
constexpr int LDS_K=0, LDS_V=NSLOT*SLOTB, LDS_WS=2*NSLOT*SLOTB, LDS_OST=LDS_WS+NW*64*4, LDS_BYTES=LDS_OST+NW*4096;
constexpr float C2=0.125f*1.4426950408889634f;
__device__ __forceinline__ void glds16(const void*gsrc,unsigned lds_dst){unsigned keep;
  asm volatile("s_mov_b32 %0, m0\n\ts_mov_b32 m0, %2\n\ts_nop 0\n\tglobal_load_lds_dwordx4 %1, off\n\ts_mov_b32 m0, %0":"=&s"(keep):"v"(gsrc),"s"(lds_dst):"memory");}
__device__ __forceinline__ float max3f(float a,float b,float c){float r;asm("v_max3_f32 %0, %1, %2, %3":"=v"(r):"v"(a),"v"(b),"v"(c));return r;}
__device__ __forceinline__ float max2f(float a,float b){float r;asm("v_max_f32_e32 %0, %1, %2":"=v"(r):"v"(a),"v"(b));return r;}
__device__ __forceinline__ float fadd_s(float a,float b){float r;asm("v_add_f32_e32 %0, %1, %2":"=v"(r):"v"(a),"v"(b));return r;}
__device__ __forceinline__ float fsub_s(float a,float b){float r;asm("v_sub_f32_e32 %0, %1, %2":"=v"(r):"v"(a),"v"(b));return r;}
typedef float f32x2_t __attribute__((ext_vector_type(2))); typedef __bf16 bf16x2_t __attribute__((ext_vector_type(2)));
__device__ __forceinline__ unsigned cvtpk_s(float lo,float hi){f32x2_t v={lo,hi};bf16x2_t b=__builtin_convertvector(v,bf16x2_t);return __builtin_bit_cast(unsigned,b);}
#define WAIT_BAR(N) asm volatile("s_waitcnt vmcnt(" #N ") lgkmcnt(0)\n\ts_barrier":::"memory")

__device__ __forceinline__ void qkt(f32x16&p0,f32x16&p1,const char*Kslot,const bf16x8*qr,const f32x16&negm,int r32,int hi){
  const char*kb=Kslot+hi*1024+r32*16;
  #pragma unroll
  for(int d0=0;d0<4;++d0){
    const bf16x8 b0=*reinterpret_cast<const bf16x8*>(kb+d0*2048);
    const bf16x8 b1=*reinterpret_cast<const bf16x8*>(kb+d0*2048+512);
    if(d0==0){p0=__builtin_amdgcn_mfma_f32_32x32x16_bf16(b0,qr[0],negm,0,0,0);p1=__builtin_amdgcn_mfma_f32_32x32x16_bf16(b1,qr[0],negm,0,0,0);}
    else{p0=__builtin_amdgcn_mfma_f32_32x32x16_bf16(b0,qr[d0],p0,0,0,0);p1=__builtin_amdgcn_mfma_f32_32x32x16_bf16(b1,qr[d0],p1,0,0,0);}}
}
typedef __attribute__((address_space(3))) const char* lds_cptr;
typedef short v4i16_t __attribute__((ext_vector_type(4)));
__device__ __forceinline__ void kload8(bf16x8*kf,lds_cptr kp){
  kf[0]=*(const __attribute__((address_space(3))) bf16x8*)(kp);      kf[1]=*(const __attribute__((address_space(3))) bf16x8*)(kp+512);
  kf[2]=*(const __attribute__((address_space(3))) bf16x8*)(kp+2048); kf[3]=*(const __attribute__((address_space(3))) bf16x8*)(kp+2560);
  kf[4]=*(const __attribute__((address_space(3))) bf16x8*)(kp+4096); kf[5]=*(const __attribute__((address_space(3))) bf16x8*)(kp+4608);
  kf[6]=*(const __attribute__((address_space(3))) bf16x8*)(kp+6144); kf[7]=*(const __attribute__((address_space(3))) bf16x8*)(kp+6656);
}
__device__ __forceinline__ void kload2(bf16x8*kf,lds_cptr kp,int j){ kf[2*j]=*(const __attribute__((address_space(3))) bf16x8*)(kp+j*2048); kf[2*j+1]=*(const __attribute__((address_space(3))) bf16x8*)(kp+j*2048+512); }
__device__ __forceinline__ s16x4 vtr(lds_cptr p){ return __builtin_bit_cast(s16x4,__builtin_amdgcn_ds_read_tr16_b64_v4i16((__attribute__((address_space(3))) v4i16_t*)p)); }
__device__ __forceinline__ float rowmax(const f32x16&p0,const f32x16&p1){
  float a=max3f(p0[0],p0[1],p1[0]),b=max3f(p0[2],p0[3],p1[1]);a=max3f(a,p1[2],p1[3]);
  #pragma unroll
  for(int r=4;r<16;r+=4){a=max3f(a,p0[r],p0[r+1]);b=max3f(b,p0[r+2],p0[r+3]);a=max3f(a,p1[r],p1[r+1]);b=max3f(b,p1[r+2],p1[r+3]);}
  const float m=max2f(a,b);
  auto rr=__builtin_amdgcn_permlane32_swap(__float_as_uint(m),__float_as_uint(m),false,false);
  return max2f(__uint_as_float(rr[0]),__uint_as_float(rr[1]));
}
__device__ __forceinline__ void pv(f32x16*o,int vb,bf16x8 pa0,bf16x8 pa1,bf16x8 pa2,bf16x8 pa3){
  #pragma unroll
  for(int d0=0;d0<2;++d0){s16x4 lo[4],hi[4];
    #pragma unroll
    for(int ks=0;ks<4;++ks){
      asm volatile("ds_read_b64_tr_b16 %0,%1 offset:%c2":"=&v"(lo[ks]):"v"(vb),"i"(d0*4096+ks*1024):"memory");
      asm volatile("ds_read_b64_tr_b16 %0,%1 offset:%c2":"=&v"(hi[ks]):"v"(vb),"i"(d0*4096+ks*1024+512):"memory");}
    asm volatile("s_waitcnt lgkmcnt(0)":::"memory");SBAR();
    #define PK(k) (bf16x8){lo[k][0],lo[k][1],lo[k][2],lo[k][3],hi[k][0],hi[k][1],hi[k][2],hi[k][3]}
    o[d0]=__builtin_amdgcn_mfma_f32_32x32x16_bf16(pa0,PK(0),o[d0],0,0,0);
    o[d0]=__builtin_amdgcn_mfma_f32_32x32x16_bf16(pa1,PK(1),o[d0],0,0,0);
    o[d0]=__builtin_amdgcn_mfma_f32_32x32x16_bf16(pa2,PK(2),o[d0],0,0,0);
    o[d0]=__builtin_amdgcn_mfma_f32_32x32x16_bf16(pa3,PK(3),o[d0],0,0,0);
    #undef PK
  }
}

#ifndef ATTN_STORE16
#define ATTN_STORE16(p,v) (*(u32x4*)(p)=(v))
#endif
template<int THRL> __device__ __forceinline__ void attn_unit(int b,int qcol,int kcol,int vcol,int ocol,int qb,const bf16*Q,const bf16*__restrict__ K,const bf16*__restrict__ V,bf16*O,char*shm){
  const int tid=threadIdx.x,lane=tid&63,r32=lane&31,hi=lane>>5; const int wid=__builtin_amdgcn_readfirstlane(tid>>6);
  const long rowbase=(long)b*SEQ; const int q0=qb*QB;
  const bf16*Qw=Q+(rowbase+q0+wid*QBLK)*PQ+qcol;
  const bf16*Kh=K+rowbase*PK+kcol,*Vh=V+rowbase*PV+vcol;
  const unsigned lds0=(unsigned)(uintptr_t)shm;
  float*wsf=(float*)(shm+LDS_WS)+wid*64;
  const bf16*ksrc=Kh+(long)lane*PK+wid*8;
  const bf16*vsrc=Vh+(long)(16*(wid&3)+(lane>>2))*PV+(wid>>2)*32+(lane&3)*8;
  const unsigned kdst=lds0+LDS_K+wid*1024, vdst=lds0+LDS_V+wid*1024;
  #define DMA_K(t,slot) glds16(ksrc+(long)(t)*KVBLK*PK,(unsigned)__builtin_amdgcn_readfirstlane(kdst+(slot)))
  #define DMA_V(t,slot) glds16(vsrc+(long)(t)*KVBLK*PV,(unsigned)__builtin_amdgcn_readfirstlane(vdst+(slot)))
  const int vb0=(int)(lds0+LDS_V)+((lane>>4)&1)*32+(lane&3)*8+(4*hi+((lane&15)>>2))*64;
  const char*Kbase=shm+LDS_K; bf16x8 kf[8];
  const lds_cptr shm3=(lds_cptr)shm; const lds_cptr kp0=shm3+LDS_K+hi*1024+r32*16; const lds_cptr vp0=shm3+LDS_V+((lane>>4)&1)*32+(lane&3)*8+(4*hi+((lane&15)>>2))*64;
  const int NT=(q0+QB)/KVBLK;
  DMA_K(0,0);DMA_V(0,0);DMA_K(1,SLOTB);
  bf16x8 qr[4];
  #pragma unroll
  for(int d0=0;d0<4;++d0)qr[d0]=*reinterpret_cast<const bf16x8*>(&Qw[(long)r32*PQ+d0*16+hi*8]);
  float mhat=0.f,l_reg=0.f;f32x16 o[2];o[0]=f32x16{};o[1]=f32x16{};f32x16 negm=f32x16{};asm volatile("":"+v"(negm));
  const int qrel=wid*QBLK+r32;
  #define CMASK(P0,P1,t) do{int jb_=(t)-(NT-4); if(jb_>=0)cmask(P0,P1,jb_,qrel,hi);}while(0)
  bool resc=false;
  #define START(P0,P1) do{ const float rm=rowmax(P0,P1); resc=false; \
    { const float dl=rm; mhat=fadd_s(mhat,dl); \
      _Pragma("unroll") for(int r=0;r<16;++r){P0[r]=fsub_s(P0[r],dl);P1[r]=fsub_s(P1[r],dl);} \
      _Pragma("unroll") for(int r=0;r<16;++r)negm[r]=-mhat; asm volatile("":"+v"(negm)); } \
    _Pragma("unroll") for(int r=0;r<16;++r)P0[r]=__builtin_amdgcn_exp2f(P0[r]); }while(0)
  #define RESC() do{ if(resc){ asm volatile("s_waitcnt lgkmcnt(0)":::"memory"); \
      _Pragma("unroll") for(int d_=0;d_<2;++d_) _Pragma("unroll") for(int r=0;r<16;++r)o[d_][r]*=wsf[crow(r,hi)]; } }while(0)
  f32x16 pA0,pA1,pB0,pB1;
  int sl_prev=0,sl_cur=0,sl_next=SLOTB;
  #define ROT() do{sl_prev=sl_cur;sl_cur=sl_next;sl_next=(sl_next==(NSLOT-1)*SLOTB)?0:sl_next+SLOTB;}while(0)
  DMA_K(2,2*SLOTB);
  WAIT_BAR(3);
  qkt(pA0,pA1,Kbase,qr,negm,r32,hi);asm volatile("s_nop 15\n\ts_nop 7":"+v"(pA0),"+v"(pA1));CMASK(pA0,pA1,0);
  START(pA0,pA1);
  _Pragma("unroll") for(int r=0;r<16;++r)pA1[r]=__builtin_amdgcn_exp2f(pA1[r]);
  WAIT_BAR(0);
  DMA_K(3,0);DMA_V(1,SLOTB);
  ROT();
  kload8(kf,kp0+sl_cur);
  WAIT_BAR(2);
  s16x4 vlo[8],vhi[8]; u32x4 pw0,pw1,pw2,pw3;
  #define PKW(P,B) cvtpk_s(P[B],P[B+1])
  #define PAF(k) __builtin_bit_cast(bf16x8,pw##k)
  #define VFR(i) (bf16x8){vlo[i][0],vlo[i][1],vlo[i][2],vlo[i][3],vhi[i][0],vhi[i][1],vhi[i][2],vhi[i][3]}
  #define PIN(x) asm volatile("":"+v"(x))
  #define MX3(a,b,c) __builtin_fmaxf(__builtin_fmaxf((a),(b)),(c))
  #define GAPA(MF,A0,A1,A2,A3,W0,W1,PW) do{ MF; sacc+=A0; sacc+=A1; sacc+=A2; sacc+=A3; PIN(sacc); W0; W1; PIN(PW); SBAR(); }while(0)
  #define EX(v) __builtin_amdgcn_exp2f(v)
  #define GAPB(MF,X,B) do{ MF; X[B]=EX(X[B]); X[B+1]=EX(X[B+1]); X[B+2]=EX(X[B+2]); X[B+3]=EX(X[B+3]); PIN(X); SBAR(); }while(0)
  #define VRD(i) do{ vlo[i]=vtr(vp_+(((i)>>2)*4096+((i)&3)*1024)); vhi[i]=vtr(vp_+(((i)>>2)*4096+((i)&3)*1024+512)); }while(0)
  #define KRD(G,j) do{ if(G){ kload2(kf,kp0+sl_next,j); SBAR(); } }while(0)
  #define STEP(C0,C1,P0,P1,t,GK,GV,GL) do{ SBAR(); \
    const lds_cptr vp_=vp0+sl_prev; \
    VRD(0); SBAR(); float sacc=(P0[0]+P0[1]); \
    GAPA(C0=__builtin_amdgcn_mfma_f32_32x32x16_bf16(kf[0],qr[0],negm,0,0,0), P0[2],P0[3],P0[4],P0[5],     pw0[0]=PKW(P0,0), pw0[1]=PKW(P0,2), pw0); \
    VRD(4); SBAR(); GAPA(C1=__builtin_amdgcn_mfma_f32_32x32x16_bf16(kf[1],qr[0],negm,0,0,0), P0[6],P0[7],P0[8],P0[9],     pw0[2]=PKW(P0,4), pw0[3]=PKW(P0,6), pw0); \
    VRD(1); SBAR(); GAPA(C0=__builtin_amdgcn_mfma_f32_32x32x16_bf16(kf[2],qr[1],C0,0,0,0),   P0[10],P0[11],P0[12],P0[13], pw1[0]=PKW(P0,8), pw1[1]=PKW(P0,10), pw1); \
    VRD(5); SBAR(); GAPA(C1=__builtin_amdgcn_mfma_f32_32x32x16_bf16(kf[3],qr[1],C1,0,0,0),   P0[14],P0[15],P1[0],P1[1],   pw1[2]=PKW(P0,12),pw1[3]=PKW(P0,14), pw1); \
    VRD(2); SBAR(); GAPA(C0=__builtin_amdgcn_mfma_f32_32x32x16_bf16(kf[4],qr[2],C0,0,0,0),   P1[2],P1[3],P1[4],P1[5],     pw2[0]=PKW(P1,0), pw2[1]=PKW(P1,2), pw2); \
    VRD(6); SBAR(); GAPA(C1=__builtin_amdgcn_mfma_f32_32x32x16_bf16(kf[5],qr[2],C1,0,0,0),   P1[6],P1[7],P1[8],P1[9],     pw2[2]=PKW(P1,4), pw2[3]=PKW(P1,6), pw2); \
    VRD(3); SBAR(); GAPA(C0=__builtin_amdgcn_mfma_f32_32x32x16_bf16(kf[6],qr[3],C0,0,0,0),   P1[10],P1[11],P1[12],P1[13], pw3[0]=PKW(P1,8), pw3[1]=PKW(P1,10), pw3); \
    VRD(7); SBAR(); GAPA(C1=__builtin_amdgcn_mfma_f32_32x32x16_bf16(kf[7],qr[3],C1,0,0,0),   P1[14],P1[15],0.f,0.f,       pw3[2]=PKW(P1,12),pw3[3]=PKW(P1,14), pw3); \
    l_reg+=sacc; \
    if(GK){DMA_K((t)+3,sl_cur);} if(GV){DMA_V((t)+1,sl_next);} \
    CMASK(C0,C1,t); \
    { float a=MX3(C0[0],C0[1],C1[0]),b=MX3(C0[2],C0[3],C1[1]); a=MX3(a,C1[2],C1[3]); \
      _Pragma("unroll") for(int r=4;r<16;r+=4){a=MX3(a,C0[r],C0[r+1]);b=MX3(b,C0[r+2],C0[r+3]);a=MX3(a,C1[r],C1[r+1]);b=MX3(b,C1[r+2],C1[r+3]);} \
      float rm=__builtin_fmaxf(a,b); { auto rr=__builtin_amdgcn_permlane32_swap(__float_as_uint(rm),__float_as_uint(rm),false,false); rm=__builtin_fmaxf(__uint_as_float(rr[0]),__uint_as_float(rr[1])); } \
      resc=false; \
      if(__builtin_expect(__any(rm>(float)THRL),0)){ const float dl=__builtin_fmaxf(rm,0.f); mhat+=dl; \
        _Pragma("unroll") for(int r=0;r<16;++r){C0[r]-=dl;C1[r]-=dl;} \
        _Pragma("unroll") for(int r=0;r<16;++r)negm[r]=-mhat; asm volatile("":"+v"(negm)); \
        const float f=__builtin_amdgcn_exp2f(-dl); l_reg*=f; if(hi==0)wsf[r32]=f; resc=true; } } \
    SBAR(); \
    GAPB(o[0]=__builtin_amdgcn_mfma_f32_32x32x16_bf16(PAF(0),VFR(0),o[0],0,0,0), C0,0); \
    GAPB(o[1]=__builtin_amdgcn_mfma_f32_32x32x16_bf16(PAF(0),VFR(4),o[1],0,0,0), C0,4); \
    KRD(GL,0); GAPB(o[0]=__builtin_amdgcn_mfma_f32_32x32x16_bf16(PAF(1),VFR(1),o[0],0,0,0), C0,8); \
    KRD(GL,1); GAPB(o[1]=__builtin_amdgcn_mfma_f32_32x32x16_bf16(PAF(1),VFR(5),o[1],0,0,0), C0,12); \
    KRD(GL,2); GAPB(o[0]=__builtin_amdgcn_mfma_f32_32x32x16_bf16(PAF(2),VFR(2),o[0],0,0,0), C1,0); \
    KRD(GL,3); GAPB(o[1]=__builtin_amdgcn_mfma_f32_32x32x16_bf16(PAF(2),VFR(6),o[1],0,0,0), C1,4); \
    GAPB(o[0]=__builtin_amdgcn_mfma_f32_32x32x16_bf16(PAF(3),VFR(3),o[0],0,0,0), C1,8); \
    GAPB(o[1]=__builtin_amdgcn_mfma_f32_32x32x16_bf16(PAF(3),VFR(7),o[1],0,0,0), C1,12); \
    }while(0)
  int t=1;
  #undef CMASK
  #define CMASK(P0,P1,t) do{}while(0)
  for(;t+5<NT;t+=2){
    STEP(pB0,pB1,pA0,pA1,t,true,true,true);     WAIT_BAR(2); RESC(); ROT();
    STEP(pA0,pA1,pB0,pB1,t+1,true,true,true);   WAIT_BAR(2); RESC(); ROT();
  }
  #undef CMASK
  #define CMASK(P0,P1,t) do{int jb_=(t)-(NT-4); if(jb_>=0)cmask(P0,P1,jb_,qrel,hi);}while(0)
  #define ENDW(tt) do{ if((tt)+3<NT){WAIT_BAR(2);} else if((tt)+2<NT){WAIT_BAR(1);} else {WAIT_BAR(0);} }while(0)
  for(;t+1<NT;t+=2){
    STEP(pB0,pB1,pA0,pA1,t,(t+3<NT),(t+1<NT),(t+1<NT));       ENDW(t);   RESC(); ROT();
    STEP(pA0,pA1,pB0,pB1,t+1,(t+4<NT),(t+2<NT),(t+2<NT));     ENDW(t+1); RESC(); ROT();
  }
  STEP(pB0,pB1,pA0,pA1,NT-1,false,false,false); RESC();
  { float sacc=pB0[0]+pB0[1]; _Pragma("unroll") for(int r=2;r<16;++r)sacc+=pB0[r]; _Pragma("unroll") for(int r=0;r<16;++r)sacc+=pB1[r]; l_reg+=sacc;
    pw0=(u32x4){PKW(pB0,0),PKW(pB0,2),PKW(pB0,4),PKW(pB0,6)};pw1=(u32x4){PKW(pB0,8),PKW(pB0,10),PKW(pB0,12),PKW(pB0,14)};pw2=(u32x4){PKW(pB1,0),PKW(pB1,2),PKW(pB1,4),PKW(pB1,6)};pw3=(u32x4){PKW(pB1,8),PKW(pB1,10),PKW(pB1,12),PKW(pB1,14)};
    SBAR(); pv(o,vb0+sl_cur,PAF(0),PAF(1),PAF(2),PAF(3)); }
  #undef PKW
  #undef PAF
  #undef VFR
  #undef PIN
  #undef MX3
  #undef GAPA
  #undef GAPB
  #undef EX
  #undef VRD
  #undef KRD
  #undef STEP
  #undef ENDW
  {auto rr=__builtin_amdgcn_permlane32_swap(__float_as_uint(l_reg),__float_as_uint(l_reg),false,false);l_reg=__uint_as_float(rr[0])+__uint_as_float(rr[1]);}
  if(hi==0)wsf[32+r32]=l_reg;asm volatile("s_waitcnt lgkmcnt(0)":::"memory");
  float rli[16];
  #pragma unroll
  for(int r=0;r<16;++r)rli[r]=__builtin_amdgcn_rcpf(wsf[32+crow(r,hi)]);
  bf16*Ow=O+(rowbase+q0+wid*QBLK)*PO+ocol;
  { bf16*stg=(bf16*)(shm+LDS_OST)+wid*2048;
    #pragma unroll
    for(int r=0;r<16;++r){const int orow=crow(r,hi);
      #pragma unroll
      for(int d0=0;d0<2;++d0)stg[orow*64+d0*32+r32]=__float2bfloat16(o[d0][r]*rli[r]);}
    asm volatile("s_waitcnt lgkmcnt(0)":::"memory");
    #pragma unroll
    for(int i=0;i<4;++i){const int row=i*8+(lane>>3),ch=lane&7; const u32x4 v=*(const u32x4*)(stg+row*64+ch*8); ATTN_STORE16(Ow+(long)row*PO+ch*8,v);} }
  asm volatile("s_waitcnt lgkmcnt(0)\n\ts_barrier":::"memory");
  #undef DMA_K
  #undef DMA_V
  #undef CMASK
  #undef START
  #undef RESC
  #undef ROT
}
constexpr int ATTN_LDS_BYTES=LDS_BYTES;
struct AttnTensors { const bf16* Q; const bf16* K; const bf16* V; bf16* O; };
struct AttnUnit { int bj; int qb; };
struct StaticOrder {
  int vcu;
  __device__ __forceinline__ explicit StaticOrder(int grid,int block):vcu((block%8)*(grid/8)+block/8){}
  __device__ __forceinline__ bool next(int i,AttnUnit&u)const{ if(i>=4)return false; const int s0=2*(vcu&1); u.bj=vcu>>1; u.qb=(i==0)?s0:(i==1)?7-s0:(i==2)?s0+1:6-s0; return true; }
};
template<class Sched,int THRL=8> __device__ __forceinline__ void attn_phase(char*lds,const AttnTensors&T,const Sched&S){
  AttnUnit u;
  for(int i=0;S.next(i,u);++i){ const int b=u.bj>>4,j=u.bj&15,h=j>>2,c=(j>>1)&1,vh=j&1;
    attn_unit<THRL>(b,h*128+c*64,512+h*128+c*64,1024+h*128+vh*64,j*64,u.qb,T.Q,T.K,T.V,T.O,lds); }
}
#undef SBAR
#undef WAIT_BAR
}
constexpr int NWAVES = 8;
constexpr int NB = 8, SEQ = 2048, T = NB * SEQ, D = 1024, DEPTH = 2;
constexpr int NPROJ = 4352, NGATE = 4096, NIN = 8448;
constexpr float EPS = 1e-6f;
constexpr float C2 = 0.125f * 1.4426950408889634f;
constexpr float LOG2E = 1.4426950408889634f;
constexpr int C_AQ = 0, C_AK = 512, C_AV = 1024, C_BB = 1536, C_BC = 2048, C_BX = 2560, C_CZ = 3072, C_DQ = 3584, C_DK = 4096, C_DV = 4224;
enum { I_X = 0, I_C, I_WADA, I_BADA, I_GN1, I_WIN, I_LQ1, I_LK1, I_LQ2, I_LK2, I_GSUB, I_CONVW, I_WPOOL, I_PSCALE, I_SINKS, I_WBR, I_WO, I_GN2, I_WQ, I_SK, I_UE, I_VE, I_GFIN, N_IN };

constexpr size_t MiB = 1u << 20;
constexpr size_t WS_CTL = 0, CTL_ZERO_BYTES = 1 * MiB;
constexpr size_t WS_MOD = 1 * MiB;
constexpr size_t WS_W = 2 * MiB, W_LAYER = 27 * MiB;
constexpr size_t W_WIN = 0, W_WBR = 16 * MiB + MiB / 2, W_WO = W_WBR + 4 * MiB, W_WQ = W_WO + 2 * MiB, W_SK = W_WQ + 4 * MiB, W_WP = W_SK + 65536;
constexpr size_t WS_H = 56 * MiB;
constexpr size_t WS_PROJ = 88 * MiB;
constexpr size_t WS_S32 = WS_PROJ;
constexpr size_t WS_Q2 = WS_PROJ;
#ifndef DBG_ROUTE32
#define DBG_ROUTE32 0
#endif
#if DBG_ROUTE32
constexpr size_t WS_H3 = WS_PROJ;
constexpr size_t WS_Q32 = 224 * MiB;
constexpr size_t WS_IDX = 416 * MiB, WS_WTS = WS_IDX + 8 * MiB;
#else
constexpr size_t WS_IDX = WS_PROJ + 64 * MiB, WS_WTS = WS_IDX + 8 * MiB;
#endif
constexpr size_t WS_GATES = 224 * MiB;
constexpr size_t WS_Y = 352 * MiB;
constexpr size_t WS_X1B = WS_Y;
#ifndef EXP_I8
#define EXP_I8 1
#endif
#define EXP_I8_OWN (EXP_I8 && !DBG_ROUTE32)
#if DBG_ROUTE32
constexpr size_t WS_UE = WS_PROJ, WS_VE = WS_PROJ + 32 * MiB;
constexpr size_t WS_WQ3 = WS_Y;
#else
#if EXP_I8_OWN
constexpr size_t WS_UE = 448 * MiB, WS_VE = 464 * MiB;
#else
constexpr size_t WS_UE = WS_GATES, WS_VE = WS_GATES + 32 * MiB;
#endif
#endif
constexpr size_t WS_US = 480 * MiB, WS_VS = WS_US + 65536;
constexpr size_t WS_O = 416 * MiB;
#ifndef NORM_FOLD
#define NORM_FOLD (!DBG_ROUTE32)
#ifndef EPI_HOIST
#define EPI_HOIST 1
#endif
#ifndef H2C_HOIST
#define H2C_HOIST 1
#endif
#ifndef X1_PREFETCH
#define X1_PREFETCH 1
#endif
#ifndef V_ABID
#define V_ABID 1
#endif
#ifndef ROUTE_SORTNET
#define ROUTE_SORTNET 1
#endif
#ifndef H_PLANES
#define H_PLANES 1
#endif
#ifndef TREE_BANKMASK
#define TREE_BANKMASK 1
#endif
#ifndef ROUTE_BATCH
#define ROUTE_BATCH 4
#endif
#ifndef ROW_OFFS
#define ROW_OFFS 1
#endif
#ifndef DMA_NOMASK
#define DMA_NOMASK 1
#endif
#ifndef ROW_PIPE
#define ROW_PIPE 1
#endif
#ifndef EXP6B
#define EXP6B 1
#endif
#ifndef V_PLANES
#define V_PLANES 1
#endif
constexpr unsigned EROW = EXP6B ? 768u : 1024u;
#ifndef V_MFMA
#define V_MFMA 1
#endif
#endif
constexpr size_t WS_SSQ = 481 * MiB;
constexpr size_t WS_CQ = WS_MOD + 512 * 1024;
constexpr size_t WS_END = (EXP_I8_OWN || NORM_FOLD) ? 482 * MiB : 448 * MiB;
constexpr int CW_PEERQ = 8192;
#ifndef PEER_DYNAMIC
#define PEER_DYNAMIC 0
#endif
constexpr int CW_BAR = 4096;

constexpr int RING_OFF = 0, RING_BYTES = 131072;
constexpr int LDSCTL_OFF = RING_BYTES, MISC_OFF = LDSCTL_OFF + 320;
constexpr int HAND_OFF = LDSCTL_OFF + 1024;
constexpr int LDS_BYTES = HAND_OFF + 8 * 3072;

#define GAS __attribute__((address_space(1)))
#define LAS __attribute__((address_space(3)))
typedef unsigned short bf16;
typedef unsigned v4u __attribute__((ext_vector_type(4)));
typedef unsigned v2u __attribute__((ext_vector_type(2)));
typedef float f32x4 __attribute__((ext_vector_type(4)));
typedef GAS unsigned gu32;
#define LDS_WAIT() asm volatile("s_waitcnt lgkmcnt(0)" ::: "memory")
__device__ __forceinline__ unsigned f2bf(float f) { unsigned u = __builtin_bit_cast(unsigned, f); return (u + 0x7fffu + ((u >> 16) & 1u)) >> 16; }
__device__ __forceinline__ unsigned pk2(float lo, float hi) { return f2bf(lo) | (f2bf(hi) << 16); }
__device__ __forceinline__ float bflo(unsigned w) { return __builtin_bit_cast(float, w << 16); }
__device__ __forceinline__ float bfhi(unsigned w) { return __builtin_bit_cast(float, w & 0xffff0000u); }
__device__ __forceinline__ float bf1(bf16 h) { return __builtin_bit_cast(float, (unsigned)h << 16); }

#define XB_TMO      128
#define XB_XCNT(j)  (256  + 64 * (j))
#define XB_XSUB(j)  (1280 + 64 * (j))
#define XB_XGEN(j)  (2304 + 64 * (j))
#define XB_TOP      3328
#define XB_TOPGEN   3392
#define XCD_BAR_WORDS 3456
#define XB_SPIN_CAP (1u << 18)
__device__ __forceinline__ unsigned xb_ld(unsigned* p)              { return __hip_atomic_load(p, __ATOMIC_RELAXED, __HIP_MEMORY_SCOPE_AGENT); }
__device__ __forceinline__ unsigned xb_add(unsigned* p, unsigned v) { return __hip_atomic_fetch_add(p, v, __ATOMIC_RELAXED, __HIP_MEMORY_SCOPE_AGENT); }
__device__ __forceinline__ unsigned xb_xcc_id() { return (unsigned)__builtin_amdgcn_s_getreg((3 << 11) | 20) & 0xFu; }
#define XB_SPIN(cond, bar) do { unsigned _sp = 0; while (cond) { __builtin_amdgcn_s_sleep(1); \
    if ((++_sp & 255u) == 0u) { if (xb_ld(&(bar)[XB_TMO])) break; if (_sp > XB_SPIN_CAP) { atomicAdd(&(bar)[XB_TMO], 1u); break; } } } } while (0)
struct XcdBarrier { unsigned* bar; unsigned x; volatile LAS unsigned* st; };
__device__ __forceinline__ XcdBarrier xcd_barrier_post(unsigned* bar, volatile LAS unsigned* st) {
    XcdBarrier b; b.bar = bar; b.x = xb_xcc_id(); b.st = st;
    if (threadIdx.x == 0) (void)xb_add(&bar[XB_XCNT(b.x)], 1u);
    return b;
}
__device__ __forceinline__ void xcd_barrier_complete(unsigned* bar, unsigned x, unsigned& nloc, unsigned& nx) {
    const unsigned G = gridDim.x * gridDim.y * gridDim.z;
    unsigned sum, cnt, mine, sp = 0u;
    for (;;) {
        sum = 0u; cnt = 0u; mine = 0u;
#pragma unroll
        for (unsigned j = 0; j < 16; ++j) { const unsigned c = xb_ld(&bar[XB_XCNT(j)]); sum += c; cnt += (c > 0u) ? 1u : 0u; mine = (j == x) ? c : mine; }
        if (sum == G) break;
        __builtin_amdgcn_s_sleep(1);
        if ((++sp & 255u) == 0u) { if (xb_ld(&bar[XB_TMO])) break; if (sp > XB_SPIN_CAP) { atomicAdd(&bar[XB_TMO], 1u); break; } }
    }
    nloc = mine > 0u ? mine : 1u; nx = cnt > 0u ? cnt : 1u;
}
__device__ __forceinline__ void xcd_barrier(const XcdBarrier& b) {
    asm volatile("s_waitcnt vmcnt(0)" ::: "memory");
    __syncthreads();
    if (threadIdx.x == 0) {
        unsigned* bar = b.bar;
        __builtin_amdgcn_s_waitcnt(0);
        unsigned nloc = b.st[0], nx = b.st[1];
        if (nloc == 0u) { xcd_barrier_complete(bar, b.x, nloc, nx); b.st[0] = nloc; b.st[1] = nx; }
        const unsigned old = xb_add(&bar[XB_XSUB(b.x)], 1u);
        const unsigned gen = old / nloc;
        if (old + 1u == (gen + 1u) * nloc) {
            __builtin_amdgcn_fence(__ATOMIC_RELEASE, "agent");
            asm volatile("s_waitcnt vmcnt(0)" ::: "memory");
            const unsigned og = xb_add(&bar[XB_TOP], 1u);
            const unsigned tg = og / nx;
            if (og + 1u == (tg + 1u) * nx) xb_add(&bar[XB_TOPGEN], 1u);
            else XB_SPIN(xb_ld(&bar[XB_TOPGEN]) == tg, bar);
            __builtin_amdgcn_fence(__ATOMIC_ACQUIRE, "agent");
            xb_add(&bar[XB_XGEN(b.x)], 1u);
            asm volatile("s_waitcnt vmcnt(0)" ::: "memory");
        } else {
            XB_SPIN(xb_ld(&bar[XB_XGEN(b.x)]) == gen, bar);
            __builtin_amdgcn_fence(__ATOMIC_ACQUIRE, "agent");
            asm volatile("s_waitcnt vmcnt(0)" ::: "memory");
        }
    }
    __syncthreads();
}

__device__ __forceinline__ float rdlane(float v, int l) { return __builtin_bit_cast(float, __builtin_amdgcn_readlane(__builtin_bit_cast(int, v), l)); }
__device__ __forceinline__ int rdlanei(int v, int l) { return __builtin_amdgcn_readlane(v, l); }
template <int CTRL> __device__ __forceinline__ float dppf(float v) { return __builtin_bit_cast(float, __builtin_amdgcn_mov_dpp(__builtin_bit_cast(int, v), CTRL, 0xF, 0xF, true)); }
template <int CTRL> __device__ __forceinline__ int dppi(int v) { return __builtin_amdgcn_mov_dpp(v, CTRL, 0xF, 0xF, true); }
__device__ __forceinline__ float wave_sum(float v) {
    v += dppf<0xB1>(v); v += dppf<0x4E>(v); v += dppf<0x124>(v); v += dppf<0x128>(v);
    return (rdlane(v, 0) + rdlane(v, 16)) + (rdlane(v, 32) + rdlane(v, 48));
}
__device__ __forceinline__ int wave_sumi(int v) {
    v += dppi<0xB1>(v); v += dppi<0x4E>(v); v += dppi<0x124>(v); v += dppi<0x128>(v);
    return (rdlanei(v, 0) + rdlanei(v, 16)) + (rdlanei(v, 32) + rdlanei(v, 48));
}
__device__ __forceinline__ float wave_max(float v) {
    v = fmaxf(v, dppf<0xB1>(v)); v = fmaxf(v, dppf<0x4E>(v)); v = fmaxf(v, dppf<0x124>(v)); v = fmaxf(v, dppf<0x128>(v));
    return fmaxf(fmaxf(rdlane(v, 0), rdlane(v, 16)), fmaxf(rdlane(v, 32), rdlane(v, 48)));
}

struct Ctx {
    LAS unsigned char* lds;
    int tid, lane, wave, vcu, G, gw, NGW;
};
struct Args { const float* in[N_IN]; float* out; unsigned char* ws; int ph_lo, ph_hi; };
typedef const __attribute__((address_space(4))) Args& KArgs;

template <bool GPERM = false> __device__ __forceinline__ void p0_transpose_item(const float* W, int K, int N, bf16* WT, LAS float* scr, int item, int lane, float scale) {
    const int nblk = N / 32, kb = item / nblk, nb = item % nblk, k0 = 64 * kb, n0 = 32 * nb;
#pragma unroll 8
    for (int i = 0; i < 32; ++i) { const int kk = 2 * i + (lane >> 5); scr[kk * 33 + (lane & 31)] = W[(size_t)(k0 + kk) * N + n0 + (lane & 31)] * scale; }
    LDS_WAIT(); asm volatile("" ::: "memory");
    const int c = lane & 7;
#pragma unroll
    for (int j = 0; j < 4; ++j) { const int n = (lane >> 3) + 8 * j; const LAS float* s = scr + (8 * c) * 33 + n;
        v4u o; o.x = pk2(s[0 * 33], s[1 * 33]); o.y = pk2(s[2 * 33], s[3 * 33]); o.z = pk2(s[4 * 33], s[5 * 33]); o.w = pk2(s[6 * 33], s[7 * 33]);
        int nr = n0 + n; if (GPERM && nr >= 4352) { const int z = (nr - 4352) >> 10, cc = (nr - 4352) & 1023, ch = cc & 63; nr = 4352 + 256 * (cc >> 6) + 64 * (ch >> 4) + 32 * (z >> 1) + 8 * ((ch >> 2) & 3) + 4 * (z & 1) + (ch & 3); }
        *(GAS v4u*)(WT + (size_t)nr * K + k0 + 8 * c) = o; }
    LDS_WAIT(); asm volatile("" ::: "memory");
}

__device__ __forceinline__ void norm_mod_row(int lane, const float* xrow, const float* g, const float* scale, const float* shift, bf16* orow) {
    const f32x4* xr = (const f32x4*)xrow + lane;
    f32x4 v[4]; float s = 0.f;
#pragma unroll
    for (int j = 0; j < 4; ++j) { v[j] = xr[64 * j]; s += (v[j].x * v[j].x + v[j].y * v[j].y) + (v[j].z * v[j].z + v[j].w * v[j].w); }
    const float r = 1.0f / sqrtf(wave_sum(s) * (1.0f / D) + EPS);
    unsigned long long* o8 = (unsigned long long*)orow + lane;
#pragma unroll
    for (int j = 0; j < 4; ++j) {
        const f32x4 gg = ((const f32x4*)g)[lane + 64 * j], sc = ((const f32x4*)scale)[lane + 64 * j], sh = ((const f32x4*)shift)[lane + 64 * j];
        const f32x4 y = (v[j] * r) * gg * (sc + 1.0f) + sh;
        o8[64 * j] = (unsigned long long)pk2(y.x, y.y) | ((unsigned long long)pk2(y.z, y.w) << 32);
    }
}

__device__ __forceinline__ void phase_pre(const Ctx& F, KArgs A) {
    float* mod = (float*)(A.ws + WS_MOD);
    for (int it = F.gw; it < DEPTH * 768; it += F.NGW) {
        const int l = it / 768, j0 = (it % 768) * 8;
        float acc[8][8];
#pragma unroll
        for (int b = 0; b < 8; ++b)
#pragma unroll
            for (int j = 0; j < 8; ++j) acc[b][j] = 0.f;
        for (int i = 0; i < 16; ++i) {
            const int k = F.lane + 64 * i;
            const float* wp = A.in[I_WADA] + ((size_t)l * D + k) * 6144 + j0;
            const f32x4 w0 = *(const f32x4*)wp, w1 = *(const f32x4*)(wp + 4);
#pragma unroll
            for (int b = 0; b < 8; ++b) { const float cv = A.in[I_C][b * D + k]; const float s = cv / (1.0f + __expf(-cv));
                acc[b][0] += s * w0.x; acc[b][1] += s * w0.y; acc[b][2] += s * w0.z; acc[b][3] += s * w0.w;
                acc[b][4] += s * w1.x; acc[b][5] += s * w1.y; acc[b][6] += s * w1.z; acc[b][7] += s * w1.w; }
        }
#pragma unroll
        for (int b = 0; b < 8; ++b) {
            float r[8];
#pragma unroll
            for (int j = 0; j < 8; ++j) r[j] = wave_sum(acc[b][j]);
            if (F.lane == 0) { const float* bp = A.in[I_BADA] + (size_t)l * 6144 + j0; float* mp = mod + ((size_t)l * 8 + b) * 6144 + j0;
                *(f32x4*)mp = (f32x4){r[0] + bp[0], r[1] + bp[1], r[2] + bp[2], r[3] + bp[3]}; *(f32x4*)(mp + 4) = (f32x4){r[4] + bp[4], r[5] + bp[5], r[6] + bp[6], r[7] + bp[7]}; }
        }
    }
    LAS float* scr = (LAS float*)(F.lds + RING_OFF + F.wave * 16384);
    constexpr int I_IN = 16 * 264, I_BR = 8 * 32, I_O = 16 * 32, I_Q = 16 * 64, I_P = 2 * 4;
    constexpr int PER_LAYER = I_IN + 4 * I_BR + I_O + I_Q + 4 * I_P;
    for (int it = F.gw; it < DEPTH * PER_LAYER; it += F.NGW) {
        const int l = it / PER_LAYER; int r = it % PER_LAYER;
        unsigned char* wl = A.ws + WS_W + (size_t)l * W_LAYER;
        if (r < I_IN) { const int n0 = 32 * (r % 264); const float sc = (n0 < 512 || (n0 >= C_DQ && n0 < C_DK)) ? C2 : 1.0f;
            p0_transpose_item<true>(A.in[I_WIN] + (size_t)l * D * NIN, D, NIN, (bf16*)(wl + W_WIN), scr, r, F.lane, sc); continue; }
        r -= I_IN;
        if (r < 4 * I_BR) { const int g = r / I_BR; p0_transpose_item(A.in[I_WBR] + ((size_t)l * 4 + g) * 512 * D, 512, D, (bf16*)(wl + W_WBR) + (size_t)g * D * 512, scr, r % I_BR, F.lane, 1.0f); continue; }
        r -= 4 * I_BR;
        if (r < I_O) { p0_transpose_item(A.in[I_WO] + (size_t)l * D * D, D, D, (bf16*)(wl + W_WO), scr, r, F.lane, 1.0f); continue; }
        r -= I_O;
        if (r < I_Q) { p0_transpose_item(A.in[I_WQ] + (size_t)l * D * 2048, D, 2048, (bf16*)(wl + W_WQ), scr, r, F.lane, 1.0f); continue; }
        r -= I_Q;
        { const int g = r / I_P; p0_transpose_item(A.in[I_WPOOL] + ((size_t)l * 4 + g) * 128 * 128, 128, 128, (bf16*)(wl + W_WP) + (size_t)g * 128 * 128, scr, r % I_P, F.lane, 1.0f); }
    }
    for (int i = F.gw * 64 + F.lane; i < DEPTH * 32768 / 4; i += F.NGW * 64) {
        const int l = i / 8192, e = (i % 8192) * 4;
        const f32x4 v = *(const f32x4*)(A.in[I_SK] + (size_t)l * 32768 + e);
        v2u o; o.x = pk2(v.x, v.y); o.y = pk2(v.z, v.w);
        *(v2u*)((bf16*)(A.ws + WS_W + (size_t)l * W_LAYER + W_SK) + e) = o;
    }
}
__device__ __forceinline__ void phase_h0(const Ctx& F, KArgs A) {
    const float* mod = (const float*)(A.ws + WS_MOD);
#if NORM_FOLD
    {
        float* cq = (float*)(A.ws + WS_CQ);
        for (int it = F.gw; it < DEPTH * 256; it += F.NGW) {
            const int l = it / 256, j0 = (it % 256) * 8;
            float acc[8][8];
#pragma unroll
            for (int b = 0; b < 8; ++b)
#pragma unroll
                for (int j = 0; j < 8; ++j) acc[b][j] = 0.f;
            for (int i = 0; i < 16; ++i) {
                const int k = F.lane + 64 * i;
                const float* wp = A.in[I_WQ] + ((size_t)l * D + k) * 2048 + j0;
                const f32x4 w0 = *(const f32x4*)wp, w1 = *(const f32x4*)(wp + 4);
#pragma unroll
                for (int b = 0; b < 8; ++b) { const float s = mod[((size_t)l * 8 + b) * 6144 + 3072 + k];
                    acc[b][0] += s * w0.x; acc[b][1] += s * w0.y; acc[b][2] += s * w0.z; acc[b][3] += s * w0.w;
                    acc[b][4] += s * w1.x; acc[b][5] += s * w1.y; acc[b][6] += s * w1.z; acc[b][7] += s * w1.w; }
            }
#pragma unroll
            for (int b = 0; b < 8; ++b) {
                float r[8];
#pragma unroll
                for (int j = 0; j < 8; ++j) r[j] = wave_sum(acc[b][j]);
                if (F.lane == 0) { float* cp = cq + ((size_t)l * 8 + b) * 2048 + j0; *(f32x4*)cp = (f32x4){r[0], r[1], r[2], r[3]}; *(f32x4*)(cp + 4) = (f32x4){r[4], r[5], r[6], r[7]}; }
            }
        }
    }
#endif
    bf16* H = (bf16*)(A.ws + WS_H);
    for (int m = F.gw; m < T; m += F.NGW) { const float* mb = mod + (size_t)(m >> 11) * 6144;
        norm_mod_row(F.lane, A.in[I_X] + (size_t)m * D, A.in[I_GN1], mb + 1024, mb, H + (size_t)m * D); }
}
__device__ __forceinline__ void phase_swa_naive(const Ctx& F, KArgs A, int l) {
    const bf16* P = (const bf16*)(A.ws + WS_PROJ); bf16* Y = (bf16*)(A.ws + WS_Y);
    const float* sinks = A.in[I_SINKS] + l * 8;
    for (int it = F.gw; it < T * 8; it += F.NGW) {
        const int t = it >> 3, hq = it & 7, g = hq >> 2, pos = t & (SEQ - 1);
        float q[64];
        { const v4u* qp = (const v4u*)(P + (size_t)t * NPROJ + C_DQ + hq * 64);
#pragma unroll
          for (int i = 0; i < 8; ++i) { const v4u w = qp[i]; q[8 * i] = bflo(w.x); q[8 * i + 1] = bfhi(w.x); q[8 * i + 2] = bflo(w.y); q[8 * i + 3] = bfhi(w.y); q[8 * i + 4] = bflo(w.z); q[8 * i + 5] = bfhi(w.z); q[8 * i + 6] = bflo(w.w); q[8 * i + 7] = bfhi(w.w); } }
        float s[2];
#pragma unroll
        for (int j = 0; j < 2; ++j) { const int kk = F.lane + 64 * j; float a = -1e30f;
            if (pos - kk >= 0) { const v4u* kp = (const v4u*)(P + (size_t)(t - kk) * NPROJ + C_DK + g * 64); a = 0.f;
#pragma unroll
                for (int i = 0; i < 8; ++i) { const v4u w = kp[i]; a += q[8 * i] * bflo(w.x) + q[8 * i + 1] * bfhi(w.x) + q[8 * i + 2] * bflo(w.y) + q[8 * i + 3] * bfhi(w.y) + q[8 * i + 4] * bflo(w.z) + q[8 * i + 5] * bfhi(w.z) + q[8 * i + 6] * bflo(w.w) + q[8 * i + 7] * bfhi(w.w); } }
            s[j] = a; }
        const float sk2 = sinks[hq] * LOG2E;
        const float mx = fmaxf(wave_max(fmaxf(s[0], s[1])), sk2);
        const float p0 = (pos - F.lane >= 0) ? exp2f(s[0] - mx) : 0.f, p1 = (pos - F.lane - 64 >= 0) ? exp2f(s[1] - mx) : 0.f;
        const float den = wave_sum(p0 + p1) + exp2f(sk2 - mx);
        float acc = 0.f;
        const int nk = (pos + 1 < 128) ? pos + 1 : 128;
        const bf16* vp = P + (size_t)t * NPROJ + C_DV + g * 64 + F.lane;
        for (int kk = 0; kk < nk; ++kk) { const float pk = (kk < 64) ? rdlane(p0, kk) : rdlane(p1, kk - 64); acc += pk * bf1(vp[-(long)kk * NPROJ]); }
        Y[(size_t)t * 2048 + 1536 + hq * 64 + F.lane] = (bf16)f2bf(acc / den);
    }
}
__device__ __forceinline__ void phase_conv_naive(const Ctx& F, KArgs A, int l) {
    const bf16* P = (const bf16*)(A.ws + WS_PROJ); bf16* Y = (bf16*)(A.ws + WS_Y);
    const float* cw = A.in[I_CONVW] + (size_t)l * 3 * 512;
    for (int it = F.gw * 64 + F.lane; it < (T / 4) * 64; it += F.NGW * 64) {
        const int t0 = (it >> 6) * 4, c0 = (it & 63) * 8; const bool first = (t0 & (SEQ - 1)) == 0;
        v4u za[6], zb[6], gb[4];
#pragma unroll
        for (int r = 0; r < 6; ++r) { const int row = (first && r < 2) ? t0 : t0 - 2 + r; za[r] = *(const v4u*)(P + (size_t)row * NPROJ + C_BC + c0); zb[r] = *(const v4u*)(P + (size_t)row * NPROJ + C_BX + c0); }
#pragma unroll
        for (int k = 0; k < 4; ++k) gb[k] = *(const v4u*)(P + (size_t)(t0 + k) * NPROJ + C_BB + c0);
        const f32x4 w00 = *(const f32x4*)(cw + c0), w01 = *(const f32x4*)(cw + c0 + 4), w10 = *(const f32x4*)(cw + 512 + c0), w11 = *(const f32x4*)(cw + 512 + c0 + 4), w20 = *(const f32x4*)(cw + 1024 + c0), w21 = *(const f32x4*)(cw + 1024 + c0 + 4);
        float z[6][8];
#pragma unroll
        for (int r = 0; r < 6; ++r) { const float m = (first && r < 2) ? 0.f : 1.f; const v4u a = za[r], b = zb[r];
            z[r][0] = m * bflo(a.x) * bflo(b.x); z[r][1] = m * bfhi(a.x) * bfhi(b.x); z[r][2] = m * bflo(a.y) * bflo(b.y); z[r][3] = m * bfhi(a.y) * bfhi(b.y);
            z[r][4] = m * bflo(a.z) * bflo(b.z); z[r][5] = m * bfhi(a.z) * bfhi(b.z); z[r][6] = m * bflo(a.w) * bflo(b.w); z[r][7] = m * bfhi(a.w) * bfhi(b.w); }
#pragma unroll
        for (int k = 0; k < 4; ++k) { const v4u g = gb[k];
            const float bb[8] = {bflo(g.x), bfhi(g.x), bflo(g.y), bfhi(g.y), bflo(g.z), bfhi(g.z), bflo(g.w), bfhi(g.w)};
            float y[8];
#pragma unroll
            for (int e = 0; e < 4; ++e) { y[e] = bb[e] * (w00[e] * z[k][e] + w10[e] * z[k + 1][e] + w20[e] * z[k + 2][e]); y[4 + e] = bb[4 + e] * (w01[e] * z[k][4 + e] + w11[e] * z[k + 1][4 + e] + w21[e] * z[k + 2][4 + e]); }
            v4u o; o.x = pk2(y[0], y[1]); o.y = pk2(y[2], y[3]); o.z = pk2(y[4], y[5]); o.w = pk2(y[6], y[7]);
            *(v4u*)(Y + (size_t)(t0 + k) * 2048 + 512 + c0) = o; }
    }
}
__device__ __forceinline__ void phase_pool_naive(const Ctx& F, KArgs A, int l) {
    const bf16* P = (const bf16*)(A.ws + WS_PROJ); bf16* Y = (bf16*)(A.ws + WS_Y);
    for (int it = F.gw; it < T * 4; it += F.NGW) {
        const int t = it >> 2, g = it & 3, w = 2 << g, pos = t & (SEQ - 1), cnt = (pos + 1 < w) ? pos + 1 : w;
        float d[2];
#pragma unroll
        for (int j = 0; j < 2; ++j) { const bf16* zp = P + (size_t)t * NPROJ + C_CZ + g * 128 + F.lane + 64 * j; float s = 0.f;
            for (int i = 0; i < cnt; ++i) s += bf1(zp[-(long)i * NPROJ]);
            d[j] = s / (float)cnt - bf1(zp[0]); }
        const float* wp = A.in[I_WPOOL] + ((size_t)l * 4 + g) * 128 * 128;
        float y0 = 0.f, y1 = 0.f;
        for (int c = 0; c < 64; ++c) { const float dc = rdlane(d[0], c); y0 += dc * wp[c * 128 + F.lane]; y1 += dc * wp[c * 128 + 64 + F.lane]; }
        for (int c = 0; c < 64; ++c) { const float dc = rdlane(d[1], c); y0 += dc * wp[(64 + c) * 128 + F.lane]; y1 += dc * wp[(64 + c) * 128 + 64 + F.lane]; }
        const float* ps = A.in[I_PSCALE] + (size_t)l * 512 + g * 128;
        Y[(size_t)t * 2048 + 1024 + g * 128 + F.lane] = (bf16)f2bf(y0 * ps[F.lane]);
        Y[(size_t)t * 2048 + 1024 + g * 128 + 64 + F.lane] = (bf16)f2bf(y1 * ps[64 + F.lane]);
    }
}
typedef float f32x16s __attribute__((ext_vector_type(16)));
typedef short bf16x8s __attribute__((ext_vector_type(8)));
__device__ __forceinline__ void phase_swa(const Ctx& F, KArgs A, int l) {
    const bf16* P = (const bf16*)(A.ws + WS_PROJ); bf16* Y = (bf16*)(A.ws + WS_Y);
    const float* sinks = A.in[I_SINKS] + l * 8;
    const int qi = F.lane & 31, kh = F.lane >> 5;
    for (int u = F.gw; u < (T / 32) * 8; u += F.NGW) {
        const int tq = u >> 3, hq = u & 7, g = hq >> 2, t0 = tq * 32, p0 = t0 & (SEQ - 1);
        bf16x8s qf[4];
        { const bf16* qp = P + (size_t)(t0 + qi) * NPROJ + C_DQ + hq * 64 + 8 * kh;
#pragma unroll
          for (int s = 0; s < 4; ++s) qf[s] = *(const bf16x8s*)(qp + 16 * s); }
        f32x16s acc[5];
#pragma unroll
        for (int kt = 0; kt < 5; ++kt) {
            int kr = t0 - 128 + 32 * kt + qi; if (p0 - 128 + 32 * kt + qi < 0) kr = t0;
            const bf16* kp = P + (size_t)kr * NPROJ + C_DK + g * 64 + 8 * kh;
            f32x16s c = (f32x16s){0.f, 0.f, 0.f, 0.f, 0.f, 0.f, 0.f, 0.f, 0.f, 0.f, 0.f, 0.f, 0.f, 0.f, 0.f, 0.f};
#pragma unroll
            for (int s = 0; s < 4; ++s) c = __builtin_amdgcn_mfma_f32_32x32x16_bf16(*(const bf16x8s*)(kp + 16 * s), qf[s], c, 0, 0, 0);
            acc[kt] = c;
        }
        const float sk2 = sinks[hq] * LOG2E;
        float m = sk2;
#pragma unroll
        for (int kt = 0; kt < 5; ++kt)
#pragma unroll
            for (int r = 0; r < 16; ++r) { const int koff = (r & 3) + 8 * (r >> 2) + 4 * kh, rel = qi + 128 - 32 * kt - koff;
                const bool valid = (rel >= 0) && (rel < 128) && (p0 - 128 + 32 * kt + koff >= 0);
                acc[kt][r] = valid ? acc[kt][r] : -1e30f; m = fmaxf(m, acc[kt][r]); }
        m = fmaxf(m, __shfl_xor(m, 32));
        float ls = 0.f;
#pragma unroll
        for (int kt = 0; kt < 5; ++kt)
#pragma unroll
            for (int r = 0; r < 16; ++r) { const float pv = exp2f(acc[kt][r] - m); acc[kt][r] = pv; ls += pv; }
        ls += __shfl_xor(ls, 32); ls += exp2f(sk2 - m);
        f32x16s o[2];
        o[0] = (f32x16s){0.f, 0.f, 0.f, 0.f, 0.f, 0.f, 0.f, 0.f, 0.f, 0.f, 0.f, 0.f, 0.f, 0.f, 0.f, 0.f}; o[1] = o[0];
#pragma unroll
        for (int kt = 0; kt < 5; ++kt)
#pragma unroll
            for (int s2 = 0; s2 < 2; ++s2) {
                v4u bw; bw.x = pk2(acc[kt][8 * s2 + 0], acc[kt][8 * s2 + 1]); bw.y = pk2(acc[kt][8 * s2 + 2], acc[kt][8 * s2 + 3]); bw.z = pk2(acc[kt][8 * s2 + 4], acc[kt][8 * s2 + 5]); bw.w = pk2(acc[kt][8 * s2 + 6], acc[kt][8 * s2 + 7]);
                const bf16x8s bfr = __builtin_bit_cast(bf16x8s, bw);
                int vr0 = t0 - 128 + 32 * kt + 16 * s2 + 4 * kh; const bool pre = (p0 - 128 + 32 * kt + 16 * s2 + 4 * kh < 0);
                int vr1 = vr0 + 8; const bool pre1 = (p0 - 128 + 32 * kt + 16 * s2 + 4 * kh + 8 < 0);
                if (pre) vr0 = t0; if (pre1) vr1 = t0;
#pragma unroll
                for (int mt = 0; mt < 2; ++mt) {
                    const bf16* v0 = P + (size_t)vr0 * NPROJ + C_DV + g * 64 + 32 * mt + qi; const bf16* v1 = P + (size_t)vr1 * NPROJ + C_DV + g * 64 + 32 * mt + qi;
                    v4u aw; aw.x = (unsigned)v0[0] | ((unsigned)v0[NPROJ] << 16); aw.y = (unsigned)v0[2 * NPROJ] | ((unsigned)v0[3 * NPROJ] << 16);
                    aw.z = (unsigned)v1[0] | ((unsigned)v1[NPROJ] << 16); aw.w = (unsigned)v1[2 * NPROJ] | ((unsigned)v1[3 * NPROJ] << 16);
                    o[mt] = __builtin_amdgcn_mfma_f32_32x32x16_bf16(__builtin_bit_cast(bf16x8s, aw), bfr, o[mt], 0, 0, 0);
                }
            }
        const float rl = 1.0f / ls;
        bf16* yp = Y + (size_t)(t0 + qi) * 2048 + 1536 + hq * 64 + 4 * kh;
#pragma unroll
        for (int mt = 0; mt < 2; ++mt)
#pragma unroll
            for (int q = 0; q < 4; ++q) { v2u w; w.x = pk2(o[mt][4 * q] * rl, o[mt][4 * q + 1] * rl); w.y = pk2(o[mt][4 * q + 2] * rl, o[mt][4 * q + 3] * rl);
                *(v2u*)(yp + 32 * mt + 8 * q) = w; }
    }
}
typedef short s16x4s __attribute__((ext_vector_type(4)));
__device__ __forceinline__ void phase_swa2(const Ctx& F, KArgs A, int l) {
    const bf16* P = (const bf16*)(A.ws + WS_PROJ); bf16* Y = (bf16*)(A.ws + WS_Y);
    const float* sinks = A.in[I_SINKS] + l * 8;
    constexpr int RS = 272, VOFF = 160 * RS;
    LAS unsigned char* kb = F.lds + RING_OFF; LAS unsigned char* vb = kb + VOFF;
    const int qi = F.lane & 31, kh = F.lane >> 5, hq = F.wave, g = hq >> 2;
    for (int tq = F.vcu; tq < T / 32; tq += F.G) {
        const int t0 = tq * 32, p0 = t0 & (SEQ - 1);
        __syncthreads();
#pragma unroll
        for (int c = 0; c < 5; ++c) { const int chunk = F.tid + 512 * c, row = chunk >> 4, ch = chunk & 15;
            const int gr = (p0 - 128 + row < 0) ? t0 : t0 - 128 + row;
            const v4u kv = *(const v4u*)(P + (size_t)gr * NPROJ + C_DK + ch * 8), vv = *(const v4u*)(P + (size_t)gr * NPROJ + C_DV + ch * 8);
            *(LAS v4u*)(kb + row * RS + ch * 16) = kv; *(LAS v4u*)(vb + row * RS + ch * 16) = vv; }
        bf16x8s qf[4];
        { const bf16* qp = P + (size_t)(t0 + qi) * NPROJ + C_DQ + hq * 64 + 8 * kh;
#pragma unroll
          for (int s = 0; s < 4; ++s) qf[s] = *(const bf16x8s*)(qp + 16 * s); }
        __syncthreads();
        f32x16s acc[5];
#pragma unroll
        for (int kt = 0; kt < 5; ++kt) {
            const LAS unsigned char* kp = kb + (32 * kt + qi) * RS + g * 128 + 16 * kh;
            f32x16s c = (f32x16s){0.f, 0.f, 0.f, 0.f, 0.f, 0.f, 0.f, 0.f, 0.f, 0.f, 0.f, 0.f, 0.f, 0.f, 0.f, 0.f};
#pragma unroll
            for (int s = 0; s < 4; ++s) c = __builtin_amdgcn_mfma_f32_32x32x16_bf16(*(const LAS bf16x8s*)(kp + 32 * s), qf[s], c, 0, 0, 0);
            acc[kt] = c;
        }
        const float sk2 = sinks[hq] * LOG2E;
        float m = sk2;
#pragma unroll
        for (int kt = 0; kt < 5; ++kt)
#pragma unroll
            for (int r = 0; r < 16; ++r) { const int koff = (r & 3) + 8 * (r >> 2) + 4 * kh, rel = qi + 128 - 32 * kt - koff;
                const bool valid = (rel >= 0) && (rel < 128) && (p0 - 128 + 32 * kt + koff >= 0);
                acc[kt][r] = valid ? acc[kt][r] : -1e30f; m = fmaxf(m, acc[kt][r]); }
        m = fmaxf(m, __shfl_xor(m, 32));
        float ls = 0.f;
#pragma unroll
        for (int kt = 0; kt < 5; ++kt)
#pragma unroll
            for (int r = 0; r < 16; ++r) { const float pv = exp2f(acc[kt][r] - m); acc[kt][r] = pv; ls += pv; }
        ls += __shfl_xor(ls, 32); ls += exp2f(sk2 - m);
        f32x16s o[2];
        o[0] = (f32x16s){0.f, 0.f, 0.f, 0.f, 0.f, 0.f, 0.f, 0.f, 0.f, 0.f, 0.f, 0.f, 0.f, 0.f, 0.f, 0.f}; o[1] = o[0];
        const LAS unsigned char* vl = vb + (4 * kh + ((F.lane & 15) >> 2)) * RS + (g * 64 + 16 * ((F.lane >> 4) & 1) + 4 * (F.lane & 3)) * 2;
#pragma unroll
        for (int kt = 0; kt < 5; ++kt)
#pragma unroll
            for (int s2 = 0; s2 < 2; ++s2) {
                v4u bw; bw.x = pk2(acc[kt][8 * s2 + 0], acc[kt][8 * s2 + 1]); bw.y = pk2(acc[kt][8 * s2 + 2], acc[kt][8 * s2 + 3]); bw.z = pk2(acc[kt][8 * s2 + 4], acc[kt][8 * s2 + 5]); bw.w = pk2(acc[kt][8 * s2 + 6], acc[kt][8 * s2 + 7]);
                const bf16x8s bfr = __builtin_bit_cast(bf16x8s, bw);
#pragma unroll
                for (int mt = 0; mt < 2; ++mt) {
                    const LAS unsigned char* va = vl + (32 * kt + 16 * s2) * RS + 64 * mt;
                    const s16x4s lo = __builtin_bit_cast(s16x4s, __builtin_amdgcn_ds_read_tr16_b64_v4i16((LAS s16x4s*)va));
                    const s16x4s hi = __builtin_bit_cast(s16x4s, __builtin_amdgcn_ds_read_tr16_b64_v4i16((LAS s16x4s*)(va + 8 * RS)));
                    const bf16x8s afr = (bf16x8s){lo[0], lo[1], lo[2], lo[3], hi[0], hi[1], hi[2], hi[3]};
                    o[mt] = __builtin_amdgcn_mfma_f32_32x32x16_bf16(afr, bfr, o[mt], 0, 0, 0);
                }
            }
        const float rl = 1.0f / ls;
        bf16* yp = Y + (size_t)(t0 + qi) * 2048 + 1536 + hq * 64 + 4 * kh;
#pragma unroll
        for (int mt = 0; mt < 2; ++mt)
#pragma unroll
            for (int q = 0; q < 4; ++q) { v2u w; w.x = pk2(o[mt][4 * q] * rl, o[mt][4 * q + 1] * rl); w.y = pk2(o[mt][4 * q + 2] * rl, o[mt][4 * q + 3] * rl);
                *(v2u*)(yp + 32 * mt + 8 * q) = w; }
    }
    __syncthreads();
}
__device__ __forceinline__ void phase_pool(const Ctx& F, KArgs A, int l) {
    const bf16* P = (const bf16*)(A.ws + WS_PROJ); bf16* Y = (bf16*)(A.ws + WS_Y);
    const bf16* WP = (const bf16*)(A.ws + WS_W + (size_t)l * W_LAYER + W_WP);
    const int ti = F.lane & 31, kh = F.lane >> 5;
    for (int u = F.gw; u < (T / 32) * 4; u += F.NGW) {
        const int tq = u >> 2, g = u & 3, w = 2 << g, t = tq * 32 + ti, pos = t & (SEQ - 1), cnt = (pos + 1 < w) ? pos + 1 : w;
        const float rc = 1.0f / (float)cnt;
        f32x16s acc[4];
#pragma unroll
        for (int mt = 0; mt < 4; ++mt) acc[mt] = (f32x16s){0.f, 0.f, 0.f, 0.f, 0.f, 0.f, 0.f, 0.f, 0.f, 0.f, 0.f, 0.f, 0.f, 0.f, 0.f, 0.f};
        for (int s = 0; s < 8; ++s) {
            const bf16* zp = P + (size_t)t * NPROJ + C_CZ + g * 128 + 16 * s + 8 * kh;
            float sum[8];
#pragma unroll
            for (int e = 0; e < 8; ++e) sum[e] = 0.f;
            auto win = [&](auto WC) { constexpr int W = decltype(WC)::value; v4u zw[W];
#pragma unroll
                for (int i = 0; i < W; ++i) zw[i] = *(const v4u*)(zp - (size_t)((i < cnt) ? i : 0) * NPROJ);
#pragma unroll
                for (int i = 0; i < W; ++i) { const float m = (i < cnt) ? 1.0f : 0.0f;
                    sum[0] += m * bflo(zw[i].x); sum[1] += m * bfhi(zw[i].x); sum[2] += m * bflo(zw[i].y); sum[3] += m * bfhi(zw[i].y); sum[4] += m * bflo(zw[i].z); sum[5] += m * bfhi(zw[i].z); sum[6] += m * bflo(zw[i].w); sum[7] += m * bfhi(zw[i].w); } };
            if (g == 0) win(std::integral_constant<int, 2>{}); else if (g == 1) win(std::integral_constant<int, 4>{}); else if (g == 2) win(std::integral_constant<int, 8>{}); else win(std::integral_constant<int, 16>{});
            bf16x8s afr[4];
#pragma unroll
            for (int mt = 0; mt < 4; ++mt) afr[mt] = *(const bf16x8s*)(WP + ((size_t)g * 128 + 32 * mt + ti) * 128 + 16 * s + 8 * kh);
            const v4u z0 = *(const v4u*)zp;
            v4u dw; dw.x = pk2(sum[0] * rc - bflo(z0.x), sum[1] * rc - bfhi(z0.x)); dw.y = pk2(sum[2] * rc - bflo(z0.y), sum[3] * rc - bfhi(z0.y));
            dw.z = pk2(sum[4] * rc - bflo(z0.z), sum[5] * rc - bfhi(z0.z)); dw.w = pk2(sum[6] * rc - bflo(z0.w), sum[7] * rc - bfhi(z0.w));
            const bf16x8s bfr = __builtin_bit_cast(bf16x8s, dw);
            asm volatile("" : "+v"(afr[0]), "+v"(afr[1]), "+v"(afr[2]), "+v"(afr[3]));
#pragma unroll
            for (int mt = 0; mt < 4; ++mt) acc[mt] = __builtin_amdgcn_mfma_f32_32x32x16_bf16(afr[mt], bfr, acc[mt], 0, 0, 0);
        }
        const float* ps = A.in[I_PSCALE] + (size_t)l * 512 + g * 128;
        bf16* yp = Y + (size_t)t * 2048 + 1024 + g * 128 + 4 * kh;
#pragma unroll
        for (int hb = 0; hb < 2; ++hb) {
            f32x4 scv[8];
#pragma unroll
            for (int i = 0; i < 8; ++i) scv[i] = *(const f32x4*)(ps + 32 * (2 * hb + (i >> 2)) + 8 * (i & 3) + 4 * kh);
#pragma unroll
            for (int m2 = 0; m2 < 2; ++m2)
#pragma unroll
                for (int q = 0; q < 4; ++q) { const int mt = 2 * hb + m2; const f32x4 sc = scv[4 * m2 + q];
                    v2u wv; wv.x = pk2(acc[mt][4 * q] * sc.x, acc[mt][4 * q + 1] * sc.y); wv.y = pk2(acc[mt][4 * q + 2] * sc.z, acc[mt][4 * q + 3] * sc.w);
                    *(v2u*)(yp + 32 * mt + 8 * q) = wv; } }
    }
}
__device__ __forceinline__ void phase_ya(const Ctx& F, KArgs A, int l) {
    const bf16* O = (const bf16*)(A.ws + WS_O); bf16* Y = (bf16*)(A.ws + WS_Y);
    const float lam_init = (l == 0) ? 0.2f : (0.8f - 0.6f * 0.7408182206817179f);
    const float d1 = wave_sum(A.in[I_LQ1][l * 64 + F.lane] * A.in[I_LK1][l * 64 + F.lane]);
    const float d2 = wave_sum(A.in[I_LQ2][l * 64 + F.lane] * A.in[I_LK2][l * 64 + F.lane]);
    const float lam = expf(d1) - expf(d2) + lam_init;
    const int sub = F.lane & 15, grp = F.lane >> 4;
    float gs[8];
#pragma unroll
    for (int e = 0; e < 8; ++e) gs[e] = A.in[I_GSUB][l * 128 + 8 * sub + e] * (1.0f - lam_init);
    static_assert(T % (4 * 256 * NWAVES) == 0, "phase_ya: 4 tokens per trip");
    for (int it0 = F.gw; it0 < T; it0 += 4 * F.NGW) {
        v4u av[4], bv[4];
#pragma unroll
        for (int j = 0; j < 4; ++j) { const int t = it0 + j * F.NGW; av[j] = *(const v4u*)(O + (size_t)t * 1024 + grp * 256 + 8 * sub); bv[j] = *(const v4u*)(O + (size_t)t * 1024 + grp * 256 + 128 + 8 * sub); }
#pragma unroll
      for (int j = 0; j < 4; ++j) {
        const int t = it0 + j * F.NGW, h = grp; const v4u a = av[j], b = bv[j];
        float y[8] = {bflo(a.x) - lam * bflo(b.x), bfhi(a.x) - lam * bfhi(b.x), bflo(a.y) - lam * bflo(b.y), bfhi(a.y) - lam * bfhi(b.y), bflo(a.z) - lam * bflo(b.z), bfhi(a.z) - lam * bfhi(b.z), bflo(a.w) - lam * bflo(b.w), bfhi(a.w) - lam * bfhi(b.w)};
        float ss = 0.f;
#pragma unroll
        for (int e = 0; e < 8; ++e) ss += y[e] * y[e];
        ss += __shfl_xor(ss, 1); ss += __shfl_xor(ss, 2); ss += __shfl_xor(ss, 4); ss += __shfl_xor(ss, 8);
        const float r = 1.0f / sqrtf(ss * (1.0f / 128.0f) + EPS);
        v4u o; o.x = pk2(y[0] * r * gs[0], y[1] * r * gs[1]); o.y = pk2(y[2] * r * gs[2], y[3] * r * gs[3]); o.z = pk2(y[4] * r * gs[4], y[5] * r * gs[5]); o.w = pk2(y[6] * r * gs[6], y[7] * r * gs[7]);
        *(v4u*)(Y + (size_t)t * 2048 + h * 128 + 8 * sub) = o;
      }
    }
}
__device__ __forceinline__ void expert_quant(KArgs A, int l, int lane, int w, int nw) {
    const float* ue = A.in[I_UE] + (size_t)l * 16384 * 1024; const float* ve = A.in[I_VE] + (size_t)l * 16384 * 1024;
    for (int r = w; r < 2 * 16384; r += nw) {
        const bool isv = r >= 16384; const int row = isv ? r - 16384 : r; const float* src = (isv ? ve : ue) + (size_t)row * 1024 + 8 * lane;
        const f32x4 a0 = *(const f32x4*)src, a1 = *(const f32x4*)(src + 4), b0 = *(const f32x4*)(src + 512), b1 = *(const f32x4*)(src + 516);
        float am = 0.f;
#pragma unroll
        for (int e = 0; e < 4; ++e) am = fmaxf(fmaxf(am, fmaxf(fabsf(a0[e]), fabsf(a1[e]))), fmaxf(fabsf(b0[e]), fabsf(b1[e])));
        am = wave_max(am);
#if EXP6B
        { const float inv6 = am > 0.f ? 31.0f / am : 0.f; unsigned X0 = 0, X1 = 0, Y = 0;
#pragma unroll
          for (int i = 0; i < 4; ++i) {
              const unsigned u0 = (unsigned)((int)rintf(a0[i] * inv6) + 32), u2 = (unsigned)((int)rintf(b0[i] * inv6) + 32);
              const unsigned s1 = (unsigned)(int)rintf(a1[i] * inv6) & 63u, s3 = (unsigned)(int)rintf(b1[i] * inv6) & 63u;
              X0 |= ((u0 & 15u) | ((s1 >> 2) << 4)) << (8 * i); X1 |= ((u2 & 15u) | ((s3 >> 2) << 4)) << (8 * i);
              Y |= (((u0 >> 4) << 4) | ((s1 & 3u) << 2) | ((u2 >> 4) << 6) | (s3 & 3u)) << (8 * i); }
          unsigned char* dst = A.ws + (isv ? WS_VE : WS_UE) + (size_t)row * 768;
          *(unsigned long long*)(dst + 8 * lane) = (unsigned long long)X0 | ((unsigned long long)X1 << 32); *(unsigned*)(dst + 512 + 4 * lane) = Y;
          if (lane == 0) ((float*)(A.ws + (isv ? WS_VS : WS_US)))[row] = am * (1.0f / 31.0f);
          continue; }
#endif
        const float inv = am > 0.f ? 127.0f / am : 0.f; const int bias = (isv && !V_MFMA) ? 128 : 0;
        unsigned o[4];
#pragma unroll
        for (int wd = 0; wd < 4; ++wd) { const f32x4 v = wd == 0 ? a0 : wd == 1 ? a1 : wd == 2 ? b0 : b1; unsigned x = 0;
#pragma unroll
            for (int e = 0; e < 4; ++e) x |= ((unsigned)((int)rintf(v[e] * inv) + bias) & 255u) << (8 * e);
            o[wd] = x; }
        *(v4u*)(A.ws + (isv ? WS_VE : WS_UE) + (size_t)row * 1024 + 16 * lane) = (v4u){o[0], o[1], o[2], o[3]};
        if (lane == 0) ((float*)(A.ws + (isv ? WS_VS : WS_US)))[row] = am * (1.0f / 127.0f);
    }
}
__device__ __forceinline__ void phase_h2(const Ctx& F, KArgs A, int l) {
    const float* mod = (const float*)(A.ws + WS_MOD) + (size_t)l * 8 * 6144;
    bf16* H = (bf16*)(A.ws + WS_H);
    for (int m = F.gw; m < T; m += F.NGW) { const float* mb = mod + (size_t)(m >> 11) * 6144;
        norm_mod_row(F.lane, A.out + (size_t)m * D, A.in[I_GN2] + (size_t)l * D, mb + 4096, mb + 3072, H + (size_t)m * D); }
#if DBG_ROUTE32
    {
        bf16* H3 = (bf16*)(A.ws + WS_H3);
        for (int m = F.gw; m < T; m += F.NGW) { const float* mb = mod + (size_t)(m >> 11) * 6144;
            const f32x4* xr = (const f32x4*)(A.out + (size_t)m * D) + F.lane; f32x4 v[4]; float s = 0.f;
#pragma unroll
            for (int j = 0; j < 4; ++j) { v[j] = xr[64 * j]; s += (v[j].x * v[j].x + v[j].y * v[j].y) + (v[j].z * v[j].z + v[j].w * v[j].w); }
            const float r = 1.0f / sqrtf(wave_sum(s) * (1.0f / D) + EPS);
#pragma unroll
            for (int j = 0; j < 4; ++j) {
                const f32x4 gg = ((const f32x4*)(A.in[I_GN2] + (size_t)l * D))[F.lane + 64 * j], sc = ((const f32x4*)(mb + 4096))[F.lane + 64 * j], sh = ((const f32x4*)(mb + 3072))[F.lane + 64 * j];
                const f32x4 y = (v[j] * r) * gg * (sc + 1.0f) + sh;
                unsigned hi[4], lo[4];
#pragma unroll
                for (int e = 0; e < 4; ++e) { hi[e] = f2bf(y[e]); lo[e] = f2bf(y[e] - __builtin_bit_cast(float, hi[e] << 16)); }
                const unsigned long long hw = (unsigned long long)(hi[0] | (hi[1] << 16)) | ((unsigned long long)(hi[2] | (hi[3] << 16)) << 32);
                const unsigned long long lw = (unsigned long long)(lo[0] | (lo[1] << 16)) | ((unsigned long long)(lo[2] | (lo[3] << 16)) << 32);
                unsigned long long* o8 = (unsigned long long*)(H3 + (size_t)m * 3072) + F.lane + 64 * j;
                o8[0] = hw; o8[256] = hw; o8[512] = lw;
            } }
        bf16* W3 = (bf16*)(A.ws + WS_WQ3); const float* W = A.in[I_WQ] + (size_t)l * D * 2048;
        for (size_t i = (size_t)F.gw * 64 + F.lane; i < (size_t)2048 * 1024; i += (size_t)F.NGW * 64) { const int n = (int)(i >> 10), k = (int)(i & 1023);
            const float w = W[(size_t)k * 2048 + n]; const unsigned hi = f2bf(w), lo = f2bf(w - __builtin_bit_cast(float, hi << 16));
            W3[(size_t)n * 3072 + k] = (bf16)hi; W3[(size_t)n * 3072 + 1024 + k] = (bf16)lo; W3[(size_t)n * 3072 + 2048 + k] = (bf16)hi; }
    }
}
__device__ __forceinline__ void phase_expert_convert(const Ctx& F, KArgs A, int l) {
#else
#endif
    const float* ue = A.in[I_UE] + (size_t)l * 16384 * 1024; const float* ve = A.in[I_VE] + (size_t)l * 16384 * 1024;
#if EXP_I8_OWN
    return;
#endif
    bf16* UE = (bf16*)(A.ws + WS_UE); bf16* VE = (bf16*)(A.ws + WS_VE);
    for (size_t i = (size_t)F.gw * 64 + F.lane; i < (size_t)2 * 16384 * 1024 / 8; i += (size_t)F.NGW * 64) {
        const bool isv = i >= (size_t)16384 * 1024 / 8; const size_t e = (isv ? i - (size_t)16384 * 1024 / 8 : i) * 8;
        const float* src = (isv ? ve : ue) + e; const f32x4 a = *(const f32x4*)src, b = *(const f32x4*)(src + 4);
        v4u o; o.x = pk2(a.x, a.y); o.y = pk2(a.z, a.w); o.z = pk2(b.x, b.y); o.w = pk2(b.z, b.w);
        *(v4u*)((isv ? VE : UE) + e) = o;
    }
}
__device__ __forceinline__ void phase_route_naive(const Ctx& F, KArgs A, int l) {
#if DBG_ROUTE32
    const float* Q32 = (const float*)(A.ws + WS_Q32); const float* SKF = A.in[I_SK] + (size_t)l * 32768;
#else
    const bf16* Q2 = (const bf16*)(A.ws + WS_Q2); const bf16* SK = (const bf16*)(A.ws + WS_W + (size_t)l * W_LAYER + W_SK);
#endif
    int* IDX = (int*)(A.ws + WS_IDX); float* WTS = (float*)(A.ws + WS_WTS);
    for (int it = F.gw; it < T * 8; it += F.NGW) {
        const int t = it >> 3, hh = it & 7;
        float ts[2]; int ti[2];
#pragma unroll
        for (int p = 0; p < 2; ++p) {
#if DBG_ROUTE32
            const float* qp = Q32 + (size_t)t * 2048 + hh * 256 + p * 128;
            const float* ka = SKF + ((size_t)p * 128 + F.lane) * 128; const float* kb = ka + 64 * 128;
            float sa = 0.f, sb = 0.f;
            for (int i = 0; i < 32; ++i) { const f32x4 qv = *(const f32x4*)(qp + 4 * i), av = *(const f32x4*)(ka + 4 * i), bv = *(const f32x4*)(kb + 4 * i);
                sa += qv.x * av.x + qv.y * av.y + qv.z * av.z + qv.w * av.w; sb += qv.x * bv.x + qv.y * bv.y + qv.z * bv.z + qv.w * bv.w; }
#else
            const bf16* qp = Q2 + (size_t)t * 2048 + hh * 256 + p * 128;
            const bf16* ka = SK + ((size_t)p * 128 + F.lane) * 128; const bf16* kb = ka + 64 * 128;
            float sa = 0.f, sb = 0.f;
            for (int i = 0; i < 16; ++i) { const v4u qw = *(const v4u*)(qp + 8 * i), aw = *(const v4u*)(ka + 8 * i), bw = *(const v4u*)(kb + 8 * i);
                sa += bflo(qw.x) * bflo(aw.x) + bfhi(qw.x) * bfhi(aw.x) + bflo(qw.y) * bflo(aw.y) + bfhi(qw.y) * bfhi(aw.y) + bflo(qw.z) * bflo(aw.z) + bfhi(qw.z) * bfhi(aw.z) + bflo(qw.w) * bflo(aw.w) + bfhi(qw.w) * bfhi(aw.w);
                sb += bflo(qw.x) * bflo(bw.x) + bfhi(qw.x) * bfhi(bw.x) + bflo(qw.y) * bflo(bw.y) + bfhi(qw.y) * bfhi(bw.y) + bflo(qw.z) * bflo(bw.z) + bfhi(qw.z) * bfhi(bw.z) + bflo(qw.w) * bflo(bw.w) + bfhi(qw.w) * bfhi(bw.w); }
#endif
            float tsv = 0.f; int tiv = 0;
            for (int r = 0; r < 16; ++r) {
                const float m = wave_max(fmaxf(sa, sb));
                const unsigned long long ba = __ballot(sa == m), bb = __ballot(sb == m);
                int idx;
                if (ba) { const int ln = __ffsll((long long)ba) - 1; idx = ln; if (F.lane == ln) sa = -3.0e38f; }
                else { const int ln = __ffsll((long long)bb) - 1; idx = 64 + ln; if (F.lane == ln) sb = -3.0e38f; }
                if (F.lane == r) { tsv = m; tiv = idx; }
            }
            ts[p] = tsv; ti[p] = tiv;
        }
        float cv[4];
#pragma unroll
        for (int k = 0; k < 4; ++k) cv[k] = __shfl(ts[0], (F.lane >> 4) + 4 * k) + __shfl(ts[1], F.lane & 15);
        float bs = 0.f; int bid = 0;
        for (int r = 0; r < 16; ++r) {
            const float m = wave_max(fmaxf(fmaxf(cv[0], cv[1]), fmaxf(cv[2], cv[3])));
            int id = -1;
#pragma unroll
            for (int k = 0; k < 4; ++k) { const unsigned long long bk = __ballot(cv[k] == m);
                if (id < 0 && bk) { const int ln = __ffsll((long long)bk) - 1; id = ln + 64 * k; if (F.lane == ln) cv[k] = -3.0e38f; } }
            if (F.lane == r) { bs = m; bid = id; }
        }
        const int ei = __shfl(ti[0], bid >> 4) * 128 + __shfl(ti[1], bid & 15);
        const float m0 = __shfl(bs, 0);
        const float e = (F.lane < 16) ? expf(bs - m0) : 0.f;
        const float den = wave_sum(e);
        if (F.lane < 16) { IDX[(size_t)t * 128 + hh * 16 + F.lane] = ei; WTS[(size_t)t * 128 + hh * 16 + F.lane] = e / den; }
    }
}
typedef float f32x16r __attribute__((ext_vector_type(16)));
typedef short bf16x8r __attribute__((ext_vector_type(8)));
__device__ __forceinline__ unsigned srt_key(float f) { const unsigned u = __builtin_bit_cast(unsigned, f); return u ^ ((unsigned)((int)u >> 31) | 0x80000000u); }
__device__ __forceinline__ float srt_val(unsigned k) { const unsigned u = (k & 0x80000000u) ? (k ^ 0x80000000u) : ~k; return __builtin_bit_cast(float, u); }
#define INS16(L, x) do { unsigned x_ = (x); _Pragma("unroll") for (int k_ = 0; k_ < 16; ++k_) { const unsigned h_ = L[k_] > x_ ? L[k_] : x_; x_ = L[k_] > x_ ? x_ : L[k_]; L[k_] = h_; } } while (0)
#if ROUTE_SORTNET
#define CE_(a, b) do { const unsigned h_ = (a) > (b) ? (a) : (b); (b) = (a) > (b) ? (b) : (a); (a) = h_; } while (0)
__device__ __forceinline__ void sort16_desc(unsigned (&v)[16]) { CE_(v[0], v[1]); CE_(v[2], v[3]); CE_(v[0], v[2]); CE_(v[1], v[3]); CE_(v[1], v[2]); CE_(v[4], v[5]); CE_(v[6], v[7]); CE_(v[4], v[6]); CE_(v[5], v[7]); CE_(v[5], v[6]); CE_(v[0], v[4]); CE_(v[2], v[6]); CE_(v[2], v[4]); CE_(v[1], v[5]); CE_(v[3], v[7]); CE_(v[3], v[5]); CE_(v[1], v[2]); CE_(v[3], v[4]); CE_(v[5], v[6]); CE_(v[8], v[9]); CE_(v[10], v[11]); CE_(v[8], v[10]); CE_(v[9], v[11]); CE_(v[9], v[10]); CE_(v[12], v[13]); CE_(v[14], v[15]); CE_(v[12], v[14]); CE_(v[13], v[15]); CE_(v[13], v[14]); CE_(v[8], v[12]); CE_(v[10], v[14]); CE_(v[10], v[12]); CE_(v[9], v[13]); CE_(v[11], v[15]); CE_(v[11], v[13]); CE_(v[9], v[10]); CE_(v[11], v[12]); CE_(v[13], v[14]); CE_(v[0], v[8]); CE_(v[4], v[12]); CE_(v[4], v[8]); CE_(v[2], v[10]); CE_(v[6], v[14]); CE_(v[6], v[10]); CE_(v[2], v[4]); CE_(v[6], v[8]); CE_(v[10], v[12]); CE_(v[1], v[9]); CE_(v[5], v[13]); CE_(v[5], v[9]); CE_(v[3], v[11]); CE_(v[7], v[15]); CE_(v[7], v[11]); CE_(v[3], v[5]); CE_(v[7], v[9]); CE_(v[11], v[13]); CE_(v[1], v[2]); CE_(v[3], v[4]); CE_(v[5], v[6]); CE_(v[7], v[8]); CE_(v[9], v[10]); CE_(v[11], v[12]); CE_(v[13], v[14]); }
__device__ __forceinline__ void merge16_top(unsigned (&R)[16], const unsigned (&C)[16]) {
#pragma unroll
    for (int i = 0; i < 16; ++i) R[i] = R[i] > C[15 - i] ? R[i] : C[15 - i];
    CE_(R[0], R[8]); CE_(R[1], R[9]); CE_(R[2], R[10]); CE_(R[3], R[11]); CE_(R[4], R[12]); CE_(R[5], R[13]); CE_(R[6], R[14]); CE_(R[7], R[15]); CE_(R[0], R[4]); CE_(R[1], R[5]); CE_(R[2], R[6]); CE_(R[3], R[7]); CE_(R[8], R[12]); CE_(R[9], R[13]); CE_(R[10], R[14]); CE_(R[11], R[15]); CE_(R[0], R[2]); CE_(R[1], R[3]); CE_(R[4], R[6]); CE_(R[5], R[7]); CE_(R[8], R[10]); CE_(R[9], R[11]); CE_(R[12], R[14]); CE_(R[13], R[15]); CE_(R[0], R[1]); CE_(R[2], R[3]); CE_(R[4], R[5]); CE_(R[6], R[7]); CE_(R[8], R[9]); CE_(R[10], R[11]); CE_(R[12], R[13]); CE_(R[14], R[15]); }
#endif
__device__ __forceinline__ void route_top16(unsigned (&tk)[16], const bf16* qrow, const GAS bf16* skp, int lane) {
    f32x16r acc[4];
#pragma unroll
    for (int mt = 0; mt < 4; ++mt) acc[mt] = (f32x16r){0.f, 0.f, 0.f, 0.f, 0.f, 0.f, 0.f, 0.f, 0.f, 0.f, 0.f, 0.f, 0.f, 0.f, 0.f, 0.f};
#if ROUTE_BATCH
#pragma unroll
    for (int s0 = 0; s0 < 8; s0 += ROUTE_BATCH) { bf16x8r bq[ROUTE_BATCH], a[ROUTE_BATCH][4];
#pragma unroll
        for (int i = 0; i < ROUTE_BATCH; ++i) { bq[i] = *(const bf16x8r*)(qrow + 16 * (s0 + i));
#pragma unroll
            for (int mt = 0; mt < 4; ++mt) a[i][mt] = *(const GAS bf16x8r*)(skp + (size_t)mt * 32 * 128 + 16 * (s0 + i)); }
#pragma unroll
        for (int i = 0; i < ROUTE_BATCH; ++i) asm volatile("" : "+v"(bq[i]), "+v"(a[i][0]), "+v"(a[i][1]), "+v"(a[i][2]), "+v"(a[i][3]));
#pragma unroll
        for (int i = 0; i < ROUTE_BATCH; ++i)
#pragma unroll
            for (int mt = 0; mt < 4; ++mt) acc[mt] = __builtin_amdgcn_mfma_f32_32x32x16_bf16(a[i][mt], bq[i], acc[mt], 0, 0, 0); }
#else
#pragma unroll
    for (int s = 0; s < 8; ++s) { const bf16x8r bq = *(const bf16x8r*)(qrow + 16 * s);
#pragma unroll
        for (int mt = 0; mt < 4; ++mt) { const bf16x8r a = *(const GAS bf16x8r*)(skp + (size_t)mt * 32 * 128 + 16 * s);
            acc[mt] = __builtin_amdgcn_mfma_f32_32x32x16_bf16(a, bq, acc[mt], 0, 0, 0); } }
#endif
    const unsigned lowb = (lane & 32) ? 0u : 4u;
#if ROUTE_SORTNET
#pragma unroll
    for (int mt = 0; mt < 4; ++mt) { unsigned c[16];
#pragma unroll
        for (int r = 0; r < 16; ++r) { const unsigned idx0 = 32u * mt + (r & 3) + 8u * (r >> 2);
            c[r] = (srt_key(acc[mt][r]) & ~127u) | ((127u - idx0) & ~4u) | lowb; }
        sort16_desc(c);
        if (mt == 0) {
#pragma unroll
            for (int k = 0; k < 16; ++k) tk[k] = c[k]; }
        else merge16_top(tk, c); }
    unsigned pk[16];
#pragma unroll
    for (int k = 0; k < 16; ++k) pk[k] = (unsigned)__shfl_xor((int)tk[k], 32);
    merge16_top(tk, pk);
}
#else
#pragma unroll
    for (int k = 0; k < 16; ++k) tk[k] = 0u;
#pragma unroll
    for (int mt = 0; mt < 4; ++mt)
#pragma unroll
        for (int r = 0; r < 16; ++r) { const unsigned idx0 = 32u * mt + (r & 3) + 8u * (r >> 2);
            const unsigned key = (srt_key(acc[mt][r]) & ~127u) | ((127u - idx0) & ~4u) | lowb; INS16(tk, key); }
    unsigned pk[16];
#pragma unroll
    for (int k = 0; k < 16; ++k) pk[k] = (unsigned)__shfl_xor((int)tk[k], 32);
#pragma unroll
    for (int k = 0; k < 16; ++k) INS16(tk, pk[k]);
}
#endif
template <class IP, class WP> __device__ __forceinline__ void route_unit(const Ctx& F, KArgs A, int l, int u, LAS unsigned char* scr, IP IDX, WP WTS, int tbase) {
    const bf16* Q2 = (const bf16*)(A.ws + WS_Q2); const bf16* SK = (const bf16*)(A.ws + WS_W + (size_t)l * W_LAYER + W_SK);
    asm volatile("" : "+s"(SK));
    const int row = F.lane & 31, kh = F.lane >> 5;
    {
        const int t = 4 * u + (row >> 3), hh = row & 7;
        unsigned tk0[16], tk1[16];
        const GAS bf16* SKg = (const GAS bf16*)SK;
        route_top16(tk0, Q2 + (size_t)t * 2048 + hh * 256 + 8 * kh, SKg + (size_t)row * 128 + 8 * kh, F.lane);
        route_top16(tk1, Q2 + (size_t)t * 2048 + hh * 256 + 128 + 8 * kh, SKg + 128 * 128 + (size_t)row * 128 + 8 * kh, F.lane);
        float s0[16], s1[16];
#pragma unroll
        for (int k = 0; k < 16; ++k) { s0[k] = srt_val(tk0[k] & ~127u); s1[k] = srt_val(tk1[k] & ~127u); }
        LAS unsigned* sw = (LAS unsigned*)(scr + F.lane * 36);
#pragma unroll
        for (int k = 0; k < 4; ++k) {
            sw[k] = (127u - (tk0[4 * k] & 127u)) | ((127u - (tk0[4 * k + 1] & 127u)) << 8) | ((127u - (tk0[4 * k + 2] & 127u)) << 16) | ((127u - (tk0[4 * k + 3] & 127u)) << 24);
            sw[4 + k] = (127u - (tk1[4 * k] & 127u)) | ((127u - (tk1[4 * k + 1] & 127u)) << 8) | ((127u - (tk1[4 * k + 2] & 127u)) << 16) | ((127u - (tk1[4 * k + 3] & 127u)) << 24); }
        unsigned bk[16];
#if ROUTE_SORTNET
#define PKEY_(i, j) ((srt_key(s0[i] + s1[j]) & ~255u) | (255u - (unsigned)((i) * 16 + (j))))
        {
            unsigned c[16];
#pragma unroll
            for (int j = 0; j < 16; ++j) bk[j] = PKEY_(0, j);
#pragma unroll
            for (int i = 1; i < 16; ++i) c[i - 1] = PKEY_(i, 0);
            c[15] = 0u;
            merge16_top(bk, c);
            int n = 0;
#pragma unroll
            for (int i = 1; i < 8; ++i)
#pragma unroll
                for (int j = 1; j < 8; ++j) if ((i + 1) * (j + 1) <= 16) { const unsigned key = PKEY_(i, j); if (n < 16) c[n] = key; else INS16(bk, key); ++n; }
            sort16_desc(c);
            merge16_top(bk, c);
        }
#undef PKEY_
#else
#pragma unroll
        for (int k = 0; k < 16; ++k) bk[k] = 0u;
#pragma unroll
        for (int i = 0; i < 16; ++i)
#pragma unroll
            for (int j = 0; j < 16; ++j) if ((i + 1) * (j + 1) <= 16) { const unsigned key = (srt_key(s0[i] + s1[j]) & ~255u) | (255u - (unsigned)(i * 16 + j)); INS16(bk, key); }
#endif
        LDS_WAIT();
        const LAS unsigned char* sb = (const LAS unsigned char*)(scr + F.lane * 36);
        int ei[16]; float wv[16]; float den = 0.f; const float m0 = srt_val(bk[0] & ~255u);
#pragma unroll
        for (int r = 0; r < 16; ++r) { const unsigned ij = 255u - (bk[r] & 255u); ei[r] = (int)sb[ij >> 4] * 128 + (int)sb[16 + (ij & 15)];
            wv[r] = __expf(srt_val(bk[r] & ~255u) - m0); den += wv[r]; }
        const float rden = 1.0f / den;
        if (kh == 0) {
#pragma unroll
            for (int r = 0; r < 16; ++r) IDX[(size_t)(t - tbase) * 128 + hh * 16 + r] = ei[r]; }
        else {
#pragma unroll
            for (int r = 0; r < 16; ++r) WTS[(size_t)(t - tbase) * 128 + hh * 16 + r] = wv[r] * rden; }
        LDS_WAIT();
    }
}
__device__ __forceinline__ void phase_route(const Ctx& F, KArgs A, int l) {
    LAS unsigned char* scr = F.lds + RING_OFF + F.wave * 4096;
    for (int u = F.gw; u < T / 4; u += F.NGW) route_unit(F, A, l, u, scr, (int*)(A.ws + WS_IDX), (float*)(A.ws + WS_WTS), 0);
}
#ifndef PROBE_U_VALU
#define PROBE_U_VALU 0
#endif
#ifndef PROBE_EXP_REP
#define PROBE_EXP_REP 1
#endif
typedef __bf16 bf16x2_t __attribute__((ext_vector_type(2)));
__device__ __forceinline__ float dot2bf(unsigned a, unsigned b, float c) { return __builtin_amdgcn_fdot2_f32_bf16(__builtin_bit_cast(bf16x2_t, a), __builtin_bit_cast(bf16x2_t, b), c, false); }
template <int XM> __device__ __forceinline__ float lane_xchg(float v) {
    const int x = __builtin_bit_cast(int, v);
    if constexpr (XM == 1) return __builtin_bit_cast(float, __builtin_amdgcn_mov_dpp(x, 0xB1, 0xF, 0xF, true));
    else if constexpr (XM == 2) return __builtin_bit_cast(float, __builtin_amdgcn_mov_dpp(x, 0x4E, 0xF, 0xF, true));
    else if constexpr (XM == 4) return __builtin_bit_cast(float, __builtin_amdgcn_ds_swizzle(x, 0x101F));
    else if constexpr (XM == 8) return __builtin_bit_cast(float, __builtin_amdgcn_ds_swizzle(x, 0x201F));
    else if constexpr (XM == 16) return __builtin_bit_cast(float, __builtin_amdgcn_ds_swizzle(x, 0x401F));
    else return __shfl_xor(v, 32);
}
template <int XM> __device__ __forceinline__ int lane_xchg(int x) {
    if constexpr (XM == 1) return __builtin_amdgcn_mov_dpp(x, 0xB1, 0xF, 0xF, true);
    else if constexpr (XM == 2) return __builtin_amdgcn_mov_dpp(x, 0x4E, 0xF, 0xF, true);
    else if constexpr (XM == 4) return __builtin_amdgcn_ds_swizzle(x, 0x101F);
    else if constexpr (XM == 8) return __builtin_amdgcn_ds_swizzle(x, 0x201F);
    else if constexpr (XM == 16) return __builtin_amdgcn_ds_swizzle(x, 0x401F);
    else return __shfl_xor(x, 32);
}
__device__ __forceinline__ float reduce16(const float (&p)[16], int lane) {
    float a[8], b[4], c[2];
    const bool b0 = lane & 1, b1 = lane & 2, b2 = lane & 4, b3 = lane & 8;
#pragma unroll
    for (int i = 0; i < 8; ++i) a[i] = (b0 ? p[2 * i + 1] : p[2 * i]) + lane_xchg<1>(b0 ? p[2 * i] : p[2 * i + 1]);
#pragma unroll
    for (int i = 0; i < 4; ++i) b[i] = (b1 ? a[2 * i + 1] : a[2 * i]) + lane_xchg<2>(b1 ? a[2 * i] : a[2 * i + 1]);
#pragma unroll
    for (int i = 0; i < 2; ++i) c[i] = (b2 ? b[2 * i + 1] : b[2 * i]) + lane_xchg<4>(b2 ? b[2 * i] : b[2 * i + 1]);
    float d = (b3 ? c[1] : c[0]) + lane_xchg<8>(b3 ? c[0] : c[1]);
    d += lane_xchg<16>(d);
    d += lane_xchg<32>(d);
    return d;
}
__device__ __forceinline__ void expert_token(const Ctx& F, KArgs A, int l, int t, const int idx0, const int idx1, const float wt0, const float wt1) {
    const bf16* H = (const bf16*)(A.ws + WS_H); const unsigned char* UE = A.ws + WS_UE; const unsigned char* VE = A.ws + WS_VE;
    const float* mod = (const float*)(A.ws + WS_MOD);
    bf16* Hn = (bf16*)(A.ws + WS_H);
    const unsigned lo16 = (unsigned)F.lane * 16u; (void)lo16;
    {
        const v4u ha = *(const v4u*)(H + (size_t)t * D + 8 * F.lane), hb = *(const v4u*)(H + (size_t)t * D + 512 + 8 * F.lane);
#if EXP_I8 && !DBG_ROUTE32
        const float su0 = ((const float*)(A.ws + WS_US))[idx0], su1 = ((const float*)(A.ws + WS_US))[idx1], sv0 = ((const float*)(A.ws + WS_VS))[idx0], sv1 = ((const float*)(A.ws + WS_VS))[idx1];
        float hv[16];
        hv[0] = bflo(ha.x); hv[1] = bfhi(ha.x); hv[2] = bflo(ha.y); hv[3] = bfhi(ha.y); hv[4] = bflo(ha.z); hv[5] = bfhi(ha.z); hv[6] = bflo(ha.w); hv[7] = bfhi(ha.w);
        hv[8] = bflo(hb.x); hv[9] = bfhi(hb.x); hv[10] = bflo(hb.y); hv[11] = bfhi(hb.y); hv[12] = bflo(hb.z); hv[13] = bfhi(hb.z); hv[14] = bflo(hb.w); hv[15] = bfhi(hb.w);
        float hs = 0.f;
#pragma unroll
        for (int k = 0; k < 16; ++k) hs += hv[k];
        const float hsum = wave_sum(hs);
        const unsigned lo16b = (unsigned)F.lane * 16u;
#define UB(w, i) ((float)(((w) >> (8 * (i))) & 255u))
        float act0 = 0.f, act1 = 0.f;
        for (int b = 0; b < 8 * PROBE_EXP_REP; ++b) {
            const int isel = ((b & 7) < 4) ? idx0 : idx1; const int lb = 16 * (b & 3);
            v4u rr[16];
#pragma unroll
            for (int j = 0; j < 16; ++j) { const unsigned ie = (unsigned)rdlanei(isel, lb + j); rr[j] = *(const v4u*)(UE + (size_t)ie * 1024u + lo16b) ^ 0x80808080u; }
            float p[16];
#pragma unroll
            for (int j = 0; j < 16; ++j) { const v4u r = rr[j];
                float s0 = hv[0] * UB(r.x, 0); s0 += hv[1] * UB(r.x, 1); s0 += hv[2] * UB(r.x, 2); s0 += hv[3] * UB(r.x, 3);
                float s1 = hv[4] * UB(r.y, 0); s1 += hv[5] * UB(r.y, 1); s1 += hv[6] * UB(r.y, 2); s1 += hv[7] * UB(r.y, 3);
                s0 += hv[8] * UB(r.z, 0); s0 += hv[9] * UB(r.z, 1); s0 += hv[10] * UB(r.z, 2); s0 += hv[11] * UB(r.z, 3);
                s1 += hv[12] * UB(r.w, 0); s1 += hv[13] * UB(r.w, 1); s1 += hv[14] * UB(r.w, 2); s1 += hv[15] * UB(r.w, 3);
                p[j] = s0 + s1; }
#if PROBE_U_VALU
            asm volatile("" : "+v"(hv[0]), "+v"(hv[1]), "+v"(hv[2]), "+v"(hv[3]), "+v"(hv[4]), "+v"(hv[5]), "+v"(hv[6]), "+v"(hv[7]));
#pragma unroll
            for (int j = 0; j < 16; ++j) { const v4u r = rr[j];
                float s0 = hv[0] * UB(r.x, 0); s0 += hv[1] * UB(r.x, 1); s0 += hv[2] * UB(r.x, 2); s0 += hv[3] * UB(r.x, 3);
                float s1 = hv[4] * UB(r.y, 0); s1 += hv[5] * UB(r.y, 1); s1 += hv[6] * UB(r.y, 2); s1 += hv[7] * UB(r.y, 3);
                s0 += hv[8] * UB(r.z, 0); s0 += hv[9] * UB(r.z, 1); s0 += hv[10] * UB(r.z, 2); s0 += hv[11] * UB(r.z, 3);
                s1 += hv[12] * UB(r.w, 0); s1 += hv[13] * UB(r.w, 1); s1 += hv[14] * UB(r.w, 2); s1 += hv[15] * UB(r.w, 3);
                p[j] = 0.5f * (p[j] + (s0 + s1)); }
#endif
            const float tot = reduce16(p, F.lane);
            if ((F.lane >> 4) == (b & 3)) { if ((b & 7) < 4) act0 = tot; else act1 = tot; }
        }
        act0 = su0 * (act0 - 128.0f * hsum); act1 = su1 * (act1 - 128.0f * hsum);
        const float w0 = wt0 * sv0 * 0.5f * act0 * (1.0f + erff(act0 * 0.7071067811865476f)), w1 = wt1 * sv1 * 0.5f * act1 * (1.0f + erff(act1 * 0.7071067811865476f));
        const float csum = wave_sum(w0 + w1);
        float o[16];
#pragma unroll
        for (int k = 0; k < 16; ++k) o[k] = 0.f;
        for (int b = 0; b < 8 * PROBE_EXP_REP; ++b) {
            if (b == 8) {
#pragma unroll
                for (int k = 0; k < 16; ++k) o[k] = 0.f; }
            const int isel = ((b & 7) < 4) ? idx0 : idx1; const float wsel = ((b & 7) < 4) ? w0 : w1; const int lb = 16 * (b & 3);
            v4u rr[16];
#pragma unroll
            for (int j = 0; j < 16; ++j) { const unsigned ie = (unsigned)rdlanei(isel, lb + j); rr[j] = *(const v4u*)(VE + (size_t)ie * 1024u + lo16b); }
#pragma unroll
            for (int j = 0; j < 16; ++j) { const float we = rdlane(wsel, lb + j); const v4u r = rr[j];
                o[0] += we * UB(r.x, 0); o[1] += we * UB(r.x, 1); o[2] += we * UB(r.x, 2); o[3] += we * UB(r.x, 3); o[4] += we * UB(r.y, 0); o[5] += we * UB(r.y, 1); o[6] += we * UB(r.y, 2); o[7] += we * UB(r.y, 3);
                o[8] += we * UB(r.z, 0); o[9] += we * UB(r.z, 1); o[10] += we * UB(r.z, 2); o[11] += we * UB(r.z, 3); o[12] += we * UB(r.w, 0); o[13] += we * UB(r.w, 1); o[14] += we * UB(r.w, 2); o[15] += we * UB(r.w, 3); }
        }
#pragma unroll
        for (int k = 0; k < 16; ++k) o[k] -= 128.0f * csum;
#undef UB
#else
        float act0 = 0.f, act1 = 0.f;
        for (int b = 0; b < 8 * PROBE_EXP_REP; ++b) {
            const int isel = ((b & 7) < 4) ? idx0 : idx1; const int lb = 16 * (b & 3);
            v4u ra[16], rb[16];
#pragma unroll
            for (int j = 0; j < 16; ++j) { const unsigned ie = (unsigned)rdlanei(isel, lb + j); const unsigned char* up = UE + (size_t)ie * 2048u + lo16;
                ra[j] = *(const v4u*)up; rb[j] = *(const v4u*)(up + 1024); }
            float p[16];
#pragma unroll
            for (int j = 0; j < 16; ++j) { float s = dot2bf(ha.x, ra[j].x, 0.f); s = dot2bf(ha.y, ra[j].y, s); s = dot2bf(ha.z, ra[j].z, s); s = dot2bf(ha.w, ra[j].w, s);
                s = dot2bf(hb.x, rb[j].x, s); s = dot2bf(hb.y, rb[j].y, s); s = dot2bf(hb.z, rb[j].z, s); s = dot2bf(hb.w, rb[j].w, s); p[j] = s; }
            const float tot = reduce16(p, F.lane);
            if ((F.lane >> 4) == (b & 3)) { if ((b & 7) < 4) act0 = tot; else act1 = tot; }
        }
        const float w0 = wt0 * 0.5f * act0 * (1.0f + erff(act0 * 0.7071067811865476f)), w1 = wt1 * 0.5f * act1 * (1.0f + erff(act1 * 0.7071067811865476f));
        float o[16];
#pragma unroll
        for (int k = 0; k < 16; ++k) o[k] = 0.f;
        for (int b = 0; b < 8 * PROBE_EXP_REP; ++b) {
            if (b == 8) {
#pragma unroll
                for (int k = 0; k < 16; ++k) o[k] = 0.f; }
            const int isel = ((b & 7) < 4) ? idx0 : idx1; const float wsel = ((b & 7) < 4) ? w0 : w1; const int lb = 16 * (b & 3);
            v4u ra[16], rb[16];
#pragma unroll
            for (int j = 0; j < 16; ++j) { const unsigned ie = (unsigned)rdlanei(isel, lb + j); const unsigned char* vp = VE + (size_t)ie * 2048u + lo16;
                ra[j] = *(const v4u*)vp; rb[j] = *(const v4u*)(vp + 1024); }
#pragma unroll
            for (int j = 0; j < 16; ++j) { const float we = rdlane(wsel, lb + j); const v4u a = ra[j], bb = rb[j];
                o[0] += we * bflo(a.x); o[1] += we * bfhi(a.x); o[2] += we * bflo(a.y); o[3] += we * bfhi(a.y); o[4] += we * bflo(a.z); o[5] += we * bfhi(a.z); o[6] += we * bflo(a.w); o[7] += we * bfhi(a.w);
                o[8] += we * bflo(bb.x); o[9] += we * bfhi(bb.x); o[10] += we * bflo(bb.y); o[11] += we * bfhi(bb.y); o[12] += we * bflo(bb.z); o[13] += we * bfhi(bb.z); o[14] += we * bflo(bb.w); o[15] += we * bfhi(bb.w); }
        }
#endif
        const int b = t >> 11; const float* mb = mod + ((size_t)l * 8 + b) * 6144;
        float x2[16]; float ss = 0.f;
#pragma unroll
        for (int hseg = 0; hseg < 2; ++hseg)
#pragma unroll
            for (int q4 = 0; q4 < 2; ++q4) { const int col = hseg * 512 + 8 * F.lane + 4 * q4;
                const f32x4 xv = *(const f32x4*)(A.out + (size_t)t * D + col), gv = *(const f32x4*)(mb + 5120 + col);
#pragma unroll
                for (int e = 0; e < 4; ++e) { const float v = xv[e] + gv[e] * o[hseg * 8 + q4 * 4 + e]; x2[hseg * 8 + q4 * 4 + e] = v; ss += v * v; } }
        const float r = 1.0f / sqrtf(wave_sum(ss) * (1.0f / D) + EPS);
        if (l + 1 < DEPTH) {
            const float* mn = mod + ((size_t)(l + 1) * 8 + b) * 6144; const float* gn = A.in[I_GN1] + (size_t)(l + 1) * D;
#pragma unroll
            for (int hseg = 0; hseg < 2; ++hseg) { const int col = hseg * 512 + 8 * F.lane;
                float hn[8];
#pragma unroll
                for (int q4 = 0; q4 < 2; ++q4) { const f32x4 gg = *(const f32x4*)(gn + col + 4 * q4), sc = *(const f32x4*)(mn + 1024 + col + 4 * q4), sh = *(const f32x4*)(mn + col + 4 * q4);
                    f32x4 xo;
#pragma unroll
                    for (int e = 0; e < 4; ++e) { xo[e] = x2[hseg * 8 + q4 * 4 + e]; hn[q4 * 4 + e] = xo[e] * r * gg[e] * (1.0f + sc[e]) + sh[e]; }
                    *(f32x4*)(A.out + (size_t)t * D + col + 4 * q4) = xo; }
                v4u ov; ov.x = pk2(hn[0], hn[1]); ov.y = pk2(hn[2], hn[3]); ov.z = pk2(hn[4], hn[5]); ov.w = pk2(hn[6], hn[7]);
                *(v4u*)(Hn + (size_t)t * D + col) = ov; }
        } else {
            const float* gf = A.in[I_GFIN];
#pragma unroll
            for (int hseg = 0; hseg < 2; ++hseg)
#pragma unroll
                for (int q4 = 0; q4 < 2; ++q4) { const int col = hseg * 512 + 8 * F.lane + 4 * q4; const f32x4 gg = *(const f32x4*)(gf + col); f32x4 xo;
#pragma unroll
                    for (int e = 0; e < 4; ++e) xo[e] = x2[hseg * 8 + q4 * 4 + e] * r * gg[e];
                    *(f32x4*)(A.out + (size_t)t * D + col) = xo; }
        }
    }
}

struct HQ { int q1[4], q2[4]; float s1, s2; int c1, c2; };
struct NextB { const unsigned char* tab; int isel; int lb; };
template <int N> __device__ __forceinline__ void vm_wait() { asm volatile("s_waitcnt vmcnt(%0)" :: "n"(N) : "memory"); }
__device__ __forceinline__ void dma_row(const NextB& nb, int j, unsigned lo16b, LAS unsigned char* slot) {
    const unsigned ie = (unsigned)rdlanei(nb.isel, nb.lb + j);
#if EXP6B
#if DMA_NOMASK
    const unsigned off = lo16b < (lo16b - 768u) ? lo16b : lo16b - 768u;
#if ROW_OFFS
    __builtin_amdgcn_global_load_lds((const unsigned*)(nb.tab + (size_t)(ie + off)), (LAS unsigned*)slot, 16, 0, 0);
#else
    __builtin_amdgcn_global_load_lds((const unsigned*)(nb.tab + (size_t)ie * 768u + off), (LAS unsigned*)slot, 16, 0, 0);
#endif
#else
    if (lo16b < 768u) __builtin_amdgcn_global_load_lds((const unsigned*)(nb.tab + (size_t)ie * 768u + lo16b), (LAS unsigned*)slot, 16, 0, 0);
#endif
#else
    __builtin_amdgcn_global_load_lds((const unsigned*)(nb.tab + (size_t)ie * 1024u + lo16b), (LAS unsigned*)slot, 16, 0, 0);
#endif
}
#define UBF(w, i) ((float)(((w) >> (8 * (i))) & 255u))
__device__ __forceinline__ v4u ring_row(const LAS unsigned char* slot, unsigned lo16b) {
#if EXP6B
    const v2u X = *(const LAS v2u*)(slot + (lo16b >> 1)); const unsigned Y = *(const LAS unsigned*)(slot + 512 + (lo16b >> 2));
    v4u r;
    r.x = (X.x & 0x0F0F0F0Fu) | (Y & 0x30303030u);
    r.y = (X.x & 0xF0F0F0F0u) | (Y & 0x0C0C0C0Cu);
    r.z = (X.y & 0x0F0F0F0Fu) | ((Y >> 2) & 0x30303030u);
    r.w = (X.y & 0xF0F0F0F0u) | ((Y << 2) & 0x0C0C0C0Cu);
    return r;
#else
    return *(const LAS v4u*)(slot + lo16b);
#endif
}
#if ROW_PIPE
__device__ __forceinline__ void lds_raw(v4u& raw, const LAS unsigned char* slot, unsigned lo16b) {
#if EXP6B
    const v2u X = *(const LAS v2u*)(slot + (lo16b >> 1)); raw.x = X.x; raw.y = X.y; raw.z = *(const LAS unsigned*)(slot + 512 + (lo16b >> 2));
#else
    raw = *(const LAS v4u*)(slot + lo16b);
#endif
}
__device__ __forceinline__ v4u decode_raw(const v4u& raw) {
#if EXP6B
    v4u r;
    r.x = (raw.x & 0x0F0F0F0Fu) | (raw.z & 0x30303030u);
    r.y = (raw.x & 0xF0F0F0F0u) | (raw.z & 0x0C0C0C0Cu);
    r.z = (raw.y & 0x0F0F0F0Fu) | ((raw.z >> 2) & 0x30303030u);
    r.w = (raw.y & 0xF0F0F0F0u) | ((raw.z << 2) & 0x0C0C0C0Cu);
    return r;
#else
    return raw;
#endif
}
__device__ __forceinline__ void vm_wait_n(int n) {
    switch (n) { case 15: vm_wait<15>(); break; case 14: vm_wait<14>(); break; case 13: vm_wait<13>(); break; case 12: vm_wait<12>(); break; case 11: vm_wait<11>(); break; case 10: vm_wait<10>(); break;
        case 9: vm_wait<9>(); break; case 8: vm_wait<8>(); break; case 7: vm_wait<7>(); break; case 6: vm_wait<6>(); break; case 5: vm_wait<5>(); break; case 4: vm_wait<4>(); break;
        case 3: vm_wait<3>(); break; case 2: vm_wait<2>(); break; case 1: vm_wait<1>(); break; case 0: vm_wait<0>(); break; default: break; }
}
__device__ __forceinline__ v4u row_step(LAS unsigned char* ring, v4u& raw, const NextB& nb, unsigned lo16b, int B, bool refill, int waitn) {
    __builtin_amdgcn_sched_barrier(0);
#if EXP6B
    asm volatile("s_waitcnt lgkmcnt(0)" : "+v"(raw.x), "+v"(raw.y), "+v"(raw.z) :: "memory");
#else
    asm volatile("s_waitcnt lgkmcnt(0)" : "+v"(raw.x), "+v"(raw.y), "+v"(raw.z), "+v"(raw.w) :: "memory");
#endif
    if (refill) dma_row(nb, B, lo16b, ring + B * 1024);
    const v4u cur = raw;
    if (waitn >= 0) { vm_wait_n(waitn); lds_raw(raw, ring + ((B + 1) & 15) * 1024, lo16b); __builtin_amdgcn_sched_barrier(0); }
    return decode_raw(cur);
}
#endif
#if EXP6B && H_PLANES == 1
typedef int TreeT;
#else
typedef float TreeT;
#endif
template <int L, int B> __device__ __forceinline__ TreeT rs_tree(LAS unsigned char* ring, const HQ& hq, const NextB& nb, int lane, unsigned lo16b, v4u& raw) {
    if constexpr (L == 0) {
#if ROW_PIPE
        const v4u r = row_step(ring, raw, nb, lo16b, B, true, 15);
#else
        vm_wait<15>();
        const v4u r = ring_row(ring + B * 1024, lo16b);
#endif
#if EXP6B
        int e1 = __builtin_amdgcn_sdot4(hq.q1[0], (int)r.x, 0, false); e1 = __builtin_amdgcn_sdot4(hq.q1[2], (int)r.z, e1, false);
        int d1 = __builtin_amdgcn_sdot4(hq.q1[1], (int)r.y, hq.c1, false); d1 = __builtin_amdgcn_sdot4(hq.q1[3], (int)r.w, d1, false); d1 += e1 << 2;
#if H_PLANES == 2
        int e2 = __builtin_amdgcn_sdot4(hq.q2[0], (int)r.x, 0, false); e2 = __builtin_amdgcn_sdot4(hq.q2[2], (int)r.z, e2, false);
        int d2 = __builtin_amdgcn_sdot4(hq.q2[1], (int)r.y, hq.c2, false); d2 = __builtin_amdgcn_sdot4(hq.q2[3], (int)r.w, d2, false); d2 += e2 << 2;
#endif
#else
        int d1 = __builtin_amdgcn_sdot4(hq.q1[0], (int)r.x, 0, false); d1 = __builtin_amdgcn_sdot4(hq.q1[1], (int)r.y, d1, false); d1 = __builtin_amdgcn_sdot4(hq.q1[2], (int)r.z, d1, false); d1 = __builtin_amdgcn_sdot4(hq.q1[3], (int)r.w, d1, false);
        int d2 = __builtin_amdgcn_sdot4(hq.q2[0], (int)r.x, 0, false); d2 = __builtin_amdgcn_sdot4(hq.q2[1], (int)r.y, d2, false); d2 = __builtin_amdgcn_sdot4(hq.q2[2], (int)r.z, d2, false); d2 = __builtin_amdgcn_sdot4(hq.q2[3], (int)r.w, d2, false);
#endif
#if H_PLANES == 2
        const float p = (float)d1 * hq.s1 + (float)d2 * hq.s2;
#else
        const int p = d1;
#endif
#if !ROW_PIPE
        asm volatile("s_waitcnt lgkmcnt(0)" :: "v"(p) : "memory");
        dma_row(nb, B, lo16b, ring + B * 1024);
#endif
        return p;
    } else {
        constexpr int HS = 1 << (L - 1);
        const TreeT lo = rs_tree<L - 1, B>(ring, hq, nb, lane, lo16b, raw), hi = rs_tree<L - 1, B + HS>(ring, hq, nb, lane, lo16b, raw);
#if TREE_BANKMASK && EXP6B && H_PLANES == 1
        if constexpr (HS >= 4) {
            int t;
            if constexpr (HS == 4) { t = lo + __builtin_amdgcn_mov_dpp(lo, 0x104, 0xF, 0xF, true);
                asm volatile("s_nop 1\n\tv_add_u32_dpp %0, %1, %1 row_shr:4 row_mask:0xf bank_mask:0xa" : "+v"(t) : "v"(hi)); }
            else { t = lo + __builtin_amdgcn_mov_dpp(lo, 0x128, 0xF, 0xF, true);
                asm volatile("s_nop 1\n\tv_add_u32_dpp %0, %1, %1 row_ror:8 row_mask:0xf bank_mask:0xc" : "+v"(t) : "v"(hi)); }
            return t;
        }
#endif
        const bool up = lane & HS;
        return (up ? hi : lo) + lane_xchg<HS>(up ? lo : hi);
    }
}
__device__ __forceinline__ float consume_u(LAS unsigned char* ring, const HQ& hq, const NextB& nb, int lane, unsigned lo16b, v4u& raw) {
    TreeT d = rs_tree<4, 0>(ring, hq, nb, lane, lo16b, raw);
    d += lane_xchg<16>(d);
    d += lane_xchg<32>(d);
#if EXP6B && H_PLANES == 1
    return (float)d * hq.s1;
#else
    return d;
#endif
}
template <bool LASTB> __device__ __forceinline__ void consume_v(LAS unsigned char* ring, float (&o)[16], float wsel, int lb, const NextB& nb, unsigned lo16b) {
#pragma unroll
    for (int j = 0; j < 16; ++j) {
        if constexpr (LASTB) { switch (j) { case 0: vm_wait<15>(); break; case 1: vm_wait<14>(); break; case 2: vm_wait<13>(); break; case 3: vm_wait<12>(); break; case 4: vm_wait<11>(); break; case 5: vm_wait<10>(); break; case 6: vm_wait<9>(); break; case 7: vm_wait<8>(); break;
            case 8: vm_wait<7>(); break; case 9: vm_wait<6>(); break; case 10: vm_wait<5>(); break; case 11: vm_wait<4>(); break; case 12: vm_wait<3>(); break; case 13: vm_wait<2>(); break; case 14: vm_wait<1>(); break; default: vm_wait<0>(); break; } }
        else vm_wait<15>();
        const float we = rdlane(wsel, lb + j); const v4u r = *(const LAS v4u*)(ring + j * 1024 + lo16b);
        o[0] += we * UBF(r.x, 0); o[1] += we * UBF(r.x, 1); o[2] += we * UBF(r.x, 2); o[3] += we * UBF(r.x, 3); o[4] += we * UBF(r.y, 0); o[5] += we * UBF(r.y, 1); o[6] += we * UBF(r.y, 2); o[7] += we * UBF(r.y, 3);
        o[8] += we * UBF(r.z, 0); o[9] += we * UBF(r.z, 1); o[10] += we * UBF(r.z, 2); o[11] += we * UBF(r.z, 3); o[12] += we * UBF(r.w, 0); o[13] += we * UBF(r.w, 1); o[14] += we * UBF(r.w, 2); o[15] += we * UBF(r.w, 3);
        if constexpr (!LASTB) { asm volatile("s_waitcnt lgkmcnt(0)" :: "v"(o[0]), "v"(o[5]), "v"(o[10]), "v"(o[15]) : "memory"); dma_row(nb, j, lo16b, ring + j * 1024); }
    }
}
#if V_MFMA
typedef int v4i __attribute__((ext_vector_type(4)));
#if V_ABID
template <bool LASTB, int J> __device__ __forceinline__ void vm_row(LAS unsigned char* ring, v4i (&a1)[4], int aq, const NextB& nb, unsigned lo16b, v4u& raw) {
    const v4u r = row_step(ring, raw, nb, lo16b, J, !LASTB, LASTB ? 14 - J : 15);
    a1[0] = __builtin_amdgcn_mfma_i32_4x4x4i8(aq, (int)r.x, a1[0], 4, J, 0); a1[1] = __builtin_amdgcn_mfma_i32_4x4x4i8(aq, (int)r.y, a1[1], 4, J, 0);
    a1[2] = __builtin_amdgcn_mfma_i32_4x4x4i8(aq, (int)r.z, a1[2], 4, J, 0); a1[3] = __builtin_amdgcn_mfma_i32_4x4x4i8(aq, (int)r.w, a1[3], 4, J, 0);
}
template <bool LASTB> __device__ __forceinline__ void consume_vm(LAS unsigned char* ring, v4i (&a1)[4], v4i (&a2)[4], int cqsel, int lb, const NextB& nb, unsigned lo16b, unsigned sh8, v4u& raw) {
    static_assert(ROW_PIPE && V_PLANES == 1, "V_ABID: pipelined rows, one c plane");
    const int aq = (__shfl(cqsel, lb + (int)(lo16b >> 6)) & 255) << sh8;
    vm_row<LASTB, 0>(ring, a1, aq, nb, lo16b, raw); vm_row<LASTB, 1>(ring, a1, aq, nb, lo16b, raw); vm_row<LASTB, 2>(ring, a1, aq, nb, lo16b, raw); vm_row<LASTB, 3>(ring, a1, aq, nb, lo16b, raw);
    vm_row<LASTB, 4>(ring, a1, aq, nb, lo16b, raw); vm_row<LASTB, 5>(ring, a1, aq, nb, lo16b, raw); vm_row<LASTB, 6>(ring, a1, aq, nb, lo16b, raw); vm_row<LASTB, 7>(ring, a1, aq, nb, lo16b, raw);
    vm_row<LASTB, 8>(ring, a1, aq, nb, lo16b, raw); vm_row<LASTB, 9>(ring, a1, aq, nb, lo16b, raw); vm_row<LASTB, 10>(ring, a1, aq, nb, lo16b, raw); vm_row<LASTB, 11>(ring, a1, aq, nb, lo16b, raw);
    vm_row<LASTB, 12>(ring, a1, aq, nb, lo16b, raw); vm_row<LASTB, 13>(ring, a1, aq, nb, lo16b, raw); vm_row<LASTB, 14>(ring, a1, aq, nb, lo16b, raw); vm_row<LASTB, 15>(ring, a1, aq, nb, lo16b, raw);
    (void)a2;
}
#else
template <bool LASTB> __device__ __forceinline__ void consume_vm(LAS unsigned char* ring, v4i (&a1)[4], v4i (&a2)[4], int cqsel, int lb, const NextB& nb, unsigned lo16b, unsigned sh8, v4u& raw) {
#pragma unroll
    for (int j = 0; j < 16; ++j) {
#if ROW_PIPE
        const v4u r = row_step(ring, raw, nb, lo16b, j, !LASTB, LASTB ? 14 - j : 15); const int cs = rdlanei(cqsel, lb + j);
#else
        if constexpr (LASTB) { switch (j) { case 0: vm_wait<15>(); break; case 1: vm_wait<14>(); break; case 2: vm_wait<13>(); break; case 3: vm_wait<12>(); break; case 4: vm_wait<11>(); break; case 5: vm_wait<10>(); break; case 6: vm_wait<9>(); break; case 7: vm_wait<8>(); break;
            case 8: vm_wait<7>(); break; case 9: vm_wait<6>(); break; case 10: vm_wait<5>(); break; case 11: vm_wait<4>(); break; case 12: vm_wait<3>(); break; case 13: vm_wait<2>(); break; case 14: vm_wait<1>(); break; default: vm_wait<0>(); break; } }
        else vm_wait<15>();
        const int cs = rdlanei(cqsel, lb + j); const v4u r = ring_row(ring + j * 1024, lo16b);
#endif
        const int c1 = (cs & 255) << sh8, c2 = ((cs >> 8) & 255) << sh8;
#if V_PLANES == 2
        a1[0] = __builtin_amdgcn_mfma_i32_4x4x4i8(c1, (int)r.x, a1[0], 0, 0, 0); a2[0] = __builtin_amdgcn_mfma_i32_4x4x4i8(c2, (int)r.x, a2[0], 0, 0, 0);
        a1[1] = __builtin_amdgcn_mfma_i32_4x4x4i8(c1, (int)r.y, a1[1], 0, 0, 0); a2[1] = __builtin_amdgcn_mfma_i32_4x4x4i8(c2, (int)r.y, a2[1], 0, 0, 0);
        a1[2] = __builtin_amdgcn_mfma_i32_4x4x4i8(c1, (int)r.z, a1[2], 0, 0, 0); a2[2] = __builtin_amdgcn_mfma_i32_4x4x4i8(c2, (int)r.z, a2[2], 0, 0, 0);
        a1[3] = __builtin_amdgcn_mfma_i32_4x4x4i8(c1, (int)r.w, a1[3], 0, 0, 0); a2[3] = __builtin_amdgcn_mfma_i32_4x4x4i8(c2, (int)r.w, a2[3], 0, 0, 0);
#else
        a1[0] = __builtin_amdgcn_mfma_i32_4x4x4i8(c1, (int)r.x, a1[0], 0, 0, 0); a1[1] = __builtin_amdgcn_mfma_i32_4x4x4i8(c1, (int)r.y, a1[1], 0, 0, 0);
        a1[2] = __builtin_amdgcn_mfma_i32_4x4x4i8(c1, (int)r.z, a1[2], 0, 0, 0); a1[3] = __builtin_amdgcn_mfma_i32_4x4x4i8(c1, (int)r.w, a1[3], 0, 0, 0); (void)c2;
#endif
#if !ROW_PIPE
        if constexpr (!LASTB) { asm volatile("s_waitcnt lgkmcnt(0)" :: "v"(r.x), "v"(r.y), "v"(r.z), "v"(r.w) : "memory"); dma_row(nb, j, lo16b, ring + j * 1024); }
#endif
    }
}
#endif
#endif
template <bool HAVE_X1> __device__ __forceinline__ void expert_epilogue(const Ctx& F, KArgs A, int l, int t, const float (&o)[16], const float (&x1v)[16]) {
    const float* mod = (const float*)(A.ws + WS_MOD); bf16* Hn = (bf16*)(A.ws + WS_H);
    const int b = t >> 11; const float* mb = mod + ((size_t)l * 8 + b) * 6144;
    float x2[16]; float ss = 0.f;
#pragma unroll
    for (int hseg = 0; hseg < 2; ++hseg)
#pragma unroll
        for (int q4 = 0; q4 < 2; ++q4) { const int col = hseg * 512 + 8 * F.lane + 4 * q4;
            f32x4 xv; if constexpr (HAVE_X1) xv = (f32x4){x1v[hseg * 8 + q4 * 4], x1v[hseg * 8 + q4 * 4 + 1], x1v[hseg * 8 + q4 * 4 + 2], x1v[hseg * 8 + q4 * 4 + 3]}; else xv = *(const f32x4*)(A.out + (size_t)t * D + col);
            const f32x4 gv = *(const f32x4*)(mb + 5120 + col);
#pragma unroll
            for (int e = 0; e < 4; ++e) { const float v = xv[e] + gv[e] * o[hseg * 8 + q4 * 4 + e]; x2[hseg * 8 + q4 * 4 + e] = v; ss += v * v; } }
    const float r = 1.0f / sqrtf(wave_sum(ss) * (1.0f / D) + EPS);
    if (l + 1 < DEPTH) {
        const float* mn = mod + ((size_t)(l + 1) * 8 + b) * 6144; const float* gn = A.in[I_GN1] + (size_t)(l + 1) * D;
#pragma unroll
        for (int hseg = 0; hseg < 2; ++hseg) { const int col = hseg * 512 + 8 * F.lane;
            float hn[8];
#pragma unroll
            for (int q4 = 0; q4 < 2; ++q4) { const f32x4 gg = *(const f32x4*)(gn + col + 4 * q4), sc = *(const f32x4*)(mn + 1024 + col + 4 * q4), sh = *(const f32x4*)(mn + col + 4 * q4);
                f32x4 xo;
#pragma unroll
                for (int e = 0; e < 4; ++e) { xo[e] = x2[hseg * 8 + q4 * 4 + e]; hn[q4 * 4 + e] = xo[e] * r * gg[e] * (1.0f + sc[e]) + sh[e]; }
                *(f32x4*)(A.out + (size_t)t * D + col + 4 * q4) = xo; }
            v4u ov; ov.x = pk2(hn[0], hn[1]); ov.y = pk2(hn[2], hn[3]); ov.z = pk2(hn[4], hn[5]); ov.w = pk2(hn[6], hn[7]);
            *(v4u*)(Hn + (size_t)t * D + col) = ov; }
    } else {
        const float* gf = A.in[I_GFIN];
#pragma unroll
        for (int hseg = 0; hseg < 2; ++hseg)
#pragma unroll
            for (int q4 = 0; q4 < 2; ++q4) { const int col = hseg * 512 + 8 * F.lane + 4 * q4; const f32x4 gg = *(const f32x4*)(gf + col); f32x4 xo;
#pragma unroll
                for (int e = 0; e < 4; ++e) xo[e] = x2[hseg * 8 + q4 * 4 + e] * r * gg[e];
                *(f32x4*)(A.out + (size_t)t * D + col) = xo; }
    }
}
#if EPI_HOIST
struct EpiC { float g2[16], cn[16], shn[16]; };
__device__ __forceinline__ void epi_coeffs(EpiC& C, const Ctx& F, KArgs A, int l, int t0) {
    const float* mod = (const float*)(A.ws + WS_MOD); const int b = t0 >> 11; const float* mb = mod + ((size_t)l * 8 + b) * 6144;
#pragma unroll
    for (int i = 0; i < 4; ++i) { const int col = (i >> 1) * 512 + 8 * F.lane + 4 * (i & 1);
        const f32x4 gv = *(const f32x4*)(mb + 5120 + col);
        f32x4 gg, sc, sh;
        if (l + 1 < DEPTH) { const float* mn = mod + ((size_t)(l + 1) * 8 + b) * 6144; gg = *(const f32x4*)(A.in[I_GN1] + (size_t)(l + 1) * D + col); sc = *(const f32x4*)(mn + 1024 + col); sh = *(const f32x4*)(mn + col); }
        else { gg = *(const f32x4*)(A.in[I_GFIN] + col); sc = (f32x4){0.f, 0.f, 0.f, 0.f}; sh = sc; }
#pragma unroll
        for (int e = 0; e < 4; ++e) { C.g2[4 * i + e] = gv[e]; C.cn[4 * i + e] = gg[e] * (1.0f + sc[e]); C.shn[4 * i + e] = sh[e]; } }
}
__device__ __forceinline__ void expert_epilogue_c(const Ctx& F, KArgs A, int l, int t, const float (&o)[16], const float (&x1v)[16], const EpiC& C) {
    bf16* Hn = (bf16*)(A.ws + WS_H);
    float x2[16]; float ss = 0.f;
#pragma unroll
    for (int e = 0; e < 16; ++e) { const float v = x1v[e] + C.g2[e] * o[e]; x2[e] = v; ss += v * v; }
    const float r = 1.0f / sqrtf(wave_sum(ss) * (1.0f / D) + EPS);
    if (l + 1 < DEPTH) {
#pragma unroll
        for (int hseg = 0; hseg < 2; ++hseg) { const int col = hseg * 512 + 8 * F.lane;
            float hn[8];
#pragma unroll
            for (int q4 = 0; q4 < 2; ++q4) {
#pragma unroll
                for (int e = 0; e < 4; ++e) hn[q4 * 4 + e] = x2[hseg * 8 + q4 * 4 + e] * r * C.cn[hseg * 8 + q4 * 4 + e] + C.shn[hseg * 8 + q4 * 4 + e]; }
            { v4u xo; xo.x = pk2(x2[hseg * 8 + 0], x2[hseg * 8 + 1]); xo.y = pk2(x2[hseg * 8 + 2], x2[hseg * 8 + 3]); xo.z = pk2(x2[hseg * 8 + 4], x2[hseg * 8 + 5]); xo.w = pk2(x2[hseg * 8 + 6], x2[hseg * 8 + 7]);
              *(v4u*)((bf16*)A.out + (size_t)t * D + col) = xo; }
            v4u ov; ov.x = pk2(hn[0], hn[1]); ov.y = pk2(hn[2], hn[3]); ov.z = pk2(hn[4], hn[5]); ov.w = pk2(hn[6], hn[7]);
            *(v4u*)(Hn + (size_t)t * D + col) = ov; }
    } else {
#pragma unroll
        for (int hseg = 0; hseg < 2; ++hseg)
#pragma unroll
            for (int q4 = 0; q4 < 2; ++q4) { const int col = hseg * 512 + 8 * F.lane + 4 * q4; f32x4 xo;
#pragma unroll
                for (int e = 0; e < 4; ++e) xo[e] = x2[hseg * 8 + q4 * 4 + e] * r * C.cn[hseg * 8 + q4 * 4 + e];
                *(f32x4*)(A.out + (size_t)t * D + col) = xo; }
    }
}
#endif
__device__ __forceinline__ void experts_unit4(const Ctx& F, KArgs A, int l, int t0, LAS unsigned char* ring, const LAS unsigned short* il, const LAS float* wl) {
    const bf16* H = (const bf16*)(A.ws + WS_H); const unsigned char* UE = A.ws + WS_UE; const unsigned char* VE = A.ws + WS_VE;
    const float* US = (const float*)(A.ws + WS_US); const float* VS = (const float*)(A.ws + WS_VS);
    const unsigned lo16b = (unsigned)F.lane * 16u;
#if EPI_HOIST
    static_assert(NORM_FOLD, "EPI_HOIST: x1 comes from the token loop");
    EpiC EC; epi_coeffs(EC, F, A, l, t0);
#endif
#if H2C_HOIST
    float cg[16], csh[16];
    { const float* mb = (const float*)(A.ws + WS_MOD) + ((size_t)l * 8 + (t0 >> 11)) * 6144; const float* g2 = A.in[I_GN2] + (size_t)l * D;
#pragma unroll
      for (int i = 0; i < 4; ++i) { const int col = (i >> 1) * 512 + 8 * F.lane + 4 * (i & 1);
          const f32x4 gg = *(const f32x4*)(g2 + col), sc = *(const f32x4*)(mb + 4096 + col), sh = *(const f32x4*)(mb + 3072 + col);
#pragma unroll
          for (int e = 0; e < 4; ++e) { cg[4 * i + e] = gg[e] * (1.0f + sc[e]); csh[4 * i + e] = sh[e]; } } }
#endif
#if X1_PREFETCH
    f32x4 xn[4];
    auto ldx1 = [&](f32x4 (&xv)[4], int tok) {
        const bf16* xr = (const bf16*)(A.ws + WS_X1B) + (size_t)tok * D + 8 * F.lane; const v4u a = *(const v4u*)xr, b = *(const v4u*)(xr + 512);
        xv[0] = (f32x4){bflo(a.x), bfhi(a.x), bflo(a.y), bfhi(a.y)}; xv[1] = (f32x4){bflo(a.z), bfhi(a.z), bflo(a.w), bfhi(a.w)};
        xv[2] = (f32x4){bflo(b.x), bfhi(b.x), bflo(b.y), bfhi(b.y)}; xv[3] = (f32x4){bflo(b.z), bfhi(b.z), bflo(b.w), bfhi(b.w)}; };
    ldx1(xn, t0);
#endif
    int nidx0 = il[F.lane];
#if ROW_OFFS
    int nro0 = nidx0 * (int)EROW;
#else
#define nro0 nidx0
#define ro0 idx0
#define ro1 idx1
#endif
    { NextB nb{UE, nro0, 0};
#pragma unroll
      for (int j = 0; j < 16; ++j) dma_row(nb, j, lo16b, ring + j * 1024); }
    v4u raw = (v4u){0u, 0u, 0u, 0u};
#pragma unroll 1
    for (int k = 0; k < 4; ++k) {
        const int t = t0 + k; const int idx0 = nidx0, idx1 = il[k * 128 + 64 + F.lane]; const float wx0k = wl[k * 128 + F.lane], wx1k = wl[k * 128 + 64 + F.lane];
#if ROW_OFFS
        const int ro0 = nro0, ro1 = idx1 * (int)EROW;
#endif
        nidx0 = il[(k < 3 ? k + 1 : 3) * 128 + F.lane];
#if ROW_OFFS
        nro0 = nidx0 * (int)EROW;
#endif
        const float su0 = US[idx0], su1 = US[idx1], sv0 = VS[idx0], sv1 = VS[idx1];
        HQ hq; float x1v[16];
        { float hv[16];
#if NORM_FOLD
          {
              const float* xr = A.out + (size_t)t * D; const float* mb = (const float*)(A.ws + WS_MOD) + ((size_t)l * 8 + (t >> 11)) * 6144; const float* g2 = A.in[I_GN2] + (size_t)l * D;
              float ss = 0.f;
#pragma unroll
              for (int hseg = 0; hseg < 2; ++hseg)
#pragma unroll
                  for (int q4 = 0; q4 < 2; ++q4) {
#if X1_PREFETCH
                      const f32x4 xv = xn[hseg * 2 + q4];
#else
                      const f32x4 xv = *(const f32x4*)(xr + hseg * 512 + 8 * F.lane + 4 * q4);
#endif
#pragma unroll
                      for (int e = 0; e < 4; ++e) { hv[hseg * 8 + q4 * 4 + e] = xv[e]; x1v[hseg * 8 + q4 * 4 + e] = xv[e]; ss += xv[e] * xv[e]; } }
#if X1_PREFETCH
              ldx1(xn, t + (k < 3 ? 1 : 0));
#endif
              const float r = 1.0f / sqrtf(wave_sum(ss) * (1.0f / D) + EPS);
#pragma unroll
              for (int hseg = 0; hseg < 2; ++hseg)
#pragma unroll
#if H2C_HOIST
                  for (int q4 = 0; q4 < 2; ++q4) {
#pragma unroll
                      for (int e = 0; e < 4; ++e) hv[hseg * 8 + q4 * 4 + e] = hv[hseg * 8 + q4 * 4 + e] * r * cg[hseg * 8 + q4 * 4 + e] + csh[hseg * 8 + q4 * 4 + e]; }
#else
                  for (int q4 = 0; q4 < 2; ++q4) { const int col = hseg * 512 + 8 * F.lane + 4 * q4;
                      const f32x4 gg = *(const f32x4*)(g2 + col), sc = *(const f32x4*)(mb + 4096 + col), sh = *(const f32x4*)(mb + 3072 + col);
#pragma unroll
                      for (int e = 0; e < 4; ++e) hv[hseg * 8 + q4 * 4 + e] = hv[hseg * 8 + q4 * 4 + e] * r * gg[e] * (1.0f + sc[e]) + sh[e]; }
#endif
          }
#else
          const v4u ha = *(const v4u*)(H + (size_t)t * D + 8 * F.lane), hb = *(const v4u*)(H + (size_t)t * D + 512 + 8 * F.lane);
          hv[0] = bflo(ha.x); hv[1] = bfhi(ha.x); hv[2] = bflo(ha.y); hv[3] = bfhi(ha.y); hv[4] = bflo(ha.z); hv[5] = bfhi(ha.z); hv[6] = bflo(ha.w); hv[7] = bfhi(ha.w);
          hv[8] = bflo(hb.x); hv[9] = bfhi(hb.x); hv[10] = bflo(hb.y); hv[11] = bfhi(hb.y); hv[12] = bflo(hb.z); hv[13] = bfhi(hb.z); hv[14] = bflo(hb.w); hv[15] = bfhi(hb.w);
#endif
          float am = 0.f;
#pragma unroll
          for (int e = 0; e < 16; ++e) am = fmaxf(am, fabsf(hv[e]));
          am = wave_max(am);
          const float inv1 = am > 0.f ? 127.0f / am : 0.f; hq.s1 = am * (1.0f / 127.0f); hq.s2 = hq.s1 * (1.0f / 254.0f); const float inv2 = inv1 * 254.0f;
#pragma unroll
          for (int w = 0; w < 4; ++w) { unsigned p1 = 0, p2 = 0;
#pragma unroll
              for (int e = 0; e < 4; ++e) { const float h = hv[4 * w + e]; const float a = rintf(h * inv1); const float b = fminf(fmaxf(rintf((h - a * hq.s1) * inv2), -127.f), 127.f);
                  p1 |= ((unsigned)(int)a & 255u) << (8 * e); p2 |= ((unsigned)(int)b & 255u) << (8 * e); }
              hq.q1[w] = (int)p1; hq.q2[w] = (int)p2; }
#if EXP6B
          hq.c1 = -128 * __builtin_amdgcn_sdot4(hq.q1[0], 0x01010101, __builtin_amdgcn_sdot4(hq.q1[2], 0x01010101, 0, false), false);
          hq.c2 = -128 * __builtin_amdgcn_sdot4(hq.q2[0], 0x01010101, __builtin_amdgcn_sdot4(hq.q2[2], 0x01010101, 0, false), false);
          hq.s1 *= 0.25f; hq.s2 *= 0.25f;
#else
          hq.c1 = 0; hq.c2 = 0;
#endif
        }
#if ROW_PIPE
        if (k == 0) { vm_wait<15>(); lds_raw(raw, ring, lo16b); }
#endif
        float act0 = 0.f, act1 = 0.f;
#pragma unroll 1
        for (int q = 0; q < 8; ++q) {
            const int qn = (q + 1) & 7; NextB nb{q < 7 ? UE : VE, qn < 4 ? ro0 : ro1, 16 * (qn & 3)};
            const float tot = consume_u(ring, hq, nb, F.lane, lo16b, raw);
            if ((F.lane >> 4) == (q & 3)) { if (q < 4) act0 = tot; else act1 = tot; }
        }
        act0 *= su0; act1 *= su1;
        const float w0 = wx0k * sv0 * 0.5f * act0 * (1.0f + erff(act0 * 0.7071067811865476f)), w1 = wx1k * sv1 * 0.5f * act1 * (1.0f + erff(act1 * 0.7071067811865476f));
#if V_MFMA
        float o[16];
        { const float cam = wave_max(fmaxf(fabsf(w0), fabsf(w1)));
          const float ci1 = cam > 0.f ? 127.0f / cam : 0.f, S1 = cam * (1.0f / 127.0f), S2 = S1 * (1.0f / 254.0f), ci2 = ci1 * 254.0f;
          int cq0, cq1;
          { const float a = rintf(w0 * ci1), b = fminf(fmaxf(rintf((w0 - a * S1) * ci2), -127.f), 127.f); cq0 = ((int)a & 255) | (((int)b & 255) << 8); }
          { const float a = rintf(w1 * ci1), b = fminf(fmaxf(rintf((w1 - a * S1) * ci2), -127.f), 127.f); cq1 = ((int)a & 255) | (((int)b & 255) << 8); }
          const unsigned sh8 = 8u * ((unsigned)F.lane & 3u);
          v4i a1[4], a2[4];
#pragma unroll
          for (int e = 0; e < 4; ++e) { a1[e] = (v4i){0, 0, 0, 0}; a2[e] = (v4i){0, 0, 0, 0}; }
#pragma unroll 1
          for (int q = 0; q < 7; ++q) {
              const int qn = q + 1; NextB nb{VE, qn < 4 ? ro0 : ro1, 16 * (qn & 3)};
              consume_vm<false>(ring, a1, a2, q < 4 ? cq0 : cq1, 16 * (q & 3), nb, lo16b, sh8, raw);
          }
          if (k < 3) { NextB nb{UE, nro0, 0}; consume_vm<false>(ring, a1, a2, cq1, 48, nb, lo16b, sh8, raw); }
          else { NextB nb{UE, 0, 0}; consume_vm<true>(ring, a1, a2, cq1, 48, nb, lo16b, sh8, raw); }
#if EXP6B
          static_assert(V_PLANES == 1, "6-bit rows: one c plane");
          { const int csum = wave_sumi((int)(signed char)(cq0 & 255) + (int)(signed char)(cq1 & 255));
#pragma unroll
            for (int e = 0; e < 16; ++e) o[e] = ((e >> 2) & 1) ? (0.25f * S1) * (float)a1[e >> 2][e & 3] : S1 * (float)(a1[e >> 2][e & 3] - 32 * csum); }
#else
#pragma unroll
          for (int e = 0; e < 16; ++e) o[e] = S1 * (float)a1[e >> 2][e & 3] + S2 * (float)a2[e >> 2][e & 3];
#endif
        }
#else
        const float csum = wave_sum(w0 + w1);
        float o[16];
#pragma unroll
        for (int e = 0; e < 16; ++e) o[e] = 0.f;
#pragma unroll 1
        for (int q = 0; q < 7; ++q) {
            const int qn = q + 1; NextB nb{VE, qn < 4 ? idx0 : idx1, 16 * (qn & 3)};
            consume_v<false>(ring, o, q < 4 ? w0 : w1, 16 * (q & 3), nb, lo16b);
        }
        if (k < 3) { NextB nb{UE, nidx0, 0}; consume_v<false>(ring, o, w1, 48, nb, lo16b); }
        else { NextB nb{UE, 0, 0}; consume_v<true>(ring, o, w1, 48, nb, lo16b); }
#pragma unroll
        for (int e = 0; e < 16; ++e) o[e] -= 128.0f * csum;
#endif
#if EPI_HOIST
        expert_epilogue_c(F, A, l, t, o, x1v, EC);
#else
        expert_epilogue<(NORM_FOLD) != 0>(F, A, l, t, o, x1v);
#endif
    }
}
#undef UBF
__device__ __forceinline__ void phase_experts(const Ctx& F, KArgs A, int l) {
    const int* IDX = (const int*)(A.ws + WS_IDX); const float* WTS = (const float*)(A.ws + WS_WTS);
    for (int t = F.gw; t < T; t += F.NGW)
        expert_token(F, A, l, t, IDX[(size_t)t * 128 + F.lane], IDX[(size_t)t * 128 + 64 + F.lane], WTS[(size_t)t * 128 + F.lane], WTS[(size_t)t * 128 + 64 + F.lane]);
}
__device__ __forceinline__ void phase_peer(const Ctx& F, KArgs A, int l) {
    LAS unsigned char* scr = F.lds + RING_OFF + F.wave * 16384;
    LAS unsigned short* il = (LAS unsigned short*)(F.lds + HAND_OFF + F.wave * 3072); LAS float* wl = (LAS float*)(F.lds + HAND_OFF + F.wave * 3072 + 1024);
#ifndef PROBE_PEER_CUS
#define PROBE_PEER_CUS 256
#endif
    if (F.vcu >= PROBE_PEER_CUS) return;
#if PEER_DYNAMIC
    unsigned* ctr = (unsigned*)(A.ws + WS_CTL) + CW_PEERQ + 64 * l;
    for (int u = F.gw; u < T / 4; ) {
#else
    for (int u = F.gw; u < T / 4; u += PROBE_PEER_CUS * NWAVES) {
#endif
        Ctx G = F; asm volatile("" : "+v"(G.lane));
        route_unit(G, A, l, u, scr, il, wl, 4 * u);
        LDS_WAIT();
#if EXP_I8 && !DBG_ROUTE32
        asm volatile("" : "+v"(G.lane));
        __builtin_amdgcn_s_setprio(2);
        experts_unit4(G, A, l, 4 * u, scr, il, wl);
        __builtin_amdgcn_s_setprio(0);
#if PEER_DYNAMIC
        { unsigned nu = 0; if (F.lane == 0) nu = __hip_atomic_fetch_add(ctr, 1u, __ATOMIC_RELAXED, __HIP_MEMORY_SCOPE_AGENT); u = (int)__builtin_amdgcn_readfirstlane(nu) + F.NGW; }
#endif
#else
#pragma unroll 1
        for (int k = 0; k < 4; ++k) expert_token(F, A, l, 4 * u + k, il[k * 128 + F.lane], il[k * 128 + 64 + F.lane], wl[k * 128 + F.lane], wl[k * 128 + 64 + F.lane]);
#endif
        LDS_WAIT();
    }
}
__device__ __forceinline__ bool ph_in_range(int k) {
    const __attribute__((address_space(4))) Args* ap_ = (const __attribute__((address_space(4))) Args*)__builtin_amdgcn_kernarg_segment_ptr(); asm volatile("" : "+s"(ap_));
    return ap_->ph_lo <= k && k < ap_->ph_hi;
}
#ifndef FUSE_PEER
#define FUSE_PEER (!DBG_ROUTE32)
#endif
constexpr int PPL = (FUSE_PEER ? 8 : 9) - ((NORM_FOLD) ? 1 : 0);
constexpr int N_PHASES = 2 + PPL * DEPTH;
#ifndef ONLY_MASK
#define ONLY_MASK 0xffffffffu
#endif
#ifndef REP_MASK
#define REP_MASK 0u
#endif
#define ONLY(k, stmt) do { if constexpr ((ONLY_MASK >> (k)) & 1u) { for (int rep_ = 0; rep_ < (((REP_MASK >> (k)) & 1u) ? 2 : 1); ++rep_) { stmt; } } } while (0)
__global__ void __launch_bounds__(NWAVES * 64, 2) mega_fwd(Args args) {
    extern __shared__ __attribute__((aligned(16))) unsigned char lds[];
#define MKARGS() const __attribute__((address_space(4))) Args* ap_ = (const __attribute__((address_space(4))) Args*)__builtin_amdgcn_kernarg_segment_ptr(); asm volatile("" : "+s"(ap_)); KArgs A = *ap_
#define MKCTX() MKARGS(); Ctx F; { int tid_ = threadIdx.x; asm volatile("" : "+v"(tid_)); int bx_ = blockIdx.x; asm volatile("" : "+s"(bx_)); \
        F.lds = (LAS unsigned char*)lds; F.tid = tid_; F.lane = tid_ & 63; F.wave = __builtin_amdgcn_readfirstlane(tid_ >> 6); F.G = gridDim.x; \
        F.vcu = (F.G % 8 == 0) ? (bx_ % 8) * (F.G / 8) + bx_ / 8 : bx_; F.gw = F.vcu * NWAVES + F.wave; F.NGW = F.G * NWAVES; }
    for (int u = threadIdx.x; u < (LDS_BYTES - LDSCTL_OFF) / 4; u += NWAVES * 64) ((LAS unsigned*)((LAS unsigned char*)lds + LDSCTL_OFF))[u] = 0u;
    __syncthreads();
    { MKARGS();
      if (A.ph_hi - A.ph_lo > 1) (void)xcd_barrier_post((unsigned*)(A.ws + WS_CTL) + CW_BAR, (volatile LAS unsigned*)((LAS unsigned char*)lds + MISC_OFF) + 8); }

#define IN(k) ph_in_range(k)
#define SEAM(k) do { if (IN(k) && IN((k) + 1)) { MKARGS(); XcdBarrier b_; b_.bar = (unsigned*)(A.ws + WS_CTL) + CW_BAR; b_.x = xb_xcc_id(); b_.st = (volatile LAS unsigned*)((LAS unsigned char*)lds + MISC_OFF) + 8; xcd_barrier(b_); } } while (0)
    if (IN(0)) { MKCTX(); ONLY(0, phase_pre(F, A)); } SEAM(0);
    if (IN(1)) { MKCTX(); ONLY(1, phase_h0(F, A)); } SEAM(1);
#if DBG_ROUTE32
#define QGEMM(l) do { pg8::Gemm g{(const bf16*)(A.ws + WS_H3), (const bf16*)(A.ws + WS_WQ3), 3072, 3072, 3072, 0, 0}; pg8::StaticOrder S; S.init(T, 2048, F.G, (int)blockIdx.x); \
        pg8::EpiF32 E{(float*)(A.ws + WS_Q32), 2048}; pg8::gemm_phase<pg8::EpiF32, pg8::StaticOrder, true, true>(F.lds + RING_OFF, g, S, E); } while (0)
#define ROUTE_EXTRA(l) phase_expert_convert(F, A, (l))
#define ROUTE(l) phase_route_naive(F, A, (l))
#else
#define QGEMM(l) do { unsigned char* wl = A.ws + WS_W + (size_t)(l) * W_LAYER; \
        pg8::Gemm g{(const bf16*)(A.ws + WS_H), (const bf16*)(wl + W_WQ), D, D, D, 0, 0}; pg8::StaticOrder S; S.init(T, 2048, F.G, (int)blockIdx.x); \
        QEPI(l); } while (0)
#define ROUTE_EXTRA(l) do {} while (0)
#if NORM_FOLD
#define WOEPI(l) pg8::EpiWoN<((l) != 0)> E{A.in[I_X], (const bf16*)A.out, (bf16*)(A.ws + WS_X1B), (const float*)(A.ws + WS_MOD) + (size_t)(l) * 8 * 6144, A.in[I_GN2] + (size_t)(l) * D, (bf16*)(A.ws + WS_H), (float*)(A.ws + WS_SSQ)}; \
        ONLY(9, (pg8::gemm_phase<pg8::EpiWoN<((l) != 0)>, pg8::StaticOrder, true, true>(F.lds + RING_OFF, g, S, E)))
#else
#define WOEPI(l) pg8::EpiWo E{(l) == 0 ? A.in[I_X] : A.out, A.out, (const float*)(A.ws + WS_MOD) + (size_t)(l) * 8 * 6144 + 2048}; \
        ONLY(9, (pg8::gemm_phase<pg8::EpiWo, pg8::StaticOrder, true, true>(F.lds + RING_OFF, g, S, E)))
#endif
#if NORM_FOLD
#define QEPI(l) pg8::EpiQN E{(bf16*)(A.ws + WS_Q2), (const float*)(A.ws + WS_SSQ), (const float*)(A.ws + WS_CQ) + (size_t)(l) * 8 * 2048, EPS}; \
        pg8::gemm_phase<pg8::EpiQN, pg8::StaticOrder, true, true>(F.lds + RING_OFF, g, S, E)
#else
#define QEPI(l) pg8::EpiBf16 E{(bf16*)(A.ws + WS_Q2), 2048}; \
        pg8::gemm_phase<pg8::EpiBf16, pg8::StaticOrder, true, true>(F.lds + RING_OFF, g, S, E)
#endif
#define ROUTE(l) phase_route(F, A, (l))
#endif
#ifndef NAIVE_MIX
#define NAIVE_MIX 0
#endif
#if NAIVE_MIX & 1
#define MIX_SWA(l) phase_swa_naive(F, A, (l))
#else
#define MIX_SWA(l) phase_swa2(F, A, (l))
#endif
#if NAIVE_MIX & 2
#define MIX_POOL(l) phase_pool_naive(F, A, (l))
#else
#define MIX_POOL(l) phase_pool(F, A, (l))
#endif
#define LAYER(l) do { \
    constexpr int P0_ = 2 + PPL * (l); \
    if (IN(P0_ + 0)) { MKCTX(); unsigned char* wl = A.ws + WS_W + (size_t)(l) * W_LAYER; \
        pg8::Gemm g{(const bf16*)(A.ws + WS_H), (const bf16*)(wl + W_WIN), D, D, D, 0, 0}; pg8::StaticOrder S; S.init(T, NIN, F.G, (int)blockIdx.x); \
        pg8::EpiProj E{(bf16*)(A.ws + WS_PROJ), (bf16*)(A.ws + WS_GATES)}; \
        ONLY(2, (pg8::gemm_phase<pg8::EpiProj, pg8::StaticOrder, true, true>(F.lds + RING_OFF, g, S, E))); \
        if (EXP_I8_OWN && (int)blockIdx.x >= 64) expert_quant(A, (l), F.lane, ((int)blockIdx.x - 64) * NWAVES + F.wave, (F.G - 64) * NWAVES);     \
        } \
    SEAM(P0_ + 0); \
    if (IN(P0_ + 1)) { { MKARGS(); \
        const attn_body::AttnTensors AT{(const attn_body::bf16*)(A.ws + WS_PROJ), (const attn_body::bf16*)(A.ws + WS_PROJ), (const attn_body::bf16*)(A.ws + WS_PROJ), (attn_body::bf16*)(A.ws + WS_O)}; \
        const attn_body::StaticOrder S((int)gridDim.x, (int)blockIdx.x); \
        ONLY(3, attn_body::attn_phase<attn_body::StaticOrder>((char*)lds + RING_OFF, AT, S)); } \
        { MKCTX(); ONLY(4, MIX_SWA(l)); ONLY(5, phase_conv_naive(F, A, (l))); ONLY(6, MIX_POOL(l)); } } \
    SEAM(P0_ + 1); \
    if (IN(P0_ + 2)) { MKCTX(); ONLY(7, phase_ya(F, A, (l))); } \
    SEAM(P0_ + 2); \
    if (IN(P0_ + 3)) { MKCTX(); unsigned char* wl = A.ws + WS_W + (size_t)(l) * W_LAYER; \
        pg8::Gemm g{(const bf16*)(A.ws + WS_Y), (const bf16*)(wl + W_WBR), 2048, 512, 512, (size_t)512 * 2, (size_t)D * 512 * 2}; pg8::ZOrder<4> S; S.init(T, D, F.G, (int)blockIdx.x); \
        pg8::EpiMergeK E{(const bf16*)(A.ws + WS_GATES), (bf16*)(A.ws + WS_O)}; \
        ONLY(8, (pg8::gemm_phase<pg8::EpiMergeK, pg8::ZOrder<4>, true, true>(F.lds + RING_OFF, g, S, E))); } \
    SEAM(P0_ + 3); \
    if (IN(P0_ + 4)) { MKCTX(); unsigned char* wl = A.ws + WS_W + (size_t)(l) * W_LAYER; \
        pg8::Gemm g{(const bf16*)(A.ws + WS_O), (const bf16*)(wl + W_WO), D, D, D, 0, 0}; pg8::StaticOrder S; S.init(T, D, F.G, (int)blockIdx.x); \
        WOEPI(l); } \
    SEAM(P0_ + 4); \
    if constexpr (!(NORM_FOLD)) { \
        if (IN(P0_ + 5)) { MKCTX(); ONLY(10, phase_h2(F, A, (l))); } \
        SEAM(P0_ + 5); \
    } \
    constexpr int PQ_ = P0_ + ((NORM_FOLD) ? 5 : 6); \
    if (IN(PQ_)) { MKCTX(); ONLY(11, QGEMM(l)); } \
    SEAM(PQ_); \
    if constexpr (FUSE_PEER) { \
        if (IN(PQ_ + 1)) { MKCTX(); ONLY(13, phase_peer(F, A, (l))); } \
        SEAM(PQ_ + 1); \
    } else { \
        if (IN(PQ_ + 1)) { MKCTX(); ONLY(12, ROUTE(l)); ROUTE_EXTRA(l); } \
        SEAM(PQ_ + 1); \
        if (IN(PQ_ + 2)) { MKCTX(); ONLY(13, phase_experts(F, A, (l))); } \
        SEAM(PQ_ + 2); \
    } \
} while (0)
    LAYER(0);
    LAYER(1);
#undef LAYER
#undef IN
#undef SEAM
}

#ifndef MK_SINGLE
#define MK_SINGLE 1
#endif
extern "C" void kernel_launch(void* const* d_in, const int* in_sizes, int n_in, void* d_out, int out_size, void* d_ws, size_t ws_size, hipStream_t stream) {
    static int grid = 0;
    if (grid == 0) {
        if (n_in != N_IN || in_sizes[0] != T * D || out_size != T * D || ws_size < WS_END) { fprintf(stderr, "kernel_launch: unexpected shapes: n_in %d in0 %d out %d ws %zu\n", n_in, n_in > 0 ? in_sizes[0] : -1, out_size, ws_size); grid = -1; return; }
        int dev = 0, cus = 0;
        if (hipGetDevice(&dev) != hipSuccess || hipDeviceGetAttribute(&cus, hipDeviceAttributeMultiprocessorCount, dev) != hipSuccess) { grid = -1; return; }
        if (hipFuncSetAttribute((const void*)mega_fwd, hipFuncAttributeMaxDynamicSharedMemorySize, LDS_BYTES) != hipSuccess) { fprintf(stderr, "kernel_launch: hipFuncSetAttribute failed\n"); grid = -1; return; }
        (void)hipGetLastError();
        grid = cus;
        if (grid != 256) fprintf(stderr, "kernel_launch: %d CUs; this kernel is built for 256\n", grid);
    }
    if (grid < 0) return;
    if (hipMemsetAsync((char*)d_ws + WS_CTL, 0, CTL_ZERO_BYTES, stream) != hipSuccess) return;
    Args a{};
    for (int i = 0; i < N_IN; ++i) a.in[i] = (const float*)d_in[i];
    a.out = (float*)d_out; a.ws = (unsigned char*)d_ws;
#if MK_SINGLE
    a.ph_lo = 0; a.ph_hi = N_PHASES;
    hipLaunchKernelGGL(mega_fwd, dim3(grid), dim3(NWAVES * 64), LDS_BYTES, stream, a);
#else
    for (int ph = 0; ph < N_PHASES; ++ph) { a.ph_lo = ph; a.ph_hi = ph + 1; hipLaunchKernelGGL(mega_fwd, dim3(grid), dim3(NWAVES * 64), LDS_BYTES, stream, a); }
#endif
}
```

```cpp
#include <hip/hip_runtime.h>
#include <cstdio>
#include <cstdint>
#include <type_traits>
namespace pg8 {
#define PG8_LAS __attribute__((address_space(3)))
typedef unsigned short bf16_t;
typedef short bf16x8 __attribute__((ext_vector_type(8)));
typedef float f32x4 __attribute__((ext_vector_type(4)));
typedef unsigned u32x4 __attribute__((ext_vector_type(4)));
constexpr int BM = 256, BK = 64, HALF = 128, HTB = HALF * BK * 2  , STAGE_BYTES = 8 * HTB, NXCD = 8, WGM = 8;

__host__ __device__ __forceinline__ int lds_byte(int r, int c) { const int st = (r >> 4) * 2 + (c >> 5), rr = r & 15, cc = c & 31, ob = rr * 64 + cc * 2; return st * 1024 + (ob ^ (((ob >> 9) & 1) << 5)); }
__host__ __device__ __forceinline__ void stage_rc(int b, int& R, int& C) { const int st = b / 1024, sb = b % 1024, swz = sb ^ (((sb >> 9) & 1) << 5); R = (st >> 1) * 16 + swz / 64; C = (st & 1) * 32 + (swz % 64) / 2; }
__host__ __device__ __forceinline__ int perm32(int rho) { const int n = rho >> 4, i = rho & 15; return 8 * (i >> 2) + 4 * n + (i & 3); }

#ifndef GATE_ST16
#define GATE_ST16 1
#endif
#ifndef Q2_FRAG
#define Q2_FRAG 1
#endif
struct Unit { int pm, pn, z; };
struct Gemm { const bf16_t* A; const bf16_t* Bt; int lda, ldb, K; size_t zA, zB; };

struct StaticOrder {
    int nM, nN, nwg, G, c;
    __host__ __device__ void init(int M, int N, int G_, int c_) { nM = M / BM; nN = N / BM; nwg = nM * nN; G = G_; c = c_; }
    __host__ __device__ bool next(int i, Unit& u) const {
        const long L = (long)i * G + c; if (L >= nwg) return false;
        int wgid = (int)L; { const int q = nwg / NXCD, r = nwg % NXCD, xcd = wgid % NXCD, off = wgid / NXCD; wgid = (xcd < r ? xcd * (q + 1) : r * (q + 1) + (xcd - r) * q) + off; }
        const int nig = WGM * nN, gid = wgid / nig, fm = gid * WGM, gsz = (nM - fm) < WGM ? (nM - fm) : WGM;
        u.pm = fm + ((wgid % nig) % gsz); u.pn = (wgid % nig) / gsz; u.z = 0; return true;
    }
    __device__ __forceinline__ void a_ready(const Unit&) const {}
    __device__ __forceinline__ void done(const Unit&) const {}
};
template <int NZ> struct ZOrder {
    StaticOrder S;
    __host__ __device__ void init(int M, int N, int G_, int c_) { S.init(M, N, G_, c_); }
    __host__ __device__ bool next(int i, Unit& u) const { if (!S.next(i / NZ, u)) return false; u.z = i % NZ; return true; }
    __device__ __forceinline__ void a_ready(const Unit&) const {}
    __device__ __forceinline__ void done(const Unit&) const {}
};

__device__ __forceinline__ unsigned cvt_pk_bf16(float lo, float hi) { unsigned r; asm volatile("v_cvt_pk_bf16_f32 %0, %1, %2" : "=v"(r) : "v"(lo), "v"(hi)); return r; }
__device__ __forceinline__ float bf_lo(unsigned w) { return __builtin_bit_cast(float, w << 16); }
__device__ __forceinline__ float bf_hi(unsigned w) { return __builtin_bit_cast(float, w & 0xffff0000u); }
__device__ __forceinline__ float sigmoidf_(float x) { return __builtin_amdgcn_rcpf(1.0f + __expf(-x)); }

__device__ __forceinline__ void store_lines(bf16_t* p, size_t ldc_rows8  , int fr, u32x4 w0, u32x4 w1) {
    const bool up = fr & 8;
    u32x4 x = up ? w0 : w1, r;
    r.x = (unsigned)__builtin_amdgcn_mov_dpp((int)x.x, 0x128, 0xF, 0xF, true); r.y = (unsigned)__builtin_amdgcn_mov_dpp((int)x.y, 0x128, 0xF, 0xF, true);
    r.z = (unsigned)__builtin_amdgcn_mov_dpp((int)x.z, 0x128, 0xF, 0xF, true); r.w = (unsigned)__builtin_amdgcn_mov_dpp((int)x.w, 0x128, 0xF, 0xF, true);
    bf16_t* pa = up ? p - ldc_rows8 + 32 : p; bf16_t* pb = up ? p + 32 : p + ldc_rows8;
    *(u32x4*)pa = up ? r : w0;
    *(u32x4*)pb = up ? w1 : r;
}
__device__ __forceinline__ void load_lines(const bf16_t* p, size_t ldc_rows8, int fr, u32x4& w0, u32x4& w1) {
    const bool up = fr & 8;
    const bf16_t* pa = up ? p - ldc_rows8 + 32 : p; const bf16_t* pb = up ? p + 32 : p + ldc_rows8;
    const u32x4 a = *(const u32x4*)pa, b = *(const u32x4*)pb;
    const u32x4 x = up ? a : b; u32x4 r;
    r.x = (unsigned)__builtin_amdgcn_mov_dpp((int)x.x, 0x128, 0xF, 0xF, true); r.y = (unsigned)__builtin_amdgcn_mov_dpp((int)x.y, 0x128, 0xF, 0xF, true);
    r.z = (unsigned)__builtin_amdgcn_mov_dpp((int)x.z, 0x128, 0xF, 0xF, true); r.w = (unsigned)__builtin_amdgcn_mov_dpp((int)x.w, 0x128, 0xF, 0xF, true);
    w0 = up ? r : a; w1 = up ? b : r;
}
__device__ __forceinline__ void load_lines_raw(const bf16_t* p, size_t ldc_rows8, int fr, u32x4& a, u32x4& b) {
    const bool up = fr & 8;
    const bf16_t* pa = up ? p - ldc_rows8 + 32 : p; const bf16_t* pb = up ? p + 32 : p + ldc_rows8;
    a = *(const u32x4*)pa; b = *(const u32x4*)pb;
}
__device__ __forceinline__ void lines_xchg(int fr, const u32x4 a, const u32x4 b, u32x4& w0, u32x4& w1) {
    const bool up = fr & 8;
    const u32x4 x = up ? a : b; u32x4 r;
    r.x = (unsigned)__builtin_amdgcn_mov_dpp((int)x.x, 0x128, 0xF, 0xF, true); r.y = (unsigned)__builtin_amdgcn_mov_dpp((int)x.y, 0x128, 0xF, 0xF, true);
    r.z = (unsigned)__builtin_amdgcn_mov_dpp((int)x.z, 0x128, 0xF, 0xF, true); r.w = (unsigned)__builtin_amdgcn_mov_dpp((int)x.w, 0x128, 0xF, 0xF, true);
    w0 = up ? r : a; w1 = up ? b : r;
}
struct EpiBf16 {
    static constexpr bool PERM = true, AFTER_DRAIN = false;
    static __device__ __forceinline__ bool keeps_acc(const Unit&) { return false; }
    bf16_t* O; int ldc;
    __device__ __forceinline__ void operator()(const f32x4 (&acc)[2][2][4][2], const Unit& u, int wr, int wc, int fr, int fq) const {
        const int row0 = u.pm * BM + wr * 64 + fr, col0 = u.pn * BM + wc * 64 + 8 * fq;
#pragma unroll
        for (int ai = 0; ai < 2; ++ai)
#pragma unroll
            for (int m = 0; m < 4; ++m) { bf16_t* rowp = O + (size_t)(row0 + ai * HALF + m * 16) * ldc + col0;
                u32x4 w[2];
#pragma unroll
                for (int bj = 0; bj < 2; ++bj) { const f32x4 v0 = acc[ai][bj][m][0], v1 = acc[ai][bj][m][1];
                    w[bj].x = cvt_pk_bf16(v0[0], v0[1]); w[bj].y = cvt_pk_bf16(v0[2], v0[3]); w[bj].z = cvt_pk_bf16(v1[0], v1[1]); w[bj].w = cvt_pk_bf16(v1[2], v1[3]); }
                store_lines(rowp, (size_t)8 * ldc, fr, w[0], w[1]); }
    }
};
struct EpiProj {
    static constexpr bool PERM = true, AFTER_DRAIN = false;
    static __device__ __forceinline__ bool keeps_acc(const Unit&) { return false; }
    bf16_t* proj; bf16_t* gates;
    __device__ __forceinline__ void operator()(const f32x4 (&acc)[2][2][4][2], const Unit& u, int wr, int wc, int fr, int fq) const {
        const bool isg = u.pn >= 17; bf16_t* base = isg ? gates : proj; const int ldc = isg ? 4096 : 4352;
        const int row0 = u.pm * BM + wr * 64 + fr, col0 = (isg ? u.pn - 17 : u.pn) * BM + wc * 64 + 8 * fq;
#pragma unroll
        for (int ai = 0; ai < 2; ++ai)
#pragma unroll
            for (int m = 0; m < 4; ++m) { bf16_t* rowp = base + (size_t)(row0 + ai * HALF + m * 16) * ldc + col0;
                if (isg) {
                    f32x4 E[4];
#pragma unroll
                    for (int z = 0; z < 4; ++z)
#pragma unroll
                        for (int e = 0; e < 4; ++e) E[z][e] = 1.0f + __expf(-acc[ai][z >> 1][m][z & 1][e]);
                    typedef unsigned u32x2 __attribute__((ext_vector_type(2)));
                    u32x2 wz[4];
#pragma unroll
                    for (int z = 0; z < 4; ++z) { f32x4 f;
#pragma unroll
                        for (int e = 0; e < 4; ++e) f[e] = (z < 3 ? E[z + 1][e] : 1.0f) * __builtin_amdgcn_rcpf(E[z][e]);
                        wz[z].x = cvt_pk_bf16(f[0], f[1]); wz[z].y = cvt_pk_bf16(f[2], f[3]); }
#if GATE_ST16
                    { u32x4 pa, pb;
                      asm volatile("s_nop 3" : "+v"(wz[0].x), "+v"(wz[0].y), "+v"(wz[1].x), "+v"(wz[1].y), "+v"(wz[2].x), "+v"(wz[2].y), "+v"(wz[3].x), "+v"(wz[3].y));
                      { const auto s0 = __builtin_amdgcn_permlane16_swap(wz[0].x, wz[2].x, false, false), s1 = __builtin_amdgcn_permlane16_swap(wz[0].y, wz[2].y, false, false);
                        pa.x = s0[0]; pa.y = s1[0]; pa.z = s0[1]; pa.w = s1[1]; }
                      { const auto s0 = __builtin_amdgcn_permlane16_swap(wz[1].x, wz[3].x, false, false), s1 = __builtin_amdgcn_permlane16_swap(wz[1].y, wz[3].y, false, false);
                        pb.x = s0[0]; pb.y = s1[0]; pb.z = s0[1]; pb.w = s1[1]; }
                      bf16_t* gp = gates + (size_t)(row0 + ai * HALF + m * 16) * 4096 + (u.pn - 17) * 64 + wc * 16 + 4 * (fq & 2) + (fq & 1) * 2048;
                      *(u32x4*)gp = pa; *(u32x4*)(gp + 1024) = pb; }
#else
                    bf16_t* gp = gates + (size_t)(row0 + ai * HALF + m * 16) * 4096 + (u.pn - 17) * 64 + wc * 16 + 4 * fq;
#pragma unroll
                    for (int z = 0; z < 4; ++z) *(u32x2*)(gp + z * 1024) = wz[z];
#endif
                } else {
                { u32x4 w[2];
#pragma unroll
                for (int bj = 0; bj < 2; ++bj) { const f32x4 v0 = acc[ai][bj][m][0], v1 = acc[ai][bj][m][1];
                    w[bj].x = cvt_pk_bf16(v0[0], v0[1]); w[bj].y = cvt_pk_bf16(v0[2], v0[3]); w[bj].z = cvt_pk_bf16(v1[0], v1[1]); w[bj].w = cvt_pk_bf16(v1[2], v1[3]); }
                store_lines(rowp, (size_t)8 * ldc, fr, w[0], w[1]); } } }
    }
};
struct EpiMerge {
    static constexpr bool PERM = true, AFTER_DRAIN = false;
    static __device__ __forceinline__ bool keeps_acc(const Unit&) { return false; }
    const bf16_t* gates; float* s32; bf16_t* s16;
    __device__ __forceinline__ void operator()(const f32x4 (&acc)[2][2][4][2], const Unit& u, int wr, int wc, int fr, int fq) const {
        const int row0 = u.pm * BM + wr * 64 + fr, col0 = u.pn * BM + wc * 64 + 8 * fq, z = u.z;
#pragma unroll
        for (int ai = 0; ai < 2; ++ai)
#pragma unroll
            for (int m = 0; m < 4; ++m) { const size_t row = (size_t)(row0 + ai * HALF + m * 16);
#pragma unroll
                for (int bj = 0; bj < 2; ++bj) { const int col = col0 + bj * 32;
                    const u32x4 gw = *(const u32x4*)(gates + row * 4096 + (size_t)z * 1024 + col);
                    f32x4 v0 = acc[ai][bj][m][0], v1 = acc[ai][bj][m][1];
                    v0[0] *= bf_lo(gw.x); v0[1] *= bf_hi(gw.x); v0[2] *= bf_lo(gw.y); v0[3] *= bf_hi(gw.y);
                    v1[0] *= bf_lo(gw.z); v1[1] *= bf_hi(gw.z); v1[2] *= bf_lo(gw.w); v1[3] *= bf_hi(gw.w);
                    float* sp = s32 + row * 1024 + col;
                    if (z > 0) { v0 += *(const f32x4*)sp; v1 += *(const f32x4*)(sp + 4); }
                    if (z < 3) { *(f32x4*)sp = v0; *(f32x4*)(sp + 4) = v1; }
                    else { u32x4 w; w.x = cvt_pk_bf16(v0[0], v0[1]); w.y = cvt_pk_bf16(v0[2], v0[3]); w.z = cvt_pk_bf16(v1[0], v1[1]); w.w = cvt_pk_bf16(v1[2], v1[3]);
                        *(u32x4*)(s16 + row * 1024 + col) = w; } } }
    }
};
struct EpiWo {
    static constexpr bool PERM = false, AFTER_DRAIN = false;
    static __device__ __forceinline__ bool keeps_acc(const Unit&) { return false; }
    const float* xin; float* out; const float* gate;
    __device__ __forceinline__ void operator()(const f32x4 (&acc)[2][2][4][2], const Unit& u, int wr, int wc, int fr, int fq) const {
        const int row0 = u.pm * BM + wr * 64 + fr, col0 = u.pn * BM + wc * 32 + 4 * fq; const float* gb = gate + (size_t)(u.pm >> 3) * 6144;
#pragma unroll
        for (int bj = 0; bj < 2; ++bj)
#pragma unroll
            for (int n = 0; n < 2; ++n) { const int col = col0 + bj * HALF + n * 16; const f32x4 gv = *(const f32x4*)(gb + col);
#pragma unroll
                for (int ai = 0; ai < 2; ++ai)
#pragma unroll
                    for (int m = 0; m < 4; ++m) { const size_t off = (size_t)(row0 + ai * HALF + m * 16) * 1024 + col;
                        const f32x4 o = *(const f32x4*)(xin + off) + gv * acc[ai][bj][m][n]; *(f32x4*)(out + off) = o; } }
    }
};

struct EpiF32 {
    static constexpr bool PERM = false, AFTER_DRAIN = false;
    static __device__ __forceinline__ bool keeps_acc(const Unit&) { return false; }
    float* O; int ldc;
    __device__ __forceinline__ void operator()(const f32x4 (&acc)[2][2][4][2], const Unit& u, int wr, int wc, int fr, int fq) const {
        const int row0 = u.pm * BM + wr * 64 + fr, col0 = u.pn * BM + wc * 32 + 4 * fq;
#pragma unroll
        for (int bj = 0; bj < 2; ++bj)
#pragma unroll
            for (int n = 0; n < 2; ++n)
#pragma unroll
                for (int ai = 0; ai < 2; ++ai)
#pragma unroll
                    for (int m = 0; m < 4; ++m) *(f32x4*)(O + (size_t)(row0 + ai * HALF + m * 16) * ldc + col0 + bj * HALF + n * 16) = acc[ai][bj][m][n];
    }
};

template <bool XB> struct EpiWoN {
    static constexpr bool PERM = true, AFTER_DRAIN = false;
    static __device__ __forceinline__ bool keeps_acc(const Unit&) { return false; }
    const float* xin; const bf16_t* xinb; bf16_t* x1b; const float* modl; const float* g2; bf16_t* hb; float* ssq;
    __device__ __forceinline__ void operator()(const f32x4 (&acc)[2][2][4][2], const Unit& u, int wr, int wc, int fr, int fq) const {
        const int row0 = u.pm * BM + wr * 64 + fr, col0 = u.pn * BM + wc * 64 + 8 * fq; const float* mb = modl + (size_t)(u.pm >> 3) * 6144;
        f32x4 gv[2][2], gm[2][2];
#pragma unroll
        for (int bj = 0; bj < 2; ++bj)
#pragma unroll
            for (int n = 0; n < 2; ++n) { const int col = col0 + bj * 32 + 4 * n; gv[bj][n] = *(const f32x4*)(mb + 2048 + col); gm[bj][n] = *(const f32x4*)(g2 + col) * (*(const f32x4*)(mb + 4096 + col) + 1.0f); }
#pragma unroll
        for (int ai = 0; ai < 2; ++ai)
#pragma unroll
            for (int m = 0; m < 4; ++m) { const size_t rowoff = (size_t)(row0 + ai * HALF + m * 16) * 1024 + col0; float sq = 0.f;
                u32x4 wx[2], wh[2];
#pragma unroll
                for (int bj = 0; bj < 2; ++bj) { f32x4 x0, x1;
                    if constexpr (XB) { const u32x4 xw = *(const u32x4*)(xinb + rowoff + bj * 32); x0 = (f32x4){bf_lo(xw.x), bf_hi(xw.x), bf_lo(xw.y), bf_hi(xw.y)}; x1 = (f32x4){bf_lo(xw.z), bf_hi(xw.z), bf_lo(xw.w), bf_hi(xw.w)}; }
                    else { x0 = *(const f32x4*)(xin + rowoff + bj * 32); x1 = *(const f32x4*)(xin + rowoff + bj * 32 + 4); }
                    const f32x4 o0 = x0 + gv[bj][0] * acc[ai][bj][m][0], o1 = x1 + gv[bj][1] * acc[ai][bj][m][1];
                    sq += ((o0[0] * o0[0] + o0[1] * o0[1]) + (o0[2] * o0[2] + o0[3] * o0[3])) + ((o1[0] * o1[0] + o1[1] * o1[1]) + (o1[2] * o1[2] + o1[3] * o1[3]));
                    wx[bj].x = cvt_pk_bf16(o0[0], o0[1]); wx[bj].y = cvt_pk_bf16(o0[2], o0[3]); wx[bj].z = cvt_pk_bf16(o1[0], o1[1]); wx[bj].w = cvt_pk_bf16(o1[2], o1[3]);
                    const f32x4 a0 = o0 * gm[bj][0], a1 = o1 * gm[bj][1];
                    wh[bj].x = cvt_pk_bf16(a0[0], a0[1]); wh[bj].y = cvt_pk_bf16(a0[2], a0[3]); wh[bj].z = cvt_pk_bf16(a1[0], a1[1]); wh[bj].w = cvt_pk_bf16(a1[2], a1[3]); }
                store_lines(x1b + rowoff, (size_t)8 * 1024, fr, wx[0], wx[1]);
                store_lines(hb + rowoff, (size_t)8 * 1024, fr, wh[0], wh[1]);
                sq += __shfl_xor(sq, 16); sq += __shfl_xor(sq, 32);
                if (fq == 0) ssq[(size_t)(row0 + ai * HALF + m * 16) * 16 + u.pn * 4 + wc] = sq; }
    }
};
struct EpiQN {
    static constexpr bool PERM = true, AFTER_DRAIN = false;
    static __device__ __forceinline__ bool keeps_acc(const Unit&) { return false; }
    bf16_t* O; const float* ssq; const float* cq; float eps;
    __device__ __forceinline__ void operator()(const f32x4 (&acc)[2][2][4][2], const Unit& u, int wr, int wc, int fr, int fq) const {
        const int row0 = u.pm * BM + wr * 64 + fr, col0 = u.pn * BM + wc * 64 + 8 * fq; const float* cb = cq + (size_t)(u.pm >> 3) * 2048 + col0;
        f32x4 c[2][2];
#pragma unroll
        for (int bj = 0; bj < 2; ++bj) { c[bj][0] = *(const f32x4*)(cb + bj * 32); c[bj][1] = *(const f32x4*)(cb + bj * 32 + 4); }
        float rr[8];
#pragma unroll
        for (int ai = 0; ai < 2; ++ai)
#pragma unroll
            for (int m = 0; m < 4; ++m) { const int row = row0 + ai * HALF + m * 16; const f32x4* sp = (const f32x4*)(ssq + (size_t)row * 16);
                const f32x4 s0 = sp[0], s1 = sp[1], s2 = sp[2], s3 = sp[3];
                const float ss = ((((s0[0] + s0[1]) + (s0[2] + s0[3])) + ((s1[0] + s1[1]) + (s1[2] + s1[3]))) + (((s2[0] + s2[1]) + (s2[2] + s2[3])) + ((s3[0] + s3[1]) + (s3[2] + s3[3]))));
                rr[ai * 4 + m] = 1.0f / sqrtf(ss * (1.0f / 1024.0f) + eps); }
#pragma unroll
        for (int ai = 0; ai < 2; ++ai)
#pragma unroll
            for (int m = 0; m < 4; ++m) { const int row = row0 + ai * HALF + m * 16;
                const float r = rr[ai * 4 + m];
                bf16_t* rowp = O + (size_t)row * 2048 + col0;
                u32x4 w[2];
#pragma unroll
                for (int bj = 0; bj < 2; ++bj) { const f32x4 v0 = acc[ai][bj][m][0] * r + c[bj][0], v1 = acc[ai][bj][m][1] * r + c[bj][1];
                    w[bj].x = cvt_pk_bf16(v0[0], v0[1]); w[bj].y = cvt_pk_bf16(v0[2], v0[3]); w[bj].z = cvt_pk_bf16(v1[0], v1[1]); w[bj].w = cvt_pk_bf16(v1[2], v1[3]); }
#if Q2_FRAG
#pragma unroll
                for (int bj = 0; bj < 2; ++bj) { const size_t ch = ((size_t)((row >> 2) * 2 + (wc >> 1)) * 8 + 4 * (wc & 1) + 2 * bj + (fq >> 1)) * 64 + (row & 3) + 4 * u.pn + 32 * (fq & 1);
                    *(u32x4*)(O + ch * 8) = w[bj]; }
                (void)rowp; }
#else
                store_lines(rowp, (size_t)8 * 2048, fr, w[0], w[1]); }
#endif
    }
};

struct EpiMergeK {
    static constexpr bool PERM = true, AFTER_DRAIN = false;
    static __device__ __forceinline__ bool keeps_acc(const Unit& u) { return u.z < 3; }
    const bf16_t* gates; bf16_t* s16;
    __device__ __forceinline__ void operator()(f32x4 (&acc)[2][2][4][2], const Unit& u, int wr, int wc, int fr, int fq) const {
        const int row0 = u.pm * BM + wr * 64 + fr, col0 = u.pn * BM + wc * 64 + 8 * fq, z = u.z;
        u32x4 ga[8], gb[8];
#pragma unroll
        for (int ai = 0; ai < 2; ++ai)
#pragma unroll
            for (int m = 0; m < 4; ++m) { const size_t row = (size_t)(row0 + ai * HALF + m * 16);
                load_lines_raw(gates + row * 4096 + (size_t)z * 1024 + col0, (size_t)8 * 4096, fr, ga[ai * 4 + m], gb[ai * 4 + m]); }
#pragma unroll
        for (int ai = 0; ai < 2; ++ai)
#pragma unroll
            for (int m = 0; m < 4; ++m) { const size_t row = (size_t)(row0 + ai * HALF + m * 16); u32x4 wl[2];
                u32x4 gl[2]; lines_xchg(fr, ga[ai * 4 + m], gb[ai * 4 + m], gl[0], gl[1]);
#pragma unroll
                for (int bj = 0; bj < 2; ++bj) { const int col = col0 + bj * 32;
                    const u32x4 gw = gl[bj];
                    const float g[8] = {bf_lo(gw.x), bf_hi(gw.x), bf_lo(gw.y), bf_hi(gw.y), bf_lo(gw.z), bf_hi(gw.z), bf_lo(gw.w), bf_hi(gw.w)};
                    f32x4 v0 = acc[ai][bj][m][0], v1 = acc[ai][bj][m][1];
                    v0[0] *= g[0]; v0[1] *= g[1]; v0[2] *= g[2]; v0[3] *= g[3]; v1[0] *= g[4]; v1[1] *= g[5]; v1[2] *= g[6]; v1[3] *= g[7];
                    if (z < 3) { acc[ai][bj][m][0] = v0; acc[ai][bj][m][1] = v1; }
                    else { wl[bj].x = cvt_pk_bf16(v0[0], v0[1]); wl[bj].y = cvt_pk_bf16(v0[2], v0[3]); wl[bj].z = cvt_pk_bf16(v1[0], v1[1]); wl[bj].w = cvt_pk_bf16(v1[2], v1[3]); } }
                if (z == 3) store_lines(s16 + row * 1024 + col0, (size_t)8 * 1024, fr, wl[0], wl[1]); }
    }
};

template <class Epi, class Sched, bool ALIGN_EPI = false, bool SP2 = false>
__device__ __forceinline__ void gemm_phase(PG8_LAS unsigned char* lds, const Gemm g, const Sched& S, const Epi& E) {
    const int tid = threadIdx.x, wid = __builtin_amdgcn_readfirstlane(tid >> 6), lane = tid & 63, wr = wid >> 2, wc = wid & 3, fr = lane & 15, fq = lane >> 4;
    const int K = g.K, nt = K / BK;
    unsigned voffA[2], voffB[2];
#pragma unroll
    for (int i = 0; i < 2; ++i) { int R, C; stage_rc(tid * 16 + i * 8192, R, C); const int Rb = Epi::PERM ? (64 * (R >> 5) + perm32(R & 31)) : R;
        voffA[i] = (unsigned)(R * g.lda + C) * 2u; voffB[i] = (unsigned)(Rb * g.ldb + C) * 2u; }
    const size_t kstep = (size_t)(BK * 2);
    const size_t hstepA = (size_t)HALF * g.lda * 2, hstepB = (size_t)(Epi::PERM ? 32 : HALF) * g.ldb * 2;
    const size_t tstepA = 2 * hstepA, tstepB = (size_t)BM * g.ldb * 2;
    const unsigned ldsw = (unsigned)wid * 1024u;
    const int aoff = lds_byte(wr * 64 + fr, fq * 8), boff = lds_byte(wc * 32 + fr, fq * 8);
#define PG8_SA(b, h) (((b) * 2 + (h)) * HTB)
#define PG8_SB(b, h) ((4 + (b) * 2 + (h)) * HTB)
#define PG8_STAGE(bufoff, gbase, voff) do { _Pragma("unroll") for (int _i = 0; _i < 2; ++_i) \
        __builtin_amdgcn_global_load_lds((const unsigned*)((const char*)(gbase) + (voff)[_i]), (PG8_LAS unsigned*)(lds + (bufoff) + ldsw + _i * 8192), 16, 0, 0); } while (0)
#define PG8_LDA(dst, b, h) do { _Pragma("unroll") for (int m = 0; m < 4; ++m) _Pragma("unroll") for (int k = 0; k < 2; ++k) dst[m][k] = *(const PG8_LAS bf16x8*)(lds + PG8_SA(b, h) + aoff + m * 2048 + k * 1024); } while (0)
#define PG8_LDB(dst, b, h) do { _Pragma("unroll") for (int n = 0; n < 2; ++n) _Pragma("unroll") for (int k = 0; k < 2; ++k) dst[n][k] = *(const PG8_LAS bf16x8*)(lds + PG8_SB(b, h) + boff + n * 2048 + k * 1024); } while (0)
#define PG8_MMA(ai, bj, At, Bt) do { __builtin_amdgcn_s_setprio(1); _Pragma("unroll") for (int m = 0; m < 4; ++m) _Pragma("unroll") for (int n = 0; n < 2; ++n) _Pragma("unroll") for (int k = 0; k < 2; ++k) \
        acc[ai][bj][m][n] = __builtin_amdgcn_mfma_f32_16x16x32_bf16(Bt[n][k], At[m][k], acc[ai][bj][m][n], 0, 0, 0); __builtin_amdgcn_s_setprio(0); } while (0)
#define PG8_WAIT_V(n) asm volatile("s_waitcnt vmcnt(" #n ")" ::: "memory")
#define PG8_WAIT_L(n) asm volatile("s_waitcnt lgkmcnt(" #n ")" ::: "memory")
#define PG8_BAR __builtin_amdgcn_s_barrier()
#define PG8_SCHED __builtin_amdgcn_sched_barrier(0)
    Unit cur, nxt; int ui = 0;
    if (!S.next(0, cur)) return;
    f32x4 acc[2][2][4][2];
#pragma unroll
    for (int a = 0; a < 2; ++a)
#pragma unroll
        for (int b = 0; b < 2; ++b)
#pragma unroll
            for (int m = 0; m < 4; ++m)
#pragma unroll
                for (int n = 0; n < 2; ++n) acc[a][b][m][n] = (f32x4){0.f, 0.f, 0.f, 0.f};
    bf16x8 At[4][2], B0[2][2], B1[2][2];
    const char* cA = (const char*)g.A + (size_t)cur.pm * tstepA + (size_t)cur.z * g.zA; const char* cB = (const char*)g.Bt + (size_t)cur.pn * tstepB + (size_t)cur.z * g.zB;
    S.a_ready(cur);
    if constexpr (SP2) {
        PG8_STAGE(PG8_SB(0, 0), cB, voffB); PG8_STAGE(PG8_SB(0, 1), cB + hstepB, voffB); PG8_STAGE(PG8_SA(0, 0), cA, voffA); PG8_STAGE(PG8_SA(0, 1), cA + hstepA, voffA);
        if (wr == 1) PG8_BAR;
        PG8_WAIT_V(2); PG8_BAR;
        PG8_STAGE(PG8_SB(1, 0), cB + kstep, voffB); PG8_STAGE(PG8_SA(1, 0), cA + kstep, voffA); PG8_STAGE(PG8_SB(1, 1), cB + hstepB + kstep, voffB);
        PG8_WAIT_V(6); PG8_BAR;
    } else {
        PG8_STAGE(PG8_SB(0, 0), cB, voffB); PG8_STAGE(PG8_SA(0, 0), cA, voffA); PG8_STAGE(PG8_SB(0, 1), cB + hstepB, voffB); PG8_STAGE(PG8_SA(0, 1), cA + hstepA, voffA);
        if (wr == 1) PG8_BAR;
        PG8_WAIT_V(4); PG8_BAR;
        PG8_STAGE(PG8_SB(1, 0), cB + kstep, voffB); PG8_STAGE(PG8_SA(1, 0), cA + kstep, voffA); PG8_STAGE(PG8_SB(1, 1), cB + hstepB + kstep, voffB);
        PG8_WAIT_V(6); PG8_BAR;
    }
    for (;;) {
        const bool has_next = S.next(ui + 1, nxt);
        const char* nA = has_next ? (const char*)g.A + (size_t)nxt.pm * tstepA + (size_t)nxt.z * g.zA : cA; const char* nB = has_next ? (const char*)g.Bt + (size_t)nxt.pn * tstepB + (size_t)nxt.z * g.zB : cB;
        for (int t = 0; t < nt; t += 2) {
            const bool last = (t == nt - 2);
            const char* a1 = cA + (size_t)(t + 1) * kstep;
            const char* a2 = last ? nA : cA + (size_t)(t + 2) * kstep; const char* b2 = last ? nB : cB + (size_t)(t + 2) * kstep;
            const char* a3 = a2 + kstep; const char* b3 = b2 + kstep;
            if (last && has_next) S.a_ready(nxt);
            if constexpr (SP2) {
            PG8_LDB(B0, 0, 0); PG8_LDB(B1, 0, 1); PG8_SCHED; PG8_LDA(At, 0, 0); PG8_STAGE(PG8_SA(1, 1), a1 + hstepA, voffA);
            PG8_WAIT_V(8); PG8_WAIT_L(0); PG8_BAR; PG8_MMA(0, 0, At, B0); PG8_MMA(0, 1, At, B1); PG8_BAR; PG8_SCHED;
            PG8_LDA(At, 0, 1); PG8_STAGE(PG8_SB(0, 0), b2, voffB); PG8_STAGE(PG8_SB(0, 1), b2 + hstepB, voffB); PG8_STAGE(PG8_SA(0, 0), a2, voffA);
            PG8_WAIT_V(8); PG8_WAIT_L(0); PG8_BAR; PG8_MMA(1, 0, At, B0); PG8_MMA(1, 1, At, B1); PG8_BAR; PG8_SCHED;
            PG8_LDB(B0, 1, 0); PG8_LDB(B1, 1, 1); PG8_SCHED; PG8_LDA(At, 1, 0); PG8_STAGE(PG8_SA(0, 1), a2 + hstepA, voffA);
            PG8_WAIT_V(8); PG8_WAIT_L(0); PG8_BAR; PG8_MMA(0, 0, At, B0); PG8_MMA(0, 1, At, B1); PG8_BAR; PG8_SCHED;
            PG8_LDA(At, 1, 1); PG8_STAGE(PG8_SB(1, 0), b3, voffB); PG8_STAGE(PG8_SB(1, 1), b3 + hstepB, voffB); PG8_STAGE(PG8_SA(1, 0), a3, voffA);
            PG8_WAIT_V(8); PG8_WAIT_L(0); PG8_BAR; PG8_MMA(1, 0, At, B0); PG8_MMA(1, 1, At, B1); PG8_BAR; PG8_SCHED;
            } else {
            PG8_LDB(B0, 0, 0); PG8_SCHED; PG8_LDA(At, 0, 0); PG8_STAGE(PG8_SA(1, 1), a1 + hstepA, voffA);
            PG8_WAIT_L(8); PG8_BAR; PG8_WAIT_L(0); PG8_MMA(0, 0, At, B0); PG8_BAR; PG8_SCHED;
            PG8_LDB(B1, 0, 1); PG8_STAGE(PG8_SB(0, 0), b2, voffB);
            PG8_BAR; PG8_WAIT_L(0); PG8_MMA(0, 1, At, B1); PG8_BAR;
            PG8_LDA(At, 0, 1); PG8_STAGE(PG8_SA(0, 0), a2, voffA);
            PG8_BAR; PG8_WAIT_L(0); PG8_MMA(1, 0, At, B0); PG8_BAR; PG8_SCHED;
            PG8_STAGE(PG8_SB(0, 1), b2 + hstepB, voffB);
            PG8_WAIT_V(6); PG8_BAR; PG8_MMA(1, 1, At, B1); PG8_BAR;
            PG8_LDB(B0, 1, 0); PG8_SCHED; PG8_LDA(At, 1, 0); PG8_STAGE(PG8_SA(0, 1), a2 + hstepA, voffA);
            PG8_WAIT_L(8); PG8_BAR; PG8_WAIT_L(0); PG8_MMA(0, 0, At, B0); PG8_BAR; PG8_SCHED;
            PG8_LDB(B1, 1, 1); PG8_STAGE(PG8_SB(1, 0), b3, voffB);
            PG8_BAR; PG8_WAIT_L(0); PG8_MMA(0, 1, At, B1); PG8_BAR;
            PG8_LDA(At, 1, 1); PG8_STAGE(PG8_SA(1, 0), a3, voffA);
            PG8_BAR; PG8_WAIT_L(0); PG8_MMA(1, 0, At, B0); PG8_BAR; PG8_SCHED;
            PG8_STAGE(PG8_SB(1, 1), b3 + hstepB, voffB);
            PG8_WAIT_V(6); PG8_BAR; PG8_MMA(1, 1, At, B1); PG8_BAR;
            }
        }
        if constexpr (ALIGN_EPI) { if (wr == 0) PG8_BAR; }
        if constexpr (!Epi::AFTER_DRAIN) { E(acc, cur, wr, wc, fr, fq); S.done(cur); }
        if (!has_next) break;
        if (!Epi::keeps_acc(cur)) {
#pragma unroll
        for (int a = 0; a < 2; ++a)
#pragma unroll
            for (int b = 0; b < 2; ++b)
#pragma unroll
                for (int m = 0; m < 4; ++m)
#pragma unroll
                    for (int n = 0; n < 2; ++n) acc[a][b][m][n] = (f32x4){0.f, 0.f, 0.f, 0.f};
        }
        cur = nxt; cA = nA; cB = nB; ++ui;
        if constexpr (ALIGN_EPI) { if (wr == 1) PG8_BAR; }
    }
    PG8_WAIT_V(0);
    if constexpr (!ALIGN_EPI) { if (wr == 0) PG8_BAR; }
    PG8_BAR;
    if constexpr (Epi::AFTER_DRAIN) { E.fused(acc, cur, wr, wc, fr, fq, lds, wid, lane); S.done(cur); }
#undef PG8_SA
#undef PG8_SB
#undef PG8_STAGE
#undef PG8_LDA
#undef PG8_LDB
#undef PG8_MMA
#undef PG8_WAIT_V
#undef PG8_WAIT_L
#undef PG8_BAR
#undef PG8_SCHED
}
}

#ifndef PG8_SP2
#define PG8_SP2 true
#endif
#ifndef PG8_ALIGN
#define PG8_ALIGN true
#endif
#include <hip/hip_bf16.h>
#include <cmath>
namespace attn_body {
using bf16=__hip_bfloat16;
using bf16x8=__attribute__((ext_vector_type(8)))short;
using s16x4=__attribute__((ext_vector_type(4)))short;
using f32x16=__attribute__((ext_vector_type(16)))float;
using u32x4=__attribute__((ext_vector_type(4)))unsigned;
constexpr int SEQ=2048,D=64,PQ=4352,PK=4352,PV=4352,PO=1024;
constexpr int NW=8,QBLK=32,QB=QBLK*NW,KVBLK=64,NQB=SEQ/QB;
constexpr int ATTN_UNIT_ROWS=QB;
__device__ __forceinline__ int crow(int r,int hi){return (r&3)+8*(r>>2)+4*hi;}
#define SBAR() __builtin_amdgcn_sched_barrier(0)
__device__ __forceinline__ void cmask(f32x16&p0,f32x16&p1,int jb,int qrel,int hi){
  const float NEG=-INFINITY; int kb=64*jb+4*hi;
  #pragma unroll
  for(int r=0;r<16;++r){int kv=kb+(r&3)+8*(r>>2); if(kv>qrel)p0[r]=NEG; if(kv+32>qrel)p1[r]=NEG;}
}

constexpr int NSLOT=3, SLOTB=8192;
constexpr int LDS_K=0, LDS_V=NSLOT*SLOTB, LDS_WS=2*NSLOT*SLOTB, LDS_OST=LDS_WS+NW*64*4, LDS_BYTES=LDS_OST+NW*4096;
constexpr float C2=0.125f*1.4426950408889634f;
__device__ __forceinline__ void glds16(const void*gsrc,unsigned lds_dst){unsigned keep;
  asm volatile("s_mov_b32 %0, m0\n\ts_mov_b32 m0, %2\n\ts_nop 0\n\tglobal_load_lds_dwordx4 %1, off\n\ts_mov_b32 m0, %0":"=&s"(keep):"v"(gsrc),"s"(lds_dst):"memory");}
__device__ __forceinline__ float max3f(float a,float b,float c){float r;asm("v_max3_f32 %0, %1, %2, %3":"=v"(r):"v"(a),"v"(b),"v"(c));return r;}
__device__ __forceinline__ float max2f(float a,float b){float r;asm("v_max_f32_e32 %0, %1, %2":"=v"(r):"v"(a),"v"(b));return r;}
__device__ __forceinline__ float fadd_s(float a,float b){float r;asm("v_add_f32_e32 %0, %1, %2":"=v"(r):"v"(a),"v"(b));return r;}
__device__ __forceinline__ float fsub_s(float a,float b){float r;asm("v_sub_f32_e32 %0, %1, %2":"=v"(r):"v"(a),"v"(b));return r;}
typedef float f32x2_t __attribute__((ext_vector_type(2))); typedef __bf16 bf16x2_t __attribute__((ext_vector_type(2)));
__device__ __forceinline__ unsigned cvtpk_s(float lo,float hi){f32x2_t v={lo,hi};bf16x2_t b=__builtin_convertvector(v,bf16x2_t);return __builtin_bit_cast(unsigned,b);}
#define WAIT_BAR(N) asm volatile("s_waitcnt vmcnt(" #N ") lgkmcnt(0)\n\ts_barrier":::"memory")

__device__ __forceinline__ void qkt(f32x16&p0,f32x16&p1,const char*Kslot,const bf16x8*qr,const f32x16&negm,int r32,int hi){
  const char*kb=Kslot+hi*1024+r32*16;
  #pragma unroll
  for(int d0=0;d0<4;++d0){
    const bf16x8 b0=*reinterpret_cast<const bf16x8*>(kb+d0*2048);
    const bf16x8 b1=*reinterpret_cast<const bf16x8*>(kb+d0*2048+512);
    if(d0==0){p0=__builtin_amdgcn_mfma_f32_32x32x16_bf16(b0,qr[0],negm,0,0,0);p1=__builtin_amdgcn_mfma_f32_32x32x16_bf16(b1,qr[0],negm,0,0,0);}
    else{p0=__builtin_amdgcn_mfma_f32_32x32x16_bf16(b0,qr[d0],p0,0,0,0);p1=__builtin_amdgcn_mfma_f32_32x32x16_bf16(b1,qr[d0],p1,0,0,0);}}
}
typedef __attribute__((address_space(3))) const char* lds_cptr;
typedef short v4i16_t __attribute__((ext_vector_type(4)));
__device__ __forceinline__ void kload8(bf16x8*kf,lds_cptr kp){
  kf[0]=*(const __attribute__((address_space(3))) bf16x8*)(kp);      kf[1]=*(const __attribute__((address_space(3))) bf16x8*)(kp+512);
  kf[2]=*(const __attribute__((address_space(3))) bf16x8*)(kp+2048); kf[3]=*(const __attribute__((address_space(3))) bf16x8*)(kp+2560);
  kf[4]=*(const __attribute__((address_space(3))) bf16x8*)(kp+4096); kf[5]=*(const __attribute__((address_space(3))) bf16x8*)(kp+4608);
  kf[6]=*(const __attribute__((address_space(3))) bf16x8*)(kp+6144); kf[7]=*(const __attribute__((address_space(3))) bf16x8*)(kp+6656);
}
__device__ __forceinline__ void kload2(bf16x8*kf,lds_cptr kp,int j){ kf[2*j]=*(const __attribute__((address_space(3))) bf16x8*)(kp+j*2048); kf[2*j+1]=*(const __attribute__((address_space(3))) bf16x8*)(kp+j*2048+512); }
__device__ __forceinline__ s16x4 vtr(lds_cptr p){ return __builtin_bit_cast(s16x4,__builtin_amdgcn_ds_read_tr16_b64_v4i16((__attribute__((address_space(3))) v4i16_t*)p)); }
__device__ __forceinline__ float rowmax(const f32x16&p0,const f32x16&p1){
  float a=max3f(p0[0],p0[1],p1[0]),b=max3f(p0[2],p0[3],p1[1]);a=max3f(a,p1[2],p1[3]);
  #pragma unroll
  for(int r=4;r<16;r+=4){a=max3f(a,p0[r],p0[r+1]);b=max3f(b,p0[r+2],p0[r+3]);a=max3f(a,p1[r],p1[r+1]);b=max3f(b,p1[r+2],p1[r+3]);}
  const float m=max2f(a,b);
  auto rr=__builtin_amdgcn_permlane32_swap(__float_as_uint(m),__float_as_uint(m),false,false);
  return max2f(__uint_as_float(rr[0]),__uint_as_float(rr[1]));
}
__device__ __forceinline__ void pv(f32x16*o,int vb,bf16x8 pa0,bf16x8 pa1,bf16x8 pa2,bf16x8 pa3){
  #pragma unroll
  for(int d0=0;d0<2;++d0){s16x4 lo[4],hi[4];
    #pragma unroll
    for(int ks=0;ks<4;++ks){
      asm volatile("ds_read_b64_tr_b16 %0,%1 offset:%c2":"=&v"(lo[ks]):"v"(vb),"i"(d0*4096+ks*1024):"memory");
      asm volatile("ds_read_b64_tr_b16 %0,%1 offset:%c2":"=&v"(hi[ks]):"v"(vb),"i"(d0*4096+ks*1024+512):"memory");}
    asm volatile("s_waitcnt lgkmcnt(0)":::"memory");SBAR();
    #define PK(k) (bf16x8){lo[k][0],lo[k][1],lo[k][2],lo[k][3],hi[k][0],hi[k][1],hi[k][2],hi[k][3]}
    o[d0]=__builtin_amdgcn_mfma_f32_32x32x16_bf16(pa0,PK(0),o[d0],0,0,0);
    o[d0]=__builtin_amdgcn_mfma_f32_32x32x16_bf16(pa1,PK(1),o[d0],0,0,0);
    o[d0]=__builtin_amdgcn_mfma_f32_32x32x16_bf16(pa2,PK(2),o[d0],0,0,0);
    o[d0]=__builtin_amdgcn_mfma_f32_32x32x16_bf16(pa3,PK(3),o[d0],0,0,0);
    #undef PK
  }
}

#ifndef ATTN_STORE16
#define ATTN_STORE16(p,v) (*(u32x4*)(p)=(v))
#endif
template<int THRL> __device__ __forceinline__ void attn_unit(int b,int qcol,int kcol,int vcol,int ocol,int qb,const bf16*Q,const bf16*__restrict__ K,const bf16*__restrict__ V,bf16*O,char*shm){
  const int tid=threadIdx.x,lane=tid&63,r32=lane&31,hi=lane>>5; const int wid=__builtin_amdgcn_readfirstlane(tid>>6);
  const long rowbase=(long)b*SEQ; const int q0=qb*QB;
  const bf16*Qw=Q+(rowbase+q0+wid*QBLK)*PQ+qcol;
  const bf16*Kh=K+rowbase*PK+kcol,*Vh=V+rowbase*PV+vcol;
  const unsigned lds0=(unsigned)(uintptr_t)shm;
  float*wsf=(float*)(shm+LDS_WS)+wid*64;
  const bf16*ksrc=Kh+(long)lane*PK+wid*8;
  const bf16*vsrc=Vh+(long)(16*(wid&3)+(lane>>2))*PV+(wid>>2)*32+(lane&3)*8;
  const unsigned kdst=lds0+LDS_K+wid*1024, vdst=lds0+LDS_V+wid*1024;
  #define DMA_K(t,slot) glds16(ksrc+(long)(t)*KVBLK*PK,(unsigned)__builtin_amdgcn_readfirstlane(kdst+(slot)))
  #define DMA_V(t,slot) glds16(vsrc+(long)(t)*KVBLK*PV,(unsigned)__builtin_amdgcn_readfirstlane(vdst+(slot)))
  const int vb0=(int)(lds0+LDS_V)+((lane>>4)&1)*32+(lane&3)*8+(4*hi+((lane&15)>>2))*64;
  const char*Kbase=shm+LDS_K; bf16x8 kf[8];
  const lds_cptr shm3=(lds_cptr)shm; const lds_cptr kp0=shm3+LDS_K+hi*1024+r32*16; const lds_cptr vp0=shm3+LDS_V+((lane>>4)&1)*32+(lane&3)*8+(4*hi+((lane&15)>>2))*64;
  const int NT=(q0+QB)/KVBLK;
  DMA_K(0,0);DMA_V(0,0);DMA_K(1,SLOTB);
  bf16x8 qr[4];
  #pragma unroll
  for(int d0=0;d0<4;++d0)qr[d0]=*reinterpret_cast<const bf16x8*>(&Qw[(long)r32*PQ+d0*16+hi*8]);
  float mhat=0.f,l_reg=0.f;f32x16 o[2];o[0]=f32x16{};o[1]=f32x16{};f32x16 negm=f32x16{};asm volatile("":"+v"(negm));
  const int qrel=wid*QBLK+r32;
  #define CMASK(P0,P1,t) do{int jb_=(t)-(NT-4); if(jb_>=0)cmask(P0,P1,jb_,qrel,hi);}while(0)
  bool resc=false;
  #define START(P0,P1) do{ const float rm=rowmax(P0,P1); resc=false; \
    { const float dl=rm; mhat=fadd_s(mhat,dl); \
      _Pragma("unroll") for(int r=0;r<16;++r){P0[r]=fsub_s(P0[r],dl);P1[r]=fsub_s(P1[r],dl);} \
      _Pragma("unroll") for(int r=0;r<16;++r)negm[r]=-mhat; asm volatile("":"+v"(negm)); } \
    _Pragma("unroll") for(int r=0;r<16;++r)P0[r]=__builtin_amdgcn_exp2f(P0[r]); }while(0)
  #define RESC() do{ if(resc){ asm volatile("s_waitcnt lgkmcnt(0)":::"memory"); \
      _Pragma("unroll") for(int d_=0;d_<2;++d_) _Pragma("unroll") for(int r=0;r<16;++r)o[d_][r]*=wsf[crow(r,hi)]; } }while(0)
  f32x16 pA0,pA1,pB0,pB1;
  int sl_prev=0,sl_cur=0,sl_next=SLOTB;
  #define ROT() do{sl_prev=sl_cur;sl_cur=sl_next;sl_next=(sl_next==(NSLOT-1)*SLOTB)?0:sl_next+SLOTB;}while(0)
  DMA_K(2,2*SLOTB);
  WAIT_BAR(3);
  qkt(pA0,pA1,Kbase,qr,negm,r32,hi);asm volatile("s_nop 15\n\ts_nop 7":"+v"(pA0),"+v"(pA1));CMASK(pA0,pA1,0);
  START(pA0,pA1);
  _Pragma("unroll") for(int r=0;r<16;++r)pA1[r]=__builtin_amdgcn_exp2f(pA1[r]);
  WAIT_BAR(0);
  DMA_K(3,0);DMA_V(1,SLOTB);
  ROT();
  kload8(kf,kp0+sl_cur);
  WAIT_BAR(2);
  s16x4 vlo[8],vhi[8]; u32x4 pw0,pw1,pw2,pw3;
  #define PKW(P,B) cvtpk_s(P[B],P[B+1])
  #define PAF(k) __builtin_bit_cast(bf16x8,pw##k)
  #define VFR(i) (bf16x8){vlo[i][0],vlo[i][1],vlo[i][2],vlo[i][3],vhi[i][0],vhi[i][1],vhi[i][2],vhi[i][3]}
  #define PIN(x) asm volatile("":"+v"(x))
  #define MX3(a,b,c) __builtin_fmaxf(__builtin_fmaxf((a),(b)),(c))
  #define GAPA(MF,A0,A1,A2,A3,W0,W1,PW) do{ MF; sacc+=A0; sacc+=A1; sacc+=A2; sacc+=A3; PIN(sacc); W0; W1; PIN(PW); SBAR(); }while(0)
  #define EX(v) __builtin_amdgcn_exp2f(v)
  #define GAPB(MF,X,B) do{ MF; X[B]=EX(X[B]); X[B+1]=EX(X[B+1]); X[B+2]=EX(X[B+2]); X[B+3]=EX(X[B+3]); PIN(X); SBAR(); }while(0)
  #define VRD(i) do{ vlo[i]=vtr(vp_+(((i)>>2)*4096+((i)&3)*1024)); vhi[i]=vtr(vp_+(((i)>>2)*4096+((i)&3)*1024+512)); }while(0)
  #define KRD(G,j) do{ if(G){ kload2(kf,kp0+sl_next,j); SBAR(); } }while(0)
  #define STEP(C0,C1,P0,P1,t,GK,GV,GL) do{ SBAR(); \
    const lds_cptr vp_=vp0+sl_prev; \
    VRD(0); SBAR(); float sacc=(P0[0]+P0[1]); \
    GAPA(C0=__builtin_amdgcn_mfma_f32_32x32x16_bf16(kf[0],qr[0],negm,0,0,0), P0[2],P0[3],P0[4],P0[5],     pw0[0]=PKW(P0,0), pw0[1]=PKW(P0,2), pw0); \
    VRD(4); SBAR(); GAPA(C1=__builtin_amdgcn_mfma_f32_32x32x16_bf16(kf[1],qr[0],negm,0,0,0), P0[6],P0[7],P0[8],P0[9],     pw0[2]=PKW(P0,4), pw0[3]=PKW(P0,6), pw0); \
    VRD(1); SBAR(); GAPA(C0=__builtin_amdgcn_mfma_f32_32x32x16_bf16(kf[2],qr[1],C0,0,0,0),   P0[10],P0[11],P0[12],P0[13], pw1[0]=PKW(P0,8), pw1[1]=PKW(P0,10), pw1); \
    VRD(5); SBAR(); GAPA(C1=__builtin_amdgcn_mfma_f32_32x32x16_bf16(kf[3],qr[1],C1,0,0,0),   P0[14],P0[15],P1[0],P1[1],   pw1[2]=PKW(P0,12),pw1[3]=PKW(P0,14), pw1); \
    VRD(2); SBAR(); GAPA(C0=__builtin_amdgcn_mfma_f32_32x32x16_bf16(kf[4],qr[2],C0,0,0,0),   P1[2],P1[3],P1[4],P1[5],     pw2[0]=PKW(P1,0), pw2[1]=PKW(P1,2), pw2); \
    VRD(6); SBAR(); GAPA(C1=__builtin_amdgcn_mfma_f32_32x32x16_bf16(kf[5],qr[2],C1,0,0,0),   P1[6],P1[7],P1[8],P1[9],     pw2[2]=PKW(P1,4), pw2[3]=PKW(P1,6), pw2); \
    VRD(3); SBAR(); GAPA(C0=__builtin_amdgcn_mfma_f32_32x32x16_bf16(kf[6],qr[3],C0,0,0,0),   P1[10],P1[11],P1[12],P1[13], pw3[0]=PKW(P1,8), pw3[1]=PKW(P1,10), pw3); \
    VRD(7); SBAR(); GAPA(C1=__builtin_amdgcn_mfma_f32_32x32x16_bf16(kf[7],qr[3],C1,0,0,0),   P1[14],P1[15],0.f,0.f,       pw3[2]=PKW(P1,12),pw3[3]=PKW(P1,14), pw3); \
    l_reg+=sacc; \
    if(GK){DMA_K((t)+3,sl_cur);} if(GV){DMA_V((t)+1,sl_next);} \
    CMASK(C0,C1,t); \
    { float a=MX3(C0[0],C0[1],C1[0]),b=MX3(C0[2],C0[3],C1[1]); a=MX3(a,C1[2],C1[3]); \
      _Pragma("unroll") for(int r=4;r<16;r+=4){a=MX3(a,C0[r],C0[r+1]);b=MX3(b,C0[r+2],C0[r+3]);a=MX3(a,C1[r],C1[r+1]);b=MX3(b,C1[r+2],C1[r+3]);} \
      float rm=__builtin_fmaxf(a,b); { auto rr=__builtin_amdgcn_permlane32_swap(__float_as_uint(rm),__float_as_uint(rm),false,false); rm=__builtin_fmaxf(__uint_as_float(rr[0]),__uint_as_float(rr[1])); } \
      resc=false; \
      if(__builtin_expect(__any(rm>(float)THRL),0)){ const float dl=__builtin_fmaxf(rm,0.f); mhat+=dl; \
        _Pragma("unroll") for(int r=0;r<16;++r){C0[r]-=dl;C1[r]-=dl;} \
        _Pragma("unroll") for(int r=0;r<16;++r)negm[r]=-mhat; asm volatile("":"+v"(negm)); \
        const float f=__builtin_amdgcn_exp2f(-dl); l_reg*=f; if(hi==0)wsf[r32]=f; resc=true; } } \
    SBAR(); \
    GAPB(o[0]=__builtin_amdgcn_mfma_f32_32x32x16_bf16(PAF(0),VFR(0),o[0],0,0,0), C0,0); \
    GAPB(o[1]=__builtin_amdgcn_mfma_f32_32x32x16_bf16(PAF(0),VFR(4),o[1],0,0,0), C0,4); \
    KRD(GL,0); GAPB(o[0]=__builtin_amdgcn_mfma_f32_32x32x16_bf16(PAF(1),VFR(1),o[0],0,0,0), C0,8); \
    KRD(GL,1); GAPB(o[1]=__builtin_amdgcn_mfma_f32_32x32x16_bf16(PAF(1),VFR(5),o[1],0,0,0), C0,12); \
    KRD(GL,2); GAPB(o[0]=__builtin_amdgcn_mfma_f32_32x32x16_bf16(PAF(2),VFR(2),o[0],0,0,0), C1,0); \
    KRD(GL,3); GAPB(o[1]=__builtin_amdgcn_mfma_f32_32x32x16_bf16(PAF(2),VFR(6),o[1],0,0,0), C1,4); \
    GAPB(o[0]=__builtin_amdgcn_mfma_f32_32x32x16_bf16(PAF(3),VFR(3),o[0],0,0,0), C1,8); \
    GAPB(o[1]=__builtin_amdgcn_mfma_f32_32x32x16_bf16(PAF(3),VFR(7),o[1],0,0,0), C1,12); \
    }while(0)
  int t=1;
  #undef CMASK
  #define CMASK(P0,P1,t) do{}while(0)
  for(;t+5<NT;t+=2){
    STEP(pB0,pB1,pA0,pA1,t,true,true,true);     WAIT_BAR(2); RESC(); ROT();
    STEP(pA0,pA1,pB0,pB1,t+1,true,true,true);   WAIT_BAR(2); RESC(); ROT();
  }
  #undef CMASK
  #define CMASK(P0,P1,t) do{int jb_=(t)-(NT-4); if(jb_>=0)cmask(P0,P1,jb_,qrel,hi);}while(0)
  #define ENDW(tt) do{ if((tt)+3<NT){WAIT_BAR(2);} else if((tt)+2<NT){WAIT_BAR(1);} else {WAIT_BAR(0);} }while(0)
  for(;t+1<NT;t+=2){
    STEP(pB0,pB1,pA0,pA1,t,(t+3<NT),(t+1<NT),(t+1<NT));       ENDW(t);   RESC(); ROT();
    STEP(pA0,pA1,pB0,pB1,t+1,(t+4<NT),(t+2<NT),(t+2<NT));     ENDW(t+1); RESC(); ROT();
  }
  STEP(pB0,pB1,pA0,pA1,NT-1,false,false,false); RESC();
  { float sacc=pB0[0]+pB0[1]; _Pragma("unroll") for(int r=2;r<16;++r)sacc+=pB0[r]; _Pragma("unroll") for(int r=0;r<16;++r)sacc+=pB1[r]; l_reg+=sacc;
    pw0=(u32x4){PKW(pB0,0),PKW(pB0,2),PKW(pB0,4),PKW(pB0,6)};pw1=(u32x4){PKW(pB0,8),PKW(pB0,10),PKW(pB0,12),PKW(pB0,14)};pw2=(u32x4){PKW(pB1,0),PKW(pB1,2),PKW(pB1,4),PKW(pB1,6)};pw3=(u32x4){PKW(pB1,8),PKW(pB1,10),PKW(pB1,12),PKW(pB1,14)};
    SBAR(); pv(o,vb0+sl_cur,PAF(0),PAF(1),PAF(2),PAF(3)); }
  #undef PKW
  #undef PAF
  #undef VFR
  #undef PIN
  #undef MX3
  #undef GAPA
  #undef GAPB
  #undef EX
  #undef VRD
  #undef KRD
  #undef STEP
  #undef ENDW
  {auto rr=__builtin_amdgcn_permlane32_swap(__float_as_uint(l_reg),__float_as_uint(l_reg),false,false);l_reg=__uint_as_float(rr[0])+__uint_as_float(rr[1]);}
  if(hi==0)wsf[32+r32]=l_reg;asm volatile("s_waitcnt lgkmcnt(0)":::"memory");
  float rli[16];
  #pragma unroll
  for(int r=0;r<16;++r)rli[r]=__builtin_amdgcn_rcpf(wsf[32+crow(r,hi)]);
  bf16*Ow=O+(rowbase+q0+wid*QBLK)*PO+ocol;
  { bf16*stg=(bf16*)(shm+LDS_OST)+wid*2048;
    #pragma unroll
    for(int r=0;r<16;++r){const int orow=crow(r,hi);
      #pragma unroll
      for(int d0=0;d0<2;++d0)stg[orow*64+d0*32+r32]=__float2bfloat16(o[d0][r]*rli[r]);}
    asm volatile("s_waitcnt lgkmcnt(0)":::"memory");
    #pragma unroll
    for(int i=0;i<4;++i){const int row=i*8+(lane>>3),ch=lane&7; const u32x4 v=*(const u32x4*)(stg+row*64+ch*8); ATTN_STORE16(Ow+(long)row*PO+ch*8,v);} }
  asm volatile("s_waitcnt lgkmcnt(0)\n\ts_barrier":::"memory");
  #undef DMA_K
  #undef DMA_V
  #undef CMASK
  #undef START
  #undef RESC
  #undef ROT
}
constexpr int ATTN_LDS_BYTES=LDS_BYTES;
struct AttnTensors { const bf16* Q; const bf16* K; const bf16* V; bf16* O; };
struct AttnUnit { int bj; int qb; };
struct StaticOrder {
  int vcu;
  __device__ __forceinline__ explicit StaticOrder(int grid,int block):vcu((block%8)*(grid/8)+block/8){}
  __device__ __forceinline__ bool next(int i,AttnUnit&u)const{ if(i>=4)return false; const int s0=2*(vcu&1); u.bj=vcu>>1; u.qb=(i==0)?s0:(i==1)?7-s0:(i==2)?s0+1:6-s0; return true; }
};
struct RangeOrder {
  StaticOrder S; int lo, hi;
  __device__ __forceinline__ RangeOrder(int grid,int block,int lo_,int hi_):S(grid,block),lo(lo_),hi(hi_){}
  __device__ __forceinline__ bool next(int i,AttnUnit&u)const{ return i+lo<hi && S.next(i+lo,u); }
};
template<class Sched,int THRL=8> __device__ __forceinline__ void attn_phase(char*lds,const AttnTensors&T,const Sched&S){
  AttnUnit u;
  for(int i=0;S.next(i,u);++i){ const int b=u.bj>>4,j=u.bj&15,h=j>>2,c=(j>>1)&1,vh=j&1;
    attn_unit<THRL>(b,h*128+c*64,512+h*128+c*64,1024+h*128+vh*64,j*64,u.qb,T.Q,T.K,T.V,T.O,lds); }
}
#undef SBAR
#undef WAIT_BAR
}
constexpr int NWAVES = 8;
constexpr int NB = 8, SEQ = 2048, T = NB * SEQ, D = 1024, DEPTH = 2;
constexpr int NPROJ = 4352, NGATE = 4096, NIN = 8448;
constexpr float EPS = 1e-6f;
constexpr float C2 = 0.125f * 1.4426950408889634f;
constexpr float LOG2E = 1.4426950408889634f;
constexpr int C_AQ = 0, C_AK = 512, C_AV = 1024, C_BB = 1536, C_BC = 2048, C_BX = 2560, C_CZ = 3072, C_DQ = 3584, C_DK = 4096, C_DV = 4224;
enum { I_X = 0, I_C, I_WADA, I_BADA, I_GN1, I_WIN, I_LQ1, I_LK1, I_LQ2, I_LK2, I_GSUB, I_CONVW, I_WPOOL, I_PSCALE, I_SINKS, I_WBR, I_WO, I_GN2, I_WQ, I_SK, I_UE, I_VE, I_GFIN, N_IN };

constexpr size_t MiB = 1u << 20;
constexpr size_t WS_CTL = 0, CTL_ZERO_BYTES = 1 * MiB;
constexpr size_t WS_MOD = 1 * MiB;
constexpr size_t WS_W = 2 * MiB, W_LAYER = 27 * MiB;
constexpr size_t W_WIN = 0, W_WBR = 16 * MiB + MiB / 2, W_WO = W_WBR + 4 * MiB, W_WQ = W_WO + 2 * MiB, W_SK = W_WQ + 4 * MiB, W_WP = W_SK + 65536, W_WPF = W_WP + 4 * 128 * 128 * 2;
constexpr size_t WS_H = 56 * MiB;
constexpr size_t WS_PROJ = 88 * MiB;
constexpr size_t WS_S32 = WS_PROJ;
constexpr size_t WS_Q2 = WS_PROJ;
#ifndef DBG_ROUTE32
#define DBG_ROUTE32 0
#endif
#if DBG_ROUTE32
constexpr size_t WS_H3 = WS_PROJ;
constexpr size_t WS_Q32 = 224 * MiB;
constexpr size_t WS_IDX = 416 * MiB, WS_WTS = WS_IDX + 8 * MiB;
#else
constexpr size_t WS_IDX = WS_PROJ + 64 * MiB, WS_WTS = WS_IDX + 8 * MiB;
#endif
constexpr size_t WS_GATES = 224 * MiB;
constexpr size_t WS_Y = 352 * MiB;
constexpr size_t WS_X1B = WS_Y;
#ifndef EXP_I8
#define EXP_I8 1
#endif
#define EXP_I8_OWN (EXP_I8 && !DBG_ROUTE32)
#if DBG_ROUTE32
constexpr size_t WS_UE = WS_PROJ, WS_VE = WS_PROJ + 32 * MiB;
constexpr size_t WS_WQ3 = WS_Y;
#else
#if EXP_I8_OWN
constexpr size_t WS_UE = 448 * MiB, WS_VE = 464 * MiB;
#else
constexpr size_t WS_UE = WS_GATES, WS_VE = WS_GATES + 32 * MiB;
#endif
#endif
constexpr size_t WS_US = 480 * MiB, WS_VS = WS_US + 65536;
constexpr size_t WS_O = 416 * MiB;
#ifndef NORM_FOLD
#define NORM_FOLD (!DBG_ROUTE32)
#ifndef EPI_HOIST
#define EPI_HOIST 1
#endif
#ifndef H2C_HOIST
#define H2C_HOIST 1
#endif
#ifndef X1_PREFETCH
#define X1_PREFETCH 1
#endif
#ifndef V_ABID
#define V_ABID 1
#endif
#ifndef ROUTE_SORTNET
#define ROUTE_SORTNET 1
#endif
#ifndef H_PLANES
#define H_PLANES 1
#endif
#ifndef POOL_STAGE
#define POOL_STAGE 1
#endif
#ifndef SK_FRAG
#define SK_FRAG 1
#endif
#ifndef POOL_LDS
#define POOL_LDS 1
#endif
#ifndef SWA_STAGE
#define SWA_STAGE 1
#endif
#ifndef Q2_FRAG
#define Q2_FRAG 1
#endif
#ifndef TREE_BANKMASK
#define TREE_BANKMASK 1
#endif
#ifndef MIX_STAGGER
#define MIX_STAGGER 4
#endif
#ifndef ROUTE_BATCH
#define ROUTE_BATCH 4
#endif
#ifndef ROW_OFFS
#define ROW_OFFS 1
#endif
#ifndef DMA_NOMASK
#define DMA_NOMASK 1
#endif
#ifndef ROW_PIPE
#define ROW_PIPE 1
#endif
#ifndef EXP6B
#define EXP6B 1
#endif
#ifndef V_PLANES
#define V_PLANES 1
#endif
#ifndef EXP5B
#define EXP5B 1
#endif
constexpr unsigned EROW = EXP6B ? (EXP5B ? 640u : 768u) : 1024u;
#ifndef V_MFMA
#define V_MFMA 1
#endif
#endif
constexpr size_t WS_SSQ = 481 * MiB;
constexpr size_t WS_CQ = WS_MOD + 512 * 1024;
constexpr size_t WS_END = (EXP_I8_OWN || NORM_FOLD) ? 482 * MiB : 448 * MiB;
constexpr int CW_PEERQ = 8192;
#ifndef PEER_DYNAMIC
#define PEER_DYNAMIC 0
#endif
constexpr int CW_BAR = 4096;

constexpr int RING_OFF = 0, RING_BYTES = 131072;
constexpr int LDSCTL_OFF = RING_BYTES, MISC_OFF = LDSCTL_OFF + 320;
constexpr int HAND_OFF = LDSCTL_OFF + 1024;
constexpr int LDS_BYTES = HAND_OFF + 8 * 3072;

#define GAS __attribute__((address_space(1)))
#define LAS __attribute__((address_space(3)))
typedef unsigned short bf16;
typedef unsigned v4u __attribute__((ext_vector_type(4)));
typedef unsigned v2u __attribute__((ext_vector_type(2)));
typedef float f32x4 __attribute__((ext_vector_type(4)));
typedef GAS unsigned gu32;
#define LDS_WAIT() asm volatile("s_waitcnt lgkmcnt(0)" ::: "memory")
__device__ __forceinline__ unsigned f2bf(float f) { unsigned u = __builtin_bit_cast(unsigned, f); return (u + 0x7fffu + ((u >> 16) & 1u)) >> 16; }
__device__ __forceinline__ unsigned pk2(float lo, float hi) { return f2bf(lo) | (f2bf(hi) << 16); }
__device__ __forceinline__ float bflo(unsigned w) { return __builtin_bit_cast(float, w << 16); }
__device__ __forceinline__ float bfhi(unsigned w) { return __builtin_bit_cast(float, w & 0xffff0000u); }
__device__ __forceinline__ float bf1(bf16 h) { return __builtin_bit_cast(float, (unsigned)h << 16); }

#define XB_TMO      128
#define XB_XCNT(j)  (256  + 64 * (j))
#define XB_XSUB(j)  (1280 + 64 * (j))
#define XB_XGEN(j)  (2304 + 64 * (j))
#define XB_TOP      3328
#define XB_TOPGEN   3392
#define XCD_BAR_WORDS 3456
#define XB_SPIN_CAP (1u << 18)
__device__ __forceinline__ unsigned xb_ld(unsigned* p)              { return __hip_atomic_load(p, __ATOMIC_RELAXED, __HIP_MEMORY_SCOPE_AGENT); }
__device__ __forceinline__ unsigned xb_add(unsigned* p, unsigned v) { return __hip_atomic_fetch_add(p, v, __ATOMIC_RELAXED, __HIP_MEMORY_SCOPE_AGENT); }
__device__ __forceinline__ unsigned xb_xcc_id() { return (unsigned)__builtin_amdgcn_s_getreg((3 << 11) | 20) & 0xFu; }
#define XB_SPIN(cond, bar) do { unsigned _sp = 0; while (cond) { __builtin_amdgcn_s_sleep(1); \
    if ((++_sp & 255u) == 0u) { if (xb_ld(&(bar)[XB_TMO])) break; if (_sp > XB_SPIN_CAP) { atomicAdd(&(bar)[XB_TMO], 1u); break; } } } } while (0)
struct XcdBarrier { unsigned* bar; unsigned x; volatile LAS unsigned* st; };
__device__ __forceinline__ XcdBarrier xcd_barrier_post(unsigned* bar, volatile LAS unsigned* st) {
    XcdBarrier b; b.bar = bar; b.x = xb_xcc_id(); b.st = st;
    if (threadIdx.x == 0) (void)xb_add(&bar[XB_XCNT(b.x)], 1u);
    return b;
}
__device__ __forceinline__ void xcd_barrier_complete(unsigned* bar, unsigned x, unsigned& nloc, unsigned& nx) {
    const unsigned G = gridDim.x * gridDim.y * gridDim.z;
    unsigned sum, cnt, mine, sp = 0u;
    for (;;) {
        sum = 0u; cnt = 0u; mine = 0u;
#pragma unroll
        for (unsigned j = 0; j < 16; ++j) { const unsigned c = xb_ld(&bar[XB_XCNT(j)]); sum += c; cnt += (c > 0u) ? 1u : 0u; mine = (j == x) ? c : mine; }
        if (sum == G) break;
        __builtin_amdgcn_s_sleep(1);
        if ((++sp & 255u) == 0u) { if (xb_ld(&bar[XB_TMO])) break; if (sp > XB_SPIN_CAP) { atomicAdd(&bar[XB_TMO], 1u); break; } }
    }
    nloc = mine > 0u ? mine : 1u; nx = cnt > 0u ? cnt : 1u;
}
__device__ __forceinline__ void xcd_barrier(const XcdBarrier& b) {
    asm volatile("s_waitcnt vmcnt(0)" ::: "memory");
    __syncthreads();
    if (threadIdx.x == 0) {
        unsigned* bar = b.bar;
        __builtin_amdgcn_s_waitcnt(0);
        unsigned nloc = b.st[0], nx = b.st[1];
        if (nloc == 0u) { xcd_barrier_complete(bar, b.x, nloc, nx); b.st[0] = nloc; b.st[1] = nx; }
        const unsigned old = xb_add(&bar[XB_XSUB(b.x)], 1u);
        const unsigned gen = old / nloc;
        if (old + 1u == (gen + 1u) * nloc) {
            __builtin_amdgcn_fence(__ATOMIC_RELEASE, "agent");
            asm volatile("s_waitcnt vmcnt(0)" ::: "memory");
            const unsigned og = xb_add(&bar[XB_TOP], 1u);
            const unsigned tg = og / nx;
            if (og + 1u == (tg + 1u) * nx) xb_add(&bar[XB_TOPGEN], 1u);
            else XB_SPIN(xb_ld(&bar[XB_TOPGEN]) == tg, bar);
            __builtin_amdgcn_fence(__ATOMIC_ACQUIRE, "agent");
            xb_add(&bar[XB_XGEN(b.x)], 1u);
            asm volatile("s_waitcnt vmcnt(0)" ::: "memory");
        } else {
            XB_SPIN(xb_ld(&bar[XB_XGEN(b.x)]) == gen, bar);
            __builtin_amdgcn_fence(__ATOMIC_ACQUIRE, "agent");
            asm volatile("s_waitcnt vmcnt(0)" ::: "memory");
        }
    }
    __syncthreads();
}

__device__ __forceinline__ float rdlane(float v, int l) { return __builtin_bit_cast(float, __builtin_amdgcn_readlane(__builtin_bit_cast(int, v), l)); }
__device__ __forceinline__ int rdlanei(int v, int l) { return __builtin_amdgcn_readlane(v, l); }
template <int CTRL> __device__ __forceinline__ float dppf(float v) { return __builtin_bit_cast(float, __builtin_amdgcn_mov_dpp(__builtin_bit_cast(int, v), CTRL, 0xF, 0xF, true)); }
template <int CTRL> __device__ __forceinline__ int dppi(int v) { return __builtin_amdgcn_mov_dpp(v, CTRL, 0xF, 0xF, true); }
__device__ __forceinline__ float wave_sum(float v) {
    v += dppf<0xB1>(v); v += dppf<0x4E>(v); v += dppf<0x124>(v); v += dppf<0x128>(v);
    return (rdlane(v, 0) + rdlane(v, 16)) + (rdlane(v, 32) + rdlane(v, 48));
}
__device__ __forceinline__ int wave_sumi(int v) {
    v += dppi<0xB1>(v); v += dppi<0x4E>(v); v += dppi<0x124>(v); v += dppi<0x128>(v);
    return (rdlanei(v, 0) + rdlanei(v, 16)) + (rdlanei(v, 32) + rdlanei(v, 48));
}
__device__ __forceinline__ float wave_max(float v) {
    v = fmaxf(v, dppf<0xB1>(v)); v = fmaxf(v, dppf<0x4E>(v)); v = fmaxf(v, dppf<0x124>(v)); v = fmaxf(v, dppf<0x128>(v));
    return fmaxf(fmaxf(rdlane(v, 0), rdlane(v, 16)), fmaxf(rdlane(v, 32), rdlane(v, 48)));
}

struct Ctx {
    LAS unsigned char* lds;
    int tid, lane, wave, vcu, G, gw, NGW;
};
struct Args { const float* in[N_IN]; float* out; unsigned char* ws; int ph_lo, ph_hi; };
typedef const __attribute__((address_space(4))) Args& KArgs;

template <bool GPERM = false> __device__ __forceinline__ void p0_transpose_item(const float* W, int K, int N, bf16* WT, LAS float* scr, int item, int lane, float scale) {
    const int nblk = N / 32, kb = item / nblk, nb = item % nblk, k0 = 64 * kb, n0 = 32 * nb;
#pragma unroll 8
    for (int i = 0; i < 32; ++i) { const int kk = 2 * i + (lane >> 5); scr[kk * 33 + (lane & 31)] = W[(size_t)(k0 + kk) * N + n0 + (lane & 31)] * scale; }
    LDS_WAIT(); asm volatile("" ::: "memory");
    const int c = lane & 7;
#pragma unroll
    for (int j = 0; j < 4; ++j) { const int n = (lane >> 3) + 8 * j; const LAS float* s = scr + (8 * c) * 33 + n;
        v4u o; o.x = pk2(s[0 * 33], s[1 * 33]); o.y = pk2(s[2 * 33], s[3 * 33]); o.z = pk2(s[4 * 33], s[5 * 33]); o.w = pk2(s[6 * 33], s[7 * 33]);
        int nr = n0 + n; if (GPERM && nr >= 4352) { const int z = (nr - 4352) >> 10, cc = (nr - 4352) & 1023, ch = cc & 63; nr = 4352 + 256 * (cc >> 6) + 64 * (ch >> 4) + 32 * (z >> 1) + 8 * ((ch >> 2) & 3) + 4 * (z & 1) + (ch & 3); }
        *(GAS v4u*)(WT + (size_t)nr * K + k0 + 8 * c) = o; }
    LDS_WAIT(); asm volatile("" ::: "memory");
}

__device__ __forceinline__ void norm_mod_row(int lane, const float* xrow, const float* g, const float* scale, const float* shift, bf16* orow) {
    const f32x4* xr = (const f32x4*)xrow + lane;
    f32x4 v[4]; float s = 0.f;
#pragma unroll
    for (int j = 0; j < 4; ++j) { v[j] = xr[64 * j]; s += (v[j].x * v[j].x + v[j].y * v[j].y) + (v[j].z * v[j].z + v[j].w * v[j].w); }
    const float r = 1.0f / sqrtf(wave_sum(s) * (1.0f / D) + EPS);
    unsigned long long* o8 = (unsigned long long*)orow + lane;
#pragma unroll
    for (int j = 0; j < 4; ++j) {
        const f32x4 gg = ((const f32x4*)g)[lane + 64 * j], sc = ((const f32x4*)scale)[lane + 64 * j], sh = ((const f32x4*)shift)[lane + 64 * j];
        const f32x4 y = (v[j] * r) * gg * (sc + 1.0f) + sh;
        o8[64 * j] = (unsigned long long)pk2(y.x, y.y) | ((unsigned long long)pk2(y.z, y.w) << 32);
    }
}

__device__ __forceinline__ void phase_pre(const Ctx& F, KArgs A) {
    float* mod = (float*)(A.ws + WS_MOD);
    for (int it = F.gw; it < DEPTH * 768; it += F.NGW) {
        const int l = it / 768, j0 = (it % 768) * 8;
        float acc[8][8];
#pragma unroll
        for (int b = 0; b < 8; ++b)
#pragma unroll
            for (int j = 0; j < 8; ++j) acc[b][j] = 0.f;
        for (int i = 0; i < 16; ++i) {
            const int k = F.lane + 64 * i;
            const float* wp = A.in[I_WADA] + ((size_t)l * D + k) * 6144 + j0;
            const f32x4 w0 = *(const f32x4*)wp, w1 = *(const f32x4*)(wp + 4);
#pragma unroll
            for (int b = 0; b < 8; ++b) { const float cv = A.in[I_C][b * D + k]; const float s = cv / (1.0f + __expf(-cv));
                acc[b][0] += s * w0.x; acc[b][1] += s * w0.y; acc[b][2] += s * w0.z; acc[b][3] += s * w0.w;
                acc[b][4] += s * w1.x; acc[b][5] += s * w1.y; acc[b][6] += s * w1.z; acc[b][7] += s * w1.w; }
        }
#pragma unroll
        for (int b = 0; b < 8; ++b) {
            float r[8];
#pragma unroll
            for (int j = 0; j < 8; ++j) r[j] = wave_sum(acc[b][j]);
            if (F.lane == 0) { const float* bp = A.in[I_BADA] + (size_t)l * 6144 + j0; float* mp = mod + ((size_t)l * 8 + b) * 6144 + j0;
                *(f32x4*)mp = (f32x4){r[0] + bp[0], r[1] + bp[1], r[2] + bp[2], r[3] + bp[3]}; *(f32x4*)(mp + 4) = (f32x4){r[4] + bp[4], r[5] + bp[5], r[6] + bp[6], r[7] + bp[7]}; }
        }
    }
    LAS float* scr = (LAS float*)(F.lds + RING_OFF + F.wave * 16384);
    constexpr int I_IN = 16 * 264, I_BR = 8 * 32, I_O = 16 * 32, I_Q = 16 * 64, I_P = 2 * 4;
    constexpr int PER_LAYER = I_IN + 4 * I_BR + I_O + I_Q + 4 * I_P;
    for (int it = F.gw; it < DEPTH * PER_LAYER; it += F.NGW) {
        const int l = it / PER_LAYER; int r = it % PER_LAYER;
        unsigned char* wl = A.ws + WS_W + (size_t)l * W_LAYER;
        if (r < I_IN) { const int n0 = 32 * (r % 264); const float sc = (n0 < 512 || (n0 >= C_DQ && n0 < C_DK)) ? C2 : 1.0f;
            p0_transpose_item<true>(A.in[I_WIN] + (size_t)l * D * NIN, D, NIN, (bf16*)(wl + W_WIN), scr, r, F.lane, sc); continue; }
        r -= I_IN;
        if (r < 4 * I_BR) { const int g = r / I_BR; p0_transpose_item(A.in[I_WBR] + ((size_t)l * 4 + g) * 512 * D, 512, D, (bf16*)(wl + W_WBR) + (size_t)g * D * 512, scr, r % I_BR, F.lane, 1.0f); continue; }
        r -= 4 * I_BR;
        if (r < I_O) { p0_transpose_item(A.in[I_WO] + (size_t)l * D * D, D, D, (bf16*)(wl + W_WO), scr, r, F.lane, 1.0f); continue; }
        r -= I_O;
        if (r < I_Q) { p0_transpose_item(A.in[I_WQ] + (size_t)l * D * 2048, D, 2048, (bf16*)(wl + W_WQ), scr, r, F.lane, 1.0f); continue; }
        r -= I_Q;
        { const int g = r / I_P; p0_transpose_item(A.in[I_WPOOL] + ((size_t)l * 4 + g) * 128 * 128, 128, 128, (bf16*)(wl + W_WP) + (size_t)g * 128 * 128, scr, r % I_P, F.lane, 1.0f); }
    }
#if SK_FRAG
    for (int i = F.gw * 64 + F.lane; i < DEPTH * 4096; i += F.NGW * 64) {
        const int l = i / 4096, c = i % 4096, ln = c & 63, s_ = (c >> 6) & 7, mt = (c >> 9) & 3, p = c >> 11;
        const float* src = A.in[I_SK] + (size_t)l * 32768 + (size_t)p * 16384 + (size_t)(32 * mt + (ln & 31)) * 128 + 16 * s_ + 8 * (ln >> 5);
        const f32x4 v0 = *(const f32x4*)src, v1 = *(const f32x4*)(src + 4);
        v4u o; o.x = pk2(v0.x, v0.y); o.y = pk2(v0.z, v0.w); o.z = pk2(v1.x, v1.y); o.w = pk2(v1.z, v1.w);
        *(v4u*)((bf16*)(A.ws + WS_W + (size_t)l * W_LAYER + W_SK) + (size_t)c * 8) = o;
    }
    for (int i = F.gw * 64 + F.lane; i < DEPTH * 8192; i += F.NGW * 64) {
        const int l = i / 8192, c = i % 8192, ln = c & 63, s_ = (c >> 6) & 7, mt = (c >> 9) & 3, g = c >> 11;
        const float* src = A.in[I_WPOOL] + ((size_t)l * 4 + g) * 128 * 128 + (size_t)(16 * s_ + 8 * (ln >> 5)) * 128 + 32 * mt + (ln & 31);
        v4u o; o.x = pk2(src[0], src[128]); o.y = pk2(src[256], src[384]); o.z = pk2(src[512], src[640]); o.w = pk2(src[768], src[896]);
        *(v4u*)((bf16*)(A.ws + WS_W + (size_t)l * W_LAYER + W_WPF) + (size_t)c * 8) = o;
    }
#else
    for (int i = F.gw * 64 + F.lane; i < DEPTH * 32768 / 4; i += F.NGW * 64) {
        const int l = i / 8192, e = (i % 8192) * 4;
        const f32x4 v = *(const f32x4*)(A.in[I_SK] + (size_t)l * 32768 + e);
        v2u o; o.x = pk2(v.x, v.y); o.y = pk2(v.z, v.w);
        *(v2u*)((bf16*)(A.ws + WS_W + (size_t)l * W_LAYER + W_SK) + e) = o;
    }
#endif
}
__device__ __forceinline__ void phase_h0(const Ctx& F, KArgs A) {
    const float* mod = (const float*)(A.ws + WS_MOD);
#if NORM_FOLD
    {
        float* cq = (float*)(A.ws + WS_CQ);
        for (int it = F.gw; it < DEPTH * 256; it += F.NGW) {
            const int l = it / 256, j0 = (it % 256) * 8;
            float acc[8][8];
#pragma unroll
            for (int b = 0; b < 8; ++b)
#pragma unroll
                for (int j = 0; j < 8; ++j) acc[b][j] = 0.f;
            for (int i = 0; i < 16; ++i) {
                const int k = F.lane + 64 * i;
                const float* wp = A.in[I_WQ] + ((size_t)l * D + k) * 2048 + j0;
                const f32x4 w0 = *(const f32x4*)wp, w1 = *(const f32x4*)(wp + 4);
#pragma unroll
                for (int b = 0; b < 8; ++b) { const float s = mod[((size_t)l * 8 + b) * 6144 + 3072 + k];
                    acc[b][0] += s * w0.x; acc[b][1] += s * w0.y; acc[b][2] += s * w0.z; acc[b][3] += s * w0.w;
                    acc[b][4] += s * w1.x; acc[b][5] += s * w1.y; acc[b][6] += s * w1.z; acc[b][7] += s * w1.w; }
            }
#pragma unroll
            for (int b = 0; b < 8; ++b) {
                float r[8];
#pragma unroll
                for (int j = 0; j < 8; ++j) r[j] = wave_sum(acc[b][j]);
                if (F.lane == 0) { float* cp = cq + ((size_t)l * 8 + b) * 2048 + j0; *(f32x4*)cp = (f32x4){r[0], r[1], r[2], r[3]}; *(f32x4*)(cp + 4) = (f32x4){r[4], r[5], r[6], r[7]}; }
            }
        }
    }
#endif
    bf16* H = (bf16*)(A.ws + WS_H);
    for (int m = F.gw; m < T; m += F.NGW) { const float* mb = mod + (size_t)(m >> 11) * 6144;
        norm_mod_row(F.lane, A.in[I_X] + (size_t)m * D, A.in[I_GN1], mb + 1024, mb, H + (size_t)m * D); }
}
__device__ __forceinline__ void phase_swa_naive(const Ctx& F, KArgs A, int l) {
    const bf16* P = (const bf16*)(A.ws + WS_PROJ); bf16* Y = (bf16*)(A.ws + WS_Y);
    const float* sinks = A.in[I_SINKS] + l * 8;
    for (int it = F.gw; it < T * 8; it += F.NGW) {
        const int t = it >> 3, hq = it & 7, g = hq >> 2, pos = t & (SEQ - 1);
        float q[64];
        { const v4u* qp = (const v4u*)(P + (size_t)t * NPROJ + C_DQ + hq * 64);
#pragma unroll
          for (int i = 0; i < 8; ++i) { const v4u w = qp[i]; q[8 * i] = bflo(w.x); q[8 * i + 1] = bfhi(w.x); q[8 * i + 2] = bflo(w.y); q[8 * i + 3] = bfhi(w.y); q[8 * i + 4] = bflo(w.z); q[8 * i + 5] = bfhi(w.z); q[8 * i + 6] = bflo(w.w); q[8 * i + 7] = bfhi(w.w); } }
        float s[2];
#pragma unroll
        for (int j = 0; j < 2; ++j) { const int kk = F.lane + 64 * j; float a = -1e30f;
            if (pos - kk >= 0) { const v4u* kp = (const v4u*)(P + (size_t)(t - kk) * NPROJ + C_DK + g * 64); a = 0.f;
#pragma unroll
                for (int i = 0; i < 8; ++i) { const v4u w = kp[i]; a += q[8 * i] * bflo(w.x) + q[8 * i + 1] * bfhi(w.x) + q[8 * i + 2] * bflo(w.y) + q[8 * i + 3] * bfhi(w.y) + q[8 * i + 4] * bflo(w.z) + q[8 * i + 5] * bfhi(w.z) + q[8 * i + 6] * bflo(w.w) + q[8 * i + 7] * bfhi(w.w); } }
            s[j] = a; }
        const float sk2 = sinks[hq] * LOG2E;
        const float mx = fmaxf(wave_max(fmaxf(s[0], s[1])), sk2);
        const float p0 = (pos - F.lane >= 0) ? exp2f(s[0] - mx) : 0.f, p1 = (pos - F.lane - 64 >= 0) ? exp2f(s[1] - mx) : 0.f;
        const float den = wave_sum(p0 + p1) + exp2f(sk2 - mx);
        float acc = 0.f;
        const int nk = (pos + 1 < 128) ? pos + 1 : 128;
        const bf16* vp = P + (size_t)t * NPROJ + C_DV + g * 64 + F.lane;
        for (int kk = 0; kk < nk; ++kk) { const float pk = (kk < 64) ? rdlane(p0, kk) : rdlane(p1, kk - 64); acc += pk * bf1(vp[-(long)kk * NPROJ]); }
        Y[(size_t)t * 2048 + 1536 + hq * 64 + F.lane] = (bf16)f2bf(acc / den);
    }
}
__device__ __forceinline__ void phase_conv_naive(const Ctx& F, KArgs A, int l) {
    const bf16* P = (const bf16*)(A.ws + WS_PROJ); bf16* Y = (bf16*)(A.ws + WS_Y);
    const float* cw = A.in[I_CONVW] + (size_t)l * 3 * 512;
    for (int it = F.gw * 64 + F.lane; it < (T / 4) * 64; it += F.NGW * 64) {
        const int t0 = (it >> 6) * 4, c0 = (it & 63) * 8; const bool first = (t0 & (SEQ - 1)) == 0;
        v4u za[6], zb[6], gb[4];
#pragma unroll
        for (int r = 0; r < 6; ++r) { const int row = (first && r < 2) ? t0 : t0 - 2 + r; za[r] = *(const v4u*)(P + (size_t)row * NPROJ + C_BC + c0); zb[r] = *(const v4u*)(P + (size_t)row * NPROJ + C_BX + c0); }
#pragma unroll
        for (int k = 0; k < 4; ++k) gb[k] = *(const v4u*)(P + (size_t)(t0 + k) * NPROJ + C_BB + c0);
        const f32x4 w00 = *(const f32x4*)(cw + c0), w01 = *(const f32x4*)(cw + c0 + 4), w10 = *(const f32x4*)(cw + 512 + c0), w11 = *(const f32x4*)(cw + 512 + c0 + 4), w20 = *(const f32x4*)(cw + 1024 + c0), w21 = *(const f32x4*)(cw + 1024 + c0 + 4);
        float z[6][8];
#pragma unroll
        for (int r = 0; r < 6; ++r) { const float m = (first && r < 2) ? 0.f : 1.f; const v4u a = za[r], b = zb[r];
            z[r][0] = m * bflo(a.x) * bflo(b.x); z[r][1] = m * bfhi(a.x) * bfhi(b.x); z[r][2] = m * bflo(a.y) * bflo(b.y); z[r][3] = m * bfhi(a.y) * bfhi(b.y);
            z[r][4] = m * bflo(a.z) * bflo(b.z); z[r][5] = m * bfhi(a.z) * bfhi(b.z); z[r][6] = m * bflo(a.w) * bflo(b.w); z[r][7] = m * bfhi(a.w) * bfhi(b.w); }
#pragma unroll
        for (int k = 0; k < 4; ++k) { const v4u g = gb[k];
            const float bb[8] = {bflo(g.x), bfhi(g.x), bflo(g.y), bfhi(g.y), bflo(g.z), bfhi(g.z), bflo(g.w), bfhi(g.w)};
            float y[8];
#pragma unroll
            for (int e = 0; e < 4; ++e) { y[e] = bb[e] * (w00[e] * z[k][e] + w10[e] * z[k + 1][e] + w20[e] * z[k + 2][e]); y[4 + e] = bb[4 + e] * (w01[e] * z[k][4 + e] + w11[e] * z[k + 1][4 + e] + w21[e] * z[k + 2][4 + e]); }
            v4u o; o.x = pk2(y[0], y[1]); o.y = pk2(y[2], y[3]); o.z = pk2(y[4], y[5]); o.w = pk2(y[6], y[7]);
            *(v4u*)(Y + (size_t)(t0 + k) * 2048 + 512 + c0) = o; }
    }
}
__device__ __forceinline__ void phase_pool_naive(const Ctx& F, KArgs A, int l) {
    const bf16* P = (const bf16*)(A.ws + WS_PROJ); bf16* Y = (bf16*)(A.ws + WS_Y);
    for (int it = F.gw; it < T * 4; it += F.NGW) {
        const int t = it >> 2, g = it & 3, w = 2 << g, pos = t & (SEQ - 1), cnt = (pos + 1 < w) ? pos + 1 : w;
        float d[2];
#pragma unroll
        for (int j = 0; j < 2; ++j) { const bf16* zp = P + (size_t)t * NPROJ + C_CZ + g * 128 + F.lane + 64 * j; float s = 0.f;
            for (int i = 0; i < cnt; ++i) s += bf1(zp[-(long)i * NPROJ]);
            d[j] = s / (float)cnt - bf1(zp[0]); }
        const float* wp = A.in[I_WPOOL] + ((size_t)l * 4 + g) * 128 * 128;
        float y0 = 0.f, y1 = 0.f;
        for (int c = 0; c < 64; ++c) { const float dc = rdlane(d[0], c); y0 += dc * wp[c * 128 + F.lane]; y1 += dc * wp[c * 128 + 64 + F.lane]; }
        for (int c = 0; c < 64; ++c) { const float dc = rdlane(d[1], c); y0 += dc * wp[(64 + c) * 128 + F.lane]; y1 += dc * wp[(64 + c) * 128 + 64 + F.lane]; }
        const float* ps = A.in[I_PSCALE] + (size_t)l * 512 + g * 128;
        Y[(size_t)t * 2048 + 1024 + g * 128 + F.lane] = (bf16)f2bf(y0 * ps[F.lane]);
        Y[(size_t)t * 2048 + 1024 + g * 128 + 64 + F.lane] = (bf16)f2bf(y1 * ps[64 + F.lane]);
    }
}
typedef float f32x16s __attribute__((ext_vector_type(16)));
typedef short bf16x8s __attribute__((ext_vector_type(8)));
__device__ __forceinline__ void phase_swa(const Ctx& F, KArgs A, int l) {
    const bf16* P = (const bf16*)(A.ws + WS_PROJ); bf16* Y = (bf16*)(A.ws + WS_Y);
    const float* sinks = A.in[I_SINKS] + l * 8;
    const int qi = F.lane & 31, kh = F.lane >> 5;
    for (int u = F.gw; u < (T / 32) * 8; u += F.NGW) {
        const int tq = u >> 3, hq = u & 7, g = hq >> 2, t0 = tq * 32, p0 = t0 & (SEQ - 1);
        bf16x8s qf[4];
        { const bf16* qp = P + (size_t)(t0 + qi) * NPROJ + C_DQ + hq * 64 + 8 * kh;
#pragma unroll
          for (int s = 0; s < 4; ++s) qf[s] = *(const bf16x8s*)(qp + 16 * s); }
        f32x16s acc[5];
#pragma unroll
        for (int kt = 0; kt < 5; ++kt) {
            int kr = t0 - 128 + 32 * kt + qi; if (p0 - 128 + 32 * kt + qi < 0) kr = t0;
            const bf16* kp = P + (size_t)kr * NPROJ + C_DK + g * 64 + 8 * kh;
            f32x16s c = (f32x16s){0.f, 0.f, 0.f, 0.f, 0.f, 0.f, 0.f, 0.f, 0.f, 0.f, 0.f, 0.f, 0.f, 0.f, 0.f, 0.f};
#pragma unroll
            for (int s = 0; s < 4; ++s) c = __builtin_amdgcn_mfma_f32_32x32x16_bf16(*(const bf16x8s*)(kp + 16 * s), qf[s], c, 0, 0, 0);
            acc[kt] = c;
        }
        const float sk2 = sinks[hq] * LOG2E;
        float m = sk2;
#pragma unroll
        for (int kt = 0; kt < 5; ++kt)
#pragma unroll
            for (int r = 0; r < 16; ++r) { const int koff = (r & 3) + 8 * (r >> 2) + 4 * kh, rel = qi + 128 - 32 * kt - koff;
                const bool valid = (rel >= 0) && (rel < 128) && (p0 - 128 + 32 * kt + koff >= 0);
                acc[kt][r] = valid ? acc[kt][r] : -1e30f; m = fmaxf(m, acc[kt][r]); }
        m = fmaxf(m, __shfl_xor(m, 32));
        float ls = 0.f;
#pragma unroll
        for (int kt = 0; kt < 5; ++kt)
#pragma unroll
            for (int r = 0; r < 16; ++r) { const float pv = exp2f(acc[kt][r] - m); acc[kt][r] = pv; ls += pv; }
        ls += __shfl_xor(ls, 32); ls += exp2f(sk2 - m);
        f32x16s o[2];
        o[0] = (f32x16s){0.f, 0.f, 0.f, 0.f, 0.f, 0.f, 0.f, 0.f, 0.f, 0.f, 0.f, 0.f, 0.f, 0.f, 0.f, 0.f}; o[1] = o[0];
#pragma unroll
        for (int kt = 0; kt < 5; ++kt)
#pragma unroll
            for (int s2 = 0; s2 < 2; ++s2) {
                v4u bw; bw.x = pk2(acc[kt][8 * s2 + 0], acc[kt][8 * s2 + 1]); bw.y = pk2(acc[kt][8 * s2 + 2], acc[kt][8 * s2 + 3]); bw.z = pk2(acc[kt][8 * s2 + 4], acc[kt][8 * s2 + 5]); bw.w = pk2(acc[kt][8 * s2 + 6], acc[kt][8 * s2 + 7]);
                const bf16x8s bfr = __builtin_bit_cast(bf16x8s, bw);
                int vr0 = t0 - 128 + 32 * kt + 16 * s2 + 4 * kh; const bool pre = (p0 - 128 + 32 * kt + 16 * s2 + 4 * kh < 0);
                int vr1 = vr0 + 8; const bool pre1 = (p0 - 128 + 32 * kt + 16 * s2 + 4 * kh + 8 < 0);
                if (pre) vr0 = t0; if (pre1) vr1 = t0;
#pragma unroll
                for (int mt = 0; mt < 2; ++mt) {
                    const bf16* v0 = P + (size_t)vr0 * NPROJ + C_DV + g * 64 + 32 * mt + qi; const bf16* v1 = P + (size_t)vr1 * NPROJ + C_DV + g * 64 + 32 * mt + qi;
                    v4u aw; aw.x = (unsigned)v0[0] | ((unsigned)v0[NPROJ] << 16); aw.y = (unsigned)v0[2 * NPROJ] | ((unsigned)v0[3 * NPROJ] << 16);
                    aw.z = (unsigned)v1[0] | ((unsigned)v1[NPROJ] << 16); aw.w = (unsigned)v1[2 * NPROJ] | ((unsigned)v1[3 * NPROJ] << 16);
                    o[mt] = __builtin_amdgcn_mfma_f32_32x32x16_bf16(__builtin_bit_cast(bf16x8s, aw), bfr, o[mt], 0, 0, 0);
                }
            }
        const float rl = 1.0f / ls;
        bf16* yp = Y + (size_t)(t0 + qi) * 2048 + 1536 + hq * 64 + 4 * kh;
#pragma unroll
        for (int mt = 0; mt < 2; ++mt)
#pragma unroll
            for (int q = 0; q < 4; ++q) { v2u w; w.x = pk2(o[mt][4 * q] * rl, o[mt][4 * q + 1] * rl); w.y = pk2(o[mt][4 * q + 2] * rl, o[mt][4 * q + 3] * rl);
                *(v2u*)(yp + 32 * mt + 8 * q) = w; }
    }
}
typedef short s16x4s __attribute__((ext_vector_type(4)));
__device__ __forceinline__ void phase_swa2(const Ctx& F, KArgs A, int l) {
    const bf16* P = (const bf16*)(A.ws + WS_PROJ); bf16* Y = (bf16*)(A.ws + WS_Y);
    const float* sinks = A.in[I_SINKS] + l * 8;
    constexpr int RS = 272, VOFF = 160 * RS;
    LAS unsigned char* kb = F.lds + RING_OFF; LAS unsigned char* vb = kb + VOFF;
    const int qi = F.lane & 31, kh = F.lane >> 5, hq = F.wave, g = hq >> 2;
    for (int tq = F.vcu; tq < T / 32; tq += F.G) {
        const int t0 = tq * 32, p0 = t0 & (SEQ - 1);
        __syncthreads();
#pragma unroll
        for (int c = 0; c < 5; ++c) { const int chunk = F.tid + 512 * c, row = chunk >> 4, ch = chunk & 15;
            const int gr = (p0 - 128 + row < 0) ? t0 : t0 - 128 + row;
            const v4u kv = *(const v4u*)(P + (size_t)gr * NPROJ + C_DK + ch * 8), vv = *(const v4u*)(P + (size_t)gr * NPROJ + C_DV + ch * 8);
            *(LAS v4u*)(kb + row * RS + ch * 16) = kv; *(LAS v4u*)(vb + row * RS + ch * 16) = vv; }
        bf16x8s qf[4];
#if SWA_STAGE
        LAS unsigned char* wst = kb + 2 * VOFF + __builtin_amdgcn_readfirstlane(F.wave) * (32 * 144);
        { v4u qv[4];
#pragma unroll
          for (int i = 0; i < 4; ++i) qv[i] = *(const v4u*)(P + (size_t)(t0 + (F.lane >> 3) + 8 * i) * NPROJ + C_DQ + hq * 64 + (F.lane & 7) * 8);
#pragma unroll
          for (int i = 0; i < 4; ++i) *(LAS v4u*)(wst + ((F.lane >> 3) + 8 * i) * 144 + (F.lane & 7) * 16) = qv[i];
          LDS_WAIT();
#pragma unroll
          for (int s = 0; s < 4; ++s) qf[s] = *(const LAS bf16x8s*)(wst + qi * 144 + (8 * kh + 16 * s) * 2);
          LDS_WAIT(); }
#else
        { const bf16* qp = P + (size_t)(t0 + qi) * NPROJ + C_DQ + hq * 64 + 8 * kh;
#pragma unroll
          for (int s = 0; s < 4; ++s) qf[s] = *(const bf16x8s*)(qp + 16 * s); }
#endif
        __syncthreads();
        f32x16s acc[5];
#pragma unroll
        for (int kt = 0; kt < 5; ++kt) {
            const LAS unsigned char* kp = kb + (32 * kt + qi) * RS + g * 128 + 16 * kh;
            f32x16s c = (f32x16s){0.f, 0.f, 0.f, 0.f, 0.f, 0.f, 0.f, 0.f, 0.f, 0.f, 0.f, 0.f, 0.f, 0.f, 0.f, 0.f};
#pragma unroll
            for (int s = 0; s < 4; ++s) c = __builtin_amdgcn_mfma_f32_32x32x16_bf16(*(const LAS bf16x8s*)(kp + 32 * s), qf[s], c, 0, 0, 0);
            acc[kt] = c;
        }
        const float sk2 = sinks[hq] * LOG2E;
        float m = sk2;
#pragma unroll
        for (int kt = 0; kt < 5; ++kt)
#pragma unroll
            for (int r = 0; r < 16; ++r) { const int koff = (r & 3) + 8 * (r >> 2) + 4 * kh, rel = qi + 128 - 32 * kt - koff;
                const bool valid = (rel >= 0) && (rel < 128) && (p0 - 128 + 32 * kt + koff >= 0);
                acc[kt][r] = valid ? acc[kt][r] : -1e30f; m = fmaxf(m, acc[kt][r]); }
        m = fmaxf(m, __shfl_xor(m, 32));
        float ls = 0.f;
#pragma unroll
        for (int kt = 0; kt < 5; ++kt)
#pragma unroll
            for (int r = 0; r < 16; ++r) { const float pv = exp2f(acc[kt][r] - m); acc[kt][r] = pv; ls += pv; }
        ls += __shfl_xor(ls, 32); ls += exp2f(sk2 - m);
        f32x16s o[2];
        o[0] = (f32x16s){0.f, 0.f, 0.f, 0.f, 0.f, 0.f, 0.f, 0.f, 0.f, 0.f, 0.f, 0.f, 0.f, 0.f, 0.f, 0.f}; o[1] = o[0];
        const LAS unsigned char* vl = vb + (4 * kh + ((F.lane & 15) >> 2)) * RS + (g * 64 + 16 * ((F.lane >> 4) & 1) + 4 * (F.lane & 3)) * 2;
#pragma unroll
        for (int kt = 0; kt < 5; ++kt)
#pragma unroll
            for (int s2 = 0; s2 < 2; ++s2) {
                v4u bw; bw.x = pk2(acc[kt][8 * s2 + 0], acc[kt][8 * s2 + 1]); bw.y = pk2(acc[kt][8 * s2 + 2], acc[kt][8 * s2 + 3]); bw.z = pk2(acc[kt][8 * s2 + 4], acc[kt][8 * s2 + 5]); bw.w = pk2(acc[kt][8 * s2 + 6], acc[kt][8 * s2 + 7]);
                const bf16x8s bfr = __builtin_bit_cast(bf16x8s, bw);
#pragma unroll
                for (int mt = 0; mt < 2; ++mt) {
                    const LAS unsigned char* va = vl + (32 * kt + 16 * s2) * RS + 64 * mt;
                    const s16x4s lo = __builtin_bit_cast(s16x4s, __builtin_amdgcn_ds_read_tr16_b64_v4i16((LAS s16x4s*)va));
                    const s16x4s hi = __builtin_bit_cast(s16x4s, __builtin_amdgcn_ds_read_tr16_b64_v4i16((LAS s16x4s*)(va + 8 * RS)));
                    const bf16x8s afr = (bf16x8s){lo[0], lo[1], lo[2], lo[3], hi[0], hi[1], hi[2], hi[3]};
                    o[mt] = __builtin_amdgcn_mfma_f32_32x32x16_bf16(afr, bfr, o[mt], 0, 0, 0);
                }
            }
        const float rl = 1.0f / ls;
#if SWA_STAGE
#pragma unroll
        for (int mt = 0; mt < 2; ++mt)
#pragma unroll
            for (int q = 0; q < 4; ++q) { v2u w; w.x = pk2(o[mt][4 * q] * rl, o[mt][4 * q + 1] * rl); w.y = pk2(o[mt][4 * q + 2] * rl, o[mt][4 * q + 3] * rl);
                *(LAS v2u*)(wst + qi * 144 + (32 * mt + 8 * q + 4 * kh) * 2) = w; }
        LDS_WAIT();
#pragma unroll
        for (int i = 0; i < 4; ++i) { const int row = (F.lane >> 3) + 8 * i; const v4u v = *(const LAS v4u*)(wst + row * 144 + (F.lane & 7) * 16);
            *(v4u*)(Y + (size_t)(t0 + row) * 2048 + 1536 + hq * 64 + (F.lane & 7) * 8) = v; }
        LDS_WAIT();
#else
        bf16* yp = Y + (size_t)(t0 + qi) * 2048 + 1536 + hq * 64 + 4 * kh;
#pragma unroll
        for (int mt = 0; mt < 2; ++mt)
#pragma unroll
            for (int q = 0; q < 4; ++q) { v2u w; w.x = pk2(o[mt][4 * q] * rl, o[mt][4 * q + 1] * rl); w.y = pk2(o[mt][4 * q + 2] * rl, o[mt][4 * q + 3] * rl);
                *(v2u*)(yp + 32 * mt + 8 * q) = w; }
#endif
    }
    __syncthreads();
}
__device__ __forceinline__ void phase_pool(const Ctx& F, KArgs A, int l) {
    const bf16* P = (const bf16*)(A.ws + WS_PROJ); bf16* Y = (bf16*)(A.ws + WS_Y);
    const bf16* WP = (const bf16*)(A.ws + WS_W + (size_t)l * W_LAYER + W_WP);
    const int ti = F.lane & 31, kh = F.lane >> 5;
    for (int u = F.gw; u < (T / 32) * 4; u += F.NGW) {
        const int tq = u >> 2, g = u & 3, w = 2 << g, t = tq * 32 + ti, pos = t & (SEQ - 1), cnt = (pos + 1 < w) ? pos + 1 : w;
        const float rc = 1.0f / (float)cnt;
        f32x16s acc[4];
#pragma unroll
        for (int mt = 0; mt < 4; ++mt) acc[mt] = (f32x16s){0.f, 0.f, 0.f, 0.f, 0.f, 0.f, 0.f, 0.f, 0.f, 0.f, 0.f, 0.f, 0.f, 0.f, 0.f, 0.f};
#if POOL_LDS
        { LAS unsigned char* zt = F.lds + RING_OFF + __builtin_amdgcn_readfirstlane(F.wave) * 16384;
          v4u zr[12];
#pragma unroll
          for (int i = 0; i < 12; ++i) { const int row = (F.lane >> 4) + 4 * i; int gr = tq * 32 - (w - 1) + row; gr = gr < 0 ? 0 : gr; gr = gr > tq * 32 + 31 ? tq * 32 + 31 : gr;
              zr[i] = *(const v4u*)(P + (size_t)gr * NPROJ + C_CZ + g * 128 + (F.lane & 15) * 8); }
#pragma unroll
          for (int i = 0; i < 12; ++i) *(LAS v4u*)(zt + ((F.lane >> 4) + 4 * i) * 272 + (F.lane & 15) * 16) = zr[i];
          LDS_WAIT();
          const bf16* WPF = (const bf16*)(A.ws + WS_W + (size_t)l * W_LAYER + W_WPF) + (size_t)g * 4 * 8 * 512 + F.lane * 8;
          for (int s = 0; s < 8; ++s) {
            bf16x8s afr[4];
#pragma unroll
            for (int mt = 0; mt < 4; ++mt) afr[mt] = *(const bf16x8s*)(WPF + (size_t)(mt * 8 + s) * 512);
            const LAS unsigned char* zp = zt + (w - 1 + ti) * 272 + (16 * s + 8 * kh) * 2;
            float sum[8];
#pragma unroll
            for (int e = 0; e < 8; ++e) sum[e] = 0.f;
            auto win = [&](auto WC) { constexpr int W = decltype(WC)::value;
#pragma unroll
                for (int i = 0; i < W; ++i) { const v4u zw = *(const LAS v4u*)(zp - i * 272); const float m = (i < cnt) ? 1.0f : 0.0f;
                    sum[0] += m * bflo(zw.x); sum[1] += m * bfhi(zw.x); sum[2] += m * bflo(zw.y); sum[3] += m * bfhi(zw.y); sum[4] += m * bflo(zw.z); sum[5] += m * bfhi(zw.z); sum[6] += m * bflo(zw.w); sum[7] += m * bfhi(zw.w); } };
            if (g == 0) win(std::integral_constant<int, 2>{}); else if (g == 1) win(std::integral_constant<int, 4>{}); else if (g == 2) win(std::integral_constant<int, 8>{}); else win(std::integral_constant<int, 16>{});
            const v4u z0 = *(const LAS v4u*)zp;
            v4u dw; dw.x = pk2(sum[0] * rc - bflo(z0.x), sum[1] * rc - bfhi(z0.x)); dw.y = pk2(sum[2] * rc - bflo(z0.y), sum[3] * rc - bfhi(z0.y));
            dw.z = pk2(sum[4] * rc - bflo(z0.z), sum[5] * rc - bfhi(z0.z)); dw.w = pk2(sum[6] * rc - bflo(z0.w), sum[7] * rc - bfhi(z0.w));
            const bf16x8s bfr = __builtin_bit_cast(bf16x8s, dw);
            asm volatile("" : "+v"(afr[0]), "+v"(afr[1]), "+v"(afr[2]), "+v"(afr[3]));
#pragma unroll
            for (int mt = 0; mt < 4; ++mt) acc[mt] = __builtin_amdgcn_mfma_f32_32x32x16_bf16(afr[mt], bfr, acc[mt], 0, 0, 0);
          }
          LDS_WAIT(); }
#else
        for (int s = 0; s < 8; ++s) {
            const bf16* zp = P + (size_t)t * NPROJ + C_CZ + g * 128 + 16 * s + 8 * kh;
            float sum[8];
#pragma unroll
            for (int e = 0; e < 8; ++e) sum[e] = 0.f;
            auto win = [&](auto WC) { constexpr int W = decltype(WC)::value; v4u zw[W];
#pragma unroll
                for (int i = 0; i < W; ++i) zw[i] = *(const v4u*)(zp - (size_t)((i < cnt) ? i : 0) * NPROJ);
#pragma unroll
                for (int i = 0; i < W; ++i) { const float m = (i < cnt) ? 1.0f : 0.0f;
                    sum[0] += m * bflo(zw[i].x); sum[1] += m * bfhi(zw[i].x); sum[2] += m * bflo(zw[i].y); sum[3] += m * bfhi(zw[i].y); sum[4] += m * bflo(zw[i].z); sum[5] += m * bfhi(zw[i].z); sum[6] += m * bflo(zw[i].w); sum[7] += m * bfhi(zw[i].w); } };
            if (g == 0) win(std::integral_constant<int, 2>{}); else if (g == 1) win(std::integral_constant<int, 4>{}); else if (g == 2) win(std::integral_constant<int, 8>{}); else win(std::integral_constant<int, 16>{});
            bf16x8s afr[4];
#pragma unroll
            for (int mt = 0; mt < 4; ++mt) afr[mt] = *(const bf16x8s*)(WP + ((size_t)g * 128 + 32 * mt + ti) * 128 + 16 * s + 8 * kh);
            const v4u z0 = *(const v4u*)zp;
            v4u dw; dw.x = pk2(sum[0] * rc - bflo(z0.x), sum[1] * rc - bfhi(z0.x)); dw.y = pk2(sum[2] * rc - bflo(z0.y), sum[3] * rc - bfhi(z0.y));
            dw.z = pk2(sum[4] * rc - bflo(z0.z), sum[5] * rc - bfhi(z0.z)); dw.w = pk2(sum[6] * rc - bflo(z0.w), sum[7] * rc - bfhi(z0.w));
            const bf16x8s bfr = __builtin_bit_cast(bf16x8s, dw);
            asm volatile("" : "+v"(afr[0]), "+v"(afr[1]), "+v"(afr[2]), "+v"(afr[3]));
#pragma unroll
            for (int mt = 0; mt < 4; ++mt) acc[mt] = __builtin_amdgcn_mfma_f32_32x32x16_bf16(afr[mt], bfr, acc[mt], 0, 0, 0);
        }
#endif
        const float* ps = A.in[I_PSCALE] + (size_t)l * 512 + g * 128;
#if POOL_STAGE
        LAS unsigned char* stg = F.lds + RING_OFF + __builtin_amdgcn_readfirstlane(F.wave) * 16384;
#else
        bf16* yp = Y + (size_t)t * 2048 + 1024 + g * 128 + 4 * kh;
#endif
#pragma unroll
        for (int mt = 0; mt < 4; ++mt) {
            f32x4 scv[4];
#pragma unroll
            for (int i = 0; i < 4; ++i) scv[i] = *(const f32x4*)(ps + 32 * mt + 8 * i + 4 * kh);
#pragma unroll
                for (int q = 0; q < 4; ++q) { const f32x4 sc = scv[q];
                    v2u wv; wv.x = pk2(acc[mt][4 * q] * sc.x, acc[mt][4 * q + 1] * sc.y); wv.y = pk2(acc[mt][4 * q + 2] * sc.z, acc[mt][4 * q + 3] * sc.w);
#if POOL_STAGE
                    *(LAS v2u*)(stg + ti * 272 + (32 * mt + 8 * q + 4 * kh) * 2) = wv; } }
        LDS_WAIT();
#pragma unroll
        for (int i = 0; i < 8; ++i) { const int row = (F.lane >> 4) + 4 * i, ch = F.lane & 15; const v4u v = *(const LAS v4u*)(stg + row * 272 + ch * 16);
            *(v4u*)(Y + (size_t)(tq * 32 + row) * 2048 + 1024 + g * 128 + ch * 8) = v; }
        LDS_WAIT();
#else
                    *(v2u*)(yp + 32 * mt + 8 * q) = wv; } }
#endif
    }
}
__device__ __forceinline__ void phase_ya(const Ctx& F, KArgs A, int l) {
    const bf16* O = (const bf16*)(A.ws + WS_O); bf16* Y = (bf16*)(A.ws + WS_Y);
    const float lam_init = (l == 0) ? 0.2f : (0.8f - 0.6f * 0.7408182206817179f);
    const float d1 = wave_sum(A.in[I_LQ1][l * 64 + F.lane] * A.in[I_LK1][l * 64 + F.lane]);
    const float d2 = wave_sum(A.in[I_LQ2][l * 64 + F.lane] * A.in[I_LK2][l * 64 + F.lane]);
    const float lam = expf(d1) - expf(d2) + lam_init;
    const int sub = F.lane & 15, grp = F.lane >> 4;
    float gs[8];
#pragma unroll
    for (int e = 0; e < 8; ++e) gs[e] = A.in[I_GSUB][l * 128 + 8 * sub + e] * (1.0f - lam_init);
    static_assert(T % (4 * 256 * NWAVES) == 0, "phase_ya: 4 tokens per trip");
    for (int it0 = F.gw; it0 < T; it0 += 4 * F.NGW) {
        v4u av[4], bv[4];
#pragma unroll
        for (int j = 0; j < 4; ++j) { const int t = it0 + j * F.NGW; av[j] = *(const v4u*)(O + (size_t)t * 1024 + grp * 256 + 8 * sub); bv[j] = *(const v4u*)(O + (size_t)t * 1024 + grp * 256 + 128 + 8 * sub); }
#pragma unroll
      for (int j = 0; j < 4; ++j) {
        const int t = it0 + j * F.NGW, h = grp; const v4u a = av[j], b = bv[j];
        float y[8] = {bflo(a.x) - lam * bflo(b.x), bfhi(a.x) - lam * bfhi(b.x), bflo(a.y) - lam * bflo(b.y), bfhi(a.y) - lam * bfhi(b.y), bflo(a.z) - lam * bflo(b.z), bfhi(a.z) - lam * bfhi(b.z), bflo(a.w) - lam * bflo(b.w), bfhi(a.w) - lam * bfhi(b.w)};
        float ss = 0.f;
#pragma unroll
        for (int e = 0; e < 8; ++e) ss += y[e] * y[e];
        ss += __shfl_xor(ss, 1); ss += __shfl_xor(ss, 2); ss += __shfl_xor(ss, 4); ss += __shfl_xor(ss, 8);
        const float r = 1.0f / sqrtf(ss * (1.0f / 128.0f) + EPS);
        v4u o; o.x = pk2(y[0] * r * gs[0], y[1] * r * gs[1]); o.y = pk2(y[2] * r * gs[2], y[3] * r * gs[3]); o.z = pk2(y[4] * r * gs[4], y[5] * r * gs[5]); o.w = pk2(y[6] * r * gs[6], y[7] * r * gs[7]);
        *(v4u*)(Y + (size_t)t * 2048 + h * 128 + 8 * sub) = o;
      }
    }
}
__device__ __forceinline__ void expert_quant(KArgs A, int l, int lane, int w, int nw) {
    const float* ue = A.in[I_UE] + (size_t)l * 16384 * 1024; const float* ve = A.in[I_VE] + (size_t)l * 16384 * 1024;
    for (int r = w; r < 2 * 16384; r += nw) {
        const bool isv = r >= 16384; const int row = isv ? r - 16384 : r; const float* src = (isv ? ve : ue) + (size_t)row * 1024 + 8 * lane;
        const f32x4 a0 = *(const f32x4*)src, a1 = *(const f32x4*)(src + 4), b0 = *(const f32x4*)(src + 512), b1 = *(const f32x4*)(src + 516);
        float am = 0.f;
#pragma unroll
        for (int e = 0; e < 4; ++e) am = fmaxf(fmaxf(am, fmaxf(fabsf(a0[e]), fabsf(a1[e]))), fmaxf(fabsf(b0[e]), fabsf(b1[e])));
        am = wave_max(am);
#if EXP6B
#if EXP5B
        { const float inv5 = am > 0.f ? 15.0f / am : 0.f; unsigned X0 = 0, X1 = 0, P = 0;
#pragma unroll
          for (int i = 0; i < 4; ++i) {
              const unsigned u0 = (unsigned)((int)rintf(a0[i] * inv5) + 16), u2 = (unsigned)((int)rintf(b0[i] * inv5) + 16);
              const unsigned s1 = (unsigned)(int)rintf(a1[i] * inv5) & 31u, s3 = (unsigned)(int)rintf(b1[i] * inv5) & 31u;
              X0 |= ((u0 & 15u) | ((s1 >> 1) << 4)) << (8 * i); X1 |= ((u2 & 15u) | ((s3 >> 1) << 4)) << (8 * i);
              P |= (((u0 >> 4) << 4) | ((s1 & 1u) << 3) | ((u2 >> 4) << 5) | ((s3 & 1u) << 2)) << (8 * i); }
          const unsigned Pp = (unsigned)__shfl_xor((int)P, 32);
          unsigned char* dst = A.ws + (isv ? WS_VE : WS_UE) + (size_t)row * EROW;
          *(unsigned long long*)(dst + 8 * lane) = (unsigned long long)X0 | ((unsigned long long)X1 << 32);
          if (lane < 32) *(unsigned*)(dst + 512 + 4 * lane) = P | ((Pp << 4) | (Pp >> 28));
          if (lane == 0) ((float*)(A.ws + (isv ? WS_VS : WS_US)))[row] = am * (1.0f / 15.0f);
          continue; }
#else
        { const float inv6 = am > 0.f ? 31.0f / am : 0.f; unsigned X0 = 0, X1 = 0, Y = 0;
#pragma unroll
          for (int i = 0; i < 4; ++i) {
              const unsigned u0 = (unsigned)((int)rintf(a0[i] * inv6) + 32), u2 = (unsigned)((int)rintf(b0[i] * inv6) + 32);
              const unsigned s1 = (unsigned)(int)rintf(a1[i] * inv6) & 63u, s3 = (unsigned)(int)rintf(b1[i] * inv6) & 63u;
              X0 |= ((u0 & 15u) | ((s1 >> 2) << 4)) << (8 * i); X1 |= ((u2 & 15u) | ((s3 >> 2) << 4)) << (8 * i);
              Y |= (((u0 >> 4) << 4) | ((s1 & 3u) << 2) | ((u2 >> 4) << 6) | (s3 & 3u)) << (8 * i); }
          unsigned char* dst = A.ws + (isv ? WS_VE : WS_UE) + (size_t)row * 768;
          *(unsigned long long*)(dst + 8 * lane) = (unsigned long long)X0 | ((unsigned long long)X1 << 32); *(unsigned*)(dst + 512 + 4 * lane) = Y;
          if (lane == 0) ((float*)(A.ws + (isv ? WS_VS : WS_US)))[row] = am * (1.0f / 31.0f);
          continue; }
#endif
#endif
        const float inv = am > 0.f ? 127.0f / am : 0.f; const int bias = (isv && !V_MFMA) ? 128 : 0;
        unsigned o[4];
#pragma unroll
        for (int wd = 0; wd < 4; ++wd) { const f32x4 v = wd == 0 ? a0 : wd == 1 ? a1 : wd == 2 ? b0 : b1; unsigned x = 0;
#pragma unroll
            for (int e = 0; e < 4; ++e) x |= ((unsigned)((int)rintf(v[e] * inv) + bias) & 255u) << (8 * e);
            o[wd] = x; }
        *(v4u*)(A.ws + (isv ? WS_VE : WS_UE) + (size_t)row * 1024 + 16 * lane) = (v4u){o[0], o[1], o[2], o[3]};
        if (lane == 0) ((float*)(A.ws + (isv ? WS_VS : WS_US)))[row] = am * (1.0f / 127.0f);
    }
}
__device__ __forceinline__ void phase_h2(const Ctx& F, KArgs A, int l) {
    const float* mod = (const float*)(A.ws + WS_MOD) + (size_t)l * 8 * 6144;
    bf16* H = (bf16*)(A.ws + WS_H);
    for (int m = F.gw; m < T; m += F.NGW) { const float* mb = mod + (size_t)(m >> 11) * 6144;
        norm_mod_row(F.lane, A.out + (size_t)m * D, A.in[I_GN2] + (size_t)l * D, mb + 4096, mb + 3072, H + (size_t)m * D); }
#if DBG_ROUTE32
    {
        bf16* H3 = (bf16*)(A.ws + WS_H3);
        for (int m = F.gw; m < T; m += F.NGW) { const float* mb = mod + (size_t)(m >> 11) * 6144;
            const f32x4* xr = (const f32x4*)(A.out + (size_t)m * D) + F.lane; f32x4 v[4]; float s = 0.f;
#pragma unroll
            for (int j = 0; j < 4; ++j) { v[j] = xr[64 * j]; s += (v[j].x * v[j].x + v[j].y * v[j].y) + (v[j].z * v[j].z + v[j].w * v[j].w); }
            const float r = 1.0f / sqrtf(wave_sum(s) * (1.0f / D) + EPS);
#pragma unroll
            for (int j = 0; j < 4; ++j) {
                const f32x4 gg = ((const f32x4*)(A.in[I_GN2] + (size_t)l * D))[F.lane + 64 * j], sc = ((const f32x4*)(mb + 4096))[F.lane + 64 * j], sh = ((const f32x4*)(mb + 3072))[F.lane + 64 * j];
                const f32x4 y = (v[j] * r) * gg * (sc + 1.0f) + sh;
                unsigned hi[4], lo[4];
#pragma unroll
                for (int e = 0; e < 4; ++e) { hi[e] = f2bf(y[e]); lo[e] = f2bf(y[e] - __builtin_bit_cast(float, hi[e] << 16)); }
                const unsigned long long hw = (unsigned long long)(hi[0] | (hi[1] << 16)) | ((unsigned long long)(hi[2] | (hi[3] << 16)) << 32);
                const unsigned long long lw = (unsigned long long)(lo[0] | (lo[1] << 16)) | ((unsigned long long)(lo[2] | (lo[3] << 16)) << 32);
                unsigned long long* o8 = (unsigned long long*)(H3 + (size_t)m * 3072) + F.lane + 64 * j;
                o8[0] = hw; o8[256] = hw; o8[512] = lw;
            } }
        bf16* W3 = (bf16*)(A.ws + WS_WQ3); const float* W = A.in[I_WQ] + (size_t)l * D * 2048;
        for (size_t i = (size_t)F.gw * 64 + F.lane; i < (size_t)2048 * 1024; i += (size_t)F.NGW * 64) { const int n = (int)(i >> 10), k = (int)(i & 1023);
            const float w = W[(size_t)k * 2048 + n]; const unsigned hi = f2bf(w), lo = f2bf(w - __builtin_bit_cast(float, hi << 16));
            W3[(size_t)n * 3072 + k] = (bf16)hi; W3[(size_t)n * 3072 + 1024 + k] = (bf16)lo; W3[(size_t)n * 3072 + 2048 + k] = (bf16)hi; }
    }
}
__device__ __forceinline__ void phase_expert_convert(const Ctx& F, KArgs A, int l) {
#else
#endif
    const float* ue = A.in[I_UE] + (size_t)l * 16384 * 1024; const float* ve = A.in[I_VE] + (size_t)l * 16384 * 1024;
#if EXP_I8_OWN
    return;
#endif
    bf16* UE = (bf16*)(A.ws + WS_UE); bf16* VE = (bf16*)(A.ws + WS_VE);
    for (size_t i = (size_t)F.gw * 64 + F.lane; i < (size_t)2 * 16384 * 1024 / 8; i += (size_t)F.NGW * 64) {
        const bool isv = i >= (size_t)16384 * 1024 / 8; const size_t e = (isv ? i - (size_t)16384 * 1024 / 8 : i) * 8;
        const float* src = (isv ? ve : ue) + e; const f32x4 a = *(const f32x4*)src, b = *(const f32x4*)(src + 4);
        v4u o; o.x = pk2(a.x, a.y); o.y = pk2(a.z, a.w); o.z = pk2(b.x, b.y); o.w = pk2(b.z, b.w);
        *(v4u*)((isv ? VE : UE) + e) = o;
    }
}
__device__ __forceinline__ void phase_route_naive(const Ctx& F, KArgs A, int l) {
#if DBG_ROUTE32
    const float* Q32 = (const float*)(A.ws + WS_Q32); const float* SKF = A.in[I_SK] + (size_t)l * 32768;
#else
    const bf16* Q2 = (const bf16*)(A.ws + WS_Q2); const bf16* SK = (const bf16*)(A.ws + WS_W + (size_t)l * W_LAYER + W_SK);
#endif
    int* IDX = (int*)(A.ws + WS_IDX); float* WTS = (float*)(A.ws + WS_WTS);
    for (int it = F.gw; it < T * 8; it += F.NGW) {
        const int t = it >> 3, hh = it & 7;
        float ts[2]; int ti[2];
#pragma unroll
        for (int p = 0; p < 2; ++p) {
#if DBG_ROUTE32
            const float* qp = Q32 + (size_t)t * 2048 + hh * 256 + p * 128;
            const float* ka = SKF + ((size_t)p * 128 + F.lane) * 128; const float* kb = ka + 64 * 128;
            float sa = 0.f, sb = 0.f;
            for (int i = 0; i < 32; ++i) { const f32x4 qv = *(const f32x4*)(qp + 4 * i), av = *(const f32x4*)(ka + 4 * i), bv = *(const f32x4*)(kb + 4 * i);
                sa += qv.x * av.x + qv.y * av.y + qv.z * av.z + qv.w * av.w; sb += qv.x * bv.x + qv.y * bv.y + qv.z * bv.z + qv.w * bv.w; }
#else
            const bf16* qp = Q2 + (size_t)t * 2048 + hh * 256 + p * 128;
            const bf16* ka = SK + ((size_t)p * 128 + F.lane) * 128; const bf16* kb = ka + 64 * 128;
            float sa = 0.f, sb = 0.f;
            for (int i = 0; i < 16; ++i) { const v4u qw = *(const v4u*)(qp + 8 * i), aw = *(const v4u*)(ka + 8 * i), bw = *(const v4u*)(kb + 8 * i);
                sa += bflo(qw.x) * bflo(aw.x) + bfhi(qw.x) * bfhi(aw.x) + bflo(qw.y) * bflo(aw.y) + bfhi(qw.y) * bfhi(aw.y) + bflo(qw.z) * bflo(aw.z) + bfhi(qw.z) * bfhi(aw.z) + bflo(qw.w) * bflo(aw.w) + bfhi(qw.w) * bfhi(aw.w);
                sb += bflo(qw.x) * bflo(bw.x) + bfhi(qw.x) * bfhi(bw.x) + bflo(qw.y) * bflo(bw.y) + bfhi(qw.y) * bfhi(bw.y) + bflo(qw.z) * bflo(bw.z) + bfhi(qw.z) * bfhi(bw.z) + bflo(qw.w) * bflo(bw.w) + bfhi(qw.w) * bfhi(bw.w); }
#endif
            float tsv = 0.f; int tiv = 0;
            for (int r = 0; r < 16; ++r) {
                const float m = wave_max(fmaxf(sa, sb));
                const unsigned long long ba = __ballot(sa == m), bb = __ballot(sb == m);
                int idx;
                if (ba) { const int ln = __ffsll((long long)ba) - 1; idx = ln; if (F.lane == ln) sa = -3.0e38f; }
                else { const int ln = __ffsll((long long)bb) - 1; idx = 64 + ln; if (F.lane == ln) sb = -3.0e38f; }
                if (F.lane == r) { tsv = m; tiv = idx; }
            }
            ts[p] = tsv; ti[p] = tiv;
        }
        float cv[4];
#pragma unroll
        for (int k = 0; k < 4; ++k) cv[k] = __shfl(ts[0], (F.lane >> 4) + 4 * k) + __shfl(ts[1], F.lane & 15);
        float bs = 0.f; int bid = 0;
        for (int r = 0; r < 16; ++r) {
            const float m = wave_max(fmaxf(fmaxf(cv[0], cv[1]), fmaxf(cv[2], cv[3])));
            int id = -1;
#pragma unroll
            for (int k = 0; k < 4; ++k) { const unsigned long long bk = __ballot(cv[k] == m);
                if (id < 0 && bk) { const int ln = __ffsll((long long)bk) - 1; id = ln + 64 * k; if (F.lane == ln) cv[k] = -3.0e38f; } }
            if (F.lane == r) { bs = m; bid = id; }
        }
        const int ei = __shfl(ti[0], bid >> 4) * 128 + __shfl(ti[1], bid & 15);
        const float m0 = __shfl(bs, 0);
        const float e = (F.lane < 16) ? expf(bs - m0) : 0.f;
        const float den = wave_sum(e);
        if (F.lane < 16) { IDX[(size_t)t * 128 + hh * 16 + F.lane] = ei; WTS[(size_t)t * 128 + hh * 16 + F.lane] = e / den; }
    }
}
typedef float f32x16r __attribute__((ext_vector_type(16)));
typedef short bf16x8r __attribute__((ext_vector_type(8)));
__device__ __forceinline__ unsigned srt_key(float f) { const unsigned u = __builtin_bit_cast(unsigned, f); return u ^ ((unsigned)((int)u >> 31) | 0x80000000u); }
__device__ __forceinline__ float srt_val(unsigned k) { const unsigned u = (k & 0x80000000u) ? (k ^ 0x80000000u) : ~k; return __builtin_bit_cast(float, u); }
#define INS16(L, x) do { unsigned x_ = (x); _Pragma("unroll") for (int k_ = 0; k_ < 16; ++k_) { const unsigned h_ = L[k_] > x_ ? L[k_] : x_; x_ = L[k_] > x_ ? x_ : L[k_]; L[k_] = h_; } } while (0)
#if ROUTE_SORTNET
#define CE_(a, b) do { const unsigned h_ = (a) > (b) ? (a) : (b); (b) = (a) > (b) ? (b) : (a); (a) = h_; } while (0)
__device__ __forceinline__ void sort16_desc(unsigned (&v)[16]) { CE_(v[0], v[1]); CE_(v[2], v[3]); CE_(v[0], v[2]); CE_(v[1], v[3]); CE_(v[1], v[2]); CE_(v[4], v[5]); CE_(v[6], v[7]); CE_(v[4], v[6]); CE_(v[5], v[7]); CE_(v[5], v[6]); CE_(v[0], v[4]); CE_(v[2], v[6]); CE_(v[2], v[4]); CE_(v[1], v[5]); CE_(v[3], v[7]); CE_(v[3], v[5]); CE_(v[1], v[2]); CE_(v[3], v[4]); CE_(v[5], v[6]); CE_(v[8], v[9]); CE_(v[10], v[11]); CE_(v[8], v[10]); CE_(v[9], v[11]); CE_(v[9], v[10]); CE_(v[12], v[13]); CE_(v[14], v[15]); CE_(v[12], v[14]); CE_(v[13], v[15]); CE_(v[13], v[14]); CE_(v[8], v[12]); CE_(v[10], v[14]); CE_(v[10], v[12]); CE_(v[9], v[13]); CE_(v[11], v[15]); CE_(v[11], v[13]); CE_(v[9], v[10]); CE_(v[11], v[12]); CE_(v[13], v[14]); CE_(v[0], v[8]); CE_(v[4], v[12]); CE_(v[4], v[8]); CE_(v[2], v[10]); CE_(v[6], v[14]); CE_(v[6], v[10]); CE_(v[2], v[4]); CE_(v[6], v[8]); CE_(v[10], v[12]); CE_(v[1], v[9]); CE_(v[5], v[13]); CE_(v[5], v[9]); CE_(v[3], v[11]); CE_(v[7], v[15]); CE_(v[7], v[11]); CE_(v[3], v[5]); CE_(v[7], v[9]); CE_(v[11], v[13]); CE_(v[1], v[2]); CE_(v[3], v[4]); CE_(v[5], v[6]); CE_(v[7], v[8]); CE_(v[9], v[10]); CE_(v[11], v[12]); CE_(v[13], v[14]); }
__device__ __forceinline__ void merge16_top(unsigned (&R)[16], const unsigned (&C)[16]) {
#pragma unroll
    for (int i = 0; i < 16; ++i) R[i] = R[i] > C[15 - i] ? R[i] : C[15 - i];
    CE_(R[0], R[8]); CE_(R[1], R[9]); CE_(R[2], R[10]); CE_(R[3], R[11]); CE_(R[4], R[12]); CE_(R[5], R[13]); CE_(R[6], R[14]); CE_(R[7], R[15]); CE_(R[0], R[4]); CE_(R[1], R[5]); CE_(R[2], R[6]); CE_(R[3], R[7]); CE_(R[8], R[12]); CE_(R[9], R[13]); CE_(R[10], R[14]); CE_(R[11], R[15]); CE_(R[0], R[2]); CE_(R[1], R[3]); CE_(R[4], R[6]); CE_(R[5], R[7]); CE_(R[8], R[10]); CE_(R[9], R[11]); CE_(R[12], R[14]); CE_(R[13], R[15]); CE_(R[0], R[1]); CE_(R[2], R[3]); CE_(R[4], R[5]); CE_(R[6], R[7]); CE_(R[8], R[9]); CE_(R[10], R[11]); CE_(R[12], R[13]); CE_(R[14], R[15]); }
#endif
__device__ __forceinline__ void route_top16(unsigned (&tk)[16], const bf16* qrow, const GAS bf16* skp, int lane) {
    f32x16r acc[4];
#pragma unroll
    for (int mt = 0; mt < 4; ++mt) acc[mt] = (f32x16r){0.f, 0.f, 0.f, 0.f, 0.f, 0.f, 0.f, 0.f, 0.f, 0.f, 0.f, 0.f, 0.f, 0.f, 0.f, 0.f};
#if ROUTE_BATCH
#pragma unroll
    for (int s0 = 0; s0 < 8; s0 += ROUTE_BATCH) { bf16x8r bq[ROUTE_BATCH], a[ROUTE_BATCH][4];
#pragma unroll
        for (int i = 0; i < ROUTE_BATCH; ++i) { bq[i] = *(const bf16x8r*)(qrow + (Q2_FRAG ? 512 : 16) * (s0 + i));
#pragma unroll
#if SK_FRAG
            for (int mt = 0; mt < 4; ++mt) a[i][mt] = *(const GAS bf16x8r*)(skp + (size_t)(mt * 8 + s0 + i) * 512); }
#else
            for (int mt = 0; mt < 4; ++mt) a[i][mt] = *(const GAS bf16x8r*)(skp + (size_t)mt * 32 * 128 + 16 * (s0 + i)); }
#endif
#pragma unroll
        for (int i = 0; i < ROUTE_BATCH; ++i) asm volatile("" : "+v"(bq[i]), "+v"(a[i][0]), "+v"(a[i][1]), "+v"(a[i][2]), "+v"(a[i][3]));
#pragma unroll
        for (int i = 0; i < ROUTE_BATCH; ++i)
#pragma unroll
            for (int mt = 0; mt < 4; ++mt) acc[mt] = __builtin_amdgcn_mfma_f32_32x32x16_bf16(a[i][mt], bq[i], acc[mt], 0, 0, 0); }
#else
#pragma unroll
    for (int s = 0; s < 8; ++s) { const bf16x8r bq = *(const bf16x8r*)(qrow + 16 * s);
#pragma unroll
        for (int mt = 0; mt < 4; ++mt) { const bf16x8r a = *(const GAS bf16x8r*)(skp + (size_t)mt * 32 * 128 + 16 * s);
            acc[mt] = __builtin_amdgcn_mfma_f32_32x32x16_bf16(a, bq, acc[mt], 0, 0, 0); } }
#endif
    const unsigned lowb = (lane & 32) ? 0u : 4u;
#if ROUTE_SORTNET
#pragma unroll
    for (int mt = 0; mt < 4; ++mt) { unsigned c[16];
#pragma unroll
        for (int r = 0; r < 16; ++r) { const unsigned idx0 = 32u * mt + (r & 3) + 8u * (r >> 2);
            c[r] = (srt_key(acc[mt][r]) & ~127u) | ((127u - idx0) & ~4u) | lowb; }
        sort16_desc(c);
        if (mt == 0) {
#pragma unroll
            for (int k = 0; k < 16; ++k) tk[k] = c[k]; }
        else merge16_top(tk, c); }
    unsigned pk[16];
#pragma unroll
    for (int k = 0; k < 16; ++k) pk[k] = (unsigned)__shfl_xor((int)tk[k], 32);
    merge16_top(tk, pk);
}
#else
#pragma unroll
    for (int k = 0; k < 16; ++k) tk[k] = 0u;
#pragma unroll
    for (int mt = 0; mt < 4; ++mt)
#pragma unroll
        for (int r = 0; r < 16; ++r) { const unsigned idx0 = 32u * mt + (r & 3) + 8u * (r >> 2);
            const unsigned key = (srt_key(acc[mt][r]) & ~127u) | ((127u - idx0) & ~4u) | lowb; INS16(tk, key); }
    unsigned pk[16];
#pragma unroll
    for (int k = 0; k < 16; ++k) pk[k] = (unsigned)__shfl_xor((int)tk[k], 32);
#pragma unroll
    for (int k = 0; k < 16; ++k) INS16(tk, pk[k]);
}
#endif
template <class IP, class WP> __device__ __forceinline__ void route_unit(const Ctx& F, KArgs A, int l, int u, LAS unsigned char* scr, IP IDX, WP WTS, int tbase) {
    const bf16* Q2 = (const bf16*)(A.ws + WS_Q2); const bf16* SK = (const bf16*)(A.ws + WS_W + (size_t)l * W_LAYER + W_SK);
    asm volatile("" : "+s"(SK));
    const int row = F.lane & 31, kh = F.lane >> 5;
    {
#if Q2_FRAG
        const int t = 4 * u + (row & 3), hh = row >> 2;
#else
        const int t = 4 * u + (row >> 3), hh = row & 7;
#endif
        unsigned tk0[16], tk1[16];
        const GAS bf16* SKg = (const GAS bf16*)SK;
#if SK_FRAG && Q2_FRAG
        route_top16(tk0, Q2 + ((size_t)(u * 2 + 0) * 512 + F.lane) * 8, SKg + (size_t)F.lane * 8, F.lane);
        route_top16(tk1, Q2 + ((size_t)(u * 2 + 1) * 512 + F.lane) * 8, SKg + 128 * 128 + (size_t)F.lane * 8, F.lane);
#elif SK_FRAG
        route_top16(tk0, Q2 + (size_t)t * 2048 + hh * 256 + 8 * kh, SKg + (size_t)F.lane * 8, F.lane);
        route_top16(tk1, Q2 + (size_t)t * 2048 + hh * 256 + 128 + 8 * kh, SKg + 128 * 128 + (size_t)F.lane * 8, F.lane);
#else
        route_top16(tk0, Q2 + (size_t)t * 2048 + hh * 256 + 8 * kh, SKg + (size_t)row * 128 + 8 * kh, F.lane);
        route_top16(tk1, Q2 + (size_t)t * 2048 + hh * 256 + 128 + 8 * kh, SKg + 128 * 128 + (size_t)row * 128 + 8 * kh, F.lane);
#endif
        float s0[16], s1[16];
#pragma unroll
        for (int k = 0; k < 16; ++k) { s0[k] = srt_val(tk0[k] & ~127u); s1[k] = srt_val(tk1[k] & ~127u); }
        LAS unsigned* sw = (LAS unsigned*)(scr + F.lane * 36);
#pragma unroll
        for (int k = 0; k < 4; ++k) {
            sw[k] = (127u - (tk0[4 * k] & 127u)) | ((127u - (tk0[4 * k + 1] & 127u)) << 8) | ((127u - (tk0[4 * k + 2] & 127u)) << 16) | ((127u - (tk0[4 * k + 3] & 127u)) << 24);
            sw[4 + k] = (127u - (tk1[4 * k] & 127u)) | ((127u - (tk1[4 * k + 1] & 127u)) << 8) | ((127u - (tk1[4 * k + 2] & 127u)) << 16) | ((127u - (tk1[4 * k + 3] & 127u)) << 24); }
        unsigned bk[16];
#if ROUTE_SORTNET
#define PKEY_(i, j) ((srt_key(s0[i] + s1[j]) & ~255u) | (255u - (unsigned)((i) * 16 + (j))))
        {
            unsigned c[16];
#pragma unroll
            for (int j = 0; j < 16; ++j) bk[j] = PKEY_(0, j);
#pragma unroll
            for (int i = 1; i < 16; ++i) c[i - 1] = PKEY_(i, 0);
            c[15] = 0u;
            merge16_top(bk, c);
            int n = 0;
#pragma unroll
            for (int i = 1; i < 8; ++i)
#pragma unroll
                for (int j = 1; j < 8; ++j) if ((i + 1) * (j + 1) <= 16) { const unsigned key = PKEY_(i, j); if (n < 16) c[n] = key; else INS16(bk, key); ++n; }
            sort16_desc(c);
            merge16_top(bk, c);
        }
#undef PKEY_
#else
#pragma unroll
        for (int k = 0; k < 16; ++k) bk[k] = 0u;
#pragma unroll
        for (int i = 0; i < 16; ++i)
#pragma unroll
            for (int j = 0; j < 16; ++j) if ((i + 1) * (j + 1) <= 16) { const unsigned key = (srt_key(s0[i] + s1[j]) & ~255u) | (255u - (unsigned)(i * 16 + j)); INS16(bk, key); }
#endif
        LDS_WAIT();
        const LAS unsigned char* sb = (const LAS unsigned char*)(scr + F.lane * 36);
        int ei[16]; float wv[16]; float den = 0.f; const float m0 = srt_val(bk[0] & ~255u);
#pragma unroll
        for (int r = 0; r < 16; ++r) { const unsigned ij = 255u - (bk[r] & 255u); ei[r] = (int)sb[ij >> 4] * 128 + (int)sb[16 + (ij & 15)];
            wv[r] = __expf(srt_val(bk[r] & ~255u) - m0); den += wv[r]; }
        const float rden = 1.0f / den;
        if (kh == 0) {
#pragma unroll
            for (int r = 0; r < 16; ++r) IDX[(size_t)(t - tbase) * 128 + hh * 16 + r] = ei[r]; }
        else {
#pragma unroll
            for (int r = 0; r < 16; ++r) WTS[(size_t)(t - tbase) * 128 + hh * 16 + r] = wv[r] * rden; }
        LDS_WAIT();
    }
}
__device__ __forceinline__ void phase_route(const Ctx& F, KArgs A, int l) {
    LAS unsigned char* scr = F.lds + RING_OFF + F.wave * 4096;
    for (int u = F.gw; u < T / 4; u += F.NGW) route_unit(F, A, l, u, scr, (int*)(A.ws + WS_IDX), (float*)(A.ws + WS_WTS), 0);
}
#ifndef PROBE_U_VALU
#define PROBE_U_VALU 0
#endif
#ifndef PROBE_EXP_REP
#define PROBE_EXP_REP 1
#endif
typedef __bf16 bf16x2_t __attribute__((ext_vector_type(2)));
__device__ __forceinline__ float dot2bf(unsigned a, unsigned b, float c) { return __builtin_amdgcn_fdot2_f32_bf16(__builtin_bit_cast(bf16x2_t, a), __builtin_bit_cast(bf16x2_t, b), c, false); }
template <int XM> __device__ __forceinline__ float lane_xchg(float v) {
    const int x = __builtin_bit_cast(int, v);
    if constexpr (XM == 1) return __builtin_bit_cast(float, __builtin_amdgcn_mov_dpp(x, 0xB1, 0xF, 0xF, true));
    else if constexpr (XM == 2) return __builtin_bit_cast(float, __builtin_amdgcn_mov_dpp(x, 0x4E, 0xF, 0xF, true));
    else if constexpr (XM == 4) return __builtin_bit_cast(float, __builtin_amdgcn_ds_swizzle(x, 0x101F));
    else if constexpr (XM == 8) return __builtin_bit_cast(float, __builtin_amdgcn_ds_swizzle(x, 0x201F));
    else if constexpr (XM == 16) return __builtin_bit_cast(float, __builtin_amdgcn_ds_swizzle(x, 0x401F));
    else return __shfl_xor(v, 32);
}
template <int XM> __device__ __forceinline__ int lane_xchg(int x) {
    if constexpr (XM == 1) return __builtin_amdgcn_mov_dpp(x, 0xB1, 0xF, 0xF, true);
    else if constexpr (XM == 2) return __builtin_amdgcn_mov_dpp(x, 0x4E, 0xF, 0xF, true);
    else if constexpr (XM == 4) return __builtin_amdgcn_ds_swizzle(x, 0x101F);
    else if constexpr (XM == 8) return __builtin_amdgcn_ds_swizzle(x, 0x201F);
    else if constexpr (XM == 16) return __builtin_amdgcn_ds_swizzle(x, 0x401F);
    else return __shfl_xor(x, 32);
}
__device__ __forceinline__ float reduce16(const float (&p)[16], int lane) {
    float a[8], b[4], c[2];
    const bool b0 = lane & 1, b1 = lane & 2, b2 = lane & 4, b3 = lane & 8;
#pragma unroll
    for (int i = 0; i < 8; ++i) a[i] = (b0 ? p[2 * i + 1] : p[2 * i]) + lane_xchg<1>(b0 ? p[2 * i] : p[2 * i + 1]);
#pragma unroll
    for (int i = 0; i < 4; ++i) b[i] = (b1 ? a[2 * i + 1] : a[2 * i]) + lane_xchg<2>(b1 ? a[2 * i] : a[2 * i + 1]);
#pragma unroll
    for (int i = 0; i < 2; ++i) c[i] = (b2 ? b[2 * i + 1] : b[2 * i]) + lane_xchg<4>(b2 ? b[2 * i] : b[2 * i + 1]);
    float d = (b3 ? c[1] : c[0]) + lane_xchg<8>(b3 ? c[0] : c[1]);
    d += lane_xchg<16>(d);
    d += lane_xchg<32>(d);
    return d;
}
__device__ __forceinline__ void expert_token(const Ctx& F, KArgs A, int l, int t, const int idx0, const int idx1, const float wt0, const float wt1) {
    const bf16* H = (const bf16*)(A.ws + WS_H); const unsigned char* UE = A.ws + WS_UE; const unsigned char* VE = A.ws + WS_VE;
    const float* mod = (const float*)(A.ws + WS_MOD);
    bf16* Hn = (bf16*)(A.ws + WS_H);
    const unsigned lo16 = (unsigned)F.lane * 16u; (void)lo16;
    {
        const v4u ha = *(const v4u*)(H + (size_t)t * D + 8 * F.lane), hb = *(const v4u*)(H + (size_t)t * D + 512 + 8 * F.lane);
#if EXP_I8 && !DBG_ROUTE32
        const float su0 = ((const float*)(A.ws + WS_US))[idx0], su1 = ((const float*)(A.ws + WS_US))[idx1], sv0 = ((const float*)(A.ws + WS_VS))[idx0], sv1 = ((const float*)(A.ws + WS_VS))[idx1];
        float hv[16];
        hv[0] = bflo(ha.x); hv[1] = bfhi(ha.x); hv[2] = bflo(ha.y); hv[3] = bfhi(ha.y); hv[4] = bflo(ha.z); hv[5] = bfhi(ha.z); hv[6] = bflo(ha.w); hv[7] = bfhi(ha.w);
        hv[8] = bflo(hb.x); hv[9] = bfhi(hb.x); hv[10] = bflo(hb.y); hv[11] = bfhi(hb.y); hv[12] = bflo(hb.z); hv[13] = bfhi(hb.z); hv[14] = bflo(hb.w); hv[15] = bfhi(hb.w);
        float hs = 0.f;
#pragma unroll
        for (int k = 0; k < 16; ++k) hs += hv[k];
        const float hsum = wave_sum(hs);
        const unsigned lo16b = (unsigned)F.lane * 16u;
#define UB(w, i) ((float)(((w) >> (8 * (i))) & 255u))
        float act0 = 0.f, act1 = 0.f;
        for (int b = 0; b < 8 * PROBE_EXP_REP; ++b) {
            const int isel = ((b & 7) < 4) ? idx0 : idx1; const int lb = 16 * (b & 3);
            v4u rr[16];
#pragma unroll
            for (int j = 0; j < 16; ++j) { const unsigned ie = (unsigned)rdlanei(isel, lb + j); rr[j] = *(const v4u*)(UE + (size_t)ie * 1024u + lo16b) ^ 0x80808080u; }
            float p[16];
#pragma unroll
            for (int j = 0; j < 16; ++j) { const v4u r = rr[j];
                float s0 = hv[0] * UB(r.x, 0); s0 += hv[1] * UB(r.x, 1); s0 += hv[2] * UB(r.x, 2); s0 += hv[3] * UB(r.x, 3);
                float s1 = hv[4] * UB(r.y, 0); s1 += hv[5] * UB(r.y, 1); s1 += hv[6] * UB(r.y, 2); s1 += hv[7] * UB(r.y, 3);
                s0 += hv[8] * UB(r.z, 0); s0 += hv[9] * UB(r.z, 1); s0 += hv[10] * UB(r.z, 2); s0 += hv[11] * UB(r.z, 3);
                s1 += hv[12] * UB(r.w, 0); s1 += hv[13] * UB(r.w, 1); s1 += hv[14] * UB(r.w, 2); s1 += hv[15] * UB(r.w, 3);
                p[j] = s0 + s1; }
#if PROBE_U_VALU
            asm volatile("" : "+v"(hv[0]), "+v"(hv[1]), "+v"(hv[2]), "+v"(hv[3]), "+v"(hv[4]), "+v"(hv[5]), "+v"(hv[6]), "+v"(hv[7]));
#pragma unroll
            for (int j = 0; j < 16; ++j) { const v4u r = rr[j];
                float s0 = hv[0] * UB(r.x, 0); s0 += hv[1] * UB(r.x, 1); s0 += hv[2] * UB(r.x, 2); s0 += hv[3] * UB(r.x, 3);
                float s1 = hv[4] * UB(r.y, 0); s1 += hv[5] * UB(r.y, 1); s1 += hv[6] * UB(r.y, 2); s1 += hv[7] * UB(r.y, 3);
                s0 += hv[8] * UB(r.z, 0); s0 += hv[9] * UB(r.z, 1); s0 += hv[10] * UB(r.z, 2); s0 += hv[11] * UB(r.z, 3);
                s1 += hv[12] * UB(r.w, 0); s1 += hv[13] * UB(r.w, 1); s1 += hv[14] * UB(r.w, 2); s1 += hv[15] * UB(r.w, 3);
                p[j] = 0.5f * (p[j] + (s0 + s1)); }
#endif
            const float tot = reduce16(p, F.lane);
            if ((F.lane >> 4) == (b & 3)) { if ((b & 7) < 4) act0 = tot; else act1 = tot; }
        }
        act0 = su0 * (act0 - 128.0f * hsum); act1 = su1 * (act1 - 128.0f * hsum);
        const float w0 = wt0 * sv0 * 0.5f * act0 * (1.0f + erff(act0 * 0.7071067811865476f)), w1 = wt1 * sv1 * 0.5f * act1 * (1.0f + erff(act1 * 0.7071067811865476f));
        const float csum = wave_sum(w0 + w1);
        float o[16];
#pragma unroll
        for (int k = 0; k < 16; ++k) o[k] = 0.f;
        for (int b = 0; b < 8 * PROBE_EXP_REP; ++b) {
            if (b == 8) {
#pragma unroll
                for (int k = 0; k < 16; ++k) o[k] = 0.f; }
            const int isel = ((b & 7) < 4) ? idx0 : idx1; const float wsel = ((b & 7) < 4) ? w0 : w1; const int lb = 16 * (b & 3);
            v4u rr[16];
#pragma unroll
            for (int j = 0; j < 16; ++j) { const unsigned ie = (unsigned)rdlanei(isel, lb + j); rr[j] = *(const v4u*)(VE + (size_t)ie * 1024u + lo16b); }
#pragma unroll
            for (int j = 0; j < 16; ++j) { const float we = rdlane(wsel, lb + j); const v4u r = rr[j];
                o[0] += we * UB(r.x, 0); o[1] += we * UB(r.x, 1); o[2] += we * UB(r.x, 2); o[3] += we * UB(r.x, 3); o[4] += we * UB(r.y, 0); o[5] += we * UB(r.y, 1); o[6] += we * UB(r.y, 2); o[7] += we * UB(r.y, 3);
                o[8] += we * UB(r.z, 0); o[9] += we * UB(r.z, 1); o[10] += we * UB(r.z, 2); o[11] += we * UB(r.z, 3); o[12] += we * UB(r.w, 0); o[13] += we * UB(r.w, 1); o[14] += we * UB(r.w, 2); o[15] += we * UB(r.w, 3); }
        }
#pragma unroll
        for (int k = 0; k < 16; ++k) o[k] -= 128.0f * csum;
#undef UB
#else
        float act0 = 0.f, act1 = 0.f;
        for (int b = 0; b < 8 * PROBE_EXP_REP; ++b) {
            const int isel = ((b & 7) < 4) ? idx0 : idx1; const int lb = 16 * (b & 3);
            v4u ra[16], rb[16];
#pragma unroll
            for (int j = 0; j < 16; ++j) { const unsigned ie = (unsigned)rdlanei(isel, lb + j); const unsigned char* up = UE + (size_t)ie * 2048u + lo16;
                ra[j] = *(const v4u*)up; rb[j] = *(const v4u*)(up + 1024); }
            float p[16];
#pragma unroll
            for (int j = 0; j < 16; ++j) { float s = dot2bf(ha.x, ra[j].x, 0.f); s = dot2bf(ha.y, ra[j].y, s); s = dot2bf(ha.z, ra[j].z, s); s = dot2bf(ha.w, ra[j].w, s);
                s = dot2bf(hb.x, rb[j].x, s); s = dot2bf(hb.y, rb[j].y, s); s = dot2bf(hb.z, rb[j].z, s); s = dot2bf(hb.w, rb[j].w, s); p[j] = s; }
            const float tot = reduce16(p, F.lane);
            if ((F.lane >> 4) == (b & 3)) { if ((b & 7) < 4) act0 = tot; else act1 = tot; }
        }
        const float w0 = wt0 * 0.5f * act0 * (1.0f + erff(act0 * 0.7071067811865476f)), w1 = wt1 * 0.5f * act1 * (1.0f + erff(act1 * 0.7071067811865476f));
        float o[16];
#pragma unroll
        for (int k = 0; k < 16; ++k) o[k] = 0.f;
        for (int b = 0; b < 8 * PROBE_EXP_REP; ++b) {
            if (b == 8) {
#pragma unroll
                for (int k = 0; k < 16; ++k) o[k] = 0.f; }
            const int isel = ((b & 7) < 4) ? idx0 : idx1; const float wsel = ((b & 7) < 4) ? w0 : w1; const int lb = 16 * (b & 3);
            v4u ra[16], rb[16];
#pragma unroll
            for (int j = 0; j < 16; ++j) { const unsigned ie = (unsigned)rdlanei(isel, lb + j); const unsigned char* vp = VE + (size_t)ie * 2048u + lo16;
                ra[j] = *(const v4u*)vp; rb[j] = *(const v4u*)(vp + 1024); }
#pragma unroll
            for (int j = 0; j < 16; ++j) { const float we = rdlane(wsel, lb + j); const v4u a = ra[j], bb = rb[j];
                o[0] += we * bflo(a.x); o[1] += we * bfhi(a.x); o[2] += we * bflo(a.y); o[3] += we * bfhi(a.y); o[4] += we * bflo(a.z); o[5] += we * bfhi(a.z); o[6] += we * bflo(a.w); o[7] += we * bfhi(a.w);
                o[8] += we * bflo(bb.x); o[9] += we * bfhi(bb.x); o[10] += we * bflo(bb.y); o[11] += we * bfhi(bb.y); o[12] += we * bflo(bb.z); o[13] += we * bfhi(bb.z); o[14] += we * bflo(bb.w); o[15] += we * bfhi(bb.w); }
        }
#endif
        const int b = t >> 11; const float* mb = mod + ((size_t)l * 8 + b) * 6144;
        float x2[16]; float ss = 0.f;
#pragma unroll
        for (int hseg = 0; hseg < 2; ++hseg)
#pragma unroll
            for (int q4 = 0; q4 < 2; ++q4) { const int col = hseg * 512 + 8 * F.lane + 4 * q4;
                const f32x4 xv = *(const f32x4*)(A.out + (size_t)t * D + col), gv = *(const f32x4*)(mb + 5120 + col);
#pragma unroll
                for (int e = 0; e < 4; ++e) { const float v = xv[e] + gv[e] * o[hseg * 8 + q4 * 4 + e]; x2[hseg * 8 + q4 * 4 + e] = v; ss += v * v; } }
        const float r = 1.0f / sqrtf(wave_sum(ss) * (1.0f / D) + EPS);
        if (l + 1 < DEPTH) {
            const float* mn = mod + ((size_t)(l + 1) * 8 + b) * 6144; const float* gn = A.in[I_GN1] + (size_t)(l + 1) * D;
#pragma unroll
            for (int hseg = 0; hseg < 2; ++hseg) { const int col = hseg * 512 + 8 * F.lane;
                float hn[8];
#pragma unroll
                for (int q4 = 0; q4 < 2; ++q4) { const f32x4 gg = *(const f32x4*)(gn + col + 4 * q4), sc = *(const f32x4*)(mn + 1024 + col + 4 * q4), sh = *(const f32x4*)(mn + col + 4 * q4);
                    f32x4 xo;
#pragma unroll
                    for (int e = 0; e < 4; ++e) { xo[e] = x2[hseg * 8 + q4 * 4 + e]; hn[q4 * 4 + e] = xo[e] * r * gg[e] * (1.0f + sc[e]) + sh[e]; }
                    *(f32x4*)(A.out + (size_t)t * D + col + 4 * q4) = xo; }
                v4u ov; ov.x = pk2(hn[0], hn[1]); ov.y = pk2(hn[2], hn[3]); ov.z = pk2(hn[4], hn[5]); ov.w = pk2(hn[6], hn[7]);
                *(v4u*)(Hn + (size_t)t * D + col) = ov; }
        } else {
            const float* gf = A.in[I_GFIN];
#pragma unroll
            for (int hseg = 0; hseg < 2; ++hseg)
#pragma unroll
                for (int q4 = 0; q4 < 2; ++q4) { const int col = hseg * 512 + 8 * F.lane + 4 * q4; const f32x4 gg = *(const f32x4*)(gf + col); f32x4 xo;
#pragma unroll
                    for (int e = 0; e < 4; ++e) xo[e] = x2[hseg * 8 + q4 * 4 + e] * r * gg[e];
                    *(f32x4*)(A.out + (size_t)t * D + col) = xo; }
        }
    }
}

struct HQ { int q1[4], q2[4]; float s1, s2; int c1, c2; };
struct NextB { const unsigned char* tab; int isel; int lb; };
template <int N> __device__ __forceinline__ void vm_wait() { asm volatile("s_waitcnt vmcnt(%0)" :: "n"(N) : "memory"); }
__device__ __forceinline__ void dma_row(const NextB& nb, int j, unsigned lo16b, LAS unsigned char* slot) {
    const unsigned ie = (unsigned)rdlanei(nb.isel, nb.lb + j);
#if EXP6B
#if DMA_NOMASK
    const unsigned off = lo16b < (lo16b - EROW) ? lo16b : lo16b - EROW;
#if ROW_OFFS
    __builtin_amdgcn_global_load_lds((const unsigned*)(nb.tab + (size_t)(ie + off)), (LAS unsigned*)slot, 16, 0, 0);
#else
    __builtin_amdgcn_global_load_lds((const unsigned*)(nb.tab + (size_t)ie * 768u + off), (LAS unsigned*)slot, 16, 0, 0);
#endif
#else
    if (lo16b < 768u) __builtin_amdgcn_global_load_lds((const unsigned*)(nb.tab + (size_t)ie * 768u + lo16b), (LAS unsigned*)slot, 16, 0, 0);
#endif
#else
    __builtin_amdgcn_global_load_lds((const unsigned*)(nb.tab + (size_t)ie * 1024u + lo16b), (LAS unsigned*)slot, 16, 0, 0);
#endif
}
#define UBF(w, i) ((float)(((w) >> (8 * (i))) & 255u))
__device__ __forceinline__ v4u ring_row(const LAS unsigned char* slot, unsigned lo16b) {
#if EXP6B
    const v2u X = *(const LAS v2u*)(slot + (lo16b >> 1)); const unsigned Y = *(const LAS unsigned*)(slot + 512 + (lo16b >> 2));
    v4u r;
    r.x = (X.x & 0x0F0F0F0Fu) | (Y & 0x30303030u);
    r.y = (X.x & 0xF0F0F0F0u) | (Y & 0x0C0C0C0Cu);
    r.z = (X.y & 0x0F0F0F0Fu) | ((Y >> 2) & 0x30303030u);
    r.w = (X.y & 0xF0F0F0F0u) | ((Y << 2) & 0x0C0C0C0Cu);
    return r;
#else
    return *(const LAS v4u*)(slot + lo16b);
#endif
}
#if ROW_PIPE
__device__ __forceinline__ void lds_raw(v4u& raw, const LAS unsigned char* slot, unsigned lo16b) {
#if EXP6B
#if EXP5B
    const v2u X = *(const LAS v2u*)(slot + (lo16b >> 1)); raw.x = X.x; raw.y = X.y; raw.z = *(const LAS unsigned*)(slot + 512 + ((lo16b >> 2) & 127u));
#else
    const v2u X = *(const LAS v2u*)(slot + (lo16b >> 1)); raw.x = X.x; raw.y = X.y; raw.z = *(const LAS unsigned*)(slot + 512 + (lo16b >> 2));
#endif
#else
    raw = *(const LAS v4u*)(slot + lo16b);
#endif
}
__device__ __forceinline__ v4u decode_raw(const v4u& raw, unsigned lo16b) {
#if EXP6B && EXP5B
    v4u r; const unsigned z = __builtin_amdgcn_alignbit(raw.z, raw.z, (lo16b >> 7) & 4u);
    r.x = (raw.x & 0x0F0F0F0Fu) | (z & 0x10101010u);
    r.y = (raw.x & 0xF0F0F0F0u) | (z & 0x08080808u);
    r.z = (raw.y & 0x0F0F0F0Fu) | ((z >> 1) & 0x10101010u);
    r.w = (raw.y & 0xF0F0F0F0u) | ((z << 1) & 0x08080808u);
    return r;
#elif EXP6B
    v4u r;
    r.x = (raw.x & 0x0F0F0F0Fu) | (raw.z & 0x30303030u);
    r.y = (raw.x & 0xF0F0F0F0u) | (raw.z & 0x0C0C0C0Cu);
    r.z = (raw.y & 0x0F0F0F0Fu) | ((raw.z >> 2) & 0x30303030u);
    r.w = (raw.y & 0xF0F0F0F0u) | ((raw.z << 2) & 0x0C0C0C0Cu);
    return r;
#else
    return raw;
#endif
}
__device__ __forceinline__ void vm_wait_n(int n) {
    switch (n) { case 15: vm_wait<15>(); break; case 14: vm_wait<14>(); break; case 13: vm_wait<13>(); break; case 12: vm_wait<12>(); break; case 11: vm_wait<11>(); break; case 10: vm_wait<10>(); break;
        case 9: vm_wait<9>(); break; case 8: vm_wait<8>(); break; case 7: vm_wait<7>(); break; case 6: vm_wait<6>(); break; case 5: vm_wait<5>(); break; case 4: vm_wait<4>(); break;
        case 3: vm_wait<3>(); break; case 2: vm_wait<2>(); break; case 1: vm_wait<1>(); break; case 0: vm_wait<0>(); break; default: break; }
}
__device__ __forceinline__ v4u row_step(LAS unsigned char* ring, v4u& raw, const NextB& nb, unsigned lo16b, int B, bool refill, int waitn) {
    __builtin_amdgcn_sched_barrier(0);
#if EXP6B
    asm volatile("s_waitcnt lgkmcnt(0)" : "+v"(raw.x), "+v"(raw.y), "+v"(raw.z) :: "memory");
#else
    asm volatile("s_waitcnt lgkmcnt(0)" : "+v"(raw.x), "+v"(raw.y), "+v"(raw.z), "+v"(raw.w) :: "memory");
#endif
    if (refill) dma_row(nb, B, lo16b, ring + B * 1024);
    const v4u cur = raw;
    if (waitn >= 0) { vm_wait_n(waitn); lds_raw(raw, ring + ((B + 1) & 15) * 1024, lo16b); __builtin_amdgcn_sched_barrier(0); }
    return decode_raw(cur, lo16b);
}
#endif
#if EXP6B && H_PLANES == 1
typedef int TreeT;
#else
typedef float TreeT;
#endif
template <int L, int B> __device__ __forceinline__ TreeT rs_tree(LAS unsigned char* ring, const HQ& hq, const NextB& nb, int lane, unsigned lo16b, v4u& raw) {
    if constexpr (L == 0) {
#if ROW_PIPE
        const v4u r = row_step(ring, raw, nb, lo16b, B, true, 15);
#else
        vm_wait<15>();
        const v4u r = ring_row(ring + B * 1024, lo16b);
#endif
#if EXP6B
        int e1 = __builtin_amdgcn_sdot4(hq.q1[0], (int)r.x, 0, false); e1 = __builtin_amdgcn_sdot4(hq.q1[2], (int)r.z, e1, false);
        int d1 = __builtin_amdgcn_sdot4(hq.q1[1], (int)r.y, hq.c1, false); d1 = __builtin_amdgcn_sdot4(hq.q1[3], (int)r.w, d1, false); d1 += e1 << (EXP5B ? 3 : 2);
#if H_PLANES == 2
        int e2 = __builtin_amdgcn_sdot4(hq.q2[0], (int)r.x, 0, false); e2 = __builtin_amdgcn_sdot4(hq.q2[2], (int)r.z, e2, false);
        int d2 = __builtin_amdgcn_sdot4(hq.q2[1], (int)r.y, hq.c2, false); d2 = __builtin_amdgcn_sdot4(hq.q2[3], (int)r.w, d2, false); d2 += e2 << 2;
#endif
#else
        int d1 = __builtin_amdgcn_sdot4(hq.q1[0], (int)r.x, 0, false); d1 = __builtin_amdgcn_sdot4(hq.q1[1], (int)r.y, d1, false); d1 = __builtin_amdgcn_sdot4(hq.q1[2], (int)r.z, d1, false); d1 = __builtin_amdgcn_sdot4(hq.q1[3], (int)r.w, d1, false);
        int d2 = __builtin_amdgcn_sdot4(hq.q2[0], (int)r.x, 0, false); d2 = __builtin_amdgcn_sdot4(hq.q2[1], (int)r.y, d2, false); d2 = __builtin_amdgcn_sdot4(hq.q2[2], (int)r.z, d2, false); d2 = __builtin_amdgcn_sdot4(hq.q2[3], (int)r.w, d2, false);
#endif
#if H_PLANES == 2
        const float p = (float)d1 * hq.s1 + (float)d2 * hq.s2;
#else
        const int p = d1;
#endif
#if !ROW_PIPE
        asm volatile("s_waitcnt lgkmcnt(0)" :: "v"(p) : "memory");
        dma_row(nb, B, lo16b, ring + B * 1024);
#endif
        return p;
    } else {
        constexpr int HS = 1 << (L - 1);
        const TreeT lo = rs_tree<L - 1, B>(ring, hq, nb, lane, lo16b, raw), hi = rs_tree<L - 1, B + HS>(ring, hq, nb, lane, lo16b, raw);
#if TREE_BANKMASK && EXP6B && H_PLANES == 1
        if constexpr (HS >= 4) {
            int t;
            if constexpr (HS == 4) { t = lo + __builtin_amdgcn_mov_dpp(lo, 0x104, 0xF, 0xF, true);
                asm volatile("s_nop 1\n\tv_add_u32_dpp %0, %1, %1 row_shr:4 row_mask:0xf bank_mask:0xa" : "+v"(t) : "v"(hi)); }
            else { t = lo + __builtin_amdgcn_mov_dpp(lo, 0x128, 0xF, 0xF, true);
                asm volatile("s_nop 1\n\tv_add_u32_dpp %0, %1, %1 row_ror:8 row_mask:0xf bank_mask:0xc" : "+v"(t) : "v"(hi)); }
            return t;
        }
#endif
        const bool up = lane & HS;
        return (up ? hi : lo) + lane_xchg<HS>(up ? lo : hi);
    }
}
__device__ __forceinline__ float consume_u(LAS unsigned char* ring, const HQ& hq, const NextB& nb, int lane, unsigned lo16b, v4u& raw) {
    TreeT d = rs_tree<4, 0>(ring, hq, nb, lane, lo16b, raw);
    d += lane_xchg<16>(d);
    d += lane_xchg<32>(d);
#if EXP6B && H_PLANES == 1
    return (float)d * hq.s1;
#else
    return d;
#endif
}
template <bool LASTB> __device__ __forceinline__ void consume_v(LAS unsigned char* ring, float (&o)[16], float wsel, int lb, const NextB& nb, unsigned lo16b) {
#pragma unroll
    for (int j = 0; j < 16; ++j) {
        if constexpr (LASTB) { switch (j) { case 0: vm_wait<15>(); break; case 1: vm_wait<14>(); break; case 2: vm_wait<13>(); break; case 3: vm_wait<12>(); break; case 4: vm_wait<11>(); break; case 5: vm_wait<10>(); break; case 6: vm_wait<9>(); break; case 7: vm_wait<8>(); break;
            case 8: vm_wait<7>(); break; case 9: vm_wait<6>(); break; case 10: vm_wait<5>(); break; case 11: vm_wait<4>(); break; case 12: vm_wait<3>(); break; case 13: vm_wait<2>(); break; case 14: vm_wait<1>(); break; default: vm_wait<0>(); break; } }
        else vm_wait<15>();
        const float we = rdlane(wsel, lb + j); const v4u r = *(const LAS v4u*)(ring + j * 1024 + lo16b);
        o[0] += we * UBF(r.x, 0); o[1] += we * UBF(r.x, 1); o[2] += we * UBF(r.x, 2); o[3] += we * UBF(r.x, 3); o[4] += we * UBF(r.y, 0); o[5] += we * UBF(r.y, 1); o[6] += we * UBF(r.y, 2); o[7] += we * UBF(r.y, 3);
        o[8] += we * UBF(r.z, 0); o[9] += we * UBF(r.z, 1); o[10] += we * UBF(r.z, 2); o[11] += we * UBF(r.z, 3); o[12] += we * UBF(r.w, 0); o[13] += we * UBF(r.w, 1); o[14] += we * UBF(r.w, 2); o[15] += we * UBF(r.w, 3);
        if constexpr (!LASTB) { asm volatile("s_waitcnt lgkmcnt(0)" :: "v"(o[0]), "v"(o[5]), "v"(o[10]), "v"(o[15]) : "memory"); dma_row(nb, j, lo16b, ring + j * 1024); }
    }
}
#if V_MFMA
typedef int v4i __attribute__((ext_vector_type(4)));
#if V_ABID
template <bool LASTB, int J> __device__ __forceinline__ void vm_row(LAS unsigned char* ring, v4i (&a1)[4], int aq, const NextB& nb, unsigned lo16b, v4u& raw) {
    const v4u r = row_step(ring, raw, nb, lo16b, J, !LASTB, LASTB ? 14 - J : 15);
    a1[0] = __builtin_amdgcn_mfma_i32_4x4x4i8(aq, (int)r.x, a1[0], 4, J, 0); a1[1] = __builtin_amdgcn_mfma_i32_4x4x4i8(aq, (int)r.y, a1[1], 4, J, 0);
    a1[2] = __builtin_amdgcn_mfma_i32_4x4x4i8(aq, (int)r.z, a1[2], 4, J, 0); a1[3] = __builtin_amdgcn_mfma_i32_4x4x4i8(aq, (int)r.w, a1[3], 4, J, 0);
}
template <bool LASTB> __device__ __forceinline__ void consume_vm(LAS unsigned char* ring, v4i (&a1)[4], v4i (&a2)[4], int cqsel, int lb, const NextB& nb, unsigned lo16b, unsigned sh8, v4u& raw) {
    static_assert(ROW_PIPE && V_PLANES == 1, "V_ABID: pipelined rows, one c plane");
    const int aq = (__shfl(cqsel, lb + (int)(lo16b >> 6)) & 255) << sh8;
    vm_row<LASTB, 0>(ring, a1, aq, nb, lo16b, raw); vm_row<LASTB, 1>(ring, a1, aq, nb, lo16b, raw); vm_row<LASTB, 2>(ring, a1, aq, nb, lo16b, raw); vm_row<LASTB, 3>(ring, a1, aq, nb, lo16b, raw);
    vm_row<LASTB, 4>(ring, a1, aq, nb, lo16b, raw); vm_row<LASTB, 5>(ring, a1, aq, nb, lo16b, raw); vm_row<LASTB, 6>(ring, a1, aq, nb, lo16b, raw); vm_row<LASTB, 7>(ring, a1, aq, nb, lo16b, raw);
    vm_row<LASTB, 8>(ring, a1, aq, nb, lo16b, raw); vm_row<LASTB, 9>(ring, a1, aq, nb, lo16b, raw); vm_row<LASTB, 10>(ring, a1, aq, nb, lo16b, raw); vm_row<LASTB, 11>(ring, a1, aq, nb, lo16b, raw);
    vm_row<LASTB, 12>(ring, a1, aq, nb, lo16b, raw); vm_row<LASTB, 13>(ring, a1, aq, nb, lo16b, raw); vm_row<LASTB, 14>(ring, a1, aq, nb, lo16b, raw); vm_row<LASTB, 15>(ring, a1, aq, nb, lo16b, raw);
    (void)a2;
}
#else
template <bool LASTB> __device__ __forceinline__ void consume_vm(LAS unsigned char* ring, v4i (&a1)[4], v4i (&a2)[4], int cqsel, int lb, const NextB& nb, unsigned lo16b, unsigned sh8, v4u& raw) {
#pragma unroll
    for (int j = 0; j < 16; ++j) {
#if ROW_PIPE
        const v4u r = row_step(ring, raw, nb, lo16b, j, !LASTB, LASTB ? 14 - j : 15); const int cs = rdlanei(cqsel, lb + j);
#else
        if constexpr (LASTB) { switch (j) { case 0: vm_wait<15>(); break; case 1: vm_wait<14>(); break; case 2: vm_wait<13>(); break; case 3: vm_wait<12>(); break; case 4: vm_wait<11>(); break; case 5: vm_wait<10>(); break; case 6: vm_wait<9>(); break; case 7: vm_wait<8>(); break;
            case 8: vm_wait<7>(); break; case 9: vm_wait<6>(); break; case 10: vm_wait<5>(); break; case 11: vm_wait<4>(); break; case 12: vm_wait<3>(); break; case 13: vm_wait<2>(); break; case 14: vm_wait<1>(); break; default: vm_wait<0>(); break; } }
        else vm_wait<15>();
        const int cs = rdlanei(cqsel, lb + j); const v4u r = ring_row(ring + j * 1024, lo16b);
#endif
        const int c1 = (cs & 255) << sh8, c2 = ((cs >> 8) & 255) << sh8;
#if V_PLANES == 2
        a1[0] = __builtin_amdgcn_mfma_i32_4x4x4i8(c1, (int)r.x, a1[0], 0, 0, 0); a2[0] = __builtin_amdgcn_mfma_i32_4x4x4i8(c2, (int)r.x, a2[0], 0, 0, 0);
        a1[1] = __builtin_amdgcn_mfma_i32_4x4x4i8(c1, (int)r.y, a1[1], 0, 0, 0); a2[1] = __builtin_amdgcn_mfma_i32_4x4x4i8(c2, (int)r.y, a2[1], 0, 0, 0);
        a1[2] = __builtin_amdgcn_mfma_i32_4x4x4i8(c1, (int)r.z, a1[2], 0, 0, 0); a2[2] = __builtin_amdgcn_mfma_i32_4x4x4i8(c2, (int)r.z, a2[2], 0, 0, 0);
        a1[3] = __builtin_amdgcn_mfma_i32_4x4x4i8(c1, (int)r.w, a1[3], 0, 0, 0); a2[3] = __builtin_amdgcn_mfma_i32_4x4x4i8(c2, (int)r.w, a2[3], 0, 0, 0);
#else
        a1[0] = __builtin_amdgcn_mfma_i32_4x4x4i8(c1, (int)r.x, a1[0], 0, 0, 0); a1[1] = __builtin_amdgcn_mfma_i32_4x4x4i8(c1, (int)r.y, a1[1], 0, 0, 0);
        a1[2] = __builtin_amdgcn_mfma_i32_4x4x4i8(c1, (int)r.z, a1[2], 0, 0, 0); a1[3] = __builtin_amdgcn_mfma_i32_4x4x4i8(c1, (int)r.w, a1[3], 0, 0, 0); (void)c2;
#endif
#if !ROW_PIPE
        if constexpr (!LASTB) { asm volatile("s_waitcnt lgkmcnt(0)" :: "v"(r.x), "v"(r.y), "v"(r.z), "v"(r.w) : "memory"); dma_row(nb, j, lo16b, ring + j * 1024); }
#endif
    }
}
#endif
#endif
template <bool HAVE_X1> __device__ __forceinline__ void expert_epilogue(const Ctx& F, KArgs A, int l, int t, const float (&o)[16], const float (&x1v)[16]) {
    const float* mod = (const float*)(A.ws + WS_MOD); bf16* Hn = (bf16*)(A.ws + WS_H);
    const int b = t >> 11; const float* mb = mod + ((size_t)l * 8 + b) * 6144;
    float x2[16]; float ss = 0.f;
#pragma unroll
    for (int hseg = 0; hseg < 2; ++hseg)
#pragma unroll
        for (int q4 = 0; q4 < 2; ++q4) { const int col = hseg * 512 + 8 * F.lane + 4 * q4;
            f32x4 xv; if constexpr (HAVE_X1) xv = (f32x4){x1v[hseg * 8 + q4 * 4], x1v[hseg * 8 + q4 * 4 + 1], x1v[hseg * 8 + q4 * 4 + 2], x1v[hseg * 8 + q4 * 4 + 3]}; else xv = *(const f32x4*)(A.out + (size_t)t * D + col);
            const f32x4 gv = *(const f32x4*)(mb + 5120 + col);
#pragma unroll
            for (int e = 0; e < 4; ++e) { const float v = xv[e] + gv[e] * o[hseg * 8 + q4 * 4 + e]; x2[hseg * 8 + q4 * 4 + e] = v; ss += v * v; } }
    const float r = 1.0f / sqrtf(wave_sum(ss) * (1.0f / D) + EPS);
    if (l + 1 < DEPTH) {
        const float* mn = mod + ((size_t)(l + 1) * 8 + b) * 6144; const float* gn = A.in[I_GN1] + (size_t)(l + 1) * D;
#pragma unroll
        for (int hseg = 0; hseg < 2; ++hseg) { const int col = hseg * 512 + 8 * F.lane;
            float hn[8];
#pragma unroll
            for (int q4 = 0; q4 < 2; ++q4) { const f32x4 gg = *(const f32x4*)(gn + col + 4 * q4), sc = *(const f32x4*)(mn + 1024 + col + 4 * q4), sh = *(const f32x4*)(mn + col + 4 * q4);
                f32x4 xo;
#pragma unroll
                for (int e = 0; e < 4; ++e) { xo[e] = x2[hseg * 8 + q4 * 4 + e]; hn[q4 * 4 + e] = xo[e] * r * gg[e] * (1.0f + sc[e]) + sh[e]; }
                *(f32x4*)(A.out + (size_t)t * D + col + 4 * q4) = xo; }
            v4u ov; ov.x = pk2(hn[0], hn[1]); ov.y = pk2(hn[2], hn[3]); ov.z = pk2(hn[4], hn[5]); ov.w = pk2(hn[6], hn[7]);
            *(v4u*)(Hn + (size_t)t * D + col) = ov; }
    } else {
        const float* gf = A.in[I_GFIN];
#pragma unroll
        for (int hseg = 0; hseg < 2; ++hseg)
#pragma unroll
            for (int q4 = 0; q4 < 2; ++q4) { const int col = hseg * 512 + 8 * F.lane + 4 * q4; const f32x4 gg = *(const f32x4*)(gf + col); f32x4 xo;
#pragma unroll
                for (int e = 0; e < 4; ++e) xo[e] = x2[hseg * 8 + q4 * 4 + e] * r * gg[e];
                *(f32x4*)(A.out + (size_t)t * D + col) = xo; }
    }
}
#if EPI_HOIST
struct EpiC { float g2[16], cn[16], shn[16]; };
__device__ __forceinline__ void epi_coeffs(EpiC& C, const Ctx& F, KArgs A, int l, int t0) {
    const float* mod = (const float*)(A.ws + WS_MOD); const int b = t0 >> 11; const float* mb = mod + ((size_t)l * 8 + b) * 6144;
#pragma unroll
    for (int i = 0; i < 4; ++i) { const int col = (i >> 1) * 512 + 8 * F.lane + 4 * (i & 1);
        const f32x4 gv = *(const f32x4*)(mb + 5120 + col);
        f32x4 gg, sc, sh;
        if (l + 1 < DEPTH) { const float* mn = mod + ((size_t)(l + 1) * 8 + b) * 6144; gg = *(const f32x4*)(A.in[I_GN1] + (size_t)(l + 1) * D + col); sc = *(const f32x4*)(mn + 1024 + col); sh = *(const f32x4*)(mn + col); }
        else { gg = *(const f32x4*)(A.in[I_GFIN] + col); sc = (f32x4){0.f, 0.f, 0.f, 0.f}; sh = sc; }
#pragma unroll
        for (int e = 0; e < 4; ++e) { C.g2[4 * i + e] = gv[e]; C.cn[4 * i + e] = gg[e] * (1.0f + sc[e]); C.shn[4 * i + e] = sh[e]; } }
}
__device__ __forceinline__ void expert_epilogue_c(const Ctx& F, KArgs A, int l, int t, const float (&o)[16], const float (&x1v)[16], const EpiC& C) {
    bf16* Hn = (bf16*)(A.ws + WS_H);
    float x2[16]; float ss = 0.f;
#pragma unroll
    for (int e = 0; e < 16; ++e) { const float v = x1v[e] + C.g2[e] * o[e]; x2[e] = v; ss += v * v; }
    const float r = 1.0f / sqrtf(wave_sum(ss) * (1.0f / D) + EPS);
    if (l + 1 < DEPTH) {
#pragma unroll
        for (int hseg = 0; hseg < 2; ++hseg) { const int col = hseg * 512 + 8 * F.lane;
            float hn[8];
#pragma unroll
            for (int q4 = 0; q4 < 2; ++q4) {
#pragma unroll
                for (int e = 0; e < 4; ++e) hn[q4 * 4 + e] = x2[hseg * 8 + q4 * 4 + e] * r * C.cn[hseg * 8 + q4 * 4 + e] + C.shn[hseg * 8 + q4 * 4 + e]; }
            { v4u xo; xo.x = pk2(x2[hseg * 8 + 0], x2[hseg * 8 + 1]); xo.y = pk2(x2[hseg * 8 + 2], x2[hseg * 8 + 3]); xo.z = pk2(x2[hseg * 8 + 4], x2[hseg * 8 + 5]); xo.w = pk2(x2[hseg * 8 + 6], x2[hseg * 8 + 7]);
              *(v4u*)((bf16*)A.out + (size_t)t * D + col) = xo; }
            v4u ov; ov.x = pk2(hn[0], hn[1]); ov.y = pk2(hn[2], hn[3]); ov.z = pk2(hn[4], hn[5]); ov.w = pk2(hn[6], hn[7]);
            *(v4u*)(Hn + (size_t)t * D + col) = ov; }
    } else {
#pragma unroll
        for (int hseg = 0; hseg < 2; ++hseg)
#pragma unroll
            for (int q4 = 0; q4 < 2; ++q4) { const int col = hseg * 512 + 8 * F.lane + 4 * q4; f32x4 xo;
#pragma unroll
                for (int e = 0; e < 4; ++e) xo[e] = x2[hseg * 8 + q4 * 4 + e] * r * C.cn[hseg * 8 + q4 * 4 + e];
                *(f32x4*)(A.out + (size_t)t * D + col) = xo; }
    }
}
#endif
__device__ __forceinline__ void experts_unit4(const Ctx& F, KArgs A, int l, int t0, LAS unsigned char* ring, const LAS unsigned short* il, const LAS float* wl) {
    const bf16* H = (const bf16*)(A.ws + WS_H); const unsigned char* UE = A.ws + WS_UE; const unsigned char* VE = A.ws + WS_VE;
    const float* US = (const float*)(A.ws + WS_US); const float* VS = (const float*)(A.ws + WS_VS);
    const unsigned lo16b = (unsigned)F.lane * 16u;
#if EPI_HOIST
    static_assert(NORM_FOLD, "EPI_HOIST: x1 comes from the token loop");
    EpiC EC; epi_coeffs(EC, F, A, l, t0);
#endif
#if H2C_HOIST
    float cg[16], csh[16];
    { const float* mb = (const float*)(A.ws + WS_MOD) + ((size_t)l * 8 + (t0 >> 11)) * 6144; const float* g2 = A.in[I_GN2] + (size_t)l * D;
#pragma unroll
      for (int i = 0; i < 4; ++i) { const int col = (i >> 1) * 512 + 8 * F.lane + 4 * (i & 1);
          const f32x4 gg = *(const f32x4*)(g2 + col), sc = *(const f32x4*)(mb + 4096 + col), sh = *(const f32x4*)(mb + 3072 + col);
#pragma unroll
          for (int e = 0; e < 4; ++e) { cg[4 * i + e] = gg[e] * (1.0f + sc[e]); csh[4 * i + e] = sh[e]; } } }
#endif
#if X1_PREFETCH
    f32x4 xn[4];
    auto ldx1 = [&](f32x4 (&xv)[4], int tok) {
        const bf16* xr = (const bf16*)(A.ws + WS_X1B) + (size_t)tok * D + 8 * F.lane; const v4u a = *(const v4u*)xr, b = *(const v4u*)(xr + 512);
        xv[0] = (f32x4){bflo(a.x), bfhi(a.x), bflo(a.y), bfhi(a.y)}; xv[1] = (f32x4){bflo(a.z), bfhi(a.z), bflo(a.w), bfhi(a.w)};
        xv[2] = (f32x4){bflo(b.x), bfhi(b.x), bflo(b.y), bfhi(b.y)}; xv[3] = (f32x4){bflo(b.z), bfhi(b.z), bflo(b.w), bfhi(b.w)}; };
    ldx1(xn, t0);
#endif
    int nidx0 = il[F.lane];
#if ROW_OFFS
    int nro0 = nidx0 * (int)EROW;
#else
#define nro0 nidx0
#define ro0 idx0
#define ro1 idx1
#endif
    { NextB nb{UE, nro0, 0};
#pragma unroll
      for (int j = 0; j < 16; ++j) dma_row(nb, j, lo16b, ring + j * 1024); }
    v4u raw = (v4u){0u, 0u, 0u, 0u};
#pragma unroll 1
    for (int k = 0; k < 4; ++k) {
        const int t = t0 + k; const int idx0 = nidx0, idx1 = il[k * 128 + 64 + F.lane]; const float wx0k = wl[k * 128 + F.lane], wx1k = wl[k * 128 + 64 + F.lane];
#if ROW_OFFS
        const int ro0 = nro0, ro1 = idx1 * (int)EROW;
#endif
        nidx0 = il[(k < 3 ? k + 1 : 3) * 128 + F.lane];
#if ROW_OFFS
        nro0 = nidx0 * (int)EROW;
#endif
        const float su0 = US[idx0], su1 = US[idx1], sv0 = VS[idx0], sv1 = VS[idx1];
        HQ hq; float x1v[16];
        { float hv[16];
#if NORM_FOLD
          {
              const float* xr = A.out + (size_t)t * D; const float* mb = (const float*)(A.ws + WS_MOD) + ((size_t)l * 8 + (t >> 11)) * 6144; const float* g2 = A.in[I_GN2] + (size_t)l * D;
              float ss = 0.f;
#pragma unroll
              for (int hseg = 0; hseg < 2; ++hseg)
#pragma unroll
                  for (int q4 = 0; q4 < 2; ++q4) {
#if X1_PREFETCH
                      const f32x4 xv = xn[hseg * 2 + q4];
#else
                      const f32x4 xv = *(const f32x4*)(xr + hseg * 512 + 8 * F.lane + 4 * q4);
#endif
#pragma unroll
                      for (int e = 0; e < 4; ++e) { hv[hseg * 8 + q4 * 4 + e] = xv[e]; x1v[hseg * 8 + q4 * 4 + e] = xv[e]; ss += xv[e] * xv[e]; } }
#if X1_PREFETCH
              ldx1(xn, t + (k < 3 ? 1 : 0));
#endif
              const float r = 1.0f / sqrtf(wave_sum(ss) * (1.0f / D) + EPS);
#pragma unroll
              for (int hseg = 0; hseg < 2; ++hseg)
#pragma unroll
#if H2C_HOIST
                  for (int q4 = 0; q4 < 2; ++q4) {
#pragma unroll
                      for (int e = 0; e < 4; ++e) hv[hseg * 8 + q4 * 4 + e] = hv[hseg * 8 + q4 * 4 + e] * r * cg[hseg * 8 + q4 * 4 + e] + csh[hseg * 8 + q4 * 4 + e]; }
#else
                  for (int q4 = 0; q4 < 2; ++q4) { const int col = hseg * 512 + 8 * F.lane + 4 * q4;
                      const f32x4 gg = *(const f32x4*)(g2 + col), sc = *(const f32x4*)(mb + 4096 + col), sh = *(const f32x4*)(mb + 3072 + col);
#pragma unroll
                      for (int e = 0; e < 4; ++e) hv[hseg * 8 + q4 * 4 + e] = hv[hseg * 8 + q4 * 4 + e] * r * gg[e] * (1.0f + sc[e]) + sh[e]; }
#endif
          }
#else
          const v4u ha = *(const v4u*)(H + (size_t)t * D + 8 * F.lane), hb = *(const v4u*)(H + (size_t)t * D + 512 + 8 * F.lane);
          hv[0] = bflo(ha.x); hv[1] = bfhi(ha.x); hv[2] = bflo(ha.y); hv[3] = bfhi(ha.y); hv[4] = bflo(ha.z); hv[5] = bfhi(ha.z); hv[6] = bflo(ha.w); hv[7] = bfhi(ha.w);
          hv[8] = bflo(hb.x); hv[9] = bfhi(hb.x); hv[10] = bflo(hb.y); hv[11] = bfhi(hb.y); hv[12] = bflo(hb.z); hv[13] = bfhi(hb.z); hv[14] = bflo(hb.w); hv[15] = bfhi(hb.w);
#endif
          float am = 0.f;
#pragma unroll
          for (int e = 0; e < 16; ++e) am = fmaxf(am, fabsf(hv[e]));
          am = wave_max(am);
          const float inv1 = am > 0.f ? 127.0f / am : 0.f; hq.s1 = am * (1.0f / 127.0f); hq.s2 = hq.s1 * (1.0f / 254.0f); const float inv2 = inv1 * 254.0f;
#pragma unroll
          for (int w = 0; w < 4; ++w) { unsigned p1 = 0, p2 = 0;
#pragma unroll
              for (int e = 0; e < 4; ++e) { const float h = hv[4 * w + e]; const float a = rintf(h * inv1); const float b = fminf(fmaxf(rintf((h - a * hq.s1) * inv2), -127.f), 127.f);
                  p1 |= ((unsigned)(int)a & 255u) << (8 * e); p2 |= ((unsigned)(int)b & 255u) << (8 * e); }
              hq.q1[w] = (int)p1; hq.q2[w] = (int)p2; }
#if EXP6B
          hq.c1 = -128 * __builtin_amdgcn_sdot4(hq.q1[0], 0x01010101, __builtin_amdgcn_sdot4(hq.q1[2], 0x01010101, 0, false), false);
          hq.c2 = -128 * __builtin_amdgcn_sdot4(hq.q2[0], 0x01010101, __builtin_amdgcn_sdot4(hq.q2[2], 0x01010101, 0, false), false);
          hq.s1 *= (EXP5B ? 0.125f : 0.25f); hq.s2 *= (EXP5B ? 0.125f : 0.25f);
#else
          hq.c1 = 0; hq.c2 = 0;
#endif
        }
#if ROW_PIPE
        if (k == 0) { vm_wait<15>(); lds_raw(raw, ring, lo16b); }
#endif
        float act0 = 0.f, act1 = 0.f;
#pragma unroll 1
        for (int q = 0; q < 8; ++q) {
            const int qn = (q + 1) & 7; NextB nb{q < 7 ? UE : VE, qn < 4 ? ro0 : ro1, 16 * (qn & 3)};
            const float tot = consume_u(ring, hq, nb, F.lane, lo16b, raw);
            if ((F.lane >> 4) == (q & 3)) { if (q < 4) act0 = tot; else act1 = tot; }
        }
        act0 *= su0; act1 *= su1;
        const float w0 = wx0k * sv0 * 0.5f * act0 * (1.0f + erff(act0 * 0.7071067811865476f)), w1 = wx1k * sv1 * 0.5f * act1 * (1.0f + erff(act1 * 0.7071067811865476f));
#if V_MFMA
        float o[16];
        { const float cam = wave_max(fmaxf(fabsf(w0), fabsf(w1)));
          const float ci1 = cam > 0.f ? 127.0f / cam : 0.f, S1 = cam * (1.0f / 127.0f), S2 = S1 * (1.0f / 254.0f), ci2 = ci1 * 254.0f;
          int cq0, cq1;
          { const float a = rintf(w0 * ci1), b = fminf(fmaxf(rintf((w0 - a * S1) * ci2), -127.f), 127.f); cq0 = ((int)a & 255) | (((int)b & 255) << 8); }
          { const float a = rintf(w1 * ci1), b = fminf(fmaxf(rintf((w1 - a * S1) * ci2), -127.f), 127.f); cq1 = ((int)a & 255) | (((int)b & 255) << 8); }
          const unsigned sh8 = 8u * ((unsigned)F.lane & 3u);
          v4i a1[4], a2[4];
#pragma unroll
          for (int e = 0; e < 4; ++e) { a1[e] = (v4i){0, 0, 0, 0}; a2[e] = (v4i){0, 0, 0, 0}; }
#pragma unroll 1
          for (int q = 0; q < 7; ++q) {
              const int qn = q + 1; NextB nb{VE, qn < 4 ? ro0 : ro1, 16 * (qn & 3)};
              consume_vm<false>(ring, a1, a2, q < 4 ? cq0 : cq1, 16 * (q & 3), nb, lo16b, sh8, raw);
          }
          if (k < 3) { NextB nb{UE, nro0, 0}; consume_vm<false>(ring, a1, a2, cq1, 48, nb, lo16b, sh8, raw); }
          else { NextB nb{UE, 0, 0}; consume_vm<true>(ring, a1, a2, cq1, 48, nb, lo16b, sh8, raw); }
#if EXP6B
          static_assert(V_PLANES == 1, "6-bit rows: one c plane");
          { const int csum = wave_sumi((int)(signed char)(cq0 & 255) + (int)(signed char)(cq1 & 255));
#pragma unroll
            for (int e = 0; e < 16; ++e) o[e] = ((e >> 2) & 1) ? ((EXP5B ? 0.125f : 0.25f) * S1) * (float)a1[e >> 2][e & 3] : S1 * (float)(a1[e >> 2][e & 3] - (EXP5B ? 16 : 32) * csum); }
#else
#pragma unroll
          for (int e = 0; e < 16; ++e) o[e] = S1 * (float)a1[e >> 2][e & 3] + S2 * (float)a2[e >> 2][e & 3];
#endif
        }
#else
        const float csum = wave_sum(w0 + w1);
        float o[16];
#pragma unroll
        for (int e = 0; e < 16; ++e) o[e] = 0.f;
#pragma unroll 1
        for (int q = 0; q < 7; ++q) {
            const int qn = q + 1; NextB nb{VE, qn < 4 ? idx0 : idx1, 16 * (qn & 3)};
            consume_v<false>(ring, o, q < 4 ? w0 : w1, 16 * (q & 3), nb, lo16b);
        }
        if (k < 3) { NextB nb{UE, nidx0, 0}; consume_v<false>(ring, o, w1, 48, nb, lo16b); }
        else { NextB nb{UE, 0, 0}; consume_v<true>(ring, o, w1, 48, nb, lo16b); }
#pragma unroll
        for (int e = 0; e < 16; ++e) o[e] -= 128.0f * csum;
#endif
#if EPI_HOIST
        expert_epilogue_c(F, A, l, t, o, x1v, EC);
#else
        expert_epilogue<(NORM_FOLD) != 0>(F, A, l, t, o, x1v);
#endif
    }
}
#undef UBF
__device__ __forceinline__ void phase_experts(const Ctx& F, KArgs A, int l) {
    const int* IDX = (const int*)(A.ws + WS_IDX); const float* WTS = (const float*)(A.ws + WS_WTS);
    for (int t = F.gw; t < T; t += F.NGW)
        expert_token(F, A, l, t, IDX[(size_t)t * 128 + F.lane], IDX[(size_t)t * 128 + 64 + F.lane], WTS[(size_t)t * 128 + F.lane], WTS[(size_t)t * 128 + 64 + F.lane]);
}
__device__ __forceinline__ void phase_peer(const Ctx& F, KArgs A, int l) {
    LAS unsigned char* scr = F.lds + RING_OFF + F.wave * 16384;
    LAS unsigned short* il = (LAS unsigned short*)(F.lds + HAND_OFF + F.wave * 3072); LAS float* wl = (LAS float*)(F.lds + HAND_OFF + F.wave * 3072 + 1024);
#ifndef PROBE_PEER_CUS
#define PROBE_PEER_CUS 256
#endif
    if (F.vcu >= PROBE_PEER_CUS) return;
#if PEER_DYNAMIC
    unsigned* ctr = (unsigned*)(A.ws + WS_CTL) + CW_PEERQ + 64 * l;
    for (int u = F.gw; u < T / 4; ) {
#else
    for (int u = F.gw; u < T / 4; u += PROBE_PEER_CUS * NWAVES) {
#endif
        Ctx G = F; asm volatile("" : "+v"(G.lane));
        route_unit(G, A, l, u, scr, il, wl, 4 * u);
        LDS_WAIT();
#if EXP_I8 && !DBG_ROUTE32
        asm volatile("" : "+v"(G.lane));
        __builtin_amdgcn_s_setprio(2);
        experts_unit4(G, A, l, 4 * u, scr, il, wl);
        __builtin_amdgcn_s_setprio(0);
#if PEER_DYNAMIC
        { unsigned nu = 0; if (F.lane == 0) nu = __hip_atomic_fetch_add(ctr, 1u, __ATOMIC_RELAXED, __HIP_MEMORY_SCOPE_AGENT); u = (int)__builtin_amdgcn_readfirstlane(nu) + F.NGW; }
#endif
#else
#pragma unroll 1
        for (int k = 0; k < 4; ++k) expert_token(F, A, l, 4 * u + k, il[k * 128 + F.lane], il[k * 128 + 64 + F.lane], wl[k * 128 + F.lane], wl[k * 128 + 64 + F.lane]);
#endif
        LDS_WAIT();
    }
}
__device__ __forceinline__ bool ph_in_range(int k) {
    const __attribute__((address_space(4))) Args* ap_ = (const __attribute__((address_space(4))) Args*)__builtin_amdgcn_kernarg_segment_ptr(); asm volatile("" : "+s"(ap_));
    return ap_->ph_lo <= k && k < ap_->ph_hi;
}
#ifndef FUSE_PEER
#define FUSE_PEER (!DBG_ROUTE32)
#endif
constexpr int PPL = (FUSE_PEER ? 8 : 9) - ((NORM_FOLD) ? 1 : 0);
constexpr int N_PHASES = 2 + PPL * DEPTH;
#ifndef ONLY_MASK
#define ONLY_MASK 0xffffffffu
#endif
#ifndef REP_MASK
#define REP_MASK 0u
#endif
#define ONLY(k, stmt) do { if constexpr ((ONLY_MASK >> (k)) & 1u) { for (int rep_ = 0; rep_ < (((REP_MASK >> (k)) & 1u) ? 2 : 1); ++rep_) { stmt; } } } while (0)
__global__ void __launch_bounds__(NWAVES * 64, 2) mega_fwd(Args args) {
    extern __shared__ __attribute__((aligned(16))) unsigned char lds[];
#define MKARGS() const __attribute__((address_space(4))) Args* ap_ = (const __attribute__((address_space(4))) Args*)__builtin_amdgcn_kernarg_segment_ptr(); asm volatile("" : "+s"(ap_)); KArgs A = *ap_
#define MKCTX() MKARGS(); Ctx F; { int tid_ = threadIdx.x; asm volatile("" : "+v"(tid_)); int bx_ = blockIdx.x; asm volatile("" : "+s"(bx_)); \
        F.lds = (LAS unsigned char*)lds; F.tid = tid_; F.lane = tid_ & 63; F.wave = __builtin_amdgcn_readfirstlane(tid_ >> 6); F.G = gridDim.x; \
        F.vcu = (F.G % 8 == 0) ? (bx_ % 8) * (F.G / 8) + bx_ / 8 : bx_; F.gw = F.vcu * NWAVES + F.wave; F.NGW = F.G * NWAVES; }
    for (int u = threadIdx.x; u < (LDS_BYTES - LDSCTL_OFF) / 4; u += NWAVES * 64) ((LAS unsigned*)((LAS unsigned char*)lds + LDSCTL_OFF))[u] = 0u;
    __syncthreads();
    { MKARGS();
      if (A.ph_hi - A.ph_lo > 1) (void)xcd_barrier_post((unsigned*)(A.ws + WS_CTL) + CW_BAR, (volatile LAS unsigned*)((LAS unsigned char*)lds + MISC_OFF) + 8); }

#define IN(k) ph_in_range(k)
#define SEAM(k) do { if (IN(k) && IN((k) + 1)) { MKARGS(); XcdBarrier b_; b_.bar = (unsigned*)(A.ws + WS_CTL) + CW_BAR; b_.x = xb_xcc_id(); b_.st = (volatile LAS unsigned*)((LAS unsigned char*)lds + MISC_OFF) + 8; xcd_barrier(b_); } } while (0)
    if (IN(0)) { MKCTX(); ONLY(0, phase_pre(F, A)); } SEAM(0);
    if (IN(1)) { MKCTX(); ONLY(1, phase_h0(F, A)); } SEAM(1);
#if DBG_ROUTE32
#define QGEMM(l) do { pg8::Gemm g{(const bf16*)(A.ws + WS_H3), (const bf16*)(A.ws + WS_WQ3), 3072, 3072, 3072, 0, 0}; pg8::StaticOrder S; S.init(T, 2048, F.G, (int)blockIdx.x); \
        pg8::EpiF32 E{(float*)(A.ws + WS_Q32), 2048}; pg8::gemm_phase<pg8::EpiF32, pg8::StaticOrder, true, true>(F.lds + RING_OFF, g, S, E); } while (0)
#define ROUTE_EXTRA(l) phase_expert_convert(F, A, (l))
#define ROUTE(l) phase_route_naive(F, A, (l))
#else
#define QGEMM(l) do { unsigned char* wl = A.ws + WS_W + (size_t)(l) * W_LAYER; \
        pg8::Gemm g{(const bf16*)(A.ws + WS_H), (const bf16*)(wl + W_WQ), D, D, D, 0, 0}; pg8::StaticOrder S; S.init(T, 2048, F.G, (int)blockIdx.x); \
        QEPI(l); } while (0)
#define ROUTE_EXTRA(l) do {} while (0)
#if NORM_FOLD
#define WOEPI(l) pg8::EpiWoN<((l) != 0)> E{A.in[I_X], (const bf16*)A.out, (bf16*)(A.ws + WS_X1B), (const float*)(A.ws + WS_MOD) + (size_t)(l) * 8 * 6144, A.in[I_GN2] + (size_t)(l) * D, (bf16*)(A.ws + WS_H), (float*)(A.ws + WS_SSQ)}; \
        ONLY(9, (pg8::gemm_phase<pg8::EpiWoN<((l) != 0)>, pg8::StaticOrder, true, true>(F.lds + RING_OFF, g, S, E)))
#else
#define WOEPI(l) pg8::EpiWo E{(l) == 0 ? A.in[I_X] : A.out, A.out, (const float*)(A.ws + WS_MOD) + (size_t)(l) * 8 * 6144 + 2048}; \
        ONLY(9, (pg8::gemm_phase<pg8::EpiWo, pg8::StaticOrder, true, true>(F.lds + RING_OFF, g, S, E)))
#endif
#if NORM_FOLD
#define QEPI(l) pg8::EpiQN E{(bf16*)(A.ws + WS_Q2), (const float*)(A.ws + WS_SSQ), (const float*)(A.ws + WS_CQ) + (size_t)(l) * 8 * 2048, EPS}; \
        pg8::gemm_phase<pg8::EpiQN, pg8::StaticOrder, true, true>(F.lds + RING_OFF, g, S, E)
#else
#define QEPI(l) pg8::EpiBf16 E{(bf16*)(A.ws + WS_Q2), 2048}; \
        pg8::gemm_phase<pg8::EpiBf16, pg8::StaticOrder, true, true>(F.lds + RING_OFF, g, S, E)
#endif
#define ROUTE(l) phase_route(F, A, (l))
#endif
#ifndef NAIVE_MIX
#define NAIVE_MIX 0
#endif
#if NAIVE_MIX & 1
#define MIX_SWA(l) phase_swa_naive(F, A, (l))
#else
#define MIX_SWA(l) phase_swa2(F, A, (l))
#endif
#if NAIVE_MIX & 2
#define MIX_POOL(l) phase_pool_naive(F, A, (l))
#else
#define MIX_POOL(l) phase_pool(F, A, (l))
#endif
#define LAYER(l) do { \
    constexpr int P0_ = 2 + PPL * (l); \
    if (IN(P0_ + 0)) { MKCTX(); unsigned char* wl = A.ws + WS_W + (size_t)(l) * W_LAYER; \
        pg8::Gemm g{(const bf16*)(A.ws + WS_H), (const bf16*)(wl + W_WIN), D, D, D, 0, 0}; pg8::StaticOrder S; S.init(T, NIN, F.G, (int)blockIdx.x); \
        pg8::EpiProj E{(bf16*)(A.ws + WS_PROJ), (bf16*)(A.ws + WS_GATES)}; \
        ONLY(2, (pg8::gemm_phase<pg8::EpiProj, pg8::StaticOrder, true, true>(F.lds + RING_OFF, g, S, E))); \
        if (EXP_I8_OWN && (int)blockIdx.x >= 64) expert_quant(A, (l), F.lane, ((int)blockIdx.x - 64) * NWAVES + F.wave, (F.G - 64) * NWAVES);     \
        } \
    SEAM(P0_ + 0); \
    if (IN(P0_ + 1)) { \
          \
          \
        int grp_; { int bx_ = blockIdx.x; asm volatile("" : "+s"(bx_)); const int G_ = (int)gridDim.x; const int vcu_ = (G_ % 8 == 0) ? (bx_ % 8) * (G_ / 8) + bx_ / 8 : bx_; grp_ = (MIX_STAGGER == 4) ? ((vcu_ >> 1) & 3) : (MIX_STAGGER ? 4 * ((vcu_ >> 1) & 1) : 0); } \
          \
        const int a0_ = (MIX_STAGGER == 4) ? grp_ : 4 - grp_; \
        _Pragma("unroll 1") for (int pass_ = 0; pass_ < 3; ++pass_) { \
        if (pass_ != 1) { const int lo_ = pass_ == 0 ? 0 : a0_, hi_ = pass_ == 0 ? a0_ : 4; \
        if (lo_ < hi_) { MKARGS(); \
        const attn_body::AttnTensors AT{(const attn_body::bf16*)(A.ws + WS_PROJ), (const attn_body::bf16*)(A.ws + WS_PROJ), (const attn_body::bf16*)(A.ws + WS_PROJ), (attn_body::bf16*)(A.ws + WS_O)}; \
        const attn_body::RangeOrder S((int)gridDim.x, (int)blockIdx.x, lo_, hi_); \
        ONLY(3, attn_body::attn_phase<attn_body::RangeOrder>((char*)lds + RING_OFF, AT, S)); } } \
        else { MKCTX(); ONLY(4, MIX_SWA(l)); ONLY(5, phase_conv_naive(F, A, (l))); ONLY(6, MIX_POOL(l)); } \
        __syncthreads(); } } \
    SEAM(P0_ + 1); \
    if (IN(P0_ + 2)) { MKCTX(); ONLY(7, phase_ya(F, A, (l))); } \
    SEAM(P0_ + 2); \
    if (IN(P0_ + 3)) { MKCTX(); unsigned char* wl = A.ws + WS_W + (size_t)(l) * W_LAYER; \
        pg8::Gemm g{(const bf16*)(A.ws + WS_Y), (const bf16*)(wl + W_WBR), 2048, 512, 512, (size_t)512 * 2, (size_t)D * 512 * 2}; pg8::ZOrder<4> S; S.init(T, D, F.G, (int)blockIdx.x); \
        pg8::EpiMergeK E{(const bf16*)(A.ws + WS_GATES), (bf16*)(A.ws + WS_O)}; \
        ONLY(8, (pg8::gemm_phase<pg8::EpiMergeK, pg8::ZOrder<4>, true, true>(F.lds + RING_OFF, g, S, E))); } \
    SEAM(P0_ + 3); \
    if (IN(P0_ + 4)) { MKCTX(); unsigned char* wl = A.ws + WS_W + (size_t)(l) * W_LAYER; \
        pg8::Gemm g{(const bf16*)(A.ws + WS_O), (const bf16*)(wl + W_WO), D, D, D, 0, 0}; pg8::StaticOrder S; S.init(T, D, F.G, (int)blockIdx.x); \
        WOEPI(l); } \
    SEAM(P0_ + 4); \
    if constexpr (!(NORM_FOLD)) { \
        if (IN(P0_ + 5)) { MKCTX(); ONLY(10, phase_h2(F, A, (l))); } \
        SEAM(P0_ + 5); \
    } \
    constexpr int PQ_ = P0_ + ((NORM_FOLD) ? 5 : 6); \
    if (IN(PQ_)) { MKCTX(); ONLY(11, QGEMM(l)); } \
    SEAM(PQ_); \
    if constexpr (FUSE_PEER) { \
        if (IN(PQ_ + 1)) { MKCTX(); ONLY(13, phase_peer(F, A, (l))); } \
        SEAM(PQ_ + 1); \
    } else { \
        if (IN(PQ_ + 1)) { MKCTX(); ONLY(12, ROUTE(l)); ROUTE_EXTRA(l); } \
        SEAM(PQ_ + 1); \
        if (IN(PQ_ + 2)) { MKCTX(); ONLY(13, phase_experts(F, A, (l))); } \
        SEAM(PQ_ + 2); \
    } \
} while (0)
    LAYER(0);
    LAYER(1);
#undef LAYER
#undef IN
#undef SEAM
}

#ifndef MK_SINGLE
#define MK_SINGLE 1
#endif
extern "C" void kernel_launch(void* const* d_in, const int* in_sizes, int n_in, void* d_out, int out_size, void* d_ws, size_t ws_size, hipStream_t stream) {
    static int grid = 0;
    if (grid == 0) {
        if (n_in != N_IN || in_sizes[0] != T * D || out_size != T * D || ws_size < WS_END) { fprintf(stderr, "kernel_launch: unexpected shapes: n_in %d in0 %d out %d ws %zu\n", n_in, n_in > 0 ? in_sizes[0] : -1, out_size, ws_size); grid = -1; return; }
        int dev = 0, cus = 0;
        if (hipGetDevice(&dev) != hipSuccess || hipDeviceGetAttribute(&cus, hipDeviceAttributeMultiprocessorCount, dev) != hipSuccess) { grid = -1; return; }
        if (hipFuncSetAttribute((const void*)mega_fwd, hipFuncAttributeMaxDynamicSharedMemorySize, LDS_BYTES) != hipSuccess) { fprintf(stderr, "kernel_launch: hipFuncSetAttribute failed\n"); grid = -1; return; }
        (void)hipGetLastError();
        grid = cus;
        if (grid != 256) fprintf(stderr, "kernel_launch: %d CUs; this kernel is built for 256\n", grid);
    }
    if (grid < 0) return;
    if (hipMemsetAsync((char*)d_ws + WS_CTL, 0, CTL_ZERO_BYTES, stream) != hipSuccess) return;
    Args a{};
    for (int i = 0; i < N_IN; ++i) a.in[i] = (const float*)d_in[i];
    a.out = (float*)d_out; a.ws = (unsigned char*)d_ws;
#if MK_SINGLE
    a.ph_lo = 0; a.ph_hi = N_PHASES;
    hipLaunchKernelGGL(mega_fwd, dim3(grid), dim3(NWAVES * 64), LDS_BYTES, stream, a);
#else
    for (int ph = 0; ph < N_PHASES; ++ph) { a.ph_lo = ph; a.ph_hi = ph + 1; hipLaunchKernelGGL(mega_fwd, dim3(grid), dim3(NWAVES * 64), LDS_BYTES, stream, a); }
#endif
}
```
